# Optimizing an MI355X kernel written in HIP

```python
import jax
import jax.numpy as jnp
from jax import lax
import numpy as np

D_MODEL = 1024
BATCH = 8
SEQ = 2048
DEPTH = 2
DEC_BATCH = 128
DEC_SEQ = 1
PAST_LEN = 16384
PAGE_SIZE = 128

PLE_DIM = 256
D_FF = 4 * D_MODEL
N_BRANCH = 3
EPS = 1e-6
CHUNK = 64

S5_WIDTH = D_MODEL // 2
S5_GROUP = 16
S5_GROUPS = S5_WIDTH // S5_GROUP
S5_STATE = 64

GDN_HEADS = 4
GDN_DK = 128
GDN_DV = 128
GDN_CONV_W = 4
GDN_QK_W = GDN_HEADS * GDN_DK
GDN_V_W = GDN_HEADS * GDN_DV
GDN_CONV_CH = 2 * GDN_QK_W + GDN_V_W

ML_HEADS = 4
ML_DK = 64
ML_DV = 128
ML_QK_W = ML_HEADS * ML_DK
ML_V_W = ML_HEADS * ML_DV
GATE_CAP = 15.0

IN_SPLITS = (S5_WIDTH, GDN_CONV_CH, GDN_V_W, GDN_HEADS, GDN_HEADS,
             ML_QK_W, ML_QK_W, ML_V_W, ML_V_W, ML_HEADS, ML_HEADS, N_BRANCH * D_MODEL)
D_IN = sum(IN_SPLITS)
IN_OFFSETS = tuple(int(o) for o in np.cumsum(IN_SPLITS)[:-1])

kernel_name = 'hybrid_s5_gdn_mlstm_step'


def rmsnorm(x, g):
    xf = x.astype(jnp.float32)
    y = xf * lax.rsqrt(jnp.mean(xf * xf, axis=-1, keepdims=True) + EPS)
    return (y * g.astype(jnp.float32)).astype(x.dtype)


def head_rmsnorm(x, g):
    return x * lax.rsqrt(jnp.mean(x * x, axis=-1, keepdims=True) + EPS) * g


def l2norm(x):
    return x * lax.rsqrt(jnp.sum(x * x, axis=-1, keepdims=True) + EPS)


def softcap(x, cap):
    return cap * jnp.tanh(x / cap)


def chunk_len(L):
    return CHUNK if L % CHUNK == 0 else L


def s5_mixer(u, h0_re, h0_im, A_re, A_im, log_dt, B_re, B_im, C_re, C_im, d_skip, w_glu, b_glu):
    f = jnp.float32
    bsz, L, _ = u.shape
    uf = u.astype(f).reshape(bsz, L, S5_GROUPS, S5_GROUP)
    a_re, a_im = A_re.astype(f), A_im.astype(f)
    dt = jnp.exp(log_dt.astype(f))[:, None]
    mag = jnp.exp(a_re * dt)
    lam_re, lam_im = mag * jnp.cos(a_im * dt), mag * jnp.sin(a_im * dt)
    inv = 1.0 / (a_re * a_re + a_im * a_im)
    zr, zi = lam_re - 1.0, lam_im
    fac_re = (zr * a_re + zi * a_im) * inv
    fac_im = (zi * a_re - zr * a_im) * inv
    b_re, b_im = B_re.astype(f), B_im.astype(f)
    bb_re = fac_re[..., None] * b_re - fac_im[..., None] * b_im
    bb_im = fac_re[..., None] * b_im + fac_im[..., None] * b_re
    bu_re = jnp.einsum('blgc,gpc->blgp', uf, bb_re)
    bu_im = jnp.einsum('blgc,gpc->blgp', uf, bb_im)
    shp = (1, L, S5_GROUPS, S5_STATE)
    el_re = jnp.broadcast_to(lam_re, shp)
    el_im = jnp.broadcast_to(lam_im, shp)

    def combine(e1, e2):
        a1r, a1i, b1r, b1i = e1
        a2r, a2i, b2r, b2i = e2
        return (a2r * a1r - a2i * a1i, a2r * a1i + a2i * a1r,
                a2r * b1r - a2i * b1i + b2r, a2r * b1i + a2i * b1r + b2i)

    pr, pim, hr, hi = lax.associative_scan(combine, (el_re, el_im, bu_re, bu_im), axis=1)
    g0r = h0_re.astype(f)[:, None]
    g0i = h0_im.astype(f)[:, None]
    h_re = hr + pr * g0r - pim * g0i
    h_im = hi + pr * g0i + pim * g0r
    y = (jnp.einsum('blgp,gcp->blgc', h_re, C_re.astype(f))
         - jnp.einsum('blgp,gcp->blgc', h_im, C_im.astype(f))
         + d_skip.astype(f).reshape(S5_GROUPS, S5_GROUP) * uf)
    y = jax.nn.gelu(y.reshape(bsz, L, S5_WIDTH))
    y = y * jax.nn.sigmoid(y @ w_glu.astype(f) + b_glu.astype(f))
    dtype = u.dtype
    return y.astype(dtype), h_re[:, -1].astype(dtype), h_im[:, -1].astype(dtype)


def causal_conv(x, buf, w):
    L = x.shape[1]
    xx = jnp.concatenate([buf, x], axis=1)
    out = xx[:, 0:L] * w[0]
    for j in range(1, GDN_CONV_W):
        out = out + xx[:, j:j + L] * w[j]
    return out, xx[:, L:]


def gdn_mixer(qkv, z, b_pre, a_pre, conv_buf, S0, conv_w, A_log, dt_bias, norm_g):
    f = jnp.float32
    bsz, L, _ = qkv.shape
    conv, new_buf = causal_conv(qkv.astype(f), conv_buf.astype(f), conv_w.astype(f))
    conv = jax.nn.silu(conv)
    q, k, v = jnp.split(conv, (GDN_QK_W, 2 * GDN_QK_W), axis=-1)
    q = l2norm(q.reshape(bsz, L, GDN_HEADS, GDN_DK)) * (GDN_DK ** -0.5)
    k = l2norm(k.reshape(bsz, L, GDN_HEADS, GDN_DK))
    v = v.reshape(bsz, L, GDN_HEADS, GDN_DV)
    beta = jax.nn.sigmoid(b_pre.astype(f))
    g = -jnp.exp(A_log.astype(f)) * jax.nn.softplus(a_pre.astype(f) + dt_bias.astype(f))
    c = chunk_len(L)
    n_chunks = L // c

    def to_chunks(t):
        t = t.reshape((bsz, n_chunks, c) + t.shape[2:])
        return jnp.moveaxis(jnp.moveaxis(t, 3, 2), 1, 0)

    qc, kc, vc, gc, bc = (to_chunks(t) for t in (q, k, v, g, beta))
    gcum = jnp.cumsum(gc, axis=-1)
    idx = jnp.arange(c)
    incl = idx[:, None] >= idx[None, :]
    strict = idx[:, None] > idx[None, :]
    decay = jnp.exp(jnp.where(incl, gcum[..., :, None] - gcum[..., None, :], -jnp.inf))
    kb = kc * bc[..., None]
    a_low = jnp.where(strict, jnp.einsum('nbhtd,nbhsd->nbhts', kb, kc) * decay, 0.0)
    rhs = jnp.concatenate([vc * bc[..., None], kb * jnp.exp(gcum)[..., None]], axis=-1)
    sol = lax.linalg.triangular_solve(a_low + jnp.eye(c, dtype=f), rhs, left_side=True,
                                      lower=True, unit_diagonal=True)
    u, w = sol[..., :GDN_DV], sol[..., GDN_DV:]
    attn = jnp.where(incl, jnp.einsum('nbhtd,nbhsd->nbhts', qc, kc) * decay, 0.0)
    q_dec = qc * jnp.exp(gcum)[..., None]
    k_dec = kc * jnp.exp(gcum[..., -1:] - gcum)[..., None]
    g_last = jnp.exp(gcum[..., -1])

    def step(S, xs):
        u_i, w_i, attn_i, q_i, k_i, gl_i = xs
        v_new = u_i - jnp.einsum('bhtd,bhde->bhte', w_i, S)
        o_i = jnp.einsum('bhtd,bhde->bhte', q_i, S) + jnp.einsum('bhts,bhse->bhte', attn_i, v_new)
        S = S * gl_i[..., None, None] + jnp.einsum('bhtd,bhte->bhde', k_i, v_new)
        return S, o_i

    S_fin, o = lax.scan(step, S0.astype(f), (u, w, attn, q_dec, k_dec, g_last))
    o = jnp.moveaxis(jnp.moveaxis(o, 0, 1), 2, 3).reshape(bsz, L, GDN_HEADS, GDN_DV)
    o = head_rmsnorm(o, norm_g.astype(f)) * jax.nn.silu(z.astype(f).reshape(bsz, L, GDN_HEADS, GDN_DV))
    dtype = qkv.dtype
    return o.reshape(bsz, L, GDN_V_W).astype(dtype), new_buf.astype(dtype), S_fin.astype(dtype)


def mlstm_mixer(q, k, v, o_pre, i_pre, f_pre, C0, n0, m0, b_i, b_f, norm_g):
    f = jnp.float32
    bsz, L, _ = q.shape
    q = q.astype(f).reshape(bsz, L, ML_HEADS, ML_DK)
    k = k.astype(f).reshape(bsz, L, ML_HEADS, ML_DK) * (ML_DK ** -0.5)
    v = v.astype(f).reshape(bsz, L, ML_HEADS, ML_DV)
    li = softcap(i_pre.astype(f) + b_i.astype(f), GATE_CAP)
    lf = jax.nn.log_sigmoid(softcap(f_pre.astype(f) + b_f.astype(f), GATE_CAP))
    c = chunk_len(L)
    n_chunks = L // c

    def to_chunks(t):
        return jnp.moveaxis(t.reshape((bsz, n_chunks, c) + t.shape[2:]), 1, 0)

    qc, kc, vc, lic = (to_chunks(t) for t in (q, k, v, li))
    bcum = jnp.cumsum(to_chunks(lf), axis=2)
    idx = jnp.arange(c)
    incl = (idx[:, None] >= idx[None, :])[None, :, :, None]

    def step(carry, xs):
        C, n, m = carry
        q_i, k_i, v_i, li_i, bc_i = xs
        logw = jnp.where(incl, bc_i[:, :, None, :] - bc_i[:, None, :, :] + li_i[:, None, :, :], -jnp.inf)
        inter = bc_i + m[:, None, :]
        m_t = jnp.maximum(inter, jnp.max(logw, axis=2))
        wts = jnp.exp(logw - m_t[:, :, None, :])
        sc = jnp.exp(inter - m_t)
        s_qk = jnp.einsum('bthd,bshd->btsh', q_i, k_i) * wts
        num = jnp.einsum('btsh,bshe->bthe', s_qk, v_i) + sc[..., None] * jnp.einsum('bthd,bhde->bthe', q_i, C)
        den = jnp.sum(s_qk, axis=2) + sc * jnp.einsum('bthd,bhd->bth', q_i, n)
        h = num / jnp.maximum(jnp.abs(den), jnp.exp(-m_t))[..., None]
        w_last = wts[:, -1]
        sc_last = sc[:, -1]
        C = sc_last[..., None, None] * C + jnp.einsum('bsh,bshd,bshe->bhde', w_last, k_i, v_i)
        n = sc_last[..., None] * n + jnp.einsum('bsh,bshd->bhd', w_last, k_i)
        return (C, n, m_t[:, -1]), h

    (C_fin, n_fin, m_fin), h = lax.scan(step, (C0.astype(f), n0.astype(f), m0.astype(f)),
                                        (qc, kc, vc, lic, bcum))
    h = jnp.moveaxis(h, 0, 1).reshape(bsz, L, ML_HEADS, ML_DV)
    h = head_rmsnorm(h, norm_g.astype(f).reshape(ML_HEADS, ML_DV))
    h = h * jax.nn.sigmoid(o_pre.astype(f).reshape(bsz, L, ML_HEADS, ML_DV))
    dtype = o_pre.dtype
    return (h.reshape(bsz, L, ML_V_W).astype(dtype), C_fin.astype(dtype),
            n_fin.astype(dtype), m_fin.astype(dtype))


def block(x, p, s5_h_re, s5_h_im, conv_buf, gdn_S, ml_C, ml_n, ml_m,
          norm1_g, w_in, s5_A_re, s5_A_im, s5_log_dt, s5_B_re, s5_B_im, s5_C_re, s5_C_im,
          s5_D, s5_w_glu, s5_b_glu, gdn_conv_w, gdn_A_log, gdn_dt_bias, gdn_norm_g,
          ml_b_i, ml_b_f, ml_norm_g, w_br_s5, w_br_gdn, w_br_ml, w_out, norm2_g,
          w_up, w_down, w_ple, w_ple_gate):
    bsz, L, _ = x.shape
    xn = rmsnorm(x, norm1_g)
    (u, qkv, z, b_pre, a_pre, mq, mk, mv, mo, mi, mf, gate_pre) = jnp.split(xn @ w_in, IN_OFFSETS, axis=-1)
    y_s5, s5_h_re, s5_h_im = s5_mixer(u, s5_h_re, s5_h_im, s5_A_re, s5_A_im, s5_log_dt, s5_B_re, s5_B_im,
                                      s5_C_re, s5_C_im, s5_D, s5_w_glu, s5_b_glu)
    y_gdn, conv_buf, gdn_S = gdn_mixer(qkv, z, b_pre, a_pre, conv_buf, gdn_S, gdn_conv_w,
                                       gdn_A_log, gdn_dt_bias, gdn_norm_g)
    y_ml, ml_C, ml_n, ml_m = mlstm_mixer(mq, mk, mv, mo, mi, mf, ml_C, ml_n, ml_m, ml_b_i, ml_b_f, ml_norm_g)
    gates = jax.nn.sigmoid(gate_pre.astype(jnp.float32)).reshape(bsz, L, N_BRANCH, D_MODEL)
    merged = (gates[:, :, 0] * (y_s5 @ w_br_s5) + gates[:, :, 1] * (y_gdn @ w_br_gdn)
              + gates[:, :, 2] * (y_ml @ w_br_ml))
    x = x + (merged.astype(x.dtype) @ w_out).astype(x.dtype)
    hdn = jax.nn.relu(rmsnorm(x, norm2_g) @ w_up)
    x = x + ((hdn * hdn) @ w_down).astype(x.dtype)
    x = x + ((p @ w_ple) * jax.nn.sigmoid(x @ w_ple_gate)).astype(x.dtype)
    return x, (s5_h_re, s5_h_im, conv_buf, gdn_S, ml_C, ml_n, ml_m)


def setup_inputs(seed: int = 0) -> dict:
    key = jax.random.key(seed)
    keys = iter(jax.random.split(key, 64))
    f = jnp.float32

    def nrm(shape, scale):
        return scale * jax.random.normal(next(keys), shape, f)

    def gain(shape):
        return 1.0 + nrm(shape, 0.01)

    def log_uniform(shape, lo, hi):
        return jax.random.uniform(next(keys), shape, f, minval=float(np.log(lo)), maxval=float(np.log(hi)))

    Dp = DEPTH
    gdn_dt = jnp.exp(log_uniform((Dp, GDN_HEADS), 1e-3, 1e-1))
    return {
        'x_prompt': nrm((BATCH, SEQ, D_MODEL), 1.0),
        'x_sample': nrm((DEC_BATCH, DEC_SEQ, D_MODEL), 1.0),
        'state_s5_re': nrm((Dp, DEC_BATCH, S5_GROUPS, S5_STATE), 0.1),
        'state_s5_im': nrm((Dp, DEC_BATCH, S5_GROUPS, S5_STATE), 0.1),
        'state_gdn_conv': nrm((Dp, DEC_BATCH, GDN_CONV_W - 1, GDN_CONV_CH), 1.0),
        'state_gdn': nrm((Dp, DEC_BATCH, GDN_HEADS, GDN_DK, GDN_DV), 0.5),
        'state_mlstm_C': nrm((Dp, DEC_BATCH, ML_HEADS, ML_DK, ML_DV), 0.5),
        'state_mlstm_n': nrm((Dp, DEC_BATCH, ML_HEADS, ML_DK), 0.5),
        'state_mlstm_m': nrm((Dp, DEC_BATCH, ML_HEADS), 1.0),
        'p_prompt': nrm((Dp, BATCH, SEQ, PLE_DIM), 1.0),
        'p_sample': nrm((Dp, DEC_BATCH, DEC_SEQ, PLE_DIM), 1.0),
        'norm1_g': gain((Dp, D_MODEL)),
        'w_in': nrm((Dp, D_MODEL, D_IN), D_MODEL ** -0.5),
        's5_A_re': -0.5 + nrm((Dp, S5_GROUPS, S5_STATE), 0.01),
        's5_A_im': jnp.pi * jnp.arange(S5_STATE, dtype=f) + nrm((Dp, S5_GROUPS, S5_STATE), 0.01),
        's5_log_dt': log_uniform((Dp, S5_GROUPS), 1e-3, 1e-1),
        's5_B_re': nrm((Dp, S5_GROUPS, S5_STATE, S5_GROUP), (2 * S5_GROUP) ** -0.5),
        's5_B_im': nrm((Dp, S5_GROUPS, S5_STATE, S5_GROUP), (2 * S5_GROUP) ** -0.5),
        's5_C_re': nrm((Dp, S5_GROUPS, S5_GROUP, S5_STATE), 0.5),
        's5_C_im': nrm((Dp, S5_GROUPS, S5_GROUP, S5_STATE), 0.5),
        's5_D': nrm((Dp, S5_WIDTH), 1.0),
        's5_w_glu': nrm((Dp, S5_WIDTH, S5_WIDTH), S5_WIDTH ** -0.5),
        's5_b_glu': nrm((Dp, S5_WIDTH), 0.01),
        'gdn_conv_w': nrm((Dp, GDN_CONV_W, GDN_CONV_CH), GDN_CONV_W ** -0.5),
        'gdn_A_log': jnp.log(jax.random.uniform(next(keys), (Dp, GDN_HEADS), f, minval=1.0, maxval=16.0)),
        'gdn_dt_bias': jnp.log(jnp.expm1(gdn_dt)),
        'gdn_norm_g': gain((Dp, GDN_DV)),
        'ml_b_i': nrm((Dp, ML_HEADS), 0.1),
        'ml_b_f': 3.0 + nrm((Dp, ML_HEADS), 0.5),
        'ml_norm_g': gain((Dp, ML_V_W)),
        'w_br_s5': nrm((Dp, S5_WIDTH, D_MODEL), S5_WIDTH ** -0.5),
        'w_br_gdn': nrm((Dp, GDN_V_W, D_MODEL), GDN_V_W ** -0.5),
        'w_br_ml': nrm((Dp, ML_V_W, D_MODEL), ML_V_W ** -0.5),
        'w_out': nrm((Dp, D_MODEL, D_MODEL), D_MODEL ** -0.5),
        'norm2_g': gain((Dp, D_MODEL)),
        'w_up': nrm((Dp, D_MODEL, D_FF), D_MODEL ** -0.5),
        'w_down': nrm((Dp, D_FF, D_MODEL), D_FF ** -0.5),
        'w_ple': nrm((Dp, PLE_DIM, D_MODEL), PLE_DIM ** -0.5),
        'w_ple_gate': nrm((Dp, D_MODEL, D_MODEL), D_MODEL ** -0.5),
        'final_norm_g': gain((D_MODEL,)),
    }


def reference(x_prompt, x_sample, state_s5_re, state_s5_im, state_gdn_conv, state_gdn,
              state_mlstm_C, state_mlstm_n, state_mlstm_m, p_prompt, p_sample,
              norm1_g, w_in, s5_A_re, s5_A_im, s5_log_dt, s5_B_re, s5_B_im, s5_C_re, s5_C_im,
              s5_D, s5_w_glu, s5_b_glu, gdn_conv_w, gdn_A_log, gdn_dt_bias, gdn_norm_g,
              ml_b_i, ml_b_f, ml_norm_g, w_br_s5, w_br_gdn, w_br_ml, w_out, norm2_g,
              w_up, w_down, w_ple, w_ple_gate, final_norm_g):
    layer_weights = (norm1_g, w_in, s5_A_re, s5_A_im, s5_log_dt, s5_B_re, s5_B_im, s5_C_re, s5_C_im,
                     s5_D, s5_w_glu, s5_b_glu, gdn_conv_w, gdn_A_log, gdn_dt_bias, gdn_norm_g,
                     ml_b_i, ml_b_f, ml_norm_g, w_br_s5, w_br_gdn, w_br_ml, w_out, norm2_g,
                     w_up, w_down, w_ple, w_ple_gate)
    bp = x_prompt.shape[0]
    dt = x_prompt.dtype
    xp, xs = x_prompt, x_sample
    new_p, new_s = [], []
    for i in range(DEPTH):
        lw = [w[i] for w in layer_weights]
        zero_state = (jnp.zeros((bp, S5_GROUPS, S5_STATE), dt),
                      jnp.zeros((bp, S5_GROUPS, S5_STATE), dt),
                      jnp.zeros((bp, GDN_CONV_W - 1, GDN_CONV_CH), dt),
                      jnp.zeros((bp, GDN_HEADS, GDN_DK, GDN_DV), dt),
                      jnp.zeros((bp, ML_HEADS, ML_DK, ML_DV), dt),
                      jnp.zeros((bp, ML_HEADS, ML_DK), dt),
                      jnp.zeros((bp, ML_HEADS), dt))
        xp, sp_i = block(xp, p_prompt[i], *zero_state, *lw)
        xs, ss_i = block(xs, p_sample[i], state_s5_re[i], state_s5_im[i], state_gdn_conv[i], state_gdn[i],
                         state_mlstm_C[i], state_mlstm_n[i], state_mlstm_m[i], *lw)
        new_p.append(sp_i)
        new_s.append(ss_i)
    y_prompt = rmsnorm(xp, final_norm_g)
    y_sample = rmsnorm(xs, final_norm_g)
    sp = [jnp.stack(t) for t in zip(*new_p)]
    ss = [jnp.stack(t) for t in zip(*new_s)]
    return (y_prompt, y_sample, sp[0], ss[0], sp[1], ss[1], sp[2], ss[2], sp[3], ss[3],
            sp[4], ss[4], sp[5], ss[5], sp[6], ss[6])
```

```cpp
#include <hip/hip_runtime.h>
#include <hip/hip_cooperative_groups.h>
#include <cstdio>
namespace cg = cooperative_groups;
namespace pg8 {
#define PG8_LAS __attribute__((address_space(3)))
typedef unsigned short bf16_t;
typedef short bf16x8 __attribute__((ext_vector_type(8)));
typedef float f32x4 __attribute__((ext_vector_type(4)));
typedef unsigned u32x4 __attribute__((ext_vector_type(4)));
constexpr int BM = 256, BK = 64, HALF = 128, HTB = HALF * BK * 2  , STAGE_BYTES = 8 * HTB, NXCD = 8, WGM = 8;

__host__ __device__ __forceinline__ int lds_byte(int r, int c) { const int st = (r >> 4) * 2 + (c >> 5), rr = r & 15, cc = c & 31, ob = rr * 64 + cc * 2; return st * 1024 + (ob ^ (((ob >> 9) & 1) << 5)); }
__host__ __device__ __forceinline__ void stage_rc(int b, int& R, int& C) { const int st = b / 1024, sb = b % 1024, swz = sb ^ (((sb >> 9) & 1) << 5); R = (st >> 1) * 16 + swz / 64; C = (st & 1) * 32 + (swz % 64) / 2; }
__host__ __device__ __forceinline__ int perm32(int rho) { const int n = rho >> 4, i = rho & 15; return 8 * (i >> 2) + 4 * n + (i & 3); }

struct Unit { int pm, pn; };
struct Gemm { const bf16_t* A; const bf16_t* Bt; int M, N, K; };

struct StaticOrder {
    int nM, nN, nwg, G, c;
    __host__ __device__ void init(int M, int N, int G_, int c_) { nM = M / BM; nN = N / BM; nwg = nM * nN; G = G_; c = c_; }
    __host__ __device__ bool next(int i, Unit& u) const {
        const long L = (long)i * G + c; if (L >= nwg) return false;
        int wgid = (int)L; { const int q = nwg / NXCD, r = nwg % NXCD, xcd = wgid % NXCD, off = wgid / NXCD; wgid = (xcd < r ? xcd * (q + 1) : r * (q + 1) + (xcd - r) * q) + off; }
        const int nig = WGM * nN, gid = wgid / nig, fm = gid * WGM, gsz = (nM - fm) < WGM ? (nM - fm) : WGM;
        u.pm = fm + ((wgid % nig) % gsz); u.pn = (wgid % nig) / gsz; return true;
    }
    __device__ __forceinline__ void a_ready(const Unit&) const {}
    __device__ __forceinline__ void done(const Unit&) const {}
};

template <class Epi, class Sched, bool STAMP = false>
__device__ __forceinline__ void gemm_phase(PG8_LAS unsigned char* lds, const Gemm g, const Sched& S, const Epi& E, unsigned long long* stamps) {
    int tid_ = threadIdx.x; asm volatile("" : "+v"(tid_));
    const int tid = tid_, wid = __builtin_amdgcn_readfirstlane(tid >> 6), lane = tid & 63, wr = wid >> 2, wc = wid & 3, fr = lane & 15, fq = lane >> 4;
    const int K = g.K, nt = K / BK;
    unsigned voffA[2], voffB[2];
#pragma unroll
    for (int i = 0; i < 2; ++i) { int R, C; stage_rc(tid * 16 + i * 8192, R, C); const int Rb = Epi::PERM ? ((R & ~31) + perm32(R & 31)) : R;
        voffA[i] = (unsigned)(R * K + C) * 2u; voffB[i] = (unsigned)(Rb * K + C) * 2u; }
    const size_t kstep = (size_t)(BK * 2);
    const size_t hstep = (size_t)HALF * K * 2;
    const size_t tstep = 2 * hstep;
    const unsigned ldsw = (unsigned)wid * 1024u;
    const int aoff = lds_byte(wr * 64 + fr, fq * 8), boff = lds_byte(wc * 32 + fr, fq * 8);
#define PG8_SA(b, h) (((b) * 2 + (h)) * HTB)
#define PG8_SB(b, h) ((4 + (b) * 2 + (h)) * HTB)
#define PG8_STAGE(bufoff, gbase, voff) do { _Pragma("unroll") for (int _i = 0; _i < 2; ++_i) \
        __builtin_amdgcn_global_load_lds((const unsigned*)((const char*)(gbase) + (voff)[_i]), (PG8_LAS unsigned*)(lds + (bufoff) + ldsw + _i * 8192), 16, 0, 0); } while (0)
#define PG8_LDA(dst, b, h) do { _Pragma("unroll") for (int m = 0; m < 4; ++m) _Pragma("unroll") for (int k = 0; k < 2; ++k) dst[m][k] = *(const PG8_LAS bf16x8*)(lds + PG8_SA(b, h) + aoff + m * 2048 + k * 1024); } while (0)
#define PG8_LDB(dst, b, h) do { _Pragma("unroll") for (int n = 0; n < 2; ++n) _Pragma("unroll") for (int k = 0; k < 2; ++k) dst[n][k] = *(const PG8_LAS bf16x8*)(lds + PG8_SB(b, h) + boff + n * 2048 + k * 1024); } while (0)
#define PG8_MMA(ai, bj, At, Bt) do { __builtin_amdgcn_s_setprio(1); _Pragma("unroll") for (int m = 0; m < 4; ++m) _Pragma("unroll") for (int n = 0; n < 2; ++n) _Pragma("unroll") for (int k = 0; k < 2; ++k) \
        acc[ai][bj][m][n] = __builtin_amdgcn_mfma_f32_16x16x32_bf16(Bt[n][k], At[m][k], acc[ai][bj][m][n], 0, 0, 0); __builtin_amdgcn_s_setprio(0); } while (0)
#define PG8_WAIT_V(n) asm volatile("s_waitcnt vmcnt(" #n ")" ::: "memory")
#define PG8_WAIT_L(n) asm volatile("s_waitcnt lgkmcnt(" #n ")" ::: "memory")
#define PG8_BAR __builtin_amdgcn_s_barrier()
#define PG8_SCHED __builtin_amdgcn_sched_barrier(0)
    Unit cur, nxt; int ui = 0;
    if (!S.next(0, cur)) return;
    f32x4 acc[2][2][4][2];
#pragma unroll
    for (int a = 0; a < 2; ++a)
#pragma unroll
        for (int b = 0; b < 2; ++b)
#pragma unroll
            for (int m = 0; m < 4; ++m)
#pragma unroll
                for (int n = 0; n < 2; ++n) acc[a][b][m][n] = (f32x4){0.f, 0.f, 0.f, 0.f};
    bf16x8 At[4][2], B0[2][2], B1[2][2];
    const char* cA = (const char*)g.A + (size_t)cur.pm * tstep; const char* cB = (const char*)g.Bt + (size_t)cur.pn * tstep;
    S.a_ready(cur);
    PG8_STAGE(PG8_SB(0, 0), cB, voffB); PG8_STAGE(PG8_SA(0, 0), cA, voffA); PG8_STAGE(PG8_SB(0, 1), cB + hstep, voffB); PG8_STAGE(PG8_SA(0, 1), cA + hstep, voffA);
    if (wr == 1) PG8_BAR;
    PG8_WAIT_V(4); PG8_BAR;
    PG8_STAGE(PG8_SB(1, 0), cB + kstep, voffB); PG8_STAGE(PG8_SA(1, 0), cA + kstep, voffA); PG8_STAGE(PG8_SB(1, 1), cB + hstep + kstep, voffB);
    PG8_WAIT_V(6); PG8_BAR;
    for (;;) {
        const bool has_next = S.next(ui + 1, nxt);
        const char* nA = has_next ? (const char*)g.A + (size_t)nxt.pm * tstep : cA; const char* nB = has_next ? (const char*)g.Bt + (size_t)nxt.pn * tstep : cB;
        for (int t = 0; t < nt; t += 2) {
            const bool last = (t == nt - 2);
            const char* a1 = cA + (size_t)(t + 1) * kstep;
            const char* a2 = last ? nA : cA + (size_t)(t + 2) * kstep; const char* b2 = last ? nB : cB + (size_t)(t + 2) * kstep;
            const char* a3 = a2 + kstep; const char* b3 = b2 + kstep;
            if (last && has_next) S.a_ready(nxt);
            PG8_LDB(B0, 0, 0); PG8_SCHED; PG8_LDA(At, 0, 0); PG8_STAGE(PG8_SA(1, 1), a1 + hstep, voffA);
            PG8_WAIT_L(8); PG8_BAR; PG8_WAIT_L(0); PG8_MMA(0, 0, At, B0); PG8_BAR; PG8_SCHED;
            PG8_LDB(B1, 0, 1); PG8_STAGE(PG8_SB(0, 0), b2, voffB);
            PG8_BAR; PG8_WAIT_L(0); PG8_MMA(0, 1, At, B1); PG8_BAR;
            PG8_LDA(At, 0, 1); PG8_STAGE(PG8_SA(0, 0), a2, voffA);
            PG8_BAR; PG8_WAIT_L(0); PG8_MMA(1, 0, At, B0); PG8_BAR; PG8_SCHED;
            PG8_STAGE(PG8_SB(0, 1), b2 + hstep, voffB);
            PG8_WAIT_V(6); PG8_BAR; PG8_MMA(1, 1, At, B1); PG8_BAR;
            PG8_LDB(B0, 1, 0); PG8_SCHED; PG8_LDA(At, 1, 0); PG8_STAGE(PG8_SA(0, 1), a2 + hstep, voffA);
            PG8_WAIT_L(8); PG8_BAR; PG8_WAIT_L(0); PG8_MMA(0, 0, At, B0); PG8_BAR; PG8_SCHED;
            PG8_LDB(B1, 1, 1); PG8_STAGE(PG8_SB(1, 0), b3, voffB);
            PG8_BAR; PG8_WAIT_L(0); PG8_MMA(0, 1, At, B1); PG8_BAR;
            PG8_LDA(At, 1, 1); PG8_STAGE(PG8_SA(1, 0), a3, voffA);
            PG8_BAR; PG8_WAIT_L(0); PG8_MMA(1, 0, At, B0); PG8_BAR; PG8_SCHED;
            PG8_STAGE(PG8_SB(1, 1), b3 + hstep, voffB);
            PG8_WAIT_V(6); PG8_BAR; PG8_MMA(1, 1, At, B1); PG8_BAR;
        }
        if constexpr (!Epi::AFTER_DRAIN) { E(acc, cur, wr, wc, fr, fq); S.done(cur); }
        if (!has_next) break;
#pragma unroll
        for (int a = 0; a < 2; ++a)
#pragma unroll
            for (int b = 0; b < 2; ++b)
#pragma unroll
                for (int m = 0; m < 4; ++m)
#pragma unroll
                    for (int n = 0; n < 2; ++n) acc[a][b][m][n] = (f32x4){0.f, 0.f, 0.f, 0.f};
        cur = nxt; cA = nA; cB = nB; ++ui;
    }
    PG8_WAIT_V(0);
    if (wr == 0) PG8_BAR;
    PG8_BAR;
    if constexpr (Epi::AFTER_DRAIN) { E.fused(acc, cur, wr, wc, fr, fq, lds, wid, lane); S.done(cur); }
#undef PG8_SA
#undef PG8_SB
#undef PG8_STAGE
#undef PG8_LDA
#undef PG8_LDB
#undef PG8_MMA
#undef PG8_WAIT_V
#undef PG8_WAIT_L
#undef PG8_BAR
#undef PG8_SCHED
}
}

#include <cstdio>
#include <ctime>
#include <cstdlib>
#include <cstring>
#include <cmath>
#include <vector>
#include <algorithm>
#define CK(x) do { hipError_t e_ = (x); if (e_ != hipSuccess) { fprintf(stderr, "HIP %s:%d %s\n", __FILE__, __LINE__, hipGetErrorString(e_)); exit(2); } } while (0)

#define DI __device__ __forceinline__
#define LAS __attribute__((address_space(3)))
typedef unsigned short bf16_t;
typedef short bf16x8 __attribute__((ext_vector_type(8)));
typedef short s16x4 __attribute__((ext_vector_type(4)));
typedef __bf16 bfv8 __attribute__((ext_vector_type(8)));
typedef __bf16 bfv4 __attribute__((ext_vector_type(4)));
typedef float f32x2 __attribute__((ext_vector_type(2)));
typedef float f32x4 __attribute__((ext_vector_type(4)));
typedef float f32x8 __attribute__((ext_vector_type(8)));
typedef float f32x16 __attribute__((ext_vector_type(16)));
typedef unsigned u32x4 __attribute__((ext_vector_type(4)));
typedef unsigned u32x2 __attribute__((ext_vector_type(2)));

constexpr int MP = 16384, MS = 128, MR = MP + MS, MPAD = 16640, DM = 1024, SEQ = 2048, NB = 8;
constexpr int NPROJ = 4096, NGATE = 3072, DFF = 4096, DIN = 7184;
constexpr int PU = 0, PQ = 512, PK = 1024, PV = 1536, PMQ = 2048, PMK = 2304, PMV = 2560, PZ = 3072, PMO = 3584;
constexpr float EPS = 1e-6f;
constexpr size_t O_S5RE_P = 16908288, O_S5RE_S = 16941056, O_S5IM_P = 17465344, O_S5IM_S = 17498112, O_CONV_P = 18022400, O_CONV_S = 18096128,
                 O_GDN_P = 19275776, O_GDN_S = 20324352, O_MLC_P = 37101568, O_MLC_S = 37625856, O_MLN_P = 46014464, O_MLN_S = 46018560,
                 O_MLM_P = 46084096, O_MLM_S = 46084160, O_TOTAL = 46085184;
constexpr size_t WS_R1 = 0, SZ_R1 = (size_t)MPAD * 4096 * 2;
constexpr size_t WS_XN = WS_R1 + SZ_R1, SZ_XN = (size_t)MPAD * 1024 * 2;
constexpr size_t WS_Y3 = WS_XN + SZ_XN, SZ_Y3 = (size_t)3 * MPAD * 512 * 2;
constexpr size_t WS_YS5 = WS_Y3 + SZ_Y3, SZ_YS5 = (size_t)MPAD * 512 * 2;
constexpr size_t WS_W = WS_YS5 + SZ_YS5;
constexpr size_t WO_IN = 0, WO_G = WO_IN + (size_t)4096 * 1024, WO_GLU = WO_G + (size_t)3072 * 1024, WO_BR = WO_GLU + (size_t)512 * 512,
                 WO_OUT = WO_BR + (size_t)3 * 1024 * 512, WO_UP = WO_OUT + (size_t)1024 * 1024, WO_DN = WO_UP + (size_t)4096 * 1024,
                 WO_PLE = WO_DN + (size_t)1024 * 4096, WO_PG = WO_PLE + (size_t)1024 * 256, WO_END = WO_PG + (size_t)1024 * 1024;
constexpr size_t SZ_W = WO_END * 2;
constexpr size_t WS_GS = WS_W + SZ_W;
constexpr int GI_U = 0, GI_W = 16384, GI_Q = 32768, GI_K = 49152, GI_A = 65536, GI_BYTES = 73728;
constexpr size_t SZ_GS = (size_t)1024 * GI_BYTES;
constexpr size_t WS_SG = WS_GS + SZ_GS, SZ_SG = (size_t)MR * 16 * 4;
constexpr size_t WS_GL = WS_SG + SZ_SG, SZ_GL = 8192;
constexpr size_t WS_END = WS_GL + SZ_GL;
constexpr int LDS_BYTES = 131072 + 8192;

struct KP { const float* in[40]; float* out; unsigned char* ws; };

DI float bf2f(bf16_t b) { return __uint_as_float(((unsigned)b) << 16); }
DI bf16_t f2bf(float f) { __bf16 b = (__bf16)f; return __builtin_bit_cast(bf16_t, b); }
DI bf16x8 pack8v(f32x8 v) { bfv8 b = __builtin_convertvector(v, bfv8); return __builtin_bit_cast(bf16x8, b); }
DI s16x4 pack4v(f32x4 v) { bfv4 b = __builtin_convertvector(v, bfv4); return __builtin_bit_cast(s16x4, b); }
DI bf16x8 pack16(const f32x16& x, int s) { f32x8 v;
#pragma unroll
    for (int j = 0; j < 8; ++j) v[j] = x[8 * s + j];
    return pack8v(v); }
DI float lo16(unsigned u) { return __uint_as_float(u << 16); }
DI float hi16(unsigned u) { return __uint_as_float(u & 0xffff0000u); }
DI f32x8 unpack8(bf16x8 b) { u32x4 u = __builtin_bit_cast(u32x4, b); f32x8 r;
#pragma unroll
    for (int i = 0; i < 4; ++i) { r[2 * i] = lo16(u[i]); r[2 * i + 1] = hi16(u[i]); }
    return r; }
DI float sigm(float x) { return 1.f / (1.f + __expf(-x)); }
DI float tanh_(float z) { return 1.f - 2.f / (__expf(2.f * z) + 1.f); }
DI float gelu_t(float x) { return 0.5f * x * (1.f + tanh_(0.7978845608028654f * (x + 0.044715f * x * x * x))); }
DI float silu_(float x) { return x * sigm(x); }
DI float softplus_(float x) { return x > 20.f ? x : log1pf(expf(x)); }
DI float logsig_(float x) { return x >= 0.f ? -log1pf(expf(-x)) : x - log1pf(expf(x)); }
DI float softcap_(float x) { return 15.f * tanh_(x * (1.f / 15.f)); }
DI float wave_sum(float v) {
#pragma unroll
    for (int o = 32; o; o >>= 1) v += __shfl_xor(v, o);
    return v; }
DI float wave_incl_sum(float v, int lane) {
#pragma unroll
    for (int o = 1; o < 64; o <<= 1) { float t = __shfl_up(v, o); if (lane >= o) v += t; }
    return v; }
DI float wave_incl_max(float v, int lane) {
#pragma unroll
    for (int o = 1; o < 64; o <<= 1) { float t = __shfl_up(v, o); if (lane >= o) v = fmaxf(v, t); }
    return v; }
DI int crow(int reg, int h) { return (reg & 3) + 8 * (reg >> 2) + 4 * h; }
DI int perm16(int k) { return (k & ~12) | ((k & 4) << 1) | ((k & 8) >> 1); }
#define MFMA32(a, b, c) __builtin_amdgcn_mfma_f32_32x32x16_bf16((a), (b), (c), 0, 0, 0)
#define MFMA16(a, b, c) __builtin_amdgcn_mfma_f32_16x16x32_bf16((a), (b), (c), 0, 0, 0)
#define WAVE_FENCE() do { asm volatile("s_waitcnt lgkmcnt(0)" ::: "memory"); __builtin_amdgcn_wave_barrier(); asm volatile("" ::: "memory"); } while (0)

typedef __attribute__((address_space(4))) const unsigned long long* ka_t;
struct InTab { ka_t ka; DI const float* operator[](int i) const { return (const float*)ka[i]; } };
struct Ctx {
    InTab in; float* out; unsigned char* ws; unsigned char* lds;
    bf16_t *R1, *XN, *Y3, *W, *YS5; unsigned char* GS; float *SG, *GL;
    int tid, lane, wave, G, bid;
};

template <class F> struct Epi8 {
    static constexpr bool PERM = true, AFTER_DRAIN = false;
    F f;
    DI void operator()(const f32x4 (&acc)[2][2][4][2], const pg8::Unit& u, int wr, int wc, int fr, int fq) const {
        const int row0 = u.pm * 256 + wr * 64 + fr, col0 = u.pn * 256 + wc * 32 + 8 * fq;
#pragma unroll
        for (int ai = 0; ai < 2; ++ai)
#pragma unroll
            for (int m = 0; m < 4; ++m)
#pragma unroll
                for (int bj = 0; bj < 2; ++bj) f(row0 + ai * 128 + m * 16, col0 + bj * 128, acc[ai][bj][m][0], acc[ai][bj][m][1]);
    }
};
DI f32x8 cat8(f32x4 a, f32x4 b) { f32x8 r; r[0] = a[0]; r[1] = a[1]; r[2] = a[2]; r[3] = a[3]; r[4] = b[0]; r[5] = b[1]; r[6] = b[2]; r[7] = b[3]; return r; }
struct FStore { bf16_t* dst; int ld;
    DI void operator()(int row, int col, f32x4 a, f32x4 b) const { *(bf16x8*)(dst + (size_t)row * ld + col) = pack8v(cat8(a, b)); } };
struct FSig { bf16_t* dst; int ld;
    DI void operator()(int row, int col, f32x4 a, f32x4 b) const { f32x8 v = cat8(a, b);
#pragma unroll
        for (int i = 0; i < 8; ++i) v[i] = sigm(v[i]);
        *(bf16x8*)(dst + (size_t)row * ld + col) = pack8v(v); } };
struct FGlu { const bf16_t* y; const float* bias; bf16_t* dst;
    DI void operator()(int row, int col, f32x4 a, f32x4 b) const { f32x8 v = cat8(a, b); f32x8 yv = unpack8(*(const bf16x8*)(y + (size_t)row * 512 + col));
        f32x4 b0 = *(const f32x4*)(bias + col), b1 = *(const f32x4*)(bias + col + 4);
#pragma unroll
        for (int i = 0; i < 8; ++i) v[i] = yv[i] * sigm(v[i] + (i < 4 ? b0[i] : b1[i - 4]));
        *(bf16x8*)(dst + (size_t)row * 512 + col) = pack8v(v); } };
struct FBranch { const bf16_t* gates; bf16_t* merged; int first;
    DI void operator()(int row, int col, f32x4 a, f32x4 b) const { f32x8 v = cat8(a, b); f32x8 gv = unpack8(*(const bf16x8*)(gates + (size_t)row * 4096 + col));
        bf16x8* mp = (bf16x8*)(merged + (size_t)row * 1024 + col);
        f32x8 o;
        if (first) {
#pragma unroll
            for (int i = 0; i < 8; ++i) o[i] = gv[i] * v[i];
        } else { f32x8 mv = unpack8(*mp);
#pragma unroll
            for (int i = 0; i < 8; ++i) o[i] = mv[i] + gv[i] * v[i];
        }
        *mp = pack8v(o); } };
struct FRes { float* xr;
    DI void operator()(int row, int col, f32x4 a, f32x4 b) const { if (row < MR) { f32x4* p = (f32x4*)(xr + (size_t)row * 1024 + col); p[0] = p[0] + a; p[1] = p[1] + b; } } };
struct FRelu2 { bf16_t* dst;
    DI void operator()(int row, int col, f32x4 a, f32x4 b) const { f32x8 v = cat8(a, b);
#pragma unroll
        for (int i = 0; i < 8; ++i) { float r = fmaxf(v[i], 0.f); v[i] = r * r; }
        *(bf16x8*)(dst + (size_t)row * 4096 + col) = pack8v(v); } };
struct FPle { const bf16_t* T; float* xr;
    DI void operator()(int row, int col, f32x4 a, f32x4 b) const { if (row < MR) { f32x8 v = cat8(a, b); f32x8 tv = unpack8(*(const bf16x8*)(T + (size_t)row * 1024 + col));
            f32x4* p = (f32x4*)(xr + (size_t)row * 1024 + col); f32x4 x0 = p[0], x1 = p[1];
#pragma unroll
            for (int i = 0; i < 4; ++i) { x0[i] += tv[i] * sigm(v[i]); x1[i] += tv[4 + i] * sigm(v[4 + i]); }
            p[0] = x0; p[1] = x1; } } };

template <class F> DI void run_gemm(const Ctx& c, const bf16_t* A, const bf16_t* Bt, int N, int K, const F& f) {
    pg8::Gemm g{A, Bt, MPAD, N, K}; pg8::StaticOrder S; S.init(MPAD, N, c.G, c.bid);
    Epi8<F> E{f};
    pg8::gemm_phase<Epi8<F>, pg8::StaticOrder>((PG8_LAS unsigned char*)c.lds, g, S, E, nullptr);
    __syncthreads();
}

DI void tr_task(const Ctx& c, const float* src, int ld, int K, int n, bf16_t* dst, int rot) {
    float* tile = (float*)c.lds;
    const int nkt = K >> 6, ntiles = nkt * (n >> 6);
    const int start = (c.bid + c.G - (rot % c.G)) % c.G;
    for (int t = start; t < ntiles; t += c.G) {
        const int kt = t % nkt, nt = t / nkt;
        const int r = c.tid >> 4, c4 = (c.tid & 15) * 4;
#pragma unroll
        for (int p = 0; p < 2; ++p) { const int row = r + 32 * p; const f32x4 v = *(const f32x4*)(src + (size_t)(kt * 64 + row) * ld + nt * 64 + c4);
            tile[row * 65 + c4] = v[0]; tile[row * 65 + c4 + 1] = v[1]; tile[row * 65 + c4 + 2] = v[2]; tile[row * 65 + c4 + 3] = v[3]; }
        __syncthreads();
        { const int nn = c.tid >> 3, kc = (c.tid & 7) * 8; f32x8 v;
#pragma unroll
          for (int e = 0; e < 8; ++e) v[e] = tile[(kc + e) * 65 + nn];
          *(bf16x8*)(dst + (size_t)(nt * 64 + nn) * K + kt * 64 + kc) = pack8v(v); }
        __syncthreads();
    }
}
DI void phase_weights(const Ctx& c, int L) {
    const float* win = c.in[12] + (size_t)L * 1024 * DIN;
    bf16_t* W = c.W;
    tr_task(c, win + 0, DIN, 1024, 2048, W + WO_IN, 0);
    tr_task(c, win + 2568, DIN, 1024, 1024, W + WO_IN + (size_t)2048 * 1024, 0);
    tr_task(c, win + 2048, DIN, 1024, 512, W + WO_IN + (size_t)3072 * 1024, 0);
    tr_task(c, win + 3592, DIN, 1024, 512, W + WO_IN + (size_t)3584 * 1024, 128);
    tr_task(c, win + 4112, DIN, 1024, 3072, W + WO_G, 0);
    tr_task(c, c.in[21] + (size_t)L * 512 * 512, 512, 512, 512, W + WO_GLU, 0);
    tr_task(c, c.in[30] + (size_t)L * 512 * 1024, 1024, 512, 1024, W + WO_BR, 64);
    tr_task(c, c.in[31] + (size_t)L * 512 * 1024, 1024, 512, 1024, W + WO_BR + (size_t)1024 * 512, 192);
    tr_task(c, c.in[32] + (size_t)L * 512 * 1024, 1024, 512, 1024, W + WO_BR + (size_t)2 * 1024 * 512, 64);
    tr_task(c, c.in[33] + (size_t)L * 1024 * 1024, 1024, 1024, 1024, W + WO_OUT, 0);
    tr_task(c, c.in[35] + (size_t)L * 1024 * 4096, 4096, 1024, 4096, W + WO_UP, 0);
    tr_task(c, c.in[36] + (size_t)L * 4096 * 1024, 1024, 4096, 1024, W + WO_DN, 0);
    tr_task(c, c.in[37] + (size_t)L * 256 * 1024, 1024, 256, 1024, W + WO_PLE, 0);
    tr_task(c, c.in[38] + (size_t)L * 1024 * 1024, 1024, 1024, 1024, W + WO_PG, 64);
}

template <int MODE> DI void phase_rmsnorm(const Ctx& c, int L) {
    float* wsm = (float*)c.lds;
    const float* gain = (MODE == 0 ? c.in[11] : c.in[34]) + (size_t)L * 1024;
    if (MODE == 0) {
        const float* win = c.in[12] + (size_t)L * 1024 * DIN;
        for (int idx = c.tid; idx < 16 * 1024; idx += 512) { const int s = idx & 15, k = idx >> 4;
            const int sc = s < 4 ? 2560 + s : s < 8 ? 2564 + (s - 4) : s < 12 ? 4104 + (s - 8) : 4108 + (s - 12);
            wsm[s * 1024 + k] = win[(size_t)k * DIN + sc]; }
        __syncthreads();
    }
    float* XR = c.out;
    for (int row = c.bid * 8 + c.wave; row < MR; row += c.G * 8) {
        const float* src = (MODE == 0 && L == 0) ? (row < MP ? c.in[0] + (size_t)row * 1024 : c.in[1] + (size_t)(row - MP) * 1024) : XR + (size_t)row * 1024;
        f32x4 x[4]; float ss = 0.f;
#pragma unroll
        for (int i = 0; i < 4; ++i) { x[i] = *(const f32x4*)(src + c.lane * 4 + 256 * i); ss += x[i][0] * x[i][0] + x[i][1] * x[i][1] + x[i][2] * x[i][2] + x[i][3] * x[i][3]; }
        ss = wave_sum(ss);
        const float rs = rsqrtf(ss * (1.f / 1024.f) + EPS);
        if (MODE == 0 && L == 0) {
#pragma unroll
            for (int i = 0; i < 4; ++i) *(f32x4*)(XR + (size_t)row * 1024 + c.lane * 4 + 256 * i) = x[i];
        }
#pragma unroll
        for (int i = 0; i < 4; ++i) { const f32x4 g = *(const f32x4*)(gain + c.lane * 4 + 256 * i); x[i] = x[i] * rs * g;
            *(s16x4*)(c.XN + (size_t)row * 1024 + c.lane * 4 + 256 * i) = pack4v(x[i]); }
        if (MODE == 0) {
            float mine = 0.f;
#pragma unroll 1
            for (int s = 0; s < 16; ++s) { float a = 0.f;
#pragma unroll
                for (int i = 0; i < 4; ++i) { const f32x4 w = *(const f32x4*)(wsm + s * 1024 + c.lane * 4 + 256 * i); a += x[i][0] * w[0] + x[i][1] * w[1] + x[i][2] * w[2] + x[i][3] * w[3]; }
                a = wave_sum(a); mine = (c.lane == s) ? a : mine; }
            if (c.lane < 16) c.SG[(size_t)row * 16 + c.lane] = mine;
        }
    }
    __syncthreads();
}

DI void phase_gdn_prep(const Ctx& c, int L) {
    constexpr int RS = 132;
    float* Am = (float*)c.lds; float* beta = Am + 64 * 64; float* gcum = beta + 64; float* qs = gcum + 64; float* ks = qs + 64 * RS; float* vs = ks + 64 * RS;
    const float* convw = c.in[23] + (size_t)L * 4 * 1536;
    const bf16_t* PR = c.R1;
    for (int item = c.bid; item < 1024; item += c.G) {
        const int ch = item & 31, h = (item >> 5) & 3, b = item >> 7;
        const int t0 = b * SEQ + ch * 64;
        unsigned char* gi = c.GS + (size_t)item * GI_BYTES;
        for (int idx = c.tid; idx < 64 * 384; idx += 512) {
            const int cc = idx % 384, t = idx / 384, which = cc >> 7, d = cc & 127;
            const int pcol = PQ + which * 512 + h * 128 + d, wcol = which * 512 + h * 128 + d;
            float a = 0.f;
#pragma unroll
            for (int j = 0; j < 4; ++j) { const int tt = ch * 64 + t + j - 3; if (tt >= 0) a += bf2f(PR[(size_t)(b * SEQ + tt) * NPROJ + pcol]) * convw[j * 1536 + wcol]; }
            a = silu_(a);
            (which == 0 ? qs : which == 1 ? ks : vs)[t * RS + d] = a;
        }
        __syncthreads();
        for (int rr = c.wave; rr < 128; rr += 8) { float* p = (rr < 64 ? qs : ks) + (rr & 63) * RS;
            const float a0 = p[c.lane], a1 = p[c.lane + 64]; const float s = wave_sum(a0 * a0 + a1 * a1);
            const float sc = rsqrtf(s + EPS) * (rr < 64 ? 0.08838834764831845f : 1.f);
            p[c.lane] = a0 * sc; p[c.lane + 64] = a1 * sc; }
        if (c.wave == 0) { const size_t row = (size_t)(t0 + c.lane);
            const float bt = sigm(c.SG[row * 16 + h]);
            const float g = -expf(c.in[24][L * 4 + h]) * softplus_(c.SG[row * 16 + 4 + h] + c.in[25][L * 4 + h]);
            const float gc = wave_incl_sum(g, c.lane);
            beta[c.lane] = bt; gcum[c.lane] = gc;
            if (c.lane == 63) c.GL[item] = expf(gc); }
        __syncthreads();
        { const int tb = (c.tid >> 4) * 2, sb = (c.tid & 15) * 4;
          float aa[2][4], qq[2][4];
#pragma unroll
          for (int i = 0; i < 2; ++i)
#pragma unroll
              for (int j = 0; j < 4; ++j) { aa[i][j] = 0.f; qq[i][j] = 0.f; }
          for (int d = 0; d < 128; d += 4) {
              f32x4 kt[2], qt[2], ksr[4];
#pragma unroll
              for (int i = 0; i < 2; ++i) { kt[i] = *(const f32x4*)(ks + (tb + i) * RS + d); qt[i] = *(const f32x4*)(qs + (tb + i) * RS + d); }
#pragma unroll
              for (int j = 0; j < 4; ++j) ksr[j] = *(const f32x4*)(ks + (sb + j) * RS + d);
#pragma unroll
              for (int i = 0; i < 2; ++i)
#pragma unroll
                  for (int j = 0; j < 4; ++j)
#pragma unroll
                      for (int e = 0; e < 4; ++e) { aa[i][j] += kt[i][e] * ksr[j][e]; qq[i][j] += qt[i][e] * ksr[j][e]; }
          }
          bf16_t* at = (bf16_t*)(gi + GI_A);
#pragma unroll
          for (int i = 0; i < 2; ++i)
#pragma unroll
              for (int j = 0; j < 4; ++j) { const int t = tb + i, s = sb + j; const float dec = (t >= s) ? expf(gcum[t] - gcum[s]) : 0.f;
                  Am[t * 64 + s] = (t > s) ? beta[t] * aa[i][j] * dec : 0.f;
                  at[t * 64 + (s & ~15) + perm16(s & 15)] = f2bf(qq[i][j] * dec); }
        }
        __syncthreads();
        if (c.tid < 256) {
            const int col = c.tid; float x[64];
#pragma unroll
            for (int t = 0; t < 64; ++t) x[t] = (col < 128) ? vs[t * RS + col] * beta[t] : ks[t * RS + (col - 128)] * beta[t] * expf(gcum[t]);
#pragma unroll
            for (int i = 1; i < 64; ++i) { float acc = x[i];
#pragma unroll
                for (int j4 = 0; j4 < (i + 3) / 4; ++j4) { const f32x4 a = *(const f32x4*)(Am + i * 64 + j4 * 4);
#pragma unroll
                    for (int e = 0; e < 4; ++e) if (j4 * 4 + e < i) acc -= a[e] * x[j4 * 4 + e]; }
                x[i] = acc; }
            if (col < 128) { bf16_t* up = (bf16_t*)(gi + GI_U); const int sl = col >> 5, r = col & 31;
#pragma unroll
                for (int t = 0; t < 64; ++t) { const int mt = t >> 5, tt = t & 31, hh = (tt >> 2) & 1, i = (tt & 3) + 4 * (tt >> 3);
                    up[((sl * 2 + mt) * 16 + i) * 64 + r + 32 * hh] = f2bf(x[t]); }
            } else { bf16_t* wp = (bf16_t*)(gi + GI_W); const int dk = col - 128, pd = (dk & ~15) + perm16(dk & 15);
#pragma unroll
                for (int t = 0; t < 64; ++t) wp[t * 128 + pd] = f2bf(-x[t]); }
        } else {
            bf16_t* qp = (bf16_t*)(gi + GI_Q); bf16_t* kp = (bf16_t*)(gi + GI_K);
            const float g63 = gcum[63];
            for (int idx = c.tid - 256; idx < 64 * 128; idx += 256) { const int t = idx >> 7, d = idx & 127;
                qp[t * 128 + (d & ~15) + perm16(d & 15)] = f2bf(qs[t * RS + d] * expf(gcum[t])); }
            for (int idx = c.tid - 256; idx < 64 * 128; idx += 256) { const int d = idx >> 6, t = idx & 63;
                kp[d * 64 + (t & ~15) + perm16(t & 15)] = f2bf(ks[t * RS + d] * expf(g63 - gcum[t])); }
        }
        __syncthreads();
    }
}

DI void task_gdn_seq(const Ctx& c, int L, int unit) {
    const int sl = (unit >> 3) & 3, stream = (unit & 7) + 8 * (unit >> 5);
    const int b = stream >> 2, h = stream & 3;
    const int r0_ = c.lane & 31, hh0_ = c.lane >> 5; int r = r0_, hh = hh0_, ln = c.lane;
    f32x16 S[4];
#pragma unroll
    for (int i = 0; i < 4; ++i)
#pragma unroll
        for (int j = 0; j < 16; ++j) S[i][j] = 0.f;
    bf16_t* yo = c.Y3 + (size_t)1 * MPAD * 512;
    for (int ch = 0; ch < 32; ++ch) {
        r = r0_; hh = hh0_; ln = c.lane; asm volatile("" : "+v"(r), "+v"(hh), "+v"(ln));
        const int item = stream * 32 + ch;
        const unsigned char* gi = c.GS + (size_t)item * GI_BYTES;
        const bf16_t* up = (const bf16_t*)(gi + GI_U); const bf16_t* wp = (const bf16_t*)(gi + GI_W); const bf16_t* qp = (const bf16_t*)(gi + GI_Q);
        const bf16_t* kp = (const bf16_t*)(gi + GI_K); const bf16_t* ap = (const bf16_t*)(gi + GI_A);
        const float gl = c.GL[item];
        f32x16 vn[2], o[2];
#pragma unroll
        for (int mt = 0; mt < 2; ++mt)
#pragma unroll
            for (int i = 0; i < 16; ++i) { vn[mt][i] = bf2f(up[((sl * 2 + mt) * 16 + i) * 64 + ln]); o[mt][i] = 0.f; }
        bf16x8 Sb[8];
#pragma unroll
        for (int ks = 0; ks < 8; ++ks) Sb[ks] = pack16(S[ks >> 1], ks & 1);
#pragma unroll
        for (int mt = 0; mt < 2; ++mt)
#pragma unroll
            for (int ks = 0; ks < 8; ++ks) { const bf16x8 a = *(const bf16x8*)(wp + (mt * 32 + r) * 128 + ks * 16 + hh * 8); vn[mt] = MFMA32(a, Sb[ks], vn[mt]); }
#pragma unroll
        for (int mt = 0; mt < 2; ++mt)
#pragma unroll
            for (int ks = 0; ks < 8; ++ks) { const bf16x8 a = *(const bf16x8*)(qp + (mt * 32 + r) * 128 + ks * 16 + hh * 8); o[mt] = MFMA32(a, Sb[ks], o[mt]); }
        bf16x8 Vb[4];
#pragma unroll
        for (int ks = 0; ks < 4; ++ks) Vb[ks] = pack16(vn[ks >> 1], ks & 1);
#pragma unroll
        for (int mt = 0; mt < 2; ++mt)
#pragma unroll
            for (int ks = 0; ks < 4; ++ks) { const bf16x8 a = *(const bf16x8*)(ap + (mt * 32 + r) * 64 + ks * 16 + hh * 8); o[mt] = MFMA32(a, Vb[ks], o[mt]); }
#pragma unroll
        for (int i = 0; i < 4; ++i) {
#pragma unroll
            for (int j = 0; j < 16; ++j) S[i][j] *= gl;
#pragma unroll
            for (int ks = 0; ks < 4; ++ks) { const bf16x8 a = *(const bf16x8*)(kp + (i * 32 + r) * 64 + ks * 16 + hh * 8); S[i] = MFMA32(a, Vb[ks], S[i]); }
        }
        const size_t rowb = (size_t)(b * SEQ + ch * 64);
#pragma unroll
        for (int mt = 0; mt < 2; ++mt)
#pragma unroll
            for (int i = 0; i < 16; ++i) yo[(rowb + mt * 32 + crow(i, hh)) * 512 + h * 128 + sl * 32 + r] = f2bf(o[mt][i]);
    }
    float* so = c.out + O_GDN_P + ((size_t)(L * NB + b) * 4 + h) * 128 * 128;
#pragma unroll
    for (int i = 0; i < 4; ++i)
#pragma unroll
        for (int j = 0; j < 16; ++j) so[(size_t)(i * 32 + crow(j, hh)) * 128 + sl * 32 + r] = S[i][j];
}

DI void task_ml_seq(const Ctx& c, int L, int unit, float* wl  ) {
    const int sl = (unit >> 3) & 3, stream = (unit & 7) + 8 * (unit >> 5);
    const int b = stream >> 2, h = stream & 3;
    const int lane = c.lane, r0_ = lane & 31, hh0_ = lane >> 5;
    constexpr int KP = 72, VP = 40;
    int r = r0_, hh = hh0_, lane_v = lane;
    LAS float* a_l = (LAS float*)wl; LAS float* w_l = a_l + 64; LAS float* sc_l = a_l + 128; LAS float* inv_l = a_l + 192;
    LAS bf16_t* Kl = (LAS bf16_t*)(a_l + 256); LAS bf16_t* Vl = Kl + 64 * KP;
    const bf16_t* PR = c.R1;
    const float bi = c.in[27][L * 4 + h], bfv = c.in[28][L * 4 + h];
    f32x16 C[2];
#pragma unroll
    for (int i = 0; i < 2; ++i)
#pragma unroll
        for (int j = 0; j < 16; ++j) C[i][j] = 0.f;
    float nst = 0.f, mprev = 0.f;
    bf16_t* yo = c.Y3 + (size_t)2 * MPAD * 512;
    for (int ch = 0; ch < 32; ++ch) {
        r = r0_; hh = hh0_; lane_v = lane; asm volatile("" : "+v"(r), "+v"(hh), "+v"(lane_v));
        LAS bf16_t* vbase = Vl + 4 * hh * VP + r; asm volatile("" : "+v"(vbase));
        LAS bf16_t* kbase = Kl + 4 * hh * KP + r; asm volatile("" : "+v"(kbase));
        LAS bf16_t* krow = Kl + r * KP + hh * 8; asm volatile("" : "+v"(krow));
        LAS float* a4b = a_l + 4 * hh; asm volatile("" : "+v"(a4b));
        const size_t t0 = (size_t)(b * SEQ + ch * 64);
        const bf16_t* qb = PR + t0 * NPROJ + PMQ + h * 64;
        const bf16_t* kb = PR + t0 * NPROJ + PMK + h * 64;
        const bf16_t* vb = PR + t0 * NPROJ + PMV + h * 128 + sl * 32;
        const float li = softcap_(c.SG[(t0 + lane) * 16 + 8 + h] + bi);
        const float lf = logsig_(softcap_(c.SG[(t0 + lane) * 16 + 12 + h] + bfv));
        const float bc = wave_incl_sum(lf, lane);
        const float av = li - bc;
        const float Mt = fmaxf(mprev, wave_incl_max(av, lane));
        const float sct = expf(mprev - Mt);
        const float M63 = __shfl(Mt, 63), bc63 = __shfl(bc, 63);
        const float wlast = expf(av - M63) * 0.125f;
        const float sclast = expf(mprev - M63);
        WAVE_FENCE();
        float qn = 0.f;
#pragma unroll
        for (int d8 = 0; d8 < 8; ++d8) { *(LAS bf16x8*)(Kl + lane_v * KP + d8 * 8) = *(const bf16x8*)(kb + (size_t)lane_v * NPROJ + d8 * 8); }
#pragma unroll
        for (int d8 = 0; d8 < 4; ++d8) { *(LAS bf16x8*)(Vl + lane_v * VP + d8 * 8) = *(const bf16x8*)(vb + (size_t)lane_v * NPROJ + d8 * 8); }
#pragma unroll 1
        for (int d8 = 0; d8 < 8; ++d8) { const f32x8 qv = unpack8(*(const bf16x8*)(qb + (size_t)lane_v * NPROJ + d8 * 8));
#pragma unroll
            for (int e = 0; e < 8; ++e) qn += qv[e] * __shfl(nst, d8 * 8 + e); }
        a_l[lane] = av; w_l[lane] = wlast;
        WAVE_FENCE();
        bf16x8 Vb[4];
#pragma unroll
        for (int ks = 0; ks < 4; ++ks)
#pragma unroll
            for (int j = 0; j < 8; ++j) Vb[ks][j] = (short)vbase[(16 * ks + 8 * (j >> 2) + (j & 3)) * VP];
        __builtin_amdgcn_sched_barrier(0);
        f32x16 num[2]; float dpv[2];
#pragma unroll
        for (int nt = 0; nt < 2; ++nt) {
            f32x16 PT[2];
#pragma unroll
            for (int ms = 0; ms < 2; ++ms)
#pragma unroll
                for (int j = 0; j < 16; ++j) PT[ms][j] = 0.f;
#pragma unroll
            for (int ks = 0; ks < 4; ++ks) {
                const bf16x8 bq = *(const bf16x8*)(qb + (size_t)(nt * 32 + r) * NPROJ + ks * 16 + hh * 8);
#pragma unroll
                for (int ms = 0; ms < 2; ++ms) { const bf16x8 ak = *(const LAS bf16x8*)(krow + ms * 32 * KP + ks * 16); PT[ms] = MFMA32(ak, bq, PT[ms]); }
            }
            const float Mtn = __shfl(Mt, nt * 32 + r);
            float dp = 0.f;
#pragma unroll
            for (int ms = 0; ms < 2; ++ms)
#pragma unroll
                for (int g = 0; g < 4; ++g) { const f32x4 a4 = *(const LAS f32x4*)(a4b + ms * 32 + 8 * g);
#pragma unroll
                    for (int jj = 0; jj < 4; ++jj) { const int i = 4 * g + jj; const int s = ms * 32 + 8 * g + 4 * hh + jj;
                        const float wv = (s <= nt * 32 + r) ? __expf(a4[jj] - Mtn) * 0.125f : 0.f;
                        PT[ms][i] *= wv; dp += PT[ms][i]; } }
            dp += __shfl_xor(dp, 32); dpv[nt] = dp;
#pragma unroll
            for (int j = 0; j < 16; ++j) num[nt][j] = 0.f;
#pragma unroll
            for (int ks = 0; ks < 4; ++ks) num[nt] = MFMA32(pack16(PT[ks >> 1], ks & 1), Vb[ks], num[nt]);
            __builtin_amdgcn_sched_barrier(0);
        }
        const float den = (lane < 32 ? dpv[0] : dpv[1]) + sct * qn;
        const float inv = 1.f / fmaxf(fabsf(den), expf(-(bc + Mt)));
        sc_l[lane] = sct; inv_l[lane] = inv;
        WAVE_FENCE();
        { bf16x8 Cb[4];
#pragma unroll
          for (int kd = 0; kd < 4; ++kd) Cb[kd] = pack16(C[kd >> 1], kd & 1);
#pragma unroll
          for (int mt = 0; mt < 2; ++mt) { f32x16 qc;
#pragma unroll
              for (int j = 0; j < 16; ++j) qc[j] = 0.f;
#pragma unroll
              for (int kd = 0; kd < 4; ++kd) { const bf16_t* qr = qb + (size_t)(mt * 32 + r) * NPROJ + 16 * kd + 4 * hh;
                  const s16x4 lo = *(const s16x4*)qr, hi = *(const s16x4*)(qr + 8);
                  const bf16x8 a = __builtin_shufflevector(lo, hi, 0, 1, 2, 3, 4, 5, 6, 7);
                  qc = MFMA32(a, Cb[kd], qc); }
#pragma unroll
              for (int g = 0; g < 4; ++g) { const f32x4 s4 = *(const LAS f32x4*)(a4b + 128 + mt * 32 + 8 * g), i4 = *(const LAS f32x4*)(a4b + 192 + mt * 32 + 8 * g);
#pragma unroll
                  for (int jj = 0; jj < 4; ++jj) { const int i = 4 * g + jj; const float hv = (num[mt][i] + s4[jj] * qc[i]) * i4[jj];
                      yo[(t0 + mt * 32 + 8 * g + 4 * hh + jj) * 512 + h * 128 + sl * 32 + r] = f2bf(hv); } }
              __builtin_amdgcn_sched_barrier(0);
          } }
#pragma unroll
        for (int i = 0; i < 2; ++i) {
#pragma unroll
            for (int j = 0; j < 16; ++j) C[i][j] *= sclast;
#pragma unroll
            for (int ks = 0; ks < 4; ++ks) { const f32x4 wA = *(const LAS f32x4*)(a4b + 64 + 16 * ks), wB = *(const LAS f32x4*)(a4b + 64 + 16 * ks + 8);
                f32x8 kv;
#pragma unroll
                for (int j = 0; j < 8; ++j) kv[j] = bf2f(kbase[(16 * ks + 8 * (j >> 2) + (j & 3)) * KP + i * 32]) * (j < 4 ? wA[j & 3] : wB[j & 3]);
                C[i] = MFMA32(pack8v(kv), Vb[ks], C[i]); }
            __builtin_amdgcn_sched_barrier(0);
        }
        { float na = 0.f;
#pragma unroll 8
          for (int s = 0; s < 64; ++s) na += w_l[s] * bf2f(Kl[s * KP + lane_v]);
          nst = sclast * nst + na; }
        mprev = bc63 + M63;
    }
    float* co = c.out + O_MLC_P + ((size_t)(L * NB + b) * 4 + h) * 64 * 128;
#pragma unroll
    for (int i = 0; i < 2; ++i)
#pragma unroll
        for (int j = 0; j < 16; ++j) co[(size_t)(i * 32 + crow(j, hh)) * 128 + sl * 32 + r] = C[i][j];
    if (sl == 0) { c.out[O_MLN_P + ((size_t)(L * NB + b) * 4 + h) * 64 + lane] = nst; if (lane == 0) c.out[O_MLM_P + (size_t)(L * NB + b) * 4 + h] = mprev; }
}

DI void task_gdn_sample(const Ctx& c, int L, int unit) {
    const int half = unit & 1, h = (unit >> 1) & 3, b = unit >> 3, lane = c.lane;
    const size_t row = (size_t)(MP + b);
    const bf16_t* pr = c.R1 + row * NPROJ;
    const float* cbuf = c.in[4] + ((size_t)L * MS + b) * 3 * 1536;
    const float* cw = c.in[23] + (size_t)L * 4 * 1536;
    float* cout = c.out + O_CONV_S + ((size_t)L * MS + b) * 3 * 1536;
    float qv[2], kv[2], vv;
#pragma unroll
    for (int w = 0; w < 5; ++w) {
        const int which = w < 2 ? 0 : w < 4 ? 1 : 2; const int d = (w == 4) ? half * 64 + lane : lane + 64 * (w & 1);
        const int cc = which * 512 + h * 128 + d;
        const float xin = bf2f(pr[PQ + cc]);
        const float b0 = cbuf[cc], b1 = cbuf[1536 + cc], b2 = cbuf[3072 + cc];
        float a = b0 * cw[cc] + b1 * cw[1536 + cc] + b2 * cw[3072 + cc] + xin * cw[4608 + cc];
        a = silu_(a);
        cout[cc] = b1; cout[1536 + cc] = b2; cout[3072 + cc] = xin;
        if (w < 2) qv[w] = a; else if (w < 4) kv[w - 2] = a; else vv = a;
    }
    { const float sq = wave_sum(qv[0] * qv[0] + qv[1] * qv[1]), sk = wave_sum(kv[0] * kv[0] + kv[1] * kv[1]);
      const float fq = rsqrtf(sq + EPS) * 0.08838834764831845f, fk = rsqrtf(sk + EPS);
      qv[0] *= fq; qv[1] *= fq; kv[0] *= fk; kv[1] *= fk; }
    const float qk = wave_sum(qv[0] * kv[0] + qv[1] * kv[1]);
    const float beta = sigm(c.SG[row * 16 + h]);
    const float g = -expf(c.in[24][L * 4 + h]) * softplus_(c.SG[row * 16 + 4 + h] + c.in[25][L * 4 + h]);
    const float eg = expf(g);
    const float* sin_ = c.in[5] + (((size_t)L * MS + b) * 4 + h) * 128 * 128 + half * 64 + lane;
    float* sout = c.out + O_GDN_S + (((size_t)L * MS + b) * 4 + h) * 128 * 128 + half * 64 + lane;
    float kS = 0.f, qS = 0.f;
#pragma unroll
    for (int hf = 0; hf < 2; ++hf) { const float kh = kv[hf], qh = qv[hf];
#pragma unroll 8
        for (int d = 0; d < 64; ++d) { const float sv = sin_[(size_t)(hf * 64 + d) * 128]; kS += __shfl(kh, d) * sv; qS += __shfl(qh, d) * sv; } }
    const float vnew = beta * (vv - eg * kS);
    const float o = eg * qS + qk * vnew;
#pragma unroll
    for (int hf = 0; hf < 2; ++hf) { const float kh = kv[hf];
#pragma unroll 8
        for (int d = 0; d < 64; ++d) { const float sv = sin_[(size_t)(hf * 64 + d) * 128]; sout[(size_t)(hf * 64 + d) * 128] = sv * eg + __shfl(kh, d) * vnew; } }
    c.Y3[(size_t)1 * MPAD * 512 + row * 512 + h * 128 + half * 64 + lane] = f2bf(o);
}
DI void task_ml_sample(const Ctx& c, int L, int unit) {
    const int half = unit & 1, h = (unit >> 1) & 3, b = unit >> 3, lane = c.lane;
    const size_t row = (size_t)(MP + b);
    const bf16_t* pr = c.R1 + row * NPROJ;
    const float q = bf2f(pr[PMQ + h * 64 + lane]), k = bf2f(pr[PMK + h * 64 + lane]) * 0.125f, v = bf2f(pr[PMV + h * 128 + half * 64 + lane]);
    const float li = softcap_(c.SG[row * 16 + 8 + h] + c.in[27][L * 4 + h]);
    const float lf = logsig_(softcap_(c.SG[row * 16 + 12 + h] + c.in[28][L * 4 + h]));
    const size_t sidx = ((size_t)L * MS + b) * 4 + h;
    const float m0 = c.in[8][sidx];
    const float mt = fmaxf(lf + m0, li), wts = expf(li - mt), sc = expf(lf + m0 - mt);
    const float n0 = c.in[7][sidx * 64 + lane];
    const float sqk = wave_sum(q * k) * wts, qn = wave_sum(q * n0);
    const float* cin = c.in[6] + sidx * 64 * 128 + half * 64 + lane;
    float* cout = c.out + O_MLC_S + sidx * 64 * 128 + half * 64 + lane;
    float cc[64]; float qC = 0.f;
#pragma unroll
    for (int d = 0; d < 64; ++d) { cc[d] = cin[(size_t)d * 128]; qC += __shfl(q, d) * cc[d]; }
    const float num = sqk * v + sc * qC, den = sqk + sc * qn;
    const float hv = num / fmaxf(fabsf(den), expf(-mt));
#pragma unroll
    for (int d = 0; d < 64; ++d) cout[(size_t)d * 128] = sc * cc[d] + wts * __shfl(k, d) * v;
    if (half == 0) { c.out[O_MLN_S + sidx * 64 + lane] = sc * n0 + wts * k; if (lane == 0) c.out[O_MLM_S + sidx] = mt; }
    c.Y3[(size_t)2 * MPAD * 512 + row * 512 + h * 128 + half * 64 + lane] = f2bf(hv);
}
struct S5P { float lr, li; f32x2 bb[16]; };
DI S5P s5_params(const Ctx& c, int L, int g, int p) {
    S5P P; const size_t gp = ((size_t)L * 32 + g) * 64 + p;
    const float are = c.in[13][gp], aim = c.in[14][gp], dt = expf(c.in[15][L * 32 + g]);
    const float mag = expf(are * dt); P.lr = mag * cosf(aim * dt); P.li = mag * sinf(aim * dt);
    const float inv = 1.f / (are * are + aim * aim), zr = P.lr - 1.f, zi = P.li;
    const float fre = (zr * are + zi * aim) * inv, fim = (zi * are - zr * aim) * inv;
    const float* Bre = c.in[16] + gp * 16; const float* Bim = c.in[17] + gp * 16;
#pragma unroll
    for (int q4 = 0; q4 < 4; ++q4) { const f32x4 br = *(const f32x4*)(Bre + 4 * q4), bi = *(const f32x4*)(Bim + 4 * q4);
#pragma unroll
        for (int e = 0; e < 4; ++e) { P.bb[4 * q4 + e][0] = fre * br[e] - fim * bi[e]; P.bb[4 * q4 + e][1] = fre * bi[e] + fim * br[e]; } }
    return P;
}
DI void task_s5_sample(const Ctx& c, int L, int unit) {
    const int g = unit & 31, b = unit >> 5, lane = c.lane;
    const S5P P = s5_params(c, L, g, lane);
    const size_t row = (size_t)(MP + b);
    const bf16_t* pr = c.R1 + row * NPROJ + PU + g * 16;
    float u[16];
    { const f32x8 u0 = unpack8(*(const bf16x8*)pr), u1 = unpack8(*(const bf16x8*)(pr + 8));
#pragma unroll
      for (int e = 0; e < 8; ++e) { u[e] = u0[e]; u[8 + e] = u1[e]; } }
    f32x2 bu = {0.f, 0.f};
#pragma unroll
    for (int cc = 0; cc < 16; ++cc) bu += P.bb[cc] * u[cc];
    const size_t si = (((size_t)L * MS + b) * 32 + g) * 64 + lane;
    const float h0r = c.in[2][si], h0i = c.in[3][si];
    const float hr = P.lr * h0r - P.li * h0i + bu[0], hi = P.lr * h0i + P.li * h0r + bu[1];
    c.out[O_S5RE_S + si] = hr; c.out[O_S5IM_S + si] = hi;
    const float* Cre = c.in[18] + ((size_t)L * 32 + g) * 16 * 64; const float* Cim = c.in[19] + ((size_t)L * 32 + g) * 16 * 64;
    float mine = 0.f;
#pragma unroll
    for (int cc = 0; cc < 16; ++cc) { const float y = wave_sum(hr * Cre[cc * 64 + lane] - hi * Cim[cc * 64 + lane]); mine = (lane == cc) ? y : mine; }
    if (lane < 16) { const float y = mine + c.in[20][L * 512 + g * 16 + lane] * bf2f(pr[lane]);
        c.YS5[row * 512 + g * 16 + lane] = f2bf(gelu_t(y)); }
}

DI void phase_s5_scan(const Ctx& c, int L) {
    float* U = (float*)c.lds;
    bf16_t* H = (bf16_t*)(c.lds + 32768);
    float* F = (float*)(c.lds + 65536);
    const int lane = c.lane, w = c.wave;
    float* Uw = U + w * 1024; bf16_t* Hw = H + w * 2048;
    for (int unit = c.bid; unit < 256; unit += c.G) {
        const int g = unit & 31, b = unit >> 5;
        const S5P P = s5_params(c, L, g, lane);
        float pr_ = P.lr, pi_ = P.li;
#pragma unroll
        for (int i = 0; i < 8; ++i) { const float nr = pr_ * pr_ - pi_ * pi_, ni = 2.f * pr_ * pi_; pr_ = nr; pi_ = ni; }
        const size_t rbase = (size_t)(b * SEQ + w * 256);
        const bf16_t* ub = c.R1 + rbase * NPROJ + PU + g * 16;
        bf16x8 Cb[4];
        { const int cc = lane & 15, kq = (lane >> 4) * 8; const float* Cre = c.in[18] + (((size_t)L * 32 + g) * 16 + cc) * 64; const float* Cim = c.in[19] + (((size_t)L * 32 + g) * 16 + cc) * 64;
#pragma unroll
          for (int ks = 0; ks < 4; ++ks) { f32x8 v;
#pragma unroll
              for (int j = 0; j < 8; ++j) { const int k = ks * 32 + kq + j; v[j] = (k < 64) ? Cre[k] : -Cim[k - 64]; }
              Cb[ks] = pack8v(v); } }
        const float dskip = c.in[20][L * 512 + g * 16 + (lane & 15)];
        float hr = 0.f, hi = 0.f;
        for (int pass = 0; pass < 2; ++pass) {
            if (pass == 1) {
                F[w * 128 + lane] = hr; F[w * 128 + 64 + lane] = hi;
                __syncthreads();
                hr = 0.f; hi = 0.f;
                for (int v = 0; v < w; ++v) { const float fr = F[v * 128 + lane], fi = F[v * 128 + 64 + lane];
                    const float nr = pr_ * hr - pi_ * hi + fr, ni = pr_ * hi + pi_ * hr + fi; hr = nr; hi = ni; }
            }
            for (int sub = 0; sub < 4; ++sub) {
                __syncthreads();
                { const bf16_t* up = ub + (size_t)(sub * 64 + lane) * NPROJ; const f32x8 u0 = unpack8(*(const bf16x8*)up), u1 = unpack8(*(const bf16x8*)(up + 8));
                  f32x4* d = (f32x4*)(Uw + lane * 16);
                  d[0] = (f32x4){u0[0], u0[1], u0[2], u0[3]}; d[1] = (f32x4){u0[4], u0[5], u0[6], u0[7]}; d[2] = (f32x4){u1[0], u1[1], u1[2], u1[3]}; d[3] = (f32x4){u1[4], u1[5], u1[6], u1[7]}; }
                __syncthreads();
                for (int blk = 0; blk < 4; ++blk) {
#pragma unroll 4
                    for (int st = 0; st < 16; ++st) {
                        const f32x4* up4 = (const f32x4*)(Uw + (blk * 16 + st) * 16);
                        f32x2 bu = {0.f, 0.f};
#pragma unroll
                        for (int q4 = 0; q4 < 4; ++q4) { const f32x4 uv = up4[q4];
#pragma unroll
                            for (int e = 0; e < 4; ++e) bu += P.bb[4 * q4 + e] * uv[e]; }
                        const float nr = P.lr * hr - P.li * hi + bu[0], ni = P.lr * hi + P.li * hr + bu[1]; hr = nr; hi = ni;
                        if (pass == 1) { Hw[st * 128 + lane] = f2bf(hr); Hw[st * 128 + 64 + lane] = f2bf(hi); }
                    }
                    if (pass == 1) {
                        __syncthreads();
                        f32x4 acc = {0.f, 0.f, 0.f, 0.f};
#pragma unroll
                        for (int ks = 0; ks < 4; ++ks) { const bf16x8 a = *(const bf16x8*)(Hw + (lane & 15) * 128 + ks * 32 + (lane >> 4) * 8); acc = MFMA16(a, Cb[ks], acc); }
                        const int cc = lane & 15;
#pragma unroll
                        for (int j = 0; j < 4; ++j) { const int st = (lane >> 4) * 4 + j; const int tl = blk * 16 + st;
                            const float y = acc[j] + dskip * Uw[tl * 16 + cc];
                            c.YS5[(rbase + sub * 64 + tl) * 512 + g * 16 + cc] = f2bf(gelu_t(y)); }
                        __syncthreads();
                    }
                }
            }
        }
        if (w == 7) { const size_t si = (((size_t)L * NB + b) * 32 + g) * 64 + lane; c.out[O_S5RE_P + si] = hr; c.out[O_S5IM_P + si] = hi; }
        __syncthreads();
    }
}


#ifdef SELFCHK
DI void blk_reduce2(float& a, float& b, float* red, int tid) {
    a = wave_sum(a); b = wave_sum(b);
    __syncthreads();
    if ((tid & 63) == 0) { red[tid >> 6] = a; red[8 + (tid >> 6)] = b; }
    __syncthreads();
    float x = 0.f, y = 0.f;
    for (int i = 0; i < 8; ++i) { x += red[i]; y += red[8 + i]; }
    a = x; b = y; __syncthreads();
}
DI void chk_gdn(const Ctx& c, int L, int b, int h, float* dg) {
    float* q = (float*)c.lds; float* k = q + 128; float* v = k + 128; float* part = v + 128; float* red = part + 512; float* sc_ = red + 16;
    const int tid = c.tid, dv = tid & 127, qt = tid >> 7;
    const float* convw = c.in[23] + (size_t)L * 4 * 1536;
    float S[32];
#pragma unroll
    for (int i = 0; i < 32; ++i) S[i] = 0.f;
    float e2 = 0.f, r2 = 0.f;
    for (int t = 0; t < SEQ; ++t) {
        const size_t row = (size_t)b * SEQ + t;
        if (tid < 384) { const int which = tid >> 7, d = tid & 127; float a = 0.f;
            for (int j = 0; j < 4; ++j) { const int tt = t + j - 3; if (tt >= 0) a += bf2f(c.R1[((size_t)b * SEQ + tt) * NPROJ + PQ + which * 512 + h * 128 + d]) * convw[j * 1536 + which * 512 + h * 128 + d]; }
            (which == 0 ? q : which == 1 ? k : v)[d] = silu_(a); }
        __syncthreads();
        float sq = 0.f, sk = 0.f;
        for (int d = 0; d < 128; ++d) { sq += q[d] * q[d]; sk += k[d] * k[d]; }
        const float fq = rsqrtf(sq + EPS) * 0.08838834764831845f, fk = rsqrtf(sk + EPS);
        const float beta = sigm(c.SG[row * 16 + h]);
        const float g = -expf(c.in[24][L * 4 + h]) * softplus_(c.SG[row * 16 + 4 + h] + c.in[25][L * 4 + h]);
        const float eg = expf(g);
        float ks = 0.f;
#pragma unroll
        for (int i = 0; i < 32; ++i) { S[i] *= eg; ks += k[qt * 32 + i] * fk * S[i]; }
        part[qt * 128 + dv] = ks;
        __syncthreads();
        const float kS = part[dv] + part[128 + dv] + part[256 + dv] + part[384 + dv];
        const float vnew = beta * (v[dv] - kS);
        float qs = 0.f;
#pragma unroll
        for (int i = 0; i < 32; ++i) { S[i] += k[qt * 32 + i] * fk * vnew; qs += q[qt * 32 + i] * fq * S[i]; }
        __syncthreads();
        part[qt * 128 + dv] = qs;
        __syncthreads();
        if (qt == 0) { const float o = part[dv] + part[128 + dv] + part[256 + dv] + part[384 + dv];
            const float got = bf2f(c.Y3[(size_t)1 * MPAD * 512 + row * 512 + h * 128 + dv]); e2 += (got - o) * (got - o); r2 += o * o; }
        __syncthreads();
    }
    blk_reduce2(e2, r2, red, tid);
    if (tid == 0) dg[0] = sqrtf(e2 / (r2 + 1e-30f));
    float e3 = 0.f, r3 = 0.f;
#pragma unroll
    for (int i = 0; i < 32; ++i) { const float got = c.out[O_GDN_P + (((size_t)L * NB + b) * 4 + h) * 16384 + (size_t)(qt * 32 + i) * 128 + dv]; e3 += (got - S[i]) * (got - S[i]); r3 += S[i] * S[i]; }
    blk_reduce2(e3, r3, red, tid);
    if (tid == 0) dg[1] = sqrtf(e3 / (r3 + 1e-30f));
    (void)sc_;
}
DI void chk_ml(const Ctx& c, int L, int b, int h, float* dg) {
    float* q = (float*)c.lds; float* k = q + 64; float* v = k + 64; float* n = v + 128; float* part = n + 64; float* red = part + 512;
    const int tid = c.tid, e = tid & 127, qt = tid >> 7;
    float C[16];
#pragma unroll
    for (int i = 0; i < 16; ++i) C[i] = 0.f;
    if (tid < 64) n[tid] = 0.f;
    float m = 0.f, e2 = 0.f, r2 = 0.f;
    __syncthreads();
    for (int t = 0; t < SEQ; ++t) {
        const size_t row = (size_t)b * SEQ + t;
        if (tid < 64) { q[tid] = bf2f(c.R1[row * NPROJ + PMQ + h * 64 + tid]); k[tid] = bf2f(c.R1[row * NPROJ + PMK + h * 64 + tid]) * 0.125f; }
        else if (tid < 192) v[tid - 64] = bf2f(c.R1[row * NPROJ + PMV + h * 128 + tid - 64]);
        __syncthreads();
        const float li = softcap_(c.SG[row * 16 + 8 + h] + c.in[27][L * 4 + h]);
        const float lf = logsig_(softcap_(c.SG[row * 16 + 12 + h] + c.in[28][L * 4 + h]));
        const float mn = fmaxf(lf + m, li), wts = expf(li - mn), sc = expf(lf + m - mn);
        float qk = 0.f, qn = 0.f;
        for (int d = 0; d < 64; ++d) { qk += q[d] * k[d]; qn += q[d] * n[d]; }
        float pc = 0.f;
#pragma unroll
        for (int i = 0; i < 16; ++i) pc += q[qt * 16 + i] * C[i];
        part[qt * 128 + e] = pc;
        __syncthreads();
        const float qC = part[e] + part[128 + e] + part[256 + e] + part[384 + e];
        const float sqk = qk * wts, num = sqk * v[e] + sc * qC, den = sqk + sc * qn;
        const float hv = num / fmaxf(fabsf(den), expf(-mn));
        if (qt == 0) { const float got = bf2f(c.Y3[(size_t)2 * MPAD * 512 + row * 512 + h * 128 + e]); e2 += (got - hv) * (got - hv); r2 += hv * hv; }
#pragma unroll
        for (int i = 0; i < 16; ++i) C[i] = sc * C[i] + wts * k[qt * 16 + i] * v[e];
        __syncthreads();
        if (tid < 64) n[tid] = sc * n[tid] + wts * k[tid];
        m = mn;
        __syncthreads();
    }
    blk_reduce2(e2, r2, red, tid);
    if (tid == 0) dg[2] = sqrtf(e2 / (r2 + 1e-30f));
    float e3 = 0.f, r3 = 0.f;
#pragma unroll
    for (int i = 0; i < 16; ++i) { const float got = c.out[O_MLC_P + (((size_t)L * NB + b) * 4 + h) * 8192 + (size_t)(qt * 16 + i) * 128 + e]; e3 += (got - C[i]) * (got - C[i]); r3 += C[i] * C[i]; }
    if (tid < 64) { const float got = c.out[O_MLN_P + (((size_t)L * NB + b) * 4 + h) * 64 + tid]; e3 += (got - n[tid]) * (got - n[tid]) * 64.f; r3 += n[tid] * n[tid] * 64.f; }
    if (tid == 0) { const float got = c.out[O_MLM_P + ((size_t)L * NB + b) * 4 + h]; e3 += (got - m) * (got - m) * 4096.f; r3 += m * m * 4096.f; }
    blk_reduce2(e3, r3, red, tid);
    if (tid == 0) dg[3] = sqrtf(e3 / (r3 + 1e-30f));
}
DI void chk_s5(const Ctx& c, int L, int b, int g, float* dg) {
    float* red = (float*)c.lds;
    float e2 = 0.f, r2 = 0.f, e3 = 0.f, r3 = 0.f;
    if (c.tid < 64) { const int lane = c.tid; const S5P P = s5_params(c, L, g, lane);
        const float* Cre = c.in[18] + ((size_t)L * 32 + g) * 16 * 64; const float* Cim = c.in[19] + ((size_t)L * 32 + g) * 16 * 64;
        float hr = 0.f, hi = 0.f;
        for (int t = 0; t < SEQ; ++t) { const size_t row = (size_t)b * SEQ + t; const bf16_t* pr = c.R1 + row * NPROJ + PU + g * 16;
            f32x2 bu = {0.f, 0.f};
#pragma unroll
            for (int cc = 0; cc < 16; ++cc) bu += P.bb[cc] * bf2f(pr[cc]);
            const float nr = P.lr * hr - P.li * hi + bu[0], ni = P.lr * hi + P.li * hr + bu[1]; hr = nr; hi = ni;
            for (int cc = 0; cc < 16; ++cc) { float y = wave_sum(hr * Cre[cc * 64 + lane] - hi * Cim[cc * 64 + lane]) + c.in[20][L * 512 + g * 16 + cc] * bf2f(pr[cc]);
                y = gelu_t(y); const float got = bf2f(c.YS5[row * 512 + g * 16 + cc]); if (lane == 0) { e2 += (got - y) * (got - y); r2 += y * y; } } }
        const size_t si = (((size_t)L * NB + b) * 32 + g) * 64 + lane;
        e3 = (c.out[O_S5RE_P + si] - hr) * (c.out[O_S5RE_P + si] - hr) + (c.out[O_S5IM_P + si] - hi) * (c.out[O_S5IM_P + si] - hi); r3 = hr * hr + hi * hi; }
    blk_reduce2(e2, r2, red, c.tid);
    blk_reduce2(e3, r3, red, c.tid);
    if (c.tid == 0) { dg[4] = sqrtf(e2 / (r2 + 1e-30f)); dg[5] = sqrtf(e3 / (r3 + 1e-30f)); }
}
#endif


#ifdef SELFCHK
DI float dot_bf(const bf16_t* a, const bf16_t* b, int K) { float s = 0.f; for (int k = 0; k < K; ++k) s += bf2f(a[k]) * bf2f(b[k]); return s; }
DI void chk_gemm(const Ctx& c, int L, int mode, float* dgp) {
    float* red = (float*)c.lds;
    float e2 = 0.f, r2 = 0.f;
    for (int rep = 0; rep < 2; ++rep) {
        const int sidx = c.tid + 512 * rep;
        const int row = (rep == 1 && c.tid < 64) ? MP + (c.tid * 2) : (int)(((unsigned)sidx * 7919u) % (unsigned)MP);
        float want = 0.f, got = 0.f;
        if (mode == 0) { const int col = (int)(((unsigned)sidx * 104729u) % 4096u); want = dot_bf(c.XN + (size_t)row * 1024, c.W + WO_IN + (size_t)col * 1024, 1024); got = bf2f(c.R1[(size_t)row * 4096 + col]); }
        if (mode == 1) { const int col = (int)(((unsigned)sidx * 104729u) % 3072u); want = sigm(dot_bf(c.XN + (size_t)row * 1024, c.W + WO_G + (size_t)col * 1024, 1024)); got = bf2f(c.R1[(size_t)row * 4096 + col]); }
        if (mode == 2) { const int col = (int)(((unsigned)sidx * 104729u) % 512u); const float y = bf2f(c.YS5[(size_t)row * 512 + col]);
            want = y * sigm(dot_bf(c.YS5 + (size_t)row * 512, c.W + WO_GLU + (size_t)col * 512, 512) + c.in[22][L * 512 + col]); got = bf2f(c.Y3[(size_t)row * 512 + col]); }
        if (mode == 3) { const int col = (int)(((unsigned)sidx * 104729u) % 1024u);
            for (int br = 0; br < 3; ++br) want += bf2f(c.R1[(size_t)row * 4096 + br * 1024 + col]) * dot_bf(c.Y3 + (size_t)br * MPAD * 512 + (size_t)row * 512, c.W + WO_BR + (size_t)br * 1024 * 512 + (size_t)col * 512, 512);
            got = bf2f(c.XN[(size_t)row * 1024 + col]); }
        if (mode == 4) { const int col = (int)(((unsigned)sidx * 104729u) % 4096u); const float d = fmaxf(dot_bf(c.XN + (size_t)row * 1024, c.W + WO_UP + (size_t)col * 1024, 1024), 0.f); want = d * d; got = bf2f(c.R1[(size_t)row * 4096 + col]); }
        if (mode == 5) { const int col = (int)(((unsigned)sidx * 104729u) % 1024u); want = dot_bf(c.Y3 + (size_t)row * 256, c.W + WO_PLE + (size_t)col * 256, 256); got = bf2f(c.Y3[(size_t)MPAD * 256 + (size_t)row * 1024 + col]); }
        e2 += (got - want) * (got - want); r2 += want * want;
    }
    blk_reduce2(e2, r2, red, c.tid);
    if (c.tid == 0) *dgp = sqrtf(e2 / (r2 + 1e-30f));
}
#endif

#ifdef SELFCHK
DI void chk_sg(const Ctx& c, float* dgp) {
    float* red = (float*)c.lds; float e2 = 0.f, r2 = 0.f;
    { const int sidx = c.tid >> 4, s = c.tid & 15; const int row = (sidx < 8) ? MP + sidx * 13 : (int)(((unsigned)sidx * 7919u * 37u) % (unsigned)MP);
      const float* x = row < MP ? c.in[0] + (size_t)row * 1024 : c.in[1] + (size_t)(row - MP) * 1024;
      const int sc = s < 4 ? 2560 + s : s < 8 ? 2564 + (s - 4) : s < 12 ? 4104 + (s - 8) : 4108 + (s - 12);
      float ss = 0.f; for (int k = 0; k < 1024; ++k) ss += x[k] * x[k];
      const float rs = rsqrtf(ss * (1.f / 1024.f) + EPS); float a = 0.f;
      for (int k = 0; k < 1024; ++k) a += x[k] * rs * c.in[11][k] * c.in[12][(size_t)k * DIN + sc];
      const float got = c.SG[(size_t)row * 16 + s]; e2 = (got - a) * (got - a); r2 = a * a; }
    blk_reduce2(e2, r2, red, c.tid);
    if (c.tid == 0) *dgp = sqrtf(e2 / (r2 + 1e-30f));
}
DI void chk_post(const Ctx& c, int L, float* dgp) {
    float* red = (float*)c.lds; float e2 = 0.f, r2 = 0.f;
    { const int hd8 = c.tid & 7, sidx = c.tid >> 3; const int row = (sidx < 8) ? MP + sidx * 11 : (int)(((unsigned)sidx * 7919u * 53u) % (unsigned)MP);
      const int br = hd8 >> 2, hd = hd8 & 3; float ms = 0.f;
      for (int e = 0; e < 128; ++e) { const float y = bf2f(c.Y3[(size_t)(1 + br) * MPAD * 512 + (size_t)row * 512 + hd * 128 + e]);
          const float z = bf2f(c.R1[(size_t)row * NPROJ + (br == 0 ? PZ : PMO) + hd * 128 + e]);
          const float gn = br == 0 ? c.in[26][L * 128 + e] : c.in[29][L * 512 + hd * 128 + e];
          const float w = y / (gn * (br == 0 ? silu_(z) : sigm(z))); ms += w * w; }
      ms *= (1.f / 128.f); e2 = (ms - 1.f) * (ms - 1.f); r2 = 1.f; }
    blk_reduce2(e2, r2, red, c.tid);
    if (c.tid == 0) *dgp = sqrtf(e2 / (r2 + 1e-30f));
}
DI void chk_res(const Ctx& c, int L, int mode, const float (&snap)[2], float* dgp) {
    float* red = (float*)c.lds; float e2 = 0.f, r2 = 0.f;
    for (int rep = 0; rep < 2; ++rep) { const int sidx = c.tid + 512 * rep;
        const int row = (rep == 1 && c.tid < 64) ? MP + (c.tid * 2) : (int)(((unsigned)sidx * 7919u) % (unsigned)MP); const int col = (int)(((unsigned)sidx * 104729u) % 1024u);
        const float now = c.out[(size_t)row * 1024 + col]; float before = snap[rep], want = 0.f;
        if (mode == 0) { before = row < MP ? c.in[0][(size_t)row * 1024 + col] : c.in[1][(size_t)(row - MP) * 1024 + col]; want = dot_bf(c.XN + (size_t)row * 1024, c.W + WO_OUT + (size_t)col * 1024, 1024); }
        if (mode == 1) want = dot_bf(c.R1 + (size_t)row * 4096, c.W + WO_DN + (size_t)col * 4096, 4096);
        if (mode == 2) want = bf2f(c.Y3[(size_t)MPAD * 256 + (size_t)row * 1024 + col]) * sigm(dot_bf(c.XN + (size_t)row * 1024, c.W + WO_PG + (size_t)col * 1024, 1024));
        e2 += (now - before - want) * (now - before - want); r2 += want * want; }
    blk_reduce2(e2, r2, red, c.tid);
    if (c.tid == 0) *dgp = sqrtf(e2 / (r2 + 1e-30f));
}
DI void snap_x(const Ctx& c, float (&snap)[2]) {
    for (int rep = 0; rep < 2; ++rep) { const int sidx = c.tid + 512 * rep;
        const int row = (rep == 1 && c.tid < 64) ? MP + (c.tid * 2) : (int)(((unsigned)sidx * 7919u) % (unsigned)MP); const int col = (int)(((unsigned)sidx * 104729u) % 1024u);
        snap[rep] = c.out[(size_t)row * 1024 + col]; }
}
DI void chk_sample(const Ctx& c, int L, int b, int h, float* dgp) {
    float* red = (float*)c.lds; float e2 = 0.f, r2 = 0.f, e3 = 0.f, r3 = 0.f;
    const size_t row = (size_t)(MP + b); const bf16_t* pr = c.R1 + row * NPROJ;
    if (c.tid < 128) { const int dv = c.tid;
        const float* cbuf = c.in[4] + ((size_t)L * MS + b) * 3 * 1536; const float* cw = c.in[23] + (size_t)L * 4 * 1536;
        float sq = 0.f, sk = 0.f;
        for (int d = 0; d < 128; ++d) for (int w = 0; w < 2; ++w) { const int cc = w * 512 + h * 128 + d;
            const float a = silu_(cbuf[cc] * cw[cc] + cbuf[1536 + cc] * cw[1536 + cc] + cbuf[3072 + cc] * cw[3072 + cc] + bf2f(pr[PQ + cc]) * cw[4608 + cc]); if (w == 0) sq += a * a; else sk += a * a; }
        const float fq = rsqrtf(sq + EPS) * 0.08838834764831845f, fk = rsqrtf(sk + EPS);
        const int cv = 1024 + h * 128 + dv;
        const float vv = silu_(cbuf[cv] * cw[cv] + cbuf[1536 + cv] * cw[1536 + cv] + cbuf[3072 + cv] * cw[3072 + cv] + bf2f(pr[PQ + cv]) * cw[4608 + cv]);
        const float beta = sigm(c.SG[row * 16 + h]), eg = expf(-expf(c.in[24][L * 4 + h]) * softplus_(c.SG[row * 16 + 4 + h] + c.in[25][L * 4 + h]));
        const float* S0 = c.in[5] + (((size_t)L * MS + b) * 4 + h) * 16384; const float* S1 = c.out + O_GDN_S + (((size_t)L * MS + b) * 4 + h) * 16384;
        float kS = 0.f, qS = 0.f, qk = 0.f;
        for (int d = 0; d < 128; ++d) { const int cq = h * 128 + d, ck = 512 + h * 128 + d;
            const float qd = silu_(cbuf[cq] * cw[cq] + cbuf[1536 + cq] * cw[1536 + cq] + cbuf[3072 + cq] * cw[3072 + cq] + bf2f(pr[PQ + cq]) * cw[4608 + cq]) * fq;
            const float kd = silu_(cbuf[ck] * cw[ck] + cbuf[1536 + ck] * cw[1536 + ck] + cbuf[3072 + ck] * cw[3072 + ck] + bf2f(pr[PQ + ck]) * cw[4608 + ck]) * fk;
            kS += kd * S0[d * 128 + dv]; qS += qd * S0[d * 128 + dv]; qk += qd * kd; }
        const float vnew = beta * (vv - eg * kS);
        for (int d = 0; d < 128; ++d) { const int ck = 512 + h * 128 + d;
            const float kd = silu_(cbuf[ck] * cw[ck] + cbuf[1536 + ck] * cw[1536 + ck] + cbuf[3072 + ck] * cw[3072 + ck] + bf2f(pr[PQ + ck]) * cw[4608 + ck]) * fk;
            const float want = S0[d * 128 + dv] * eg + kd * vnew, got = S1[d * 128 + dv]; e2 += (got - want) * (got - want); r2 += want * want; }
        (void)qS; (void)qk;
    } else if (c.tid < 256) { const int e = c.tid - 128;
        const size_t sidx = ((size_t)L * MS + b) * 4 + h;
        const float li = softcap_(c.SG[row * 16 + 8 + h] + c.in[27][L * 4 + h]), lf = logsig_(softcap_(c.SG[row * 16 + 12 + h] + c.in[28][L * 4 + h]));
        const float m0 = c.in[8][sidx], mt = fmaxf(lf + m0, li), wts = expf(li - mt), sc = expf(lf + m0 - mt);
        const float v = bf2f(pr[PMV + h * 128 + e]);
        for (int d = 0; d < 64; ++d) { const float k = bf2f(pr[PMK + h * 64 + d]) * 0.125f;
            const float want = sc * c.in[6][sidx * 8192 + d * 128 + e] + wts * k * v, got = c.out[O_MLC_S + sidx * 8192 + d * 128 + e]; e3 += (got - want) * (got - want); r3 += want * want; }
        if (e < 64) { const float k = bf2f(pr[PMK + h * 64 + e]) * 0.125f; const float want = sc * c.in[7][sidx * 64 + e] + wts * k, got = c.out[O_MLN_S + sidx * 64 + e]; e3 += 64.f * (got - want) * (got - want); r3 += 64.f * want * want; }
        if (e == 0) { const float got = c.out[O_MLM_S + sidx]; e3 += 4096.f * (got - mt) * (got - mt); r3 += 4096.f * mt * mt; }
    }
    blk_reduce2(e2, r2, red, c.tid);
    blk_reduce2(e3, r3, red, c.tid);
    if (c.tid == 0) { dgp[0] = sqrtf(e2 / (r2 + 1e-30f)); dgp[1] = sqrtf(e3 / (r3 + 1e-30f)); }
}
#endif
DI void phase_conv_state(const Ctx& c, int L) {
    for (int idx = c.bid * 512 + c.tid; idx < NB * 3 * 1536; idx += c.G * 512) { const int cc = idx % 1536, j = (idx / 1536) % 3, b = idx / (3 * 1536);
        c.out[O_CONV_P + ((size_t)L * NB + b) * 3 * 1536 + j * 1536 + cc] = bf2f(c.R1[(size_t)(b * SEQ + SEQ - 3 + j) * NPROJ + PQ + cc]); }
}
DI void phase_post(const Ctx& c, int L) {
    const int lane = c.lane, hd = lane >> 4, e0 = (lane & 15) * 8;
    bf16_t* yg = c.Y3 + (size_t)1 * MPAD * 512; bf16_t* ym = c.Y3 + (size_t)2 * MPAD * 512;
    const float* gg = c.in[26] + (size_t)L * 128 + e0; const float* gm = c.in[29] + (size_t)L * 512 + hd * 128 + e0;
    for (int row = c.bid * 8 + c.wave; row < MR; row += c.G * 8) {
        const bf16_t* pr = c.R1 + (size_t)row * NPROJ;
#pragma unroll
        for (int br = 0; br < 2; ++br) {
            bf16_t* yp = (br == 0 ? yg : ym) + (size_t)row * 512 + hd * 128 + e0;
            f32x8 o = unpack8(*(const bf16x8*)yp); const f32x8 z = unpack8(*(const bf16x8*)(pr + (br == 0 ? PZ : PMO) + hd * 128 + e0));
            float ss = 0.f;
#pragma unroll
            for (int e = 0; e < 8; ++e) ss += o[e] * o[e];
            ss += __shfl_xor(ss, 1); ss += __shfl_xor(ss, 2); ss += __shfl_xor(ss, 4); ss += __shfl_xor(ss, 8);
            const float rs = rsqrtf(ss * (1.f / 128.f) + EPS);
            const float* gp = br == 0 ? gg : gm;
#pragma unroll
            for (int e = 0; e < 8; ++e) o[e] = o[e] * rs * gp[e] * (br == 0 ? silu_(z[e]) : sigm(z[e]));
            *(bf16x8*)yp = pack8v(o);
        }
    }
}

DI void phase_cvt_ple(const Ctx& c, int L) {
    bf16_t* PB = c.Y3;
    for (size_t i = (size_t)c.bid * 512 + c.tid; i < (size_t)MR * 256; i += (size_t)c.G * 512) {
        const f32x4 v = *(const f32x4*)(c.out + i * 4); *(s16x4*)(c.XN + i * 4) = pack4v(v); }
    for (size_t i = (size_t)c.bid * 512 + c.tid; i < (size_t)MR * 64; i += (size_t)c.G * 512) {
        const size_t row = i >> 6, c4 = (i & 63) * 4;
        const float* src = row < MP ? c.in[9] + ((size_t)L * MP + row) * 256 + c4 : c.in[10] + ((size_t)L * MS + (row - MP)) * 256 + c4;
        *(s16x4*)(PB + row * 256 + c4) = pack4v(*(const f32x4*)src); }
}
DI void phase_final_norm(const Ctx& c) {
    const float* gain = c.in[39];
    for (int row = c.bid * 8 + c.wave; row < MR; row += c.G * 8) {
        float* xp = c.out + (size_t)row * 1024; f32x4 x[4]; float ss = 0.f;
#pragma unroll
        for (int i = 0; i < 4; ++i) { x[i] = *(const f32x4*)(xp + c.lane * 4 + 256 * i); ss += x[i][0] * x[i][0] + x[i][1] * x[i][1] + x[i][2] * x[i][2] + x[i][3] * x[i][3]; }
        ss = wave_sum(ss); const float rs = rsqrtf(ss * (1.f / 1024.f) + EPS);
#pragma unroll
        for (int i = 0; i < 4; ++i) { const f32x4 g = *(const f32x4*)(gain + c.lane * 4 + 256 * i); *(f32x4*)(xp + c.lane * 4 + 256 * i) = x[i] * rs * g; }
    }
}

__global__ void __launch_bounds__(512, 2) fwd_megakernel(KP kp) {
    extern __shared__ __attribute__((aligned(16))) unsigned char lds[];
    cg::grid_group grid = cg::this_grid();
    Ctx c; c.lds = lds; c.G = gridDim.x; c.bid = blockIdx.x;
    const ka_t ka0 = (ka_t)__builtin_amdgcn_kernarg_segment_ptr();
    (void)kp;
#define REFRESH() do { ka_t ka_ = ka0; asm volatile("" : "+s"(ka_)); int t_ = threadIdx.x; asm volatile("" : "+v"(t_)); \
        c.in.ka = ka_; c.out = (float*)ka_[40]; unsigned char* w_ = (unsigned char*)ka_[41]; c.ws = w_; \
        c.R1 = (bf16_t*)(w_ + WS_R1); c.XN = (bf16_t*)(w_ + WS_XN); c.Y3 = (bf16_t*)(w_ + WS_Y3); c.W = (bf16_t*)(w_ + WS_W); c.YS5 = (bf16_t*)(w_ + WS_YS5); \
        c.GS = w_ + WS_GS; c.SG = (float*)(w_ + WS_SG); c.GL = (float*)(w_ + WS_GL); \
        c.tid = t_; c.lane = t_ & 63; c.wave = __builtin_amdgcn_readfirstlane(t_ >> 6); \
        int b_ = blockIdx.x, g_ = gridDim.x; asm volatile("" : "+s"(b_), "+s"(g_)); c.bid = b_; c.G = g_; } while (0)
    REFRESH();
#ifndef PHMASK
#define PHMASK 0xFFFFFFFFu
#endif
#define PH(n) if (PHMASK & (1 << (n)))
    for (int L = 0; L < 2; ++L) {
        REFRESH(); PH(0) phase_weights(c, L);
        REFRESH(); PH(1) phase_rmsnorm<0>(c, L);
        grid.sync();
        REFRESH(); PH(2) run_gemm(c, c.XN, c.W + WO_IN, NPROJ, 1024, FStore{c.R1, NPROJ});
        grid.sync();
        REFRESH(); phase_conv_state(c, L);
        REFRESH(); PH(3) phase_gdn_prep(c, L);
        REFRESH(); PH(4) phase_s5_scan(c, L);
        grid.sync();
        if (c.wave == 0) {
            for (int u = c.bid; u < 256; u += c.G) { REFRESH(); if (u < 128) { PH(5) task_gdn_seq(c, L, u); } else { PH(6) task_ml_seq(c, L, u - 128, (float*)lds); } }
        } else {
            const int wid = c.bid * 7 + (c.wave - 1), nw = c.G * 7;
            REFRESH(); PH(7) for (int u = wid; u < 1024; u += nw) task_gdn_sample(c, L, u);
            REFRESH(); PH(8) for (int u = wid; u < 1024; u += nw) task_ml_sample(c, L, u);
            REFRESH(); PH(9) for (int u = wid; u < 4096; u += nw) task_s5_sample(c, L, u);
        }
        grid.sync();
#ifdef SELFCHK
        if (L == SELFCHK_L) { REFRESH(); if (c.bid == 0) { float* dg = (float*)(c.ws + WS_GL) + 1024; chk_gdn(c, L, 1, 2, dg); chk_ml(c, L, 1, 2, dg); chk_s5(c, L, 1, 7, dg); chk_gemm(c, L, 0, dg + 6); if (L == 0) chk_sg(c, dg + 12); chk_sample(c, L, 5, 1, dg + 17); } grid.sync(); }
#endif
        REFRESH(); PH(10) phase_post(c, L);
        REFRESH(); PH(11) run_gemm(c, c.XN, c.W + WO_G, NGATE, 1024, FSig{c.R1, NPROJ});
        REFRESH(); PH(12) run_gemm(c, c.YS5, c.W + WO_GLU, 512, 512, FGlu{c.YS5, c.in[22] + (size_t)L * 512, c.Y3});
        grid.sync();
#ifdef SELFCHK
        if (L == SELFCHK_L) { REFRESH(); if (c.bid == 0) { float* dg = (float*)(c.ws + WS_GL) + 1024; chk_gemm(c, L, 1, dg + 7); chk_gemm(c, L, 2, dg + 8); chk_post(c, L, dg + 13); } grid.sync(); }
#endif
        REFRESH(); PH(13) for (int br = 0; br < 3; ++br)
            run_gemm(c, c.Y3 + (size_t)br * MPAD * 512, c.W + WO_BR + (size_t)br * 1024 * 512, 1024, 512, FBranch{c.R1 + br * 1024, c.XN, br == 0 ? 1 : 0});
        grid.sync();
#ifdef SELFCHK
        if (L == SELFCHK_L) { REFRESH(); if (c.bid == 0) { float* dg = (float*)(c.ws + WS_GL) + 1024; chk_gemm(c, L, 3, dg + 9); } grid.sync(); }
#endif
        REFRESH(); PH(14) run_gemm(c, c.XN, c.W + WO_OUT, 1024, 1024, FRes{c.out});
        grid.sync();
#ifdef SELFCHK
        if (L == 0 && SELFCHK_L == 0) { REFRESH(); if (c.bid == 0) { float* dg = (float*)(c.ws + WS_GL) + 1024; float sn[2] = {0.f, 0.f}; chk_res(c, L, 0, sn, dg + 14); } grid.sync(); }
#endif
        REFRESH(); PH(15) phase_rmsnorm<1>(c, L);
        grid.sync();
        REFRESH(); PH(16) run_gemm(c, c.XN, c.W + WO_UP, DFF, 1024, FRelu2{c.R1});
        grid.sync();
#ifdef SELFCHK
        if (L == SELFCHK_L) { REFRESH(); if (c.bid == 0) { float* dg = (float*)(c.ws + WS_GL) + 1024; chk_gemm(c, L, 4, dg + 10); } grid.sync(); }
#endif
#ifdef SELFCHK
        float snp[2] = {0.f, 0.f}; REFRESH(); if (L == SELFCHK_L && c.bid == 0) snap_x(c, snp);
#endif
        REFRESH(); PH(17) run_gemm(c, c.R1, c.W + WO_DN, 1024, 4096, FRes{c.out});
        grid.sync();
#ifdef SELFCHK
        if (L == SELFCHK_L) { REFRESH(); if (c.bid == 0) { float* dg = (float*)(c.ws + WS_GL) + 1024; chk_res(c, L, 1, snp, dg + 15); } grid.sync(); }
#endif
        REFRESH(); PH(18) phase_cvt_ple(c, L);
        grid.sync();
#ifdef SELFCHK
        REFRESH(); if (L == SELFCHK_L && c.bid == 0) snap_x(c, snp);
#endif
        REFRESH(); PH(19) run_gemm(c, c.Y3, c.W + WO_PLE, 1024, 256, FStore{c.Y3 + (size_t)MPAD * 256, 1024});
        REFRESH(); PH(20) run_gemm(c, c.XN, c.W + WO_PG, 1024, 1024, FPle{c.Y3 + (size_t)MPAD * 256, c.out});
        grid.sync();
#ifdef SELFCHK
        if (L == SELFCHK_L) { REFRESH(); if (c.bid == 0) { float* dg = (float*)(c.ws + WS_GL) + 1024; chk_gemm(c, L, 5, dg + 11); chk_res(c, L, 2, snp, dg + 16); } grid.sync(); }
#endif
    }
    REFRESH(); phase_final_norm(c);
#ifdef SELFCHK
    grid.sync(); REFRESH();
    if (c.bid == 0 && c.tid == 0) { const float* dg = (const float*)(c.ws + WS_GL) + 1024; int kk = -1; float dv = 0.f;
        for (int i = 18; i >= 0; --i) if (dg[i] > SELFCHK_THR) { kk = i; dv = dg[i]; }
        if (kk >= 0) c.out[0] = __powf(10.f, (float)(2 * kk + 4)) * (1.f + fminf(dv, 8.f)); }
#endif
}

extern "C" void kernel_launch(void* const* d_in, const int* in_sizes, int n_in, void* d_out, int out_size, void* d_ws, size_t ws_size, hipStream_t stream) {
    static int grid = 0;
    if (grid == 0) {
        int dev = 0, cus = 0, per_cu = 0;
        if (hipGetDevice(&dev) != hipSuccess || hipDeviceGetAttribute(&cus, hipDeviceAttributeMultiprocessorCount, dev) != hipSuccess) { fprintf(stderr, "kernel_launch: device query failed\n"); grid = -1; return; }
        if (hipFuncSetAttribute((const void*)fwd_megakernel, hipFuncAttributeMaxDynamicSharedMemorySize, LDS_BYTES) != hipSuccess) { fprintf(stderr, "kernel_launch: hipFuncSetAttribute failed\n"); grid = -1; return; }
        if (hipOccupancyMaxActiveBlocksPerMultiprocessor(&per_cu, (const void*)fwd_megakernel, 512, LDS_BYTES) != hipSuccess || per_cu < 1) { fprintf(stderr, "kernel_launch: occupancy query says %d blocks per CU\n", per_cu); grid = -1; return; }
        grid = cus;
        if (grid > 256) grid = 256;
    }
    if (grid < 0) return;
    if (n_in != 40 || (size_t)out_size != O_TOTAL || ws_size < WS_END) { fprintf(stderr, "kernel_launch: unexpected sizes n_in %d out %d ws %zu (need %zu)\n", n_in, out_size, ws_size, (size_t)WS_END); return; }
    KP kp{};
    for (int i = 0; i < 40; ++i) kp.in[i] = (const float*)d_in[i];
    kp.out = (float*)d_out; kp.ws = (unsigned char*)d_ws;
    void* args[] = {&kp};
    hipError_t e = hipLaunchCooperativeKernel((const void*)fwd_megakernel, dim3(grid), dim3(512), args, LDS_BYTES, stream);
    if (e != hipSuccess) fprintf(stderr, "kernel_launch: cooperative launch failed: %s (grid %d)\n", hipGetErrorString(e), grid);
}
```

```cpp
#include <hip/hip_runtime.h>
#include <hip/hip_cooperative_groups.h>
#include <cstdio>
namespace cg = cooperative_groups;
namespace pg8 {
#define PG8_LAS __attribute__((address_space(3)))
typedef unsigned short bf16_t;
typedef short bf16x8 __attribute__((ext_vector_type(8)));
typedef float f32x4 __attribute__((ext_vector_type(4)));
typedef unsigned u32x4 __attribute__((ext_vector_type(4)));
constexpr int BM = 256, BK = 64, HALF = 128, HTB = HALF * BK * 2  , STAGE_BYTES = 8 * HTB, NXCD = 8, WGM = 8;

__host__ __device__ __forceinline__ int lds_byte(int r, int c) { const int st = (r >> 4) * 2 + (c >> 5), rr = r & 15, cc = c & 31, ob = rr * 64 + cc * 2; return st * 1024 + (ob ^ (((ob >> 9) & 1) << 5)); }
__host__ __device__ __forceinline__ void stage_rc(int b, int& R, int& C) { const int st = b / 1024, sb = b % 1024, swz = sb ^ (((sb >> 9) & 1) << 5); R = (st >> 1) * 16 + swz / 64; C = (st & 1) * 32 + (swz % 64) / 2; }
__host__ __device__ __forceinline__ int perm32(int rho) { const int n = rho >> 4, i = rho & 15; return 8 * (i >> 2) + 4 * n + (i & 3); }

struct Unit { int pm, pn; };
struct Gemm { const bf16_t* A; const bf16_t* Bt; int M, N, K; };

struct StaticOrder {
    int nM, nN, nwg, G, c;
    __host__ __device__ void init(int M, int N, int G_, int c_) { nM = M / BM; nN = N / BM; nwg = nM * nN; G = G_; c = c_; }
    __host__ __device__ bool next(int i, Unit& u) const {
        const long L = (long)i * G + c; if (L >= nwg) return false;
        int wgid = (int)L; { const int q = nwg / NXCD, r = nwg % NXCD, xcd = wgid % NXCD, off = wgid / NXCD; wgid = (xcd < r ? xcd * (q + 1) : r * (q + 1) + (xcd - r) * q) + off; }
        const int nig = WGM * nN, gid = wgid / nig, fm = gid * WGM, gsz = (nM - fm) < WGM ? (nM - fm) : WGM;
        u.pm = fm + ((wgid % nig) % gsz); u.pn = (wgid % nig) / gsz; return true;
    }
    __device__ __forceinline__ void a_ready(const Unit&) const {}
    __device__ __forceinline__ void done(const Unit&) const {}
};

template <class Epi, class Sched, bool STAMP = false>
__device__ __forceinline__ void gemm_phase(PG8_LAS unsigned char* lds, const Gemm g, const Sched& S, const Epi& E, unsigned long long* stamps) {
    int tid_ = threadIdx.x; asm volatile("" : "+v"(tid_));
    const int tid = tid_, wid = __builtin_amdgcn_readfirstlane(tid >> 6), lane = tid & 63, wr = wid >> 2, wc = wid & 3, fr = lane & 15, fq = lane >> 4;
    const int K = g.K, nt = K / BK;
    unsigned voffA[2], voffB[2];
#pragma unroll
    for (int i = 0; i < 2; ++i) { int R, C; stage_rc(tid * 16 + i * 8192, R, C); const int Rb = Epi::PERM ? ((R & ~31) + perm32(R & 31)) : R;
        voffA[i] = (unsigned)(R * K + C) * 2u; voffB[i] = (unsigned)(Rb * K + C) * 2u; }
    const size_t kstep = (size_t)(BK * 2);
    const size_t hstep = (size_t)HALF * K * 2;
    const size_t tstep = 2 * hstep;
    const unsigned ldsw = (unsigned)wid * 1024u;
    const int aoff = lds_byte(wr * 64 + fr, fq * 8), boff = lds_byte(wc * 32 + fr, fq * 8);
#define PG8_SA(b, h) (((b) * 2 + (h)) * HTB)
#define PG8_SB(b, h) ((4 + (b) * 2 + (h)) * HTB)
#define PG8_STAGE(bufoff, gbase, voff) do { _Pragma("unroll") for (int _i = 0; _i < 2; ++_i) \
        __builtin_amdgcn_global_load_lds((const unsigned*)((const char*)(gbase) + (voff)[_i]), (PG8_LAS unsigned*)(lds + (bufoff) + ldsw + _i * 8192), 16, 0, 0); } while (0)
#define PG8_LDA(dst, b, h) do { _Pragma("unroll") for (int m = 0; m < 4; ++m) _Pragma("unroll") for (int k = 0; k < 2; ++k) dst[m][k] = *(const PG8_LAS bf16x8*)(lds + PG8_SA(b, h) + aoff + m * 2048 + k * 1024); } while (0)
#define PG8_LDB(dst, b, h) do { _Pragma("unroll") for (int n = 0; n < 2; ++n) _Pragma("unroll") for (int k = 0; k < 2; ++k) dst[n][k] = *(const PG8_LAS bf16x8*)(lds + PG8_SB(b, h) + boff + n * 2048 + k * 1024); } while (0)
#define PG8_MMA(ai, bj, At, Bt) do { __builtin_amdgcn_s_setprio(1); _Pragma("unroll") for (int m = 0; m < 4; ++m) _Pragma("unroll") for (int n = 0; n < 2; ++n) _Pragma("unroll") for (int k = 0; k < 2; ++k) \
        acc[ai][bj][m][n] = __builtin_amdgcn_mfma_f32_16x16x32_bf16(Bt[n][k], At[m][k], acc[ai][bj][m][n], 0, 0, 0); __builtin_amdgcn_s_setprio(0); } while (0)
#define PG8_WAIT_V(n) asm volatile("s_waitcnt vmcnt(" #n ")" ::: "memory")
#define PG8_WAIT_L(n) asm volatile("s_waitcnt lgkmcnt(" #n ")" ::: "memory")
#define PG8_BAR __builtin_amdgcn_s_barrier()
#define PG8_SCHED __builtin_amdgcn_sched_barrier(0)
    Unit cur, nxt; int ui = 0;
    if (!S.next(0, cur)) return;
    f32x4 acc[2][2][4][2];
#pragma unroll
    for (int a = 0; a < 2; ++a)
#pragma unroll
        for (int b = 0; b < 2; ++b)
#pragma unroll
            for (int m = 0; m < 4; ++m)
#pragma unroll
                for (int n = 0; n < 2; ++n) acc[a][b][m][n] = (f32x4){0.f, 0.f, 0.f, 0.f};
    bf16x8 At[4][2], B0[2][2], B1[2][2];
    const char* cA = (const char*)g.A + (size_t)cur.pm * tstep; const char* cB = (const char*)g.Bt + (size_t)cur.pn * tstep;
    S.a_ready(cur);
    PG8_STAGE(PG8_SB(0, 0), cB, voffB); PG8_STAGE(PG8_SA(0, 0), cA, voffA); PG8_STAGE(PG8_SB(0, 1), cB + hstep, voffB); PG8_STAGE(PG8_SA(0, 1), cA + hstep, voffA);
    if (wr == 1) PG8_BAR;
    PG8_WAIT_V(4); PG8_BAR;
    PG8_STAGE(PG8_SB(1, 0), cB + kstep, voffB); PG8_STAGE(PG8_SA(1, 0), cA + kstep, voffA); PG8_STAGE(PG8_SB(1, 1), cB + hstep + kstep, voffB);
    PG8_WAIT_V(6); PG8_BAR;
    for (;;) {
        const bool has_next = S.next(ui + 1, nxt);
        const char* nA = has_next ? (const char*)g.A + (size_t)nxt.pm * tstep : cA; const char* nB = has_next ? (const char*)g.Bt + (size_t)nxt.pn * tstep : cB;
        for (int t = 0; t < nt; t += 2) {
            const bool last = (t == nt - 2);
            const char* a1 = cA + (size_t)(t + 1) * kstep;
            const char* a2 = last ? nA : cA + (size_t)(t + 2) * kstep; const char* b2 = last ? nB : cB + (size_t)(t + 2) * kstep;
            const char* a3 = a2 + kstep; const char* b3 = b2 + kstep;
            if (last && has_next) S.a_ready(nxt);
            PG8_LDB(B0, 0, 0); PG8_SCHED; PG8_LDA(At, 0, 0); PG8_STAGE(PG8_SA(1, 1), a1 + hstep, voffA);
            PG8_WAIT_L(8); PG8_BAR; PG8_WAIT_L(0); PG8_MMA(0, 0, At, B0); PG8_BAR; PG8_SCHED;
            PG8_LDB(B1, 0, 1); PG8_STAGE(PG8_SB(0, 0), b2, voffB);
            PG8_BAR; PG8_WAIT_L(0); PG8_MMA(0, 1, At, B1); PG8_BAR;
            PG8_LDA(At, 0, 1); PG8_STAGE(PG8_SA(0, 0), a2, voffA);
            PG8_BAR; PG8_WAIT_L(0); PG8_MMA(1, 0, At, B0); PG8_BAR; PG8_SCHED;
            PG8_STAGE(PG8_SB(0, 1), b2 + hstep, voffB);
            PG8_WAIT_V(6); PG8_BAR; PG8_MMA(1, 1, At, B1); PG8_BAR;
            PG8_LDB(B0, 1, 0); PG8_SCHED; PG8_LDA(At, 1, 0); PG8_STAGE(PG8_SA(0, 1), a2 + hstep, voffA);
            PG8_WAIT_L(8); PG8_BAR; PG8_WAIT_L(0); PG8_MMA(0, 0, At, B0); PG8_BAR; PG8_SCHED;
            PG8_LDB(B1, 1, 1); PG8_STAGE(PG8_SB(1, 0), b3, voffB);
            PG8_BAR; PG8_WAIT_L(0); PG8_MMA(0, 1, At, B1); PG8_BAR;
            PG8_LDA(At, 1, 1); PG8_STAGE(PG8_SA(1, 0), a3, voffA);
            PG8_BAR; PG8_WAIT_L(0); PG8_MMA(1, 0, At, B0); PG8_BAR; PG8_SCHED;
            PG8_STAGE(PG8_SB(1, 1), b3 + hstep, voffB);
            PG8_WAIT_V(6); PG8_BAR; PG8_MMA(1, 1, At, B1); PG8_BAR;
        }
        if constexpr (!Epi::AFTER_DRAIN) { E(acc, cur, wr, wc, fr, fq); S.done(cur); }
        if (!has_next) break;
#pragma unroll
        for (int a = 0; a < 2; ++a)
#pragma unroll
            for (int b = 0; b < 2; ++b)
#pragma unroll
                for (int m = 0; m < 4; ++m)
#pragma unroll
                    for (int n = 0; n < 2; ++n) acc[a][b][m][n] = (f32x4){0.f, 0.f, 0.f, 0.f};
        cur = nxt; cA = nA; cB = nB; ++ui;
    }
    PG8_WAIT_V(0);
    if (wr == 0) PG8_BAR;
    PG8_BAR;
    if constexpr (Epi::AFTER_DRAIN) { E.fused(acc, cur, wr, wc, fr, fq, lds, wid, lane); S.done(cur); }
#undef PG8_SA
#undef PG8_SB
#undef PG8_STAGE
#undef PG8_LDA
#undef PG8_LDB
#undef PG8_MMA
#undef PG8_WAIT_V
#undef PG8_WAIT_L
#undef PG8_BAR
#undef PG8_SCHED
}
}

#include <cstdio>
#include <ctime>
#include <cstdlib>
#include <cstring>
#include <cmath>
#include <vector>
#include <algorithm>
#define CK(x) do { hipError_t e_ = (x); if (e_ != hipSuccess) { fprintf(stderr, "HIP %s:%d %s\n", __FILE__, __LINE__, hipGetErrorString(e_)); exit(2); } } while (0)

#define DI __device__ __forceinline__
#define LAS __attribute__((address_space(3)))
typedef unsigned short bf16_t;
typedef short bf16x8 __attribute__((ext_vector_type(8)));
typedef short s16x4 __attribute__((ext_vector_type(4)));
typedef __bf16 bfv8 __attribute__((ext_vector_type(8)));
typedef __bf16 bfv4 __attribute__((ext_vector_type(4)));
typedef float f32x2 __attribute__((ext_vector_type(2)));
typedef float f32x4 __attribute__((ext_vector_type(4)));
typedef float f32x8 __attribute__((ext_vector_type(8)));
typedef float f32x16 __attribute__((ext_vector_type(16)));
typedef unsigned u32x4 __attribute__((ext_vector_type(4)));
typedef unsigned u32x2 __attribute__((ext_vector_type(2)));

constexpr int MP = 16384, MS = 128, MR = MP + MS, MPAD = 16640, DM = 1024, SEQ = 2048, NB = 8;
constexpr int NPROJ = 4096, NGATE = 3072, DFF = 4096, DIN = 7184;
constexpr int PU = 0, PQ = 512, PK = 1024, PV = 1536, PMQ = 2048, PMK = 2304, PMV = 2560, PZ = 3072, PMO = 3584;
constexpr float EPS = 1e-6f;
constexpr size_t O_S5RE_P = 16908288, O_S5RE_S = 16941056, O_S5IM_P = 17465344, O_S5IM_S = 17498112, O_CONV_P = 18022400, O_CONV_S = 18096128,
                 O_GDN_P = 19275776, O_GDN_S = 20324352, O_MLC_P = 37101568, O_MLC_S = 37625856, O_MLN_P = 46014464, O_MLN_S = 46018560,
                 O_MLM_P = 46084096, O_MLM_S = 46084160, O_TOTAL = 46085184;
constexpr size_t WS_R1 = 0, SZ_R1 = (size_t)MPAD * 4096 * 2;
constexpr size_t WS_XN = WS_R1 + SZ_R1, SZ_XN = (size_t)MPAD * 1024 * 2;
constexpr size_t WS_Y3 = WS_XN + SZ_XN, SZ_Y3 = (size_t)3 * MPAD * 512 * 2;
constexpr size_t WS_YS5 = WS_Y3 + SZ_Y3, SZ_YS5 = (size_t)MPAD * 512 * 2;
constexpr size_t WS_W = WS_YS5 + SZ_YS5;
constexpr size_t WO_IN = 0, WO_G = WO_IN + (size_t)4096 * 1024, WO_GLU = WO_G + (size_t)3072 * 1024, WO_BR = WO_GLU + (size_t)512 * 512,
                 WO_OUT = WO_BR + (size_t)3 * 1024 * 512, WO_UP = WO_OUT + (size_t)1024 * 1024, WO_DN = WO_UP + (size_t)4096 * 1024,
                 WO_PLE = WO_DN + (size_t)1024 * 4096, WO_PG = WO_PLE + (size_t)1024 * 256, WO_END = WO_PG + (size_t)1024 * 1024;
constexpr size_t SZ_W = WO_END * 2;
constexpr size_t WS_GS = WS_W + SZ_W;
constexpr int GI_U = 0, GI_W = 16384, GI_Q = 32768, GI_K = 49152, GI_A = 65536, GI_BYTES = 73728;
constexpr size_t SZ_GS = (size_t)1024 * GI_BYTES;
constexpr size_t WS_SG = WS_GS + SZ_GS, SZ_SG = (size_t)MR * 16 * 4;
constexpr size_t WS_GL = WS_SG + SZ_SG, SZ_GL = 8192;
constexpr size_t WS_MG = WS_GL + SZ_GL, SZ_MG = (size_t)1024 * 3 * 64 * 4;
constexpr size_t WS_BAR = WS_MG + SZ_MG, SZ_BAR = 16384;
constexpr size_t WS_END = WS_BAR + SZ_BAR;
constexpr int LDS_BYTES = 122880 + 32768 + 2048 + 64 + 64;

struct KP { const float* in[40]; float* out; unsigned char* ws; };

DI float bf2f(bf16_t b) { return __uint_as_float(((unsigned)b) << 16); }
DI bf16_t f2bf(float f) { __bf16 b = (__bf16)f; return __builtin_bit_cast(bf16_t, b); }
DI bf16x8 pack8v(f32x8 v) { bfv8 b = __builtin_convertvector(v, bfv8); return __builtin_bit_cast(bf16x8, b); }
DI s16x4 pack4v(f32x4 v) { bfv4 b = __builtin_convertvector(v, bfv4); return __builtin_bit_cast(s16x4, b); }
DI bf16x8 pack16(const f32x16& x, int s) { f32x8 v;
#pragma unroll
    for (int j = 0; j < 8; ++j) v[j] = x[8 * s + j];
    return pack8v(v); }
DI float lo16(unsigned u) { return __uint_as_float(u << 16); }
DI float hi16(unsigned u) { return __uint_as_float(u & 0xffff0000u); }
DI f32x8 unpack8(bf16x8 b) { u32x4 u = __builtin_bit_cast(u32x4, b); f32x8 r;
#pragma unroll
    for (int i = 0; i < 4; ++i) { r[2 * i] = lo16(u[i]); r[2 * i + 1] = hi16(u[i]); }
    return r; }
DI float sigm(float x) { return __builtin_amdgcn_rcpf(1.f + __expf(-x)); }
DI float tanh_(float z) { return 1.f - 2.f * __builtin_amdgcn_rcpf(__expf(2.f * z) + 1.f); }
DI float gelu_t(float x) { return 0.5f * x * (1.f + tanh_(0.7978845608028654f * (x + 0.044715f * x * x * x))); }
DI float silu_(float x) { return x * sigm(x); }
DI float softplus_(float x) { return x > 20.f ? x : log1pf(expf(x)); }
DI float logsig_(float x) { return x >= 0.f ? -log1pf(expf(-x)) : x - log1pf(expf(x)); }
DI float softcap_(float x) { return 15.f * tanh_(x * (1.f / 15.f)); }
DI float wave_sum(float v) {
#pragma unroll
    for (int o = 32; o; o >>= 1) v += __shfl_xor(v, o);
    return v; }
DI float wave_incl_sum(float v, int lane) {
#pragma unroll
    for (int o = 1; o < 64; o <<= 1) { float t = __shfl_up(v, o); if (lane >= o) v += t; }
    return v; }
DI float wave_incl_max(float v, int lane) {
#pragma unroll
    for (int o = 1; o < 64; o <<= 1) { float t = __shfl_up(v, o); if (lane >= o) v = fmaxf(v, t); }
    return v; }
DI void butterfly16(float (&a)[16], int lane) {
#pragma unroll
    for (int i = 0; i < 8; ++i) { const bool up = (lane & 32) != 0; const float send = up ? a[i] : a[i + 8], keep = up ? a[i + 8] : a[i]; a[i] = keep + __shfl_xor(send, 32); }
#pragma unroll
    for (int i = 0; i < 4; ++i) { const bool up = (lane & 16) != 0; const float send = up ? a[i] : a[i + 4], keep = up ? a[i + 4] : a[i]; a[i] = keep + __shfl_xor(send, 16); }
#pragma unroll
    for (int i = 0; i < 2; ++i) { const bool up = (lane & 8) != 0; const float send = up ? a[i] : a[i + 2], keep = up ? a[i + 2] : a[i]; a[i] = keep + __shfl_xor(send, 8); }
    { const bool up = (lane & 4) != 0; const float send = up ? a[0] : a[1], keep = up ? a[1] : a[0]; a[0] = keep + __shfl_xor(send, 4); }
    a[0] += __shfl_xor(a[0], 2); a[0] += __shfl_xor(a[0], 1);
}
DI int bsel16(int lane) { return ((lane >> 5) & 1) * 8 + ((lane >> 4) & 1) * 4 + ((lane >> 3) & 1) * 2 + ((lane >> 2) & 1); }
DI int crow(int reg, int h) { return (reg & 3) + 8 * (reg >> 2) + 4 * h; }
DI int perm16(int k) { return (k & ~12) | ((k & 4) << 1) | ((k & 8) >> 1); }
#define MFMA32(a, b, c) __builtin_amdgcn_mfma_f32_32x32x16_bf16((a), (b), (c), 0, 0, 0)
#define MFMA16(a, b, c) __builtin_amdgcn_mfma_f32_16x16x32_bf16((a), (b), (c), 0, 0, 0)
#define WAVE_FENCE() do { asm volatile("s_waitcnt lgkmcnt(0)" ::: "memory"); __builtin_amdgcn_wave_barrier(); asm volatile("" ::: "memory"); } while (0)

typedef __attribute__((address_space(4))) const unsigned long long* ka_t;
typedef __attribute__((address_space(1))) float gfloat_t; typedef __attribute__((address_space(1))) unsigned char guchar_t;
struct InTab { ka_t ka; DI const float* operator[](int i) const { return (const float*)(const gfloat_t*)ka[i]; } };
struct Ctx {
    InTab in; float* out; unsigned char* ws; unsigned char* lds;
    bf16_t *R1, *XN, *Y3, *W, *YS5; unsigned char* GS; float *SG, *GL;
    int tid, lane, wave, G, bid;
};

template <class F> struct Epi8 {
    static constexpr bool PERM = true, AFTER_DRAIN = false;
    F f;
    DI void operator()(const f32x4 (&acc)[2][2][4][2], const pg8::Unit& u, int wr, int wc, int fr, int fq) const {
        const int row0 = u.pm * 256 + wr * 64 + fr, col0 = u.pn * 256 + wc * 32 + 8 * fq;
#pragma unroll
        for (int ai = 0; ai < 2; ++ai)
#pragma unroll
            for (int m = 0; m < 4; ++m)
#pragma unroll
                for (int bj = 0; bj < 2; ++bj) f(row0 + ai * 128 + m * 16, col0 + bj * 128, acc[ai][bj][m][0], acc[ai][bj][m][1]);
    }
};
DI f32x8 cat8(f32x4 a, f32x4 b) { f32x8 r; r[0] = a[0]; r[1] = a[1]; r[2] = a[2]; r[3] = a[3]; r[4] = b[0]; r[5] = b[1]; r[6] = b[2]; r[7] = b[3]; return r; }
struct FStore { bf16_t* dst; int ld;
    DI void s(int row, int col, float v) const { dst[(size_t)row * ld + col] = f2bf(v); }
    DI void operator()(int row, int col, f32x4 a, f32x4 b) const { *(bf16x8*)(dst + (size_t)row * ld + col) = pack8v(cat8(a, b)); } };
struct FSig { bf16_t* dst; int ld;
    DI void s(int row, int col, float v) const { dst[(size_t)row * ld + col] = f2bf(sigm(v)); }
    DI void operator()(int row, int col, f32x4 a, f32x4 b) const { f32x8 v = cat8(a, b);
#pragma unroll
        for (int i = 0; i < 8; ++i) v[i] = sigm(v[i]);
        *(bf16x8*)(dst + (size_t)row * ld + col) = pack8v(v); } };
struct FGlu { const bf16_t* y; const float* bias; bf16_t* dst;
    DI void s(int row, int col, float v) const { dst[(size_t)row * 512 + col] = f2bf(bf2f(y[(size_t)row * 512 + col]) * sigm(v + bias[col])); }
    DI void operator()(int row, int col, f32x4 a, f32x4 b) const { f32x8 v = cat8(a, b); f32x8 yv = unpack8(*(const bf16x8*)(y + (size_t)row * 512 + col));
        f32x4 b0 = *(const f32x4*)(bias + col), b1 = *(const f32x4*)(bias + col + 4);
#pragma unroll
        for (int i = 0; i < 8; ++i) v[i] = yv[i] * sigm(v[i] + (i < 4 ? b0[i] : b1[i - 4]));
        *(bf16x8*)(dst + (size_t)row * 512 + col) = pack8v(v); } };
struct FBranch { const bf16_t* gates; bf16_t* merged; int first;
    DI void s(int row, int col, float v) const { bf16_t* mp = merged + (size_t)row * 1024 + col; const float g = bf2f(gates[(size_t)row * 4096 + col]); *mp = f2bf((first ? 0.f : bf2f(*mp)) + g * v); }
    DI void operator()(int row, int col, f32x4 a, f32x4 b) const { f32x8 v = cat8(a, b); f32x8 gv = unpack8(*(const bf16x8*)(gates + (size_t)row * 4096 + col));
        bf16x8* mp = (bf16x8*)(merged + (size_t)row * 1024 + col);
        f32x8 o;
        if (first) {
#pragma unroll
            for (int i = 0; i < 8; ++i) o[i] = gv[i] * v[i];
        } else { f32x8 mv = unpack8(*mp);
#pragma unroll
            for (int i = 0; i < 8; ++i) o[i] = mv[i] + gv[i] * v[i];
        }
        *mp = pack8v(o); } };
struct FRes { float* xr;
    DI void s(int row, int col, float v) const { xr[(size_t)row * 1024 + col] += v; }
    DI void operator()(int row, int col, f32x4 a, f32x4 b) const { if (row < MR) { f32x4* p = (f32x4*)(xr + (size_t)row * 1024 + col); p[0] = p[0] + a; p[1] = p[1] + b; } } };
struct FResB { float* xr; bf16_t* xb;
    DI void s(int row, int col, float v) const { const float x = xr[(size_t)row * 1024 + col] + v; xr[(size_t)row * 1024 + col] = x; xb[(size_t)row * 1024 + col] = f2bf(x); }
    DI void operator()(int row, int col, f32x4 a, f32x4 b) const { if (row < MR) { f32x4* p = (f32x4*)(xr + (size_t)row * 1024 + col); const f32x4 x0 = p[0] + a, x1 = p[1] + b; p[0] = x0; p[1] = x1;
            *(bf16x8*)(xb + (size_t)row * 1024 + col) = pack8v(cat8(x0, x1)); } } };
struct FRelu2 { bf16_t* dst;
    DI void s(int row, int col, float v) const { const float r = fmaxf(v, 0.f); dst[(size_t)row * 4096 + col] = f2bf(r * r); }
    DI void operator()(int row, int col, f32x4 a, f32x4 b) const { f32x8 v = cat8(a, b);
#pragma unroll
        for (int i = 0; i < 8; ++i) { float r = fmaxf(v[i], 0.f); v[i] = r * r; }
        *(bf16x8*)(dst + (size_t)row * 4096 + col) = pack8v(v); } };
struct FPle { const bf16_t* T; float* xr;
    DI void s(int row, int col, float v) const { xr[(size_t)row * 1024 + col] += bf2f(T[(size_t)row * 1024 + col]) * sigm(v); }
    DI void operator()(int row, int col, f32x4 a, f32x4 b) const { if (row < MR) { f32x8 v = cat8(a, b); f32x8 tv = unpack8(*(const bf16x8*)(T + (size_t)row * 1024 + col));
            f32x4* p = (f32x4*)(xr + (size_t)row * 1024 + col); f32x4 x0 = p[0], x1 = p[1];
#pragma unroll
            for (int i = 0; i < 4; ++i) { x0[i] += tv[i] * sigm(v[i]); x1[i] += tv[4 + i] * sigm(v[4 + i]); }
            p[0] = x0; p[1] = x1; } } };

DI f32x16 small_part(const Ctx& c, const bf16_t* A, const bf16_t* Bt, int K, int tile, int kq) {
    int r = c.lane & 31, hh = c.lane >> 5; asm volatile("" : "+v"(r), "+v"(hh));
    const int mt = tile & 3, nt = tile >> 2, K4 = K >> 2;
    const bf16_t* ap = A + (size_t)(MP + mt * 32 + r) * K + kq * K4 + hh * 8;
    const bf16_t* bp = Bt + (size_t)(nt * 32 + r) * K + kq * K4 + hh * 8;
    f32x16 acc;
#pragma unroll
    for (int j = 0; j < 16; ++j) acc[j] = 0.f;
    if (K4 >= 128) {
        bf16x8 a[8], b[8];
#pragma unroll
        for (int j = 0; j < 8; ++j) { a[j] = *(const bf16x8*)(ap + j * 16); b[j] = *(const bf16x8*)(bp + j * 16); }
        for (int k = 128; k < K4; k += 128) {
            bf16x8 an[8], bn[8];
#pragma unroll
            for (int j = 0; j < 8; ++j) { an[j] = *(const bf16x8*)(ap + k + j * 16); bn[j] = *(const bf16x8*)(bp + k + j * 16); }
#pragma unroll
            for (int j = 0; j < 8; ++j) acc = MFMA32(a[j], b[j], acc);
#pragma unroll
            for (int j = 0; j < 8; ++j) { a[j] = an[j]; b[j] = bn[j]; }
        }
#pragma unroll
        for (int j = 0; j < 8; ++j) acc = MFMA32(a[j], b[j], acc);
    } else {
#pragma unroll
        for (int j = 0; j < 4; ++j) { const bf16x8 a = *(const bf16x8*)(ap + j * 16), b = *(const bf16x8*)(bp + j * 16); acc = MFMA32(a, b, acc); }
    }
    return acc;
}
template <class F> DI void run_gemm(const Ctx& c, const bf16_t* A, const bf16_t* Bt, int N, int K, const F& f) {
    { const int ntile = 4 * (N >> 5), grp = c.wave >> 2, kq = c.wave & 3;
      LAS float* red = (LAS float*)c.lds;
      for (int t0 = 0; t0 < ntile; t0 += 2 * c.G) {
          const int t = t0 + grp * c.G + c.bid; const bool live = t < ntile;
          if (live) { const f32x16 acc = small_part(c, A, Bt, K, t, kq);
#pragma unroll
              for (int i = 0; i < 16; ++i) red[(c.wave * 16 + i) * 64 + c.lane] = acc[i]; }
          __syncthreads();
          if (live && kq == 0) { const int mt = t & 3, nt = t >> 2, r = c.lane & 31, hh = c.lane >> 5;
#pragma unroll
              for (int i = 0; i < 16; ++i) { const int o = (c.wave * 16 + i) * 64 + c.lane; const float v = (red[o] + red[o + 1024]) + (red[o + 2048] + red[o + 3072]);
                  f.s(MP + mt * 32 + crow(i, hh), nt * 32 + r, v); } }
          __syncthreads();
      } }
    pg8::Gemm g{A, Bt, MP, N, K}; pg8::StaticOrder S; S.init(MP, N, c.G, c.bid);
    Epi8<F> E{f};
    pg8::gemm_phase<Epi8<F>, pg8::StaticOrder>((PG8_LAS unsigned char*)c.lds, g, S, E, nullptr);
    __syncthreads();
}

DI void tr_task(const Ctx& c, const float* src, int ld, int K, int n, bf16_t* dst, int rot) {
    float* tile = (float*)c.lds;
    const int nkt = K >> 6, ntiles = nkt * (n >> 6);
    const int start = (c.bid + c.G - (rot % c.G)) % c.G;
    for (int t = start; t < ntiles; t += c.G) {
        const int kt = t % nkt, nt = t / nkt;
        const int r = c.tid >> 4, c4 = (c.tid & 15) * 4;
#pragma unroll
        for (int p = 0; p < 2; ++p) { const int row = r + 32 * p; const f32x4 v = *(const f32x4*)(src + (size_t)(kt * 64 + row) * ld + nt * 64 + c4);
            tile[row * 65 + c4] = v[0]; tile[row * 65 + c4 + 1] = v[1]; tile[row * 65 + c4 + 2] = v[2]; tile[row * 65 + c4 + 3] = v[3]; }
        __syncthreads();
        { const int nn = c.tid >> 3, kc = (c.tid & 7) * 8; f32x8 v;
#pragma unroll
          for (int e = 0; e < 8; ++e) v[e] = tile[(kc + e) * 65 + nn];
          *(bf16x8*)(dst + (size_t)(nt * 64 + nn) * K + kt * 64 + kc) = pack8v(v); }
        __syncthreads();
    }
}
DI void phase_weights(const Ctx& c, int L) {
    const float* win = c.in[12] + (size_t)L * 1024 * DIN;
    bf16_t* W = c.W;
    tr_task(c, win + 0, DIN, 1024, 2048, W + WO_IN, 0);
    tr_task(c, win + 2568, DIN, 1024, 1024, W + WO_IN + (size_t)2048 * 1024, 0);
    tr_task(c, win + 2048, DIN, 1024, 512, W + WO_IN + (size_t)3072 * 1024, 0);
    tr_task(c, win + 3592, DIN, 1024, 512, W + WO_IN + (size_t)3584 * 1024, 128);
    tr_task(c, win + 4112, DIN, 1024, 3072, W + WO_G, 0);
    tr_task(c, c.in[21] + (size_t)L * 512 * 512, 512, 512, 512, W + WO_GLU, 0);
    tr_task(c, c.in[30] + (size_t)L * 512 * 1024, 1024, 512, 1024, W + WO_BR, 64);
    tr_task(c, c.in[31] + (size_t)L * 512 * 1024, 1024, 512, 1024, W + WO_BR + (size_t)1024 * 512, 192);
    tr_task(c, c.in[32] + (size_t)L * 512 * 1024, 1024, 512, 1024, W + WO_BR + (size_t)2 * 1024 * 512, 64);
    tr_task(c, c.in[33] + (size_t)L * 1024 * 1024, 1024, 1024, 1024, W + WO_OUT, 0);
    tr_task(c, c.in[35] + (size_t)L * 1024 * 4096, 4096, 1024, 4096, W + WO_UP, 0);
    tr_task(c, c.in[36] + (size_t)L * 4096 * 1024, 1024, 4096, 1024, W + WO_DN, 0);
    tr_task(c, c.in[37] + (size_t)L * 256 * 1024, 1024, 256, 1024, W + WO_PLE, 0);
    tr_task(c, c.in[38] + (size_t)L * 1024 * 1024, 1024, 1024, 1024, W + WO_PG, 64);
}

template <int MODE> DI void phase_rmsnorm(const Ctx& c, int L) {
    float* wsm = (float*)c.lds;
    const float* gain = (MODE == 0 ? c.in[11] : c.in[34]) + (size_t)L * 1024;
    if (MODE == 0) {
        const float* win = c.in[12] + (size_t)L * 1024 * DIN;
        for (int idx = c.tid; idx < 4096; idx += 512) { const int k = idx >> 2, part = idx & 3, seg = part >> 1, half = part & 1;
            const f32x4 v = *(const f32x4*)(win + (size_t)k * DIN + (seg ? 4104 : 2560) + half * 4);
            const int sb = seg * 8 + half * 4;
            wsm[(sb + 0) * 1024 + k] = v[0]; wsm[(sb + 1) * 1024 + k] = v[1]; wsm[(sb + 2) * 1024 + k] = v[2]; wsm[(sb + 3) * 1024 + k] = v[3]; }
        __syncthreads();
    }
    float* XR = c.out;
    for (int row = c.bid * 8 + c.wave; row < MR; row += c.G * 8) {
        const float* src = (MODE == 0 && L == 0) ? (row < MP ? c.in[0] + (size_t)row * 1024 : c.in[1] + (size_t)(row - MP) * 1024) : XR + (size_t)row * 1024;
        f32x4 x[4]; float ss = 0.f;
#pragma unroll
        for (int i = 0; i < 4; ++i) { x[i] = *(const f32x4*)(src + c.lane * 4 + 256 * i); ss += x[i][0] * x[i][0] + x[i][1] * x[i][1] + x[i][2] * x[i][2] + x[i][3] * x[i][3]; }
        ss = wave_sum(ss);
        const float rs = rsqrtf(ss * (1.f / 1024.f) + EPS);
        if (MODE == 0 && L == 0) {
#pragma unroll
            for (int i = 0; i < 4; ++i) *(f32x4*)(XR + (size_t)row * 1024 + c.lane * 4 + 256 * i) = x[i];
        }
#pragma unroll
        for (int i = 0; i < 4; ++i) { const f32x4 g = *(const f32x4*)(gain + c.lane * 4 + 256 * i); x[i] = x[i] * rs * g;
            *(s16x4*)(c.XN + (size_t)row * 1024 + c.lane * 4 + 256 * i) = pack4v(x[i]); }
        if (MODE == 0) {
            float a[16];
#pragma unroll
            for (int s = 0; s < 16; ++s) { float t = 0.f;
#pragma unroll
                for (int i = 0; i < 4; ++i) { const f32x4 w = *(const f32x4*)(wsm + s * 1024 + c.lane * 4 + 256 * i); t += x[i][0] * w[0] + x[i][1] * w[1] + x[i][2] * w[2] + x[i][3] * w[3]; }
                a[s] = t; asm volatile("" ::: "memory"); }
#pragma unroll
            for (int i = 0; i < 8; ++i) { const bool up = (c.lane & 32) != 0; const float send = up ? a[i] : a[i + 8], keep = up ? a[i + 8] : a[i]; a[i] = keep + __shfl_xor(send, 32); }
#pragma unroll
            for (int i = 0; i < 4; ++i) { const bool up = (c.lane & 16) != 0; const float send = up ? a[i] : a[i + 4], keep = up ? a[i + 4] : a[i]; a[i] = keep + __shfl_xor(send, 16); }
#pragma unroll
            for (int i = 0; i < 2; ++i) { const bool up = (c.lane & 8) != 0; const float send = up ? a[i] : a[i + 2], keep = up ? a[i + 2] : a[i]; a[i] = keep + __shfl_xor(send, 8); }
            { const bool up = (c.lane & 4) != 0; const float send = up ? a[0] : a[1], keep = up ? a[1] : a[0]; a[0] = keep + __shfl_xor(send, 4); }
            a[0] += __shfl_xor(a[0], 2); a[0] += __shfl_xor(a[0], 1);
            if ((c.lane & 3) == 0) { const int sidx = ((c.lane >> 5) & 1) * 8 + ((c.lane >> 4) & 1) * 4 + ((c.lane >> 3) & 1) * 2 + ((c.lane >> 2) & 1); c.SG[(size_t)row * 16 + sidx] = a[0]; }
        }
    }
    __syncthreads();
}

DI void phase_gdn_prep(const Ctx& c, int L) {
    constexpr int RS = 132, AS = 68, BP = 136;
    LAS float* AmT0 = (LAS float*)c.lds;
    const float* convw = c.in[23] + (size_t)L * 4 * 1536;
    const bf16_t* PR = c.R1;
    for (int item = c.bid; item < 1024; item += c.G) {
        const int ch = item & 31, h = (item >> 5) & 3, b = item >> 7;
        const int t0 = b * SEQ + ch * 64;
        unsigned char* gi = c.GS + (size_t)item * GI_BYTES;
        LAS float* AmT = AmT0; asm volatile("" : "+v"(AmT));
        LAS float* beta = AmT + 64 * AS; LAS float* gcum = beta + 64; LAS float* part = gcum + 64;
        LAS float* vs = part + 128; asm volatile("" : "+v"(vs));
        LAS bf16_t* qb = (LAS bf16_t*)(vs + 64 * RS); asm volatile("" : "+v"(qb));
        LAS bf16_t* khi = qb + 64 * BP; asm volatile("" : "+v"(khi));
        LAS bf16_t* klo = khi + 64 * BP; asm volatile("" : "+v"(klo));
        if (c.wave == 7) { const size_t row = (size_t)(t0 + c.lane);
            const float bt = sigm(c.SG[row * 16 + h]);
            const float g = -expf(c.in[24][L * 4 + h]) * softplus_(c.SG[row * 16 + 4 + h] + c.in[25][L * 4 + h]);
            const float gc = wave_incl_sum(g, c.lane);
            beta[c.lane] = bt; gcum[c.lane] = gc;
            if (c.lane == 63) c.GL[item] = expf(gc); }
        { const int d = c.tid & 127, tq = c.tid >> 7;
          float qk[2][16];
#pragma unroll
          for (int which = 0; which < 3; ++which) {
              const int pcol = PQ + which * 512 + h * 128 + d, wcol = which * 512 + h * 128 + d;
              const float w0 = convw[wcol], w1 = convw[1536 + wcol], w2 = convw[3072 + wcol], w3 = convw[4608 + wcol];
              float xin[19];
#pragma unroll
              for (int i = 0; i < 19; ++i) { const int tt = ch * 64 + tq * 16 + i - 3; const int tc = tt < 0 ? 0 : tt;
                  const float v = bf2f(PR[(size_t)(b * SEQ + tc) * NPROJ + pcol]); xin[i] = tt < 0 ? 0.f : v; }
#pragma unroll
              for (int t = 0; t < 16; ++t) { const float a = silu_(xin[t] * w0 + xin[t + 1] * w1 + xin[t + 2] * w2 + xin[t + 3] * w3);
                  if (which == 2) vs[(tq * 16 + t) * RS + d] = a; else qk[which][t] = a; }
          }
#pragma unroll
          for (int which = 0; which < 2; ++which) {
              float ssq[16];
#pragma unroll
              for (int t = 0; t < 16; ++t) ssq[t] = qk[which][t] * qk[which][t];
              butterfly16(ssq, c.lane);
              __syncthreads();
              if ((c.lane & 3) == 0) part[c.wave * 16 + bsel16(c.lane)] = ssq[0];
              __syncthreads();
#pragma unroll
              for (int t = 0; t < 16; ++t) { const float tot = part[c.wave * 16 + t] + part[(c.wave ^ 1) * 16 + t];
                  const float v = qk[which][t] * rsqrtf(tot + EPS) * (which == 0 ? 0.08838834764831845f : 1.f);
                  const bf16_t hi = f2bf(v);
                  if (which == 0) qb[(tq * 16 + t) * BP + d] = hi;
                  else { khi[(tq * 16 + t) * BP + d] = hi; klo[(tq * 16 + t) * BP + d] = f2bf(v - bf2f(hi)); } }
          } }
        __syncthreads();
        { const int r = c.lane & 31, hh = c.lane >> 5, wq = c.wave & 3, tm = wq >> 1, tn = wq & 1;
          if (!(c.wave < 4 && tm == 0 && tn == 1)) {
              f32x16 acc;
#pragma unroll
              for (int j = 0; j < 16; ++j) acc[j] = 0.f;
              const LAS bf16_t* arow = (c.wave < 4 ? khi : qb) + (tm * 32 + r) * BP + hh * 8;
              const LAS bf16_t* brow = khi + (tn * 32 + r) * BP + hh * 8;
#pragma unroll
              for (int ks = 0; ks < 8; ++ks) { const bf16x8 av = *(const LAS bf16x8*)(arow + ks * 16), bv = *(const LAS bf16x8*)(brow + ks * 16);
                  acc = MFMA32(av, bv, acc);
                  if (c.wave < 4) { const bf16x8 al = *(const LAS bf16x8*)(arow + 64 * BP + ks * 16), bl = *(const LAS bf16x8*)(brow + 64 * BP + ks * 16);
                      acc = MFMA32(av, bl, acc); acc = MFMA32(al, bv, acc); } }
              const int s = tn * 32 + r; const float gs = gcum[s];
              bf16_t* at = (bf16_t*)(gi + GI_A);
#pragma unroll
              for (int i = 0; i < 16; ++i) { const int t = tm * 32 + crow(i, hh); const float dec = (t >= s) ? __expf(gcum[t] - gs) : 0.f;
                  if (c.wave < 4) { if (t > s) AmT[s * AS + t] = beta[t] * acc[i] * dec; }
                  else at[t * 64 + (s & ~15) + perm16(s & 15)] = f2bf(acc[i] * dec); }
          } }
        __syncthreads();
        if (c.tid < 256) {
            const int col = c.tid; float x[64];
#pragma unroll
            for (int t = 0; t < 64; ++t) x[t] = (col < 128) ? vs[t * RS + col] * beta[t] : (bf2f(khi[t * BP + (col - 128)]) + bf2f(klo[t * BP + (col - 128)])) * beta[t] * __expf(gcum[t]);
#pragma unroll
            for (int j = 0; j < 63; ++j) { const float xj = x[j];
#pragma unroll
                for (int g4 = (j + 1) / 4; g4 < 16; ++g4) { const f32x4 a = *(const LAS f32x4*)(AmT + j * AS + g4 * 4);
#pragma unroll
                    for (int e = 0; e < 4; ++e) if (g4 * 4 + e > j) x[g4 * 4 + e] -= a[e] * xj; } }
            if (col < 128) { bf16_t* up = (bf16_t*)(gi + GI_U); const int sl = col >> 5, r = col & 31;
#pragma unroll
                for (int t = 0; t < 64; ++t) { const int mt = t >> 5, tt = t & 31, hh = (tt >> 2) & 1, i = (tt & 3) + 4 * (tt >> 3);
                    up[((sl * 2 + mt) * 16 + i) * 64 + r + 32 * hh] = f2bf(x[t]); }
            } else { bf16_t* wp = (bf16_t*)(gi + GI_W); const int dk = col - 128, pd = (dk & ~15) + perm16(dk & 15);
#pragma unroll
                for (int t = 0; t < 64; ++t) wp[t * 128 + pd] = f2bf(-x[t]); }
        } else {
            bf16_t* qp = (bf16_t*)(gi + GI_Q); bf16_t* kp = (bf16_t*)(gi + GI_K);
            const float g63 = gcum[63];
            for (int idx = c.tid - 256; idx < 64 * 128; idx += 256) { const int t = idx >> 7, d = idx & 127;
                qp[t * 128 + (d & ~15) + perm16(d & 15)] = f2bf(bf2f(qb[t * BP + d]) * __expf(gcum[t])); }
            for (int idx = c.tid - 256; idx < 64 * 128; idx += 256) { const int d = idx >> 6, t = idx & 63;
                kp[d * 64 + (t & ~15) + perm16(t & 15)] = f2bf((bf2f(khi[t * BP + d]) + bf2f(klo[t * BP + d])) * __expf(g63 - gcum[t])); }
        }
        __syncthreads();
    }
}

constexpr int GB_W = 0, GB_Q = 16384, GB_A = 32768, GB_K = 40960, GB_U = 57344, GB_BYTES = 61440;
DI void dma16(const void* g, unsigned lds_addr) { asm volatile("s_mov_b32 m0, %1\n\tglobal_load_lds_dwordx4 %0, off" :: "v"(g), "s"(lds_addr) : "memory", "m0"); }
DI void gdn_issue(const Ctx& c, int item, int sl, int r, int hh, int ln, PG8_LAS unsigned char* buf) {
    const unsigned char* gi = c.GS + (size_t)item * GI_BYTES;
    const bf16_t* up = (const bf16_t*)(gi + GI_U); const bf16_t* wp = (const bf16_t*)(gi + GI_W); const bf16_t* qp = (const bf16_t*)(gi + GI_Q);
    const bf16_t* kp = (const bf16_t*)(gi + GI_K); const bf16_t* ap = (const bf16_t*)(gi + GI_A);
#pragma unroll
    for (int mt = 0; mt < 2; ++mt)
#pragma unroll
        for (int ks = 0; ks < 8; ++ks) {
            dma16((wp + (mt * 32 + r) * 128 + ks * 16 + hh * 8), (unsigned)(size_t)(buf + GB_W + (mt * 8 + ks) * 1024));
            dma16((qp + (mt * 32 + r) * 128 + ks * 16 + hh * 8), (unsigned)(size_t)(buf + GB_Q + (mt * 8 + ks) * 1024)); }
#pragma unroll
    for (int mt = 0; mt < 2; ++mt)
#pragma unroll
        for (int ks = 0; ks < 4; ++ks)
            dma16((ap + (mt * 32 + r) * 64 + ks * 16 + hh * 8), (unsigned)(size_t)(buf + GB_A + (mt * 4 + ks) * 1024));
#pragma unroll
    for (int i = 0; i < 4; ++i)
#pragma unroll
        for (int ks = 0; ks < 4; ++ks)
            dma16((kp + (i * 32 + r) * 64 + ks * 16 + hh * 8), (unsigned)(size_t)(buf + GB_K + (i * 4 + ks) * 1024));
#pragma unroll
    for (int j = 0; j < 4; ++j)
        dma16((up + (size_t)sl * 2048 + j * 512 + ln * 8), (unsigned)(size_t)(buf + GB_U + j * 1024));
}
DI void task_gdn_seq(const Ctx& c, int L, int unit) {
    const int sl = (unit >> 3) & 3, stream = (unit & 7) + 8 * (unit >> 5);
    const int b = stream >> 2, h = stream & 3;
    const int r0_ = c.lane & 31, hh0_ = c.lane >> 5; int r = r0_, hh = hh0_, ln = c.lane;
    PG8_LAS unsigned char* lbase = (PG8_LAS unsigned char*)c.lds;
    f32x16 S[4];
#pragma unroll
    for (int i = 0; i < 4; ++i)
#pragma unroll
        for (int j = 0; j < 16; ++j) S[i][j] = 0.f;
    bf16_t* yo = c.Y3 + (size_t)1 * MPAD * 512;
    gdn_issue(c, stream * 32, sl, r, hh, ln, lbase);
    for (int ch = 0; ch < 32; ++ch) {
        r = r0_; hh = hh0_; ln = c.lane; asm volatile("" : "+v"(r), "+v"(hh), "+v"(ln));
        const int item = stream * 32 + ch;
        const float gl = c.GL[item];
        asm volatile("s_waitcnt vmcnt(0)" ::: "memory");
        PG8_LAS unsigned char* buf = lbase + (ch & 1) * GB_BYTES;
        if (ch + 1 < 32) gdn_issue(c, item + 1, sl, r, hh, ln, lbase + ((ch + 1) & 1) * GB_BYTES);
        PG8_LAS unsigned char* lb = buf + ln * 16; asm volatile("" : "+v"(lb));
        PG8_LAS unsigned char* ub = buf + GB_U + ln * 2; asm volatile("" : "+v"(ub));
        f32x16 vn[2], o[2];
#pragma unroll
        for (int mt = 0; mt < 2; ++mt)
#pragma unroll
            for (int i = 0; i < 16; ++i) { vn[mt][i] = bf2f(*(const PG8_LAS bf16_t*)(ub + (mt * 16 + i) * 128)); o[mt][i] = 0.f; }
        bf16x8 Sb[8];
#pragma unroll
        for (int ks = 0; ks < 8; ++ks) Sb[ks] = pack16(S[ks >> 1], ks & 1);
#pragma unroll
        for (int mt = 0; mt < 2; ++mt)
#pragma unroll
            for (int ks = 0; ks < 8; ++ks) { const bf16x8 a = *(const PG8_LAS bf16x8*)(lb + GB_W + (mt * 8 + ks) * 1024); vn[mt] = MFMA32(a, Sb[ks], vn[mt]); }
#pragma unroll
        for (int mt = 0; mt < 2; ++mt)
#pragma unroll
            for (int ks = 0; ks < 8; ++ks) { const bf16x8 a = *(const PG8_LAS bf16x8*)(lb + GB_Q + (mt * 8 + ks) * 1024); o[mt] = MFMA32(a, Sb[ks], o[mt]); }
        bf16x8 Vb[4];
#pragma unroll
        for (int ks = 0; ks < 4; ++ks) Vb[ks] = pack16(vn[ks >> 1], ks & 1);
#pragma unroll
        for (int mt = 0; mt < 2; ++mt)
#pragma unroll
            for (int ks = 0; ks < 4; ++ks) { const bf16x8 a = *(const PG8_LAS bf16x8*)(lb + GB_A + (mt * 4 + ks) * 1024); o[mt] = MFMA32(a, Vb[ks], o[mt]); }
#pragma unroll
        for (int i = 0; i < 4; ++i) {
#pragma unroll
            for (int j = 0; j < 16; ++j) S[i][j] *= gl;
#pragma unroll
            for (int ks = 0; ks < 4; ++ks) { const bf16x8 a = *(const PG8_LAS bf16x8*)(lb + GB_K + (i * 4 + ks) * 1024); S[i] = MFMA32(a, Vb[ks], S[i]); }
        }
        const size_t rowb = (size_t)(b * SEQ + ch * 64);
#pragma unroll
        for (int mt = 0; mt < 2; ++mt)
#pragma unroll
            for (int i = 0; i < 16; ++i) yo[(rowb + mt * 32 + crow(i, hh)) * 512 + h * 128 + sl * 32 + r] = f2bf(o[mt][i]);
        asm volatile("s_waitcnt lgkmcnt(0)" ::: "memory");
    }
    float* so = c.out + O_GDN_P + ((size_t)(L * NB + b) * 4 + h) * 128 * 128;
#pragma unroll
    for (int i = 0; i < 4; ++i)
#pragma unroll
        for (int j = 0; j < 16; ++j) so[(size_t)(i * 32 + crow(j, hh)) * 128 + sl * 32 + r] = S[i][j];
}

DI void task_ml_gates(const Ctx& c, int L, int item) {
    const int ch = item & 31, h = (item >> 5) & 3, b = item >> 7, lane = c.lane;
    const size_t row = (size_t)(b * SEQ + ch * 64 + lane);
    const float li = softcap_(c.SG[row * 16 + 8 + h] + c.in[27][L * 4 + h]);
    const float lf = logsig_(softcap_(c.SG[row * 16 + 12 + h] + c.in[28][L * 4 + h]));
    const float bc = wave_incl_sum(lf, lane);
    const float av = li - bc;
    const float cm = wave_incl_max(av, lane);
    float* mg = (float*)(c.ws + WS_MG) + (size_t)item * 192;
    mg[lane] = av; mg[64 + lane] = cm; mg[128 + lane] = bc;
}
DI void ml_issue(const bf16_t* PR, int b, int h, int sl, int ch, int lane, unsigned bufaddr) {
    const size_t row = (size_t)(b * SEQ + ch * 64 + lane);
    const bf16_t* kp = PR + row * NPROJ + PMK + h * 64; const bf16_t* qp = PR + row * NPROJ + PMQ + h * 64; const bf16_t* vp = PR + row * NPROJ + PMV + h * 128 + sl * 32;
#pragma unroll
    for (int d8 = 0; d8 < 8; ++d8) { dma16(kp + d8 * 8, bufaddr + d8 * 1024); dma16(qp + d8 * 8, bufaddr + 8192 + d8 * 1024); }
#pragma unroll
    for (int d8 = 0; d8 < 4; ++d8) dma16(vp + d8 * 8, bufaddr + 16384 + d8 * 1024);
}
DI void task_ml_seq(const Ctx& c, int L, int unit, float* wl  ) {
    const int sl = (unit >> 3) & 3, stream = (unit & 7) + 8 * (unit >> 5);
    const int b = stream >> 2, h = stream & 3;
    const int lane = c.lane, r0_ = lane & 31, hh0_ = lane >> 5;
    int r = r0_, hh = hh0_, lane_v = lane;
    LAS float* a_l = (LAS float*)wl; LAS float* w_l = a_l + 64; LAS float* sc_l = a_l + 128; LAS float* inv_l = a_l + 192;
    LAS unsigned char* bufs = (LAS unsigned char*)(a_l + 256);
    const unsigned bufaddr0 = (unsigned)(size_t)bufs;
    const bf16_t* PR = c.R1;
    f32x16 C[2];
#pragma unroll
    for (int i = 0; i < 2; ++i)
#pragma unroll
        for (int j = 0; j < 16; ++j) C[i][j] = 0.f;
    float nst = 0.f, mprev = 0.f;
    bf16_t* yo = c.Y3 + (size_t)2 * MPAD * 512;
    float mgv[3];
    { const float* mg = (const float*)(c.ws + WS_MG) + (size_t)(stream * 32) * 192; mgv[0] = mg[lane]; mgv[1] = mg[64 + lane]; mgv[2] = mg[128 + lane]; }
    ml_issue(PR, b, h, sl, 0, lane, bufaddr0);
    for (int ch = 0; ch < 32; ++ch) {
        r = r0_; hh = hh0_; lane_v = lane; asm volatile("" : "+v"(r), "+v"(hh), "+v"(lane_v));
        const float av = mgv[0], cmx = mgv[1], bc = mgv[2];
        asm volatile("s_waitcnt vmcnt(0)" ::: "memory");
        if (ch + 1 < 32) ml_issue(PR, b, h, sl, ch + 1, lane_v, bufaddr0 + ((ch + 1) & 1) * 20480);
        { const int chn = ch + 1 < 32 ? ch + 1 : 31; const float* mg = (const float*)(c.ws + WS_MG) + (size_t)(stream * 32 + chn) * 192;
          mgv[0] = mg[lane_v]; mgv[1] = mg[64 + lane_v]; mgv[2] = mg[128 + lane_v]; }
        LAS unsigned char* Kc = bufs + (ch & 1) * 20480; asm volatile("" : "+v"(Kc));
        LAS unsigned char* Qc = Kc + 8192; LAS unsigned char* Vc = Kc + 16384;
        LAS unsigned char* vbase = Vc + (r >> 3) * 1024 + (r & 7) * 2 + hh * 64; asm volatile("" : "+v"(vbase));
        LAS unsigned char* kbase = Kc + (r >> 3) * 1024 + (r & 7) * 2 + hh * 64; asm volatile("" : "+v"(kbase));
        LAS unsigned char* krow = Kc + hh * 1024 + r * 16; asm volatile("" : "+v"(krow));
        LAS unsigned char* qrow = Qc + hh * 1024 + r * 16; asm volatile("" : "+v"(qrow));
        LAS unsigned char* qr4 = Qc + r * 16 + hh * 8; asm volatile("" : "+v"(qr4));
        LAS unsigned char* kn = Kc + (lane_v >> 3) * 1024 + (lane_v & 7) * 2; asm volatile("" : "+v"(kn));
        LAS unsigned char* qln = Qc + lane_v * 16; asm volatile("" : "+v"(qln));
        LAS float* a4b = a_l + 4 * hh; asm volatile("" : "+v"(a4b));
        const size_t t0 = (size_t)(b * SEQ + ch * 64);
        const float Mt = fmaxf(mprev, cmx);
        const float sct = __expf(mprev - Mt);
        const float M63 = __shfl(Mt, 63), bc63 = __shfl(bc, 63);
        const float wlast = __expf(av - M63) * 0.125f;
        const float sclast = __expf(mprev - M63);
        WAVE_FENCE();
        float qn = 0.f;
#pragma unroll
        for (int d8 = 0; d8 < 8; ++d8) { const f32x8 qv = unpack8(*(const LAS bf16x8*)(qln + d8 * 1024));
#pragma unroll
            for (int e = 0; e < 8; ++e) qn += qv[e] * __shfl(nst, d8 * 8 + e); }
        a_l[lane] = av; w_l[lane] = wlast;
        WAVE_FENCE();
        bf16x8 Vb[4];
#pragma unroll
        for (int ks = 0; ks < 4; ++ks)
#pragma unroll
            for (int j = 0; j < 8; ++j) Vb[ks][j] = (short)*(const LAS bf16_t*)(vbase + (16 * ks + 8 * (j >> 2) + (j & 3)) * 16);
        __builtin_amdgcn_sched_barrier(0);
        f32x16 num[2]; float dpv[2];
#pragma unroll
        for (int nt = 0; nt < 2; ++nt) {
            f32x16 PT[2];
#pragma unroll
            for (int ms = 0; ms < 2; ++ms)
#pragma unroll
                for (int j = 0; j < 16; ++j) PT[ms][j] = 0.f;
#pragma unroll
            for (int ks = 0; ks < 4; ++ks) {
                const bf16x8 bq = *(const LAS bf16x8*)(qrow + ks * 2048 + nt * 512);
#pragma unroll
                for (int ms = 0; ms < 2; ++ms) { const bf16x8 ak = *(const LAS bf16x8*)(krow + ks * 2048 + ms * 512); PT[ms] = MFMA32(ak, bq, PT[ms]); }
            }
            const float Mtn = __shfl(Mt, nt * 32 + r);
            float dp = 0.f;
#pragma unroll
            for (int ms = 0; ms < 2; ++ms)
#pragma unroll
                for (int g = 0; g < 4; ++g) { const f32x4 a4 = *(const LAS f32x4*)(a4b + ms * 32 + 8 * g);
#pragma unroll
                    for (int jj = 0; jj < 4; ++jj) { const int i = 4 * g + jj; const int s = ms * 32 + 8 * g + 4 * hh + jj;
                        const float wv = (s <= nt * 32 + r) ? __expf(a4[jj] - Mtn) * 0.125f : 0.f;
                        PT[ms][i] *= wv; dp += PT[ms][i]; } }
            dp += __shfl_xor(dp, 32); dpv[nt] = dp;
#pragma unroll
            for (int j = 0; j < 16; ++j) num[nt][j] = 0.f;
#pragma unroll
            for (int ks = 0; ks < 4; ++ks) num[nt] = MFMA32(pack16(PT[ks >> 1], ks & 1), Vb[ks], num[nt]);
            __builtin_amdgcn_sched_barrier(0);
        }
        const float den = (lane < 32 ? dpv[0] : dpv[1]) + sct * qn;
        const float inv = 1.f / fmaxf(fabsf(den), __expf(-(bc + Mt)));
        sc_l[lane] = sct; inv_l[lane] = inv;
        WAVE_FENCE();
        { bf16x8 Cb[4];
#pragma unroll
          for (int kd = 0; kd < 4; ++kd) Cb[kd] = pack16(C[kd >> 1], kd & 1);
#pragma unroll
          for (int mt = 0; mt < 2; ++mt) { f32x16 qc;
#pragma unroll
              for (int j = 0; j < 16; ++j) qc[j] = 0.f;
#pragma unroll
              for (int kd = 0; kd < 4; ++kd) { const LAS unsigned char* qr = qr4 + kd * 2048 + mt * 512;
                  const s16x4 lo = *(const LAS s16x4*)qr, hi = *(const LAS s16x4*)(qr + 1024);
                  const bf16x8 a = __builtin_shufflevector(lo, hi, 0, 1, 2, 3, 4, 5, 6, 7);
                  qc = MFMA32(a, Cb[kd], qc); }
#pragma unroll
              for (int g = 0; g < 4; ++g) { const f32x4 s4 = *(const LAS f32x4*)(a4b + 128 + mt * 32 + 8 * g), i4 = *(const LAS f32x4*)(a4b + 192 + mt * 32 + 8 * g);
#pragma unroll
                  for (int jj = 0; jj < 4; ++jj) { const int i = 4 * g + jj; const float hv = (num[mt][i] + s4[jj] * qc[i]) * i4[jj];
                      yo[(t0 + mt * 32 + 8 * g + 4 * hh + jj) * 512 + h * 128 + sl * 32 + r] = f2bf(hv); } }
              __builtin_amdgcn_sched_barrier(0);
          } }
#pragma unroll
        for (int i = 0; i < 2; ++i) {
#pragma unroll
            for (int j = 0; j < 16; ++j) C[i][j] *= sclast;
#pragma unroll
            for (int ks = 0; ks < 4; ++ks) { const f32x4 wA = *(const LAS f32x4*)(a4b + 64 + 16 * ks), wB = *(const LAS f32x4*)(a4b + 64 + 16 * ks + 8);
                f32x8 kv;
#pragma unroll
                for (int j = 0; j < 8; ++j) kv[j] = bf2f(*(const LAS bf16_t*)(kbase + i * 4096 + (16 * ks + 8 * (j >> 2) + (j & 3)) * 16)) * (j < 4 ? wA[j & 3] : wB[j & 3]);
                C[i] = MFMA32(pack8v(kv), Vb[ks], C[i]); }
            __builtin_amdgcn_sched_barrier(0);
        }
        { float na = 0.f;
#pragma unroll 8
          for (int s = 0; s < 64; ++s) na += w_l[s] * bf2f(*(const LAS bf16_t*)(kn + s * 16));
          nst = sclast * nst + na; }
        mprev = bc63 + M63;
        asm volatile("s_waitcnt lgkmcnt(0)" ::: "memory");
    }
    float* co = c.out + O_MLC_P + ((size_t)(L * NB + b) * 4 + h) * 64 * 128;
#pragma unroll
    for (int i = 0; i < 2; ++i)
#pragma unroll
        for (int j = 0; j < 16; ++j) co[(size_t)(i * 32 + crow(j, hh)) * 128 + sl * 32 + r] = C[i][j];
    if (sl == 0) { c.out[O_MLN_P + ((size_t)(L * NB + b) * 4 + h) * 64 + lane] = nst; if (lane == 0) c.out[O_MLM_P + (size_t)(L * NB + b) * 4 + h] = mprev; }
}

DI void task_gdn_sample(const Ctx& c, int L, int unit) {
    const int half = unit & 1, h = (unit >> 1) & 3, b = unit >> 3, lane = c.lane;
    const size_t row = (size_t)(MP + b);
    const bf16_t* pr = c.R1 + row * NPROJ;
    const float* cbuf = c.in[4] + ((size_t)L * MS + b) * 3 * 1536;
    const float* cw = c.in[23] + (size_t)L * 4 * 1536;
    float* cout = c.out + O_CONV_S + ((size_t)L * MS + b) * 3 * 1536;
    float qv[2], kv[2], vv;
#pragma unroll
    for (int w = 0; w < 5; ++w) {
        const int which = w < 2 ? 0 : w < 4 ? 1 : 2; const int d = (w == 4) ? half * 64 + lane : lane + 64 * (w & 1);
        const int cc = which * 512 + h * 128 + d;
        const float xin = bf2f(pr[PQ + cc]);
        const float b0 = cbuf[cc], b1 = cbuf[1536 + cc], b2 = cbuf[3072 + cc];
        float a = b0 * cw[cc] + b1 * cw[1536 + cc] + b2 * cw[3072 + cc] + xin * cw[4608 + cc];
        a = silu_(a);
        cout[cc] = b1; cout[1536 + cc] = b2; cout[3072 + cc] = xin;
        if (w < 2) qv[w] = a; else if (w < 4) kv[w - 2] = a; else vv = a;
    }
    { const float sq = wave_sum(qv[0] * qv[0] + qv[1] * qv[1]), sk = wave_sum(kv[0] * kv[0] + kv[1] * kv[1]);
      const float fq = rsqrtf(sq + EPS) * 0.08838834764831845f, fk = rsqrtf(sk + EPS);
      qv[0] *= fq; qv[1] *= fq; kv[0] *= fk; kv[1] *= fk; }
    const float qk = wave_sum(qv[0] * kv[0] + qv[1] * kv[1]);
    const float beta = sigm(c.SG[row * 16 + h]);
    const float g = -expf(c.in[24][L * 4 + h]) * softplus_(c.SG[row * 16 + 4 + h] + c.in[25][L * 4 + h]);
    const float eg = expf(g);
    const float* sin_ = c.in[5] + (((size_t)L * MS + b) * 4 + h) * 128 * 128 + half * 64 + lane;
    float* sout = c.out + O_GDN_S + (((size_t)L * MS + b) * 4 + h) * 128 * 128 + half * 64 + lane;
    float kS = 0.f, qS = 0.f;
#pragma unroll
    for (int hf = 0; hf < 2; ++hf) { const float kh = kv[hf], qh = qv[hf];
#pragma unroll 8
        for (int d = 0; d < 64; ++d) { const float sv = sin_[(size_t)(hf * 64 + d) * 128]; kS += __shfl(kh, d) * sv; qS += __shfl(qh, d) * sv; } }
    const float vnew = beta * (vv - eg * kS);
    const float o = eg * qS + qk * vnew;
#pragma unroll
    for (int hf = 0; hf < 2; ++hf) { const float kh = kv[hf];
#pragma unroll 8
        for (int d = 0; d < 64; ++d) { const float sv = sin_[(size_t)(hf * 64 + d) * 128]; sout[(size_t)(hf * 64 + d) * 128] = sv * eg + __shfl(kh, d) * vnew; } }
    c.Y3[(size_t)1 * MPAD * 512 + row * 512 + h * 128 + half * 64 + lane] = f2bf(o);
}
DI void task_ml_sample(const Ctx& c, int L, int unit) {
    const int half = unit & 1, h = (unit >> 1) & 3, b = unit >> 3, lane = c.lane;
    const size_t row = (size_t)(MP + b);
    const bf16_t* pr = c.R1 + row * NPROJ;
    const float q = bf2f(pr[PMQ + h * 64 + lane]), k = bf2f(pr[PMK + h * 64 + lane]) * 0.125f, v = bf2f(pr[PMV + h * 128 + half * 64 + lane]);
    const float li = softcap_(c.SG[row * 16 + 8 + h] + c.in[27][L * 4 + h]);
    const float lf = logsig_(softcap_(c.SG[row * 16 + 12 + h] + c.in[28][L * 4 + h]));
    const size_t sidx = ((size_t)L * MS + b) * 4 + h;
    const float m0 = c.in[8][sidx];
    const float mt = fmaxf(lf + m0, li), wts = expf(li - mt), sc = expf(lf + m0 - mt);
    const float n0 = c.in[7][sidx * 64 + lane];
    const float sqk = wave_sum(q * k) * wts, qn = wave_sum(q * n0);
    const float* cin = c.in[6] + sidx * 64 * 128 + half * 64 + lane;
    float* cout = c.out + O_MLC_S + sidx * 64 * 128 + half * 64 + lane;
    float cc[64]; float qC = 0.f;
#pragma unroll
    for (int d = 0; d < 64; ++d) { cc[d] = cin[(size_t)d * 128]; qC += __shfl(q, d) * cc[d]; }
    const float num = sqk * v + sc * qC, den = sqk + sc * qn;
    const float hv = num / fmaxf(fabsf(den), expf(-mt));
#pragma unroll
    for (int d = 0; d < 64; ++d) cout[(size_t)d * 128] = sc * cc[d] + wts * __shfl(k, d) * v;
    if (half == 0) { c.out[O_MLN_S + sidx * 64 + lane] = sc * n0 + wts * k; if (lane == 0) c.out[O_MLM_S + sidx] = mt; }
    c.Y3[(size_t)2 * MPAD * 512 + row * 512 + h * 128 + half * 64 + lane] = f2bf(hv);
}
struct S5P { float lr, li; f32x2 bb[16]; };
DI S5P s5_params(const Ctx& c, int L, int g, int p) {
    S5P P; const size_t gp = ((size_t)L * 32 + g) * 64 + p;
    const float are = c.in[13][gp], aim = c.in[14][gp], dt = expf(c.in[15][L * 32 + g]);
    const float mag = expf(are * dt); P.lr = mag * cosf(aim * dt); P.li = mag * sinf(aim * dt);
    const float inv = 1.f / (are * are + aim * aim), zr = P.lr - 1.f, zi = P.li;
    const float fre = (zr * are + zi * aim) * inv, fim = (zi * are - zr * aim) * inv;
    const float* Bre = c.in[16] + gp * 16; const float* Bim = c.in[17] + gp * 16;
#pragma unroll
    for (int q4 = 0; q4 < 4; ++q4) { const f32x4 br = *(const f32x4*)(Bre + 4 * q4), bi = *(const f32x4*)(Bim + 4 * q4);
#pragma unroll
        for (int e = 0; e < 4; ++e) { P.bb[4 * q4 + e][0] = fre * br[e] - fim * bi[e]; P.bb[4 * q4 + e][1] = fre * bi[e] + fim * br[e]; } }
    return P;
}
DI void task_s5_sample(const Ctx& c, int L, int unit) {
    const int g = unit & 31, b = unit >> 5, lane = c.lane;
    const S5P P = s5_params(c, L, g, lane);
    const size_t row = (size_t)(MP + b);
    const bf16_t* pr = c.R1 + row * NPROJ + PU + g * 16;
    float u[16];
    { const f32x8 u0 = unpack8(*(const bf16x8*)pr), u1 = unpack8(*(const bf16x8*)(pr + 8));
#pragma unroll
      for (int e = 0; e < 8; ++e) { u[e] = u0[e]; u[8 + e] = u1[e]; } }
    f32x2 bu = {0.f, 0.f};
#pragma unroll
    for (int cc = 0; cc < 16; ++cc) bu += P.bb[cc] * u[cc];
    const size_t si = (((size_t)L * MS + b) * 32 + g) * 64 + lane;
    const float h0r = c.in[2][si], h0i = c.in[3][si];
    const float hr = P.lr * h0r - P.li * h0i + bu[0], hi = P.lr * h0i + P.li * h0r + bu[1];
    c.out[O_S5RE_S + si] = hr; c.out[O_S5IM_S + si] = hi;
    const float* Cre = c.in[18] + ((size_t)L * 32 + g) * 16 * 64; const float* Cim = c.in[19] + ((size_t)L * 32 + g) * 16 * 64;
    float ya[16];
#pragma unroll
    for (int cc = 0; cc < 16; ++cc) ya[cc] = hr * Cre[cc * 64 + lane] - hi * Cim[cc * 64 + lane];
    butterfly16(ya, lane);
    if ((lane & 3) == 0) { const int cc = bsel16(lane); const float y = ya[0] + c.in[20][L * 512 + g * 16 + cc] * bf2f(pr[cc]);
        c.YS5[row * 512 + g * 16 + cc] = f2bf(gelu_t(y)); }
}

DI void task_s5_wave(const Ctx& c, int L, int unit, unsigned char* wlds  ) {
    LAS float* Uw = (LAS float*)wlds;
    LAS bf16_t* Hw = (LAS bf16_t*)(wlds + 4096);
    const int lane = c.lane;
    const int g = unit & 31, b = unit >> 5;
    const S5P P = s5_params(c, L, g, lane);
    const size_t rbase = (size_t)(b * SEQ);
    const bf16_t* ub = c.R1 + rbase * NPROJ + PU + g * 16;
    bf16x8 Cb[4];
    { const int cc = lane & 15, kq = (lane >> 4) * 8; const float* Cre = c.in[18] + (((size_t)L * 32 + g) * 16 + cc) * 64; const float* Cim = c.in[19] + (((size_t)L * 32 + g) * 16 + cc) * 64;
#pragma unroll
      for (int ks = 0; ks < 4; ++ks) { f32x8 v;
#pragma unroll
          for (int j = 0; j < 8; ++j) { const int k = ks * 32 + kq + j; v[j] = (k < 64) ? Cre[k] : -Cim[k - 64]; }
          Cb[ks] = pack8v(v); } }
    const float dskip = c.in[20][L * 512 + g * 16 + (lane & 15)];
    float hr = 0.f, hi = 0.f;
    for (int sub = 0; sub < 32; ++sub) {
        WAVE_FENCE();
        { const bf16_t* up = ub + (size_t)(sub * 64 + lane) * NPROJ; const f32x8 u0 = unpack8(*(const bf16x8*)up), u1 = unpack8(*(const bf16x8*)(up + 8));
          LAS f32x4* d = (LAS f32x4*)(Uw + lane * 16);
          d[0] = (f32x4){u0[0], u0[1], u0[2], u0[3]}; d[1] = (f32x4){u0[4], u0[5], u0[6], u0[7]}; d[2] = (f32x4){u1[0], u1[1], u1[2], u1[3]}; d[3] = (f32x4){u1[4], u1[5], u1[6], u1[7]}; }
        WAVE_FENCE();
        for (int blk = 0; blk < 4; ++blk) {
#pragma unroll 4
            for (int st = 0; st < 16; ++st) {
                const LAS f32x4* up4 = (const LAS f32x4*)(Uw + (blk * 16 + st) * 16);
                f32x2 bu = {0.f, 0.f};
#pragma unroll
                for (int q4 = 0; q4 < 4; ++q4) { const f32x4 uv = up4[q4];
#pragma unroll
                    for (int e = 0; e < 4; ++e) bu += P.bb[4 * q4 + e] * uv[e]; }
                const float nr = P.lr * hr - P.li * hi + bu[0], ni = P.lr * hi + P.li * hr + bu[1]; hr = nr; hi = ni;
                Hw[st * 128 + lane] = f2bf(hr); Hw[st * 128 + 64 + lane] = f2bf(hi);
            }
            WAVE_FENCE();
            f32x4 acc = {0.f, 0.f, 0.f, 0.f};
#pragma unroll
            for (int ks = 0; ks < 4; ++ks) { const bf16x8 a = *(const LAS bf16x8*)(Hw + (lane & 15) * 128 + ks * 32 + (lane >> 4) * 8); acc = MFMA16(a, Cb[ks], acc); }
            const int cc = lane & 15;
#pragma unroll
            for (int j = 0; j < 4; ++j) { const int st = (lane >> 4) * 4 + j; const int tl = blk * 16 + st;
                const float y = acc[j] + dskip * Uw[tl * 16 + cc];
                c.YS5[(rbase + sub * 64 + tl) * 512 + g * 16 + cc] = f2bf(gelu_t(y)); }
            WAVE_FENCE();
        }
    }
    { const size_t si = (((size_t)L * NB + b) * 32 + g) * 64 + lane; c.out[O_S5RE_P + si] = hr; c.out[O_S5IM_P + si] = hi; }
}

constexpr int S5Q_BASE = 122880, S5Q_F = S5Q_BASE + 32768, S5Q_FLAG = S5Q_F + 2048;
template <int PASS> DI void s5_steps16(const S5P& P, const LAS float* Ublk, LAS bf16_t* Hw, int lane, float& hr, float& hi) {
#pragma unroll
    for (int s4 = 0; s4 < 4; ++s4) {
        f32x4 uv[4][4];
#pragma unroll
        for (int j = 0; j < 4; ++j)
#pragma unroll
            for (int q4 = 0; q4 < 4; ++q4) uv[j][q4] = *(const LAS f32x4*)(Ublk + (s4 * 4 + j) * 16 + q4 * 4);
        asm volatile("" ::: "memory");
        f32x2 bu[4];
#pragma unroll
        for (int j = 0; j < 4; ++j) { f32x2 acc[4];
#pragma unroll
            for (int q4 = 0; q4 < 4; ++q4) { acc[q4] = P.bb[4 * q4] * uv[j][q4][0];
#pragma unroll
                for (int e = 1; e < 4; ++e) acc[q4] += P.bb[4 * q4 + e] * uv[j][q4][e]; }
            bu[j] = (acc[0] + acc[1]) + (acc[2] + acc[3]); }
#pragma unroll
        for (int j = 0; j < 4; ++j) { const float nr = P.lr * hr - P.li * hi + bu[j][0], ni = P.lr * hi + P.li * hr + bu[j][1]; hr = nr; hi = ni;
            if (PASS == 1) { Hw[(s4 * 4 + j) * 128 + lane] = f2bf(hr); Hw[(s4 * 4 + j) * 128 + 64 + lane] = f2bf(hi); } }
    }
}
DI void task_s5_quad(const Ctx& c, int L, int unit, int wq, int gen) {
    unsigned char* wlds = c.lds + S5Q_BASE + wq * 8192;
    LAS float* Uw = (LAS float*)wlds;
    LAS bf16_t* Hw = (LAS bf16_t*)(wlds + 4096);
    LAS float* F = (LAS float*)(c.lds + S5Q_F);
    volatile LAS int* flag = (volatile LAS int*)(c.lds + S5Q_FLAG);
    const int lane = c.lane;
    const int g = unit & 31, b = unit >> 5;
    const S5P P = s5_params(c, L, g, lane);
    float pr_ = P.lr, pi_ = P.li;
#pragma unroll
    for (int i = 0; i < 9; ++i) { const float nr = pr_ * pr_ - pi_ * pi_, ni = 2.f * pr_ * pi_; pr_ = nr; pi_ = ni; }
    const size_t rbase = (size_t)(b * SEQ + wq * 512);
    const bf16_t* ub = c.R1 + rbase * NPROJ + PU + g * 16;
    bf16x8 Cb[4];
    { const int cc = lane & 15, kq = (lane >> 4) * 8; const float* Cre = c.in[18] + (((size_t)L * 32 + g) * 16 + cc) * 64; const float* Cim = c.in[19] + (((size_t)L * 32 + g) * 16 + cc) * 64;
#pragma unroll
      for (int ks = 0; ks < 4; ++ks) { f32x8 v;
#pragma unroll
          for (int j = 0; j < 8; ++j) { const int k = ks * 32 + kq + j; v[j] = (k < 64) ? Cre[k] : -Cim[k - 64]; }
          Cb[ks] = pack8v(v); } }
    const float dskip = c.in[20][L * 512 + g * 16 + (lane & 15)];
    float hr = 0.f, hi = 0.f;
    for (int pass = 0; pass < 2; ++pass) {
        if (pass == 1) {
            hr = 0.f; hi = 0.f;
            for (int v = 0; v < wq; ++v) { while (flag[v] != gen) __builtin_amdgcn_s_sleep(2);
                asm volatile("" ::: "memory");
                const float fr = F[v * 128 + lane], fi = F[v * 128 + 64 + lane];
                const float nr = pr_ * hr - pi_ * hi + fr, ni = pr_ * hi + pi_ * hr + fi; hr = nr; hi = ni; }
        }
        for (int sub = 0; sub < 8; ++sub) {
            WAVE_FENCE();
            { const bf16_t* up = ub + (size_t)(sub * 64 + lane) * NPROJ; const f32x8 u0 = unpack8(*(const bf16x8*)up), u1 = unpack8(*(const bf16x8*)(up + 8));
              LAS f32x4* d = (LAS f32x4*)(Uw + lane * 16);
              d[0] = (f32x4){u0[0], u0[1], u0[2], u0[3]}; d[1] = (f32x4){u0[4], u0[5], u0[6], u0[7]}; d[2] = (f32x4){u1[0], u1[1], u1[2], u1[3]}; d[3] = (f32x4){u1[4], u1[5], u1[6], u1[7]}; }
            WAVE_FENCE();
            for (int blk = 0; blk < 4; ++blk) {
                if (pass == 1) s5_steps16<1>(P, Uw + blk * 256, Hw, lane, hr, hi); else s5_steps16<0>(P, Uw + blk * 256, Hw, lane, hr, hi);
                if (pass == 1) {
                    WAVE_FENCE();
                    f32x4 acc = {0.f, 0.f, 0.f, 0.f};
#pragma unroll
                    for (int ks = 0; ks < 4; ++ks) { const bf16x8 a = *(const LAS bf16x8*)(Hw + (lane & 15) * 128 + ks * 32 + (lane >> 4) * 8); acc = MFMA16(a, Cb[ks], acc); }
                    const int cc = lane & 15;
#pragma unroll
                    for (int j = 0; j < 4; ++j) { const int st = (lane >> 4) * 4 + j; const int tl = blk * 16 + st;
                        const float y = acc[j] + dskip * Uw[tl * 16 + cc];
                        c.YS5[(rbase + sub * 64 + tl) * 512 + g * 16 + cc] = f2bf(gelu_t(y)); }
                    WAVE_FENCE();
                }
            }
        }
        if (pass == 0) {
            if (wq < 3) { F[wq * 128 + lane] = hr; F[wq * 128 + 64 + lane] = hi; WAVE_FENCE(); if (lane == 0) flag[wq] = gen; }
        }
    }
    if (wq == 3) { const size_t si = (((size_t)L * NB + b) * 32 + g) * 64 + lane; c.out[O_S5RE_P + si] = hr; c.out[O_S5IM_P + si] = hi; }
}

DI void phase_s5_scan(const Ctx& c, int L) {
    float* U = (float*)c.lds;
    bf16_t* H = (bf16_t*)(c.lds + 32768);
    float* F = (float*)(c.lds + 65536);
    const int lane = c.lane, w = c.wave;
    float* Uw = U + w * 1024; bf16_t* Hw = H + w * 2048;
    for (int unit = c.bid; unit < 256; unit += c.G) {
        const int g = unit & 31, b = unit >> 5;
        const S5P P = s5_params(c, L, g, lane);
        float pr_ = P.lr, pi_ = P.li;
#pragma unroll
        for (int i = 0; i < 8; ++i) { const float nr = pr_ * pr_ - pi_ * pi_, ni = 2.f * pr_ * pi_; pr_ = nr; pi_ = ni; }
        const size_t rbase = (size_t)(b * SEQ + w * 256);
        const bf16_t* ub = c.R1 + rbase * NPROJ + PU + g * 16;
        bf16x8 Cb[4];
        { const int cc = lane & 15, kq = (lane >> 4) * 8; const float* Cre = c.in[18] + (((size_t)L * 32 + g) * 16 + cc) * 64; const float* Cim = c.in[19] + (((size_t)L * 32 + g) * 16 + cc) * 64;
#pragma unroll
          for (int ks = 0; ks < 4; ++ks) { f32x8 v;
#pragma unroll
              for (int j = 0; j < 8; ++j) { const int k = ks * 32 + kq + j; v[j] = (k < 64) ? Cre[k] : -Cim[k - 64]; }
              Cb[ks] = pack8v(v); } }
        const float dskip = c.in[20][L * 512 + g * 16 + (lane & 15)];
        float hr = 0.f, hi = 0.f;
        for (int pass = 0; pass < 2; ++pass) {
            if (pass == 1) {
                F[w * 128 + lane] = hr; F[w * 128 + 64 + lane] = hi;
                __syncthreads();
                hr = 0.f; hi = 0.f;
                for (int v = 0; v < w; ++v) { const float fr = F[v * 128 + lane], fi = F[v * 128 + 64 + lane];
                    const float nr = pr_ * hr - pi_ * hi + fr, ni = pr_ * hi + pi_ * hr + fi; hr = nr; hi = ni; }
            }
            for (int sub = 0; sub < 4; ++sub) {
                __syncthreads();
                { const bf16_t* up = ub + (size_t)(sub * 64 + lane) * NPROJ; const f32x8 u0 = unpack8(*(const bf16x8*)up), u1 = unpack8(*(const bf16x8*)(up + 8));
                  f32x4* d = (f32x4*)(Uw + lane * 16);
                  d[0] = (f32x4){u0[0], u0[1], u0[2], u0[3]}; d[1] = (f32x4){u0[4], u0[5], u0[6], u0[7]}; d[2] = (f32x4){u1[0], u1[1], u1[2], u1[3]}; d[3] = (f32x4){u1[4], u1[5], u1[6], u1[7]}; }
                __syncthreads();
                for (int blk = 0; blk < 4; ++blk) {
#pragma unroll 4
                    for (int st = 0; st < 16; ++st) {
                        const f32x4* up4 = (const f32x4*)(Uw + (blk * 16 + st) * 16);
                        f32x2 bu = {0.f, 0.f};
#pragma unroll
                        for (int q4 = 0; q4 < 4; ++q4) { const f32x4 uv = up4[q4];
#pragma unroll
                            for (int e = 0; e < 4; ++e) bu += P.bb[4 * q4 + e] * uv[e]; }
                        const float nr = P.lr * hr - P.li * hi + bu[0], ni = P.lr * hi + P.li * hr + bu[1]; hr = nr; hi = ni;
                        if (pass == 1) { Hw[st * 128 + lane] = f2bf(hr); Hw[st * 128 + 64 + lane] = f2bf(hi); }
                    }
                    if (pass == 1) {
                        __syncthreads();
                        f32x4 acc = {0.f, 0.f, 0.f, 0.f};
#pragma unroll
                        for (int ks = 0; ks < 4; ++ks) { const bf16x8 a = *(const bf16x8*)(Hw + (lane & 15) * 128 + ks * 32 + (lane >> 4) * 8); acc = MFMA16(a, Cb[ks], acc); }
                        const int cc = lane & 15;
#pragma unroll
                        for (int j = 0; j < 4; ++j) { const int st = (lane >> 4) * 4 + j; const int tl = blk * 16 + st;
                            const float y = acc[j] + dskip * Uw[tl * 16 + cc];
                            c.YS5[(rbase + sub * 64 + tl) * 512 + g * 16 + cc] = f2bf(gelu_t(y)); }
                        __syncthreads();
                    }
                }
            }
        }
        if (w == 7) { const size_t si = (((size_t)L * NB + b) * 32 + g) * 64 + lane; c.out[O_S5RE_P + si] = hr; c.out[O_S5IM_P + si] = hi; }
        __syncthreads();
    }
}


#ifdef SELFCHK
DI void blk_reduce2(float& a, float& b, float* red, int tid) {
    a = wave_sum(a); b = wave_sum(b);
    __syncthreads();
    if ((tid & 63) == 0) { red[tid >> 6] = a; red[8 + (tid >> 6)] = b; }
    __syncthreads();
    float x = 0.f, y = 0.f;
    for (int i = 0; i < 8; ++i) { x += red[i]; y += red[8 + i]; }
    a = x; b = y; __syncthreads();
}
DI void chk_gdn(const Ctx& c, int L, int b, int h, float* dg) {
    float* q = (float*)c.lds; float* k = q + 128; float* v = k + 128; float* part = v + 128; float* red = part + 512; float* sc_ = red + 16;
    const int tid = c.tid, dv = tid & 127, qt = tid >> 7;
    const float* convw = c.in[23] + (size_t)L * 4 * 1536;
    float S[32];
#pragma unroll
    for (int i = 0; i < 32; ++i) S[i] = 0.f;
    float e2 = 0.f, r2 = 0.f;
    for (int t = 0; t < SEQ; ++t) {
        const size_t row = (size_t)b * SEQ + t;
        if (tid < 384) { const int which = tid >> 7, d = tid & 127; float a = 0.f;
            for (int j = 0; j < 4; ++j) { const int tt = t + j - 3; if (tt >= 0) a += bf2f(c.R1[((size_t)b * SEQ + tt) * NPROJ + PQ + which * 512 + h * 128 + d]) * convw[j * 1536 + which * 512 + h * 128 + d]; }
            (which == 0 ? q : which == 1 ? k : v)[d] = silu_(a); }
        __syncthreads();
        float sq = 0.f, sk = 0.f;
        for (int d = 0; d < 128; ++d) { sq += q[d] * q[d]; sk += k[d] * k[d]; }
        const float fq = rsqrtf(sq + EPS) * 0.08838834764831845f, fk = rsqrtf(sk + EPS);
        const float beta = sigm(c.SG[row * 16 + h]);
        const float g = -expf(c.in[24][L * 4 + h]) * softplus_(c.SG[row * 16 + 4 + h] + c.in[25][L * 4 + h]);
        const float eg = expf(g);
        float ks = 0.f;
#pragma unroll
        for (int i = 0; i < 32; ++i) { S[i] *= eg; ks += k[qt * 32 + i] * fk * S[i]; }
        part[qt * 128 + dv] = ks;
        __syncthreads();
        const float kS = part[dv] + part[128 + dv] + part[256 + dv] + part[384 + dv];
        const float vnew = beta * (v[dv] - kS);
        float qs = 0.f;
#pragma unroll
        for (int i = 0; i < 32; ++i) { S[i] += k[qt * 32 + i] * fk * vnew; qs += q[qt * 32 + i] * fq * S[i]; }
        __syncthreads();
        part[qt * 128 + dv] = qs;
        __syncthreads();
        if (qt == 0) { const float o = part[dv] + part[128 + dv] + part[256 + dv] + part[384 + dv];
            const float got = bf2f(c.Y3[(size_t)1 * MPAD * 512 + row * 512 + h * 128 + dv]); e2 += (got - o) * (got - o); r2 += o * o; }
        __syncthreads();
    }
    blk_reduce2(e2, r2, red, tid);
    if (tid == 0) dg[0] = sqrtf(e2 / (r2 + 1e-30f));
    float e3 = 0.f, r3 = 0.f;
#pragma unroll
    for (int i = 0; i < 32; ++i) { const float got = c.out[O_GDN_P + (((size_t)L * NB + b) * 4 + h) * 16384 + (size_t)(qt * 32 + i) * 128 + dv]; e3 += (got - S[i]) * (got - S[i]); r3 += S[i] * S[i]; }
    blk_reduce2(e3, r3, red, tid);
    if (tid == 0) dg[1] = sqrtf(e3 / (r3 + 1e-30f));
    (void)sc_;
}
DI void chk_ml(const Ctx& c, int L, int b, int h, float* dg) {
    float* q = (float*)c.lds; float* k = q + 64; float* v = k + 64; float* n = v + 128; float* part = n + 64; float* red = part + 512;
    const int tid = c.tid, e = tid & 127, qt = tid >> 7;
    float C[16];
#pragma unroll
    for (int i = 0; i < 16; ++i) C[i] = 0.f;
    if (tid < 64) n[tid] = 0.f;
    float m = 0.f, e2 = 0.f, r2 = 0.f;
    __syncthreads();
    for (int t = 0; t < SEQ; ++t) {
        const size_t row = (size_t)b * SEQ + t;
        if (tid < 64) { q[tid] = bf2f(c.R1[row * NPROJ + PMQ + h * 64 + tid]); k[tid] = bf2f(c.R1[row * NPROJ + PMK + h * 64 + tid]) * 0.125f; }
        else if (tid < 192) v[tid - 64] = bf2f(c.R1[row * NPROJ + PMV + h * 128 + tid - 64]);
        __syncthreads();
        const float li = softcap_(c.SG[row * 16 + 8 + h] + c.in[27][L * 4 + h]);
        const float lf = logsig_(softcap_(c.SG[row * 16 + 12 + h] + c.in[28][L * 4 + h]));
        const float mn = fmaxf(lf + m, li), wts = expf(li - mn), sc = expf(lf + m - mn);
        float qk = 0.f, qn = 0.f;
        for (int d = 0; d < 64; ++d) { qk += q[d] * k[d]; qn += q[d] * n[d]; }
        float pc = 0.f;
#pragma unroll
        for (int i = 0; i < 16; ++i) pc += q[qt * 16 + i] * C[i];
        part[qt * 128 + e] = pc;
        __syncthreads();
        const float qC = part[e] + part[128 + e] + part[256 + e] + part[384 + e];
        const float sqk = qk * wts, num = sqk * v[e] + sc * qC, den = sqk + sc * qn;
        const float hv = num / fmaxf(fabsf(den), expf(-mn));
        if (qt == 0) { const float got = bf2f(c.Y3[(size_t)2 * MPAD * 512 + row * 512 + h * 128 + e]); e2 += (got - hv) * (got - hv); r2 += hv * hv; }
#pragma unroll
        for (int i = 0; i < 16; ++i) C[i] = sc * C[i] + wts * k[qt * 16 + i] * v[e];
        __syncthreads();
        if (tid < 64) n[tid] = sc * n[tid] + wts * k[tid];
        m = mn;
        __syncthreads();
    }
    blk_reduce2(e2, r2, red, tid);
    if (tid == 0) dg[2] = sqrtf(e2 / (r2 + 1e-30f));
    float e3 = 0.f, r3 = 0.f;
#pragma unroll
    for (int i = 0; i < 16; ++i) { const float got = c.out[O_MLC_P + (((size_t)L * NB + b) * 4 + h) * 8192 + (size_t)(qt * 16 + i) * 128 + e]; e3 += (got - C[i]) * (got - C[i]); r3 += C[i] * C[i]; }
    if (tid < 64) { const float got = c.out[O_MLN_P + (((size_t)L * NB + b) * 4 + h) * 64 + tid]; e3 += (got - n[tid]) * (got - n[tid]) * 64.f; r3 += n[tid] * n[tid] * 64.f; }
    if (tid == 0) { const float got = c.out[O_MLM_P + ((size_t)L * NB + b) * 4 + h]; e3 += (got - m) * (got - m) * 4096.f; r3 += m * m * 4096.f; }
    blk_reduce2(e3, r3, red, tid);
    if (tid == 0) dg[3] = sqrtf(e3 / (r3 + 1e-30f));
}
DI void chk_s5(const Ctx& c, int L, int b, int g, float* dg) {
    float* red = (float*)c.lds;
    float e2 = 0.f, r2 = 0.f, e3 = 0.f, r3 = 0.f;
    if (c.tid < 64) { const int lane = c.tid; const S5P P = s5_params(c, L, g, lane);
        const float* Cre = c.in[18] + ((size_t)L * 32 + g) * 16 * 64; const float* Cim = c.in[19] + ((size_t)L * 32 + g) * 16 * 64;
        float hr = 0.f, hi = 0.f;
        for (int t = 0; t < SEQ; ++t) { const size_t row = (size_t)b * SEQ + t; const bf16_t* pr = c.R1 + row * NPROJ + PU + g * 16;
            f32x2 bu = {0.f, 0.f};
#pragma unroll
            for (int cc = 0; cc < 16; ++cc) bu += P.bb[cc] * bf2f(pr[cc]);
            const float nr = P.lr * hr - P.li * hi + bu[0], ni = P.lr * hi + P.li * hr + bu[1]; hr = nr; hi = ni;
            for (int cc = 0; cc < 16; ++cc) { float y = wave_sum(hr * Cre[cc * 64 + lane] - hi * Cim[cc * 64 + lane]) + c.in[20][L * 512 + g * 16 + cc] * bf2f(pr[cc]);
                y = gelu_t(y); const float got = bf2f(c.YS5[row * 512 + g * 16 + cc]); if (lane == 0) { e2 += (got - y) * (got - y); r2 += y * y; } } }
        const size_t si = (((size_t)L * NB + b) * 32 + g) * 64 + lane;
        e3 = (c.out[O_S5RE_P + si] - hr) * (c.out[O_S5RE_P + si] - hr) + (c.out[O_S5IM_P + si] - hi) * (c.out[O_S5IM_P + si] - hi); r3 = hr * hr + hi * hi; }
    blk_reduce2(e2, r2, red, c.tid);
    blk_reduce2(e3, r3, red, c.tid);
    if (c.tid == 0) { dg[4] = sqrtf(e2 / (r2 + 1e-30f)); dg[5] = sqrtf(e3 / (r3 + 1e-30f)); }
}
#endif


#ifdef SELFCHK
DI float dot_bf(const bf16_t* a, const bf16_t* b, int K) { float s = 0.f; for (int k = 0; k < K; ++k) s += bf2f(a[k]) * bf2f(b[k]); return s; }
DI void chk_gemm(const Ctx& c, int L, int mode, float* dgp) {
    float* red = (float*)c.lds;
    float e2 = 0.f, r2 = 0.f;
    for (int rep = 0; rep < 2; ++rep) {
        const int sidx = c.tid + 512 * rep;
        const int row = (rep == 1 && c.tid < 64) ? MP + (c.tid * 2) : (int)(((unsigned)sidx * 7919u) % (unsigned)MP);
        float want = 0.f, got = 0.f;
        if (mode == 0) { const int col = (int)(((unsigned)sidx * 104729u) % 4096u); want = dot_bf(c.XN + (size_t)row * 1024, c.W + WO_IN + (size_t)col * 1024, 1024); got = bf2f(c.R1[(size_t)row * 4096 + col]); }
        if (mode == 1) { const int col = (int)(((unsigned)sidx * 104729u) % 3072u); want = sigm(dot_bf(c.XN + (size_t)row * 1024, c.W + WO_G + (size_t)col * 1024, 1024)); got = bf2f(c.R1[(size_t)row * 4096 + col]); }
        if (mode == 2) { const int col = (int)(((unsigned)sidx * 104729u) % 512u); const float y = bf2f(c.YS5[(size_t)row * 512 + col]);
            want = y * sigm(dot_bf(c.YS5 + (size_t)row * 512, c.W + WO_GLU + (size_t)col * 512, 512) + c.in[22][L * 512 + col]); got = bf2f(c.Y3[(size_t)row * 512 + col]); }
        if (mode == 3) { const int col = (int)(((unsigned)sidx * 104729u) % 1024u);
            for (int br = 0; br < 3; ++br) want += bf2f(c.R1[(size_t)row * 4096 + br * 1024 + col]) * dot_bf(c.Y3 + (size_t)br * MPAD * 512 + (size_t)row * 512, c.W + WO_BR + (size_t)br * 1024 * 512 + (size_t)col * 512, 512);
            got = bf2f(c.XN[(size_t)row * 1024 + col]); }
        if (mode == 4) { const int col = (int)(((unsigned)sidx * 104729u) % 4096u); const float d = fmaxf(dot_bf(c.XN + (size_t)row * 1024, c.W + WO_UP + (size_t)col * 1024, 1024), 0.f); want = d * d; got = bf2f(c.R1[(size_t)row * 4096 + col]); }
        if (mode == 5) { const int col = (int)(((unsigned)sidx * 104729u) % 1024u); want = dot_bf(c.Y3 + (size_t)row * 256, c.W + WO_PLE + (size_t)col * 256, 256); got = bf2f(c.Y3[(size_t)MPAD * 256 + (size_t)row * 1024 + col]); }
        e2 += (got - want) * (got - want); r2 += want * want;
    }
    blk_reduce2(e2, r2, red, c.tid);
    if (c.tid == 0) *dgp = sqrtf(e2 / (r2 + 1e-30f));
}
#endif

#ifdef SELFCHK
DI void chk_sg(const Ctx& c, float* dgp) {
    float* red = (float*)c.lds; float e2 = 0.f, r2 = 0.f;
    { const int sidx = c.tid >> 4, s = c.tid & 15; const int row = (sidx < 8) ? MP + sidx * 13 : (int)(((unsigned)sidx * 7919u * 37u) % (unsigned)MP);
      const float* x = row < MP ? c.in[0] + (size_t)row * 1024 : c.in[1] + (size_t)(row - MP) * 1024;
      const int sc = s < 4 ? 2560 + s : s < 8 ? 2564 + (s - 4) : s < 12 ? 4104 + (s - 8) : 4108 + (s - 12);
      float ss = 0.f; for (int k = 0; k < 1024; ++k) ss += x[k] * x[k];
      const float rs = rsqrtf(ss * (1.f / 1024.f) + EPS); float a = 0.f;
      for (int k = 0; k < 1024; ++k) a += x[k] * rs * c.in[11][k] * c.in[12][(size_t)k * DIN + sc];
      const float got = c.SG[(size_t)row * 16 + s]; e2 = (got - a) * (got - a); r2 = a * a; }
    blk_reduce2(e2, r2, red, c.tid);
    if (c.tid == 0) *dgp = sqrtf(e2 / (r2 + 1e-30f));
}
DI void chk_post(const Ctx& c, int L, float* dgp) {
    float* red = (float*)c.lds; float e2 = 0.f, r2 = 0.f;
    { const int hd8 = c.tid & 7, sidx = c.tid >> 3; const int row = (sidx < 8) ? MP + sidx * 11 : (int)(((unsigned)sidx * 7919u * 53u) % (unsigned)MP);
      const int br = hd8 >> 2, hd = hd8 & 3; float ms = 0.f;
      for (int e = 0; e < 128; ++e) { const float y = bf2f(c.Y3[(size_t)(1 + br) * MPAD * 512 + (size_t)row * 512 + hd * 128 + e]);
          const float z = bf2f(c.R1[(size_t)row * NPROJ + (br == 0 ? PZ : PMO) + hd * 128 + e]);
          const float gn = br == 0 ? c.in[26][L * 128 + e] : c.in[29][L * 512 + hd * 128 + e];
          const float w = y / (gn * (br == 0 ? silu_(z) : sigm(z))); ms += w * w; }
      ms *= (1.f / 128.f); e2 = (ms - 1.f) * (ms - 1.f); r2 = 1.f; }
    blk_reduce2(e2, r2, red, c.tid);
    if (c.tid == 0) *dgp = sqrtf(e2 / (r2 + 1e-30f));
}
DI void chk_res(const Ctx& c, int L, int mode, const float (&snap)[2], float* dgp) {
    float* red = (float*)c.lds; float e2 = 0.f, r2 = 0.f;
    for (int rep = 0; rep < 2; ++rep) { const int sidx = c.tid + 512 * rep;
        const int row = (rep == 1 && c.tid < 64) ? MP + (c.tid * 2) : (int)(((unsigned)sidx * 7919u) % (unsigned)MP); const int col = (int)(((unsigned)sidx * 104729u) % 1024u);
        const float now = c.out[(size_t)row * 1024 + col]; float before = snap[rep], want = 0.f;
        if (mode == 0) { before = row < MP ? c.in[0][(size_t)row * 1024 + col] : c.in[1][(size_t)(row - MP) * 1024 + col]; want = dot_bf(c.XN + (size_t)row * 1024, c.W + WO_OUT + (size_t)col * 1024, 1024); }
        if (mode == 1) want = dot_bf(c.R1 + (size_t)row * 4096, c.W + WO_DN + (size_t)col * 4096, 4096);
        if (mode == 2) want = bf2f(c.Y3[(size_t)MPAD * 256 + (size_t)row * 1024 + col]) * sigm(dot_bf(c.XN + (size_t)row * 1024, c.W + WO_PG + (size_t)col * 1024, 1024));
        e2 += (now - before - want) * (now - before - want); r2 += want * want; }
    blk_reduce2(e2, r2, red, c.tid);
    if (c.tid == 0) *dgp = sqrtf(e2 / (r2 + 1e-30f));
}
DI void snap_x(const Ctx& c, float (&snap)[2]) {
    for (int rep = 0; rep < 2; ++rep) { const int sidx = c.tid + 512 * rep;
        const int row = (rep == 1 && c.tid < 64) ? MP + (c.tid * 2) : (int)(((unsigned)sidx * 7919u) % (unsigned)MP); const int col = (int)(((unsigned)sidx * 104729u) % 1024u);
        snap[rep] = c.out[(size_t)row * 1024 + col]; }
}
DI void chk_sample(const Ctx& c, int L, int b, int h, float* dgp) {
    float* red = (float*)c.lds; float e2 = 0.f, r2 = 0.f, e3 = 0.f, r3 = 0.f;
    const size_t row = (size_t)(MP + b); const bf16_t* pr = c.R1 + row * NPROJ;
    if (c.tid < 128) { const int dv = c.tid;
        const float* cbuf = c.in[4] + ((size_t)L * MS + b) * 3 * 1536; const float* cw = c.in[23] + (size_t)L * 4 * 1536;
        float sq = 0.f, sk = 0.f;
        for (int d = 0; d < 128; ++d) for (int w = 0; w < 2; ++w) { const int cc = w * 512 + h * 128 + d;
            const float a = silu_(cbuf[cc] * cw[cc] + cbuf[1536 + cc] * cw[1536 + cc] + cbuf[3072 + cc] * cw[3072 + cc] + bf2f(pr[PQ + cc]) * cw[4608 + cc]); if (w == 0) sq += a * a; else sk += a * a; }
        const float fq = rsqrtf(sq + EPS) * 0.08838834764831845f, fk = rsqrtf(sk + EPS);
        const int cv = 1024 + h * 128 + dv;
        const float vv = silu_(cbuf[cv] * cw[cv] + cbuf[1536 + cv] * cw[1536 + cv] + cbuf[3072 + cv] * cw[3072 + cv] + bf2f(pr[PQ + cv]) * cw[4608 + cv]);
        const float beta = sigm(c.SG[row * 16 + h]), eg = expf(-expf(c.in[24][L * 4 + h]) * softplus_(c.SG[row * 16 + 4 + h] + c.in[25][L * 4 + h]));
        const float* S0 = c.in[5] + (((size_t)L * MS + b) * 4 + h) * 16384; const float* S1 = c.out + O_GDN_S + (((size_t)L * MS + b) * 4 + h) * 16384;
        float kS = 0.f, qS = 0.f, qk = 0.f;
        for (int d = 0; d < 128; ++d) { const int cq = h * 128 + d, ck = 512 + h * 128 + d;
            const float qd = silu_(cbuf[cq] * cw[cq] + cbuf[1536 + cq] * cw[1536 + cq] + cbuf[3072 + cq] * cw[3072 + cq] + bf2f(pr[PQ + cq]) * cw[4608 + cq]) * fq;
            const float kd = silu_(cbuf[ck] * cw[ck] + cbuf[1536 + ck] * cw[1536 + ck] + cbuf[3072 + ck] * cw[3072 + ck] + bf2f(pr[PQ + ck]) * cw[4608 + ck]) * fk;
            kS += kd * S0[d * 128 + dv]; qS += qd * S0[d * 128 + dv]; qk += qd * kd; }
        const float vnew = beta * (vv - eg * kS);
        for (int d = 0; d < 128; ++d) { const int ck = 512 + h * 128 + d;
            const float kd = silu_(cbuf[ck] * cw[ck] + cbuf[1536 + ck] * cw[1536 + ck] + cbuf[3072 + ck] * cw[3072 + ck] + bf2f(pr[PQ + ck]) * cw[4608 + ck]) * fk;
            const float want = S0[d * 128 + dv] * eg + kd * vnew, got = S1[d * 128 + dv]; e2 += (got - want) * (got - want); r2 += want * want; }
        (void)qS; (void)qk;
    } else if (c.tid < 256) { const int e = c.tid - 128;
        const size_t sidx = ((size_t)L * MS + b) * 4 + h;
        const float li = softcap_(c.SG[row * 16 + 8 + h] + c.in[27][L * 4 + h]), lf = logsig_(softcap_(c.SG[row * 16 + 12 + h] + c.in[28][L * 4 + h]));
        const float m0 = c.in[8][sidx], mt = fmaxf(lf + m0, li), wts = expf(li - mt), sc = expf(lf + m0 - mt);
        const float v = bf2f(pr[PMV + h * 128 + e]);
        for (int d = 0; d < 64; ++d) { const float k = bf2f(pr[PMK + h * 64 + d]) * 0.125f;
            const float want = sc * c.in[6][sidx * 8192 + d * 128 + e] + wts * k * v, got = c.out[O_MLC_S + sidx * 8192 + d * 128 + e]; e3 += (got - want) * (got - want); r3 += want * want; }
        if (e < 64) { const float k = bf2f(pr[PMK + h * 64 + e]) * 0.125f; const float want = sc * c.in[7][sidx * 64 + e] + wts * k, got = c.out[O_MLN_S + sidx * 64 + e]; e3 += 64.f * (got - want) * (got - want); r3 += 64.f * want * want; }
        if (e == 0) { const float got = c.out[O_MLM_S + sidx]; e3 += 4096.f * (got - mt) * (got - mt); r3 += 4096.f * mt * mt; }
    }
    blk_reduce2(e2, r2, red, c.tid);
    blk_reduce2(e3, r3, red, c.tid);
    if (c.tid == 0) { dgp[0] = sqrtf(e2 / (r2 + 1e-30f)); dgp[1] = sqrtf(e3 / (r3 + 1e-30f)); }
}
#endif
DI void phase_conv_state(const Ctx& c, int L) {
    for (int idx = c.bid * 512 + c.tid; idx < NB * 3 * 1536; idx += c.G * 512) { const int cc = idx % 1536, j = (idx / 1536) % 3, b = idx / (3 * 1536);
        c.out[O_CONV_P + ((size_t)L * NB + b) * 3 * 1536 + j * 1536 + cc] = bf2f(c.R1[(size_t)(b * SEQ + SEQ - 3 + j) * NPROJ + PQ + cc]); }
}
DI void phase_post(const Ctx& c, int L) {
    const int lane = c.lane, hd = lane >> 4, e0 = (lane & 15) * 8;
    bf16_t* yg = c.Y3 + (size_t)1 * MPAD * 512; bf16_t* ym = c.Y3 + (size_t)2 * MPAD * 512;
    const float* gg = c.in[26] + (size_t)L * 128 + e0; const float* gm = c.in[29] + (size_t)L * 512 + hd * 128 + e0;
    for (int row = c.bid * 8 + c.wave; row < MR; row += c.G * 8) {
        const bf16_t* pr = c.R1 + (size_t)row * NPROJ;
#pragma unroll
        for (int br = 0; br < 2; ++br) {
            bf16_t* yp = (br == 0 ? yg : ym) + (size_t)row * 512 + hd * 128 + e0;
            f32x8 o = unpack8(*(const bf16x8*)yp); const f32x8 z = unpack8(*(const bf16x8*)(pr + (br == 0 ? PZ : PMO) + hd * 128 + e0));
            float ss = 0.f;
#pragma unroll
            for (int e = 0; e < 8; ++e) ss += o[e] * o[e];
            ss += __shfl_xor(ss, 1); ss += __shfl_xor(ss, 2); ss += __shfl_xor(ss, 4); ss += __shfl_xor(ss, 8);
            const float rs = rsqrtf(ss * (1.f / 128.f) + EPS);
            const float* gp = br == 0 ? gg : gm;
#pragma unroll
            for (int e = 0; e < 8; ++e) o[e] = o[e] * rs * gp[e] * (br == 0 ? silu_(z[e]) : sigm(z[e]));
            *(bf16x8*)yp = pack8v(o);
        }
    }
}

DI void phase_cvt_ple(const Ctx& c, int L) {
    bf16_t* PB = c.Y3;
    for (size_t i = (size_t)c.bid * 512 + c.tid; i < (size_t)MR * 64; i += (size_t)c.G * 512) {
        const size_t row = i >> 6, c4 = (i & 63) * 4;
        const float* src = row < MP ? c.in[9] + ((size_t)L * MP + row) * 256 + c4 : c.in[10] + ((size_t)L * MS + (row - MP)) * 256 + c4;
        *(s16x4*)(PB + row * 256 + c4) = pack4v(*(const f32x4*)src); }
}
DI void phase_final_norm(const Ctx& c) {
    const float* gain = c.in[39];
    for (int row = c.bid * 8 + c.wave; row < MR; row += c.G * 8) {
        float* xp = c.out + (size_t)row * 1024; f32x4 x[4]; float ss = 0.f;
#pragma unroll
        for (int i = 0; i < 4; ++i) { x[i] = *(const f32x4*)(xp + c.lane * 4 + 256 * i); ss += x[i][0] * x[i][0] + x[i][1] * x[i][1] + x[i][2] * x[i][2] + x[i][3] * x[i][3]; }
        ss = wave_sum(ss); const float rs = rsqrtf(ss * (1.f / 1024.f) + EPS);
#pragma unroll
        for (int i = 0; i < 4; ++i) { const f32x4 g = *(const f32x4*)(gain + c.lane * 4 + 256 * i); *(f32x4*)(xp + c.lane * 4 + 256 * i) = x[i] * rs * g; }
    }
}

#define XB_TMO      128
#define XB_XCNT(j)  (256  + 64 * (j))
#define XB_XSUB(j)  (1280 + 64 * (j))
#define XB_XGEN(j)  (2304 + 64 * (j))
#define XB_TOP      3328
#define XB_TOPGEN   3392
#define XCD_BAR_WORDS 3456
#define XB_SPIN_CAP (1u << 18)

__device__ __forceinline__ unsigned xb_ld(unsigned* p)              { return __hip_atomic_load(p, __ATOMIC_RELAXED, __HIP_MEMORY_SCOPE_AGENT); }
__device__ __forceinline__ unsigned xb_add(unsigned* p, unsigned v) { return __hip_atomic_fetch_add(p, v, __ATOMIC_RELAXED, __HIP_MEMORY_SCOPE_AGENT); }
__device__ __forceinline__ unsigned xb_xcc_id() { return (unsigned)__builtin_amdgcn_s_getreg((3 << 11) | 20) & 0xFu; }
#define XB_SPIN(cond, bar) do { unsigned _sp = 0; while (cond) { __builtin_amdgcn_s_sleep(1); \
    if ((++_sp & 255u) == 0u) { if (xb_ld(&(bar)[XB_TMO])) break; if (_sp > XB_SPIN_CAP) { atomicAdd(&(bar)[XB_TMO], 1u); break; } } } } while (0)

struct XcdBarrier {
    unsigned* bar; unsigned x;
    volatile LAS unsigned* st;
};

__device__ __forceinline__ XcdBarrier xcd_barrier_post(unsigned* bar, volatile LAS unsigned* st) {
    XcdBarrier b; b.bar = bar; b.x = xb_xcc_id(); b.st = st;
    if (threadIdx.x == 0) (void)xb_add(&bar[XB_XCNT(b.x)], 1u);
    return b;
}
__device__ __forceinline__ void xcd_barrier_complete(unsigned* bar, unsigned x, unsigned& nloc, unsigned& nx) {
    const unsigned G = gridDim.x * gridDim.y * gridDim.z;
    unsigned sum, cnt, mine, sp = 0u;
    for (;;) {
        sum = 0u; cnt = 0u; mine = 0u;
#pragma unroll
        for (unsigned j = 0; j < 16; ++j) { const unsigned c = xb_ld(&bar[XB_XCNT(j)]); sum += c; cnt += (c > 0u) ? 1u : 0u; mine = (j == x) ? c : mine; }
        if (sum == G) break;
        __builtin_amdgcn_s_sleep(1);
        if ((++sp & 255u) == 0u) { if (xb_ld(&bar[XB_TMO])) break; if (sp > XB_SPIN_CAP) { atomicAdd(&bar[XB_TMO], 1u); break; } }
    }
    nloc = mine > 0u ? mine : 1u; nx = cnt > 0u ? cnt : 1u;
}

__device__ __forceinline__ void xcd_barrier(const XcdBarrier& b) {
    asm volatile("s_waitcnt vmcnt(0)" ::: "memory");
    __syncthreads();
    if (threadIdx.x == 0) {
        unsigned* bar = b.bar;
        __builtin_amdgcn_s_waitcnt(0);
        unsigned nloc = b.st[0], nx = b.st[1];
        if (nloc == 0u) { xcd_barrier_complete(bar, b.x, nloc, nx); b.st[0] = nloc; b.st[1] = nx; }
        const unsigned old = xb_add(&bar[XB_XSUB(b.x)], 1u);
        const unsigned gen = old / nloc;
        if (old + 1u == (gen + 1u) * nloc) {
            __builtin_amdgcn_fence(__ATOMIC_RELEASE, "agent");
            asm volatile("s_waitcnt vmcnt(0)" ::: "memory");
            const unsigned og = xb_add(&bar[XB_TOP], 1u);
            const unsigned tg = og / nx;
            if (og + 1u == (tg + 1u) * nx) xb_add(&bar[XB_TOPGEN], 1u);
            else XB_SPIN(xb_ld(&bar[XB_TOPGEN]) == tg, bar);
            __builtin_amdgcn_fence(__ATOMIC_ACQUIRE, "agent");
            xb_add(&bar[XB_XGEN(b.x)], 1u);
            asm volatile("s_waitcnt vmcnt(0)" ::: "memory");
        } else {
            XB_SPIN(xb_ld(&bar[XB_XGEN(b.x)]) == gen, bar);
            __builtin_amdgcn_fence(__ATOMIC_ACQUIRE, "agent");
            asm volatile("s_waitcnt vmcnt(0)" ::: "memory");
        }
    }
    __syncthreads();
}

__global__ void __launch_bounds__(512, 2) fwd_megakernel(KP kp) {
    extern __shared__ __attribute__((aligned(16))) unsigned char lds[];
    cg::grid_group grid = cg::this_grid();
    Ctx c; c.lds = lds; c.G = gridDim.x; c.bid = blockIdx.x;
    const ka_t ka0 = (ka_t)__builtin_amdgcn_kernarg_segment_ptr();
    (void)kp;
#define REFRESH() do { ka_t ka_ = ka0; asm volatile("" : "+s"(ka_)); int t_ = threadIdx.x; asm volatile("" : "+v"(t_)); \
        c.in.ka = ka_; c.out = (float*)(gfloat_t*)ka_[40]; unsigned char* w_ = (unsigned char*)(guchar_t*)ka_[41]; c.ws = w_; \
        c.R1 = (bf16_t*)(w_ + WS_R1); c.XN = (bf16_t*)(w_ + WS_XN); c.Y3 = (bf16_t*)(w_ + WS_Y3); c.W = (bf16_t*)(w_ + WS_W); c.YS5 = (bf16_t*)(w_ + WS_YS5); \
        c.GS = w_ + WS_GS; c.SG = (float*)(w_ + WS_SG); c.GL = (float*)(w_ + WS_GL); \
        c.tid = t_; c.lane = t_ & 63; c.wave = __builtin_amdgcn_readfirstlane(t_ >> 6); \
        int b_ = blockIdx.x, g_ = gridDim.x; asm volatile("" : "+s"(b_), "+s"(g_)); c.bid = b_; c.G = g_; } while (0)
    REFRESH();
    volatile LAS unsigned* bst = (volatile LAS unsigned*)(lds + LDS_BYTES - 16);
    if (c.tid < 4) bst[c.tid] = 0u;
    if (c.tid < 16) ((volatile LAS int*)(lds + S5Q_FLAG))[c.tid] = 0;
    __syncthreads();
    XcdBarrier xbar = xcd_barrier_post((unsigned*)(c.ws + WS_BAR), bst);
    int nsync_ = 0;
#ifndef PHMASK
#define PHMASK 0xFFFFFFFFu
#endif
#define PH(n) if (PHMASK & (1 << (n)))
#ifdef DUP_SYNC
#define GSYNC() do { grid.sync(); grid.sync(); } while (0)
#else
#define GSYNC() do { if (nsync_++ == 0) grid.sync(); else xcd_barrier(xbar); } while (0)
#endif
    for (int L = 0; L < 2; ++L) {
        REFRESH(); PH(0) phase_weights(c, L);
        REFRESH(); PH(1) phase_rmsnorm<0>(c, L);
        GSYNC();
        REFRESH(); PH(2) run_gemm(c, c.XN, c.W + WO_IN, NPROJ, 1024, FStore{c.R1, NPROJ});
#ifdef DUP_GEMM
        REFRESH(); PH(2) run_gemm(c, c.XN, c.W + WO_IN, NPROJ, 1024, FStore{c.R1, NPROJ});
#endif
        GSYNC();
#ifdef DUP_MIX
        for (int rep_ = 0; rep_ < 2; ++rep_) {
#else
        {
#endif
        REFRESH(); phase_conv_state(c, L);
        REFRESH(); for (int it = c.bid * 8 + c.wave; it < 1024; it += c.G * 8) task_ml_gates(c, L, it);
        REFRESH(); PH(3) phase_gdn_prep(c, L);
#ifdef DUP_PREP
        REFRESH(); PH(3) phase_gdn_prep(c, L);
#endif
#ifdef DUP_S5
#endif
        GSYNC();
#ifdef DUP_P4
        for (int rep4_ = 0; rep4_ < 2; ++rep4_) {
#else
        {
#endif
        if (c.wave == 0) {
            for (int u = c.bid; u < 256; u += c.G) { REFRESH(); if (u < 128) { PH(5) task_gdn_seq(c, L, u);
#ifdef DUP_GSEQ
                REFRESH(); task_gdn_seq(c, L, u);
#endif
              } else { PH(6) task_ml_seq(c, L, u - 128, (float*)lds);
#ifdef DUP_MSEQ
                REFRESH(); task_ml_seq(c, L, u - 128, (float*)lds);
#endif
              } }
        } else if (c.wave <= 4) {
            int it_ = 0;
            for (int u = c.bid; u < 256; u += c.G, ++it_) { REFRESH(); PH(4) task_s5_quad(c, L, u, c.wave - 1, L * 16 + it_ + 1); }
        } else {
            const int wid = c.bid * 3 + (c.wave - 5), nw = c.G * 3;
            REFRESH(); PH(7) for (int u = wid; u < 1024; u += nw) task_gdn_sample(c, L, u);
            REFRESH(); PH(8) for (int u = wid; u < 1024; u += nw) task_ml_sample(c, L, u);
            REFRESH(); PH(9) for (int u = wid; u < 4096; u += nw) task_s5_sample(c, L, u);
        }
        GSYNC();
        }
        }
#ifdef SELFCHK
        if (L == SELFCHK_L) { REFRESH(); if (c.bid == 0) { float* dg = (float*)(c.ws + WS_GL) + 1024; chk_gdn(c, L, 1, 2, dg); chk_ml(c, L, 1, 2, dg); chk_s5(c, L, 1, 7, dg); chk_gemm(c, L, 0, dg + 6); if (L == 0) chk_sg(c, dg + 12); chk_sample(c, L, 5, 1, dg + 17); } grid.sync(); }
#endif
        REFRESH(); PH(10) phase_post(c, L);
        REFRESH(); PH(11) run_gemm(c, c.XN, c.W + WO_G, NGATE, 1024, FSig{c.R1, NPROJ});
#ifdef DUP_GEMM
        REFRESH(); PH(11) run_gemm(c, c.XN, c.W + WO_G, NGATE, 1024, FSig{c.R1, NPROJ});
#endif
        REFRESH(); PH(12) run_gemm(c, c.YS5, c.W + WO_GLU, 512, 512, FGlu{c.YS5, c.in[22] + (size_t)L * 512, c.Y3});
#ifdef DUP_GEMM
        REFRESH(); PH(12) run_gemm(c, c.YS5, c.W + WO_GLU, 512, 512, FGlu{c.YS5, c.in[22] + (size_t)L * 512, c.Y3});
#endif
        GSYNC();
#ifdef SELFCHK
        if (L == SELFCHK_L) { REFRESH(); if (c.bid == 0) { float* dg = (float*)(c.ws + WS_GL) + 1024; chk_gemm(c, L, 1, dg + 7); chk_gemm(c, L, 2, dg + 8); chk_post(c, L, dg + 13); } grid.sync(); }
#endif
        REFRESH(); PH(13) for (int br = 0; br < 3; ++br)
            run_gemm(c, c.Y3 + (size_t)br * MPAD * 512, c.W + WO_BR + (size_t)br * 1024 * 512, 1024, 512, FBranch{c.R1 + br * 1024, c.XN, br == 0 ? 1 : 0});
#ifdef DUP_GEMM
        REFRESH(); PH(13) for (int br = 0; br < 3; ++br)
            run_gemm(c, c.Y3 + (size_t)br * MPAD * 512, c.W + WO_BR + (size_t)br * 1024 * 512, 1024, 512, FBranch{c.R1 + br * 1024, c.XN, br == 0 ? 1 : 0});
#endif
        GSYNC();
#ifdef SELFCHK
        if (L == SELFCHK_L) { REFRESH(); if (c.bid == 0) { float* dg = (float*)(c.ws + WS_GL) + 1024; chk_gemm(c, L, 3, dg + 9); } grid.sync(); }
#endif
        REFRESH(); PH(14) run_gemm(c, c.XN, c.W + WO_OUT, 1024, 1024, FRes{c.out});
        GSYNC();
#ifdef SELFCHK
        if (L == 0 && SELFCHK_L == 0) { REFRESH(); if (c.bid == 0) { float* dg = (float*)(c.ws + WS_GL) + 1024; float sn[2] = {0.f, 0.f}; chk_res(c, L, 0, sn, dg + 14); } grid.sync(); }
#endif
        REFRESH(); PH(15) phase_rmsnorm<1>(c, L);
        REFRESH(); PH(18) phase_cvt_ple(c, L);
        GSYNC();
        REFRESH(); PH(16) run_gemm(c, c.XN, c.W + WO_UP, DFF, 1024, FRelu2{c.R1});
#ifdef DUP_GEMM
        REFRESH(); PH(16) run_gemm(c, c.XN, c.W + WO_UP, DFF, 1024, FRelu2{c.R1});
#endif
        GSYNC();
#ifdef SELFCHK
        if (L == SELFCHK_L) { REFRESH(); if (c.bid == 0) { float* dg = (float*)(c.ws + WS_GL) + 1024; chk_gemm(c, L, 4, dg + 10); } grid.sync(); }
#endif
#ifdef SELFCHK
        float snp[2] = {0.f, 0.f}; REFRESH(); if (L == SELFCHK_L && c.bid == 0) snap_x(c, snp);
#endif
        REFRESH(); PH(17) run_gemm(c, c.R1, c.W + WO_DN, 1024, 4096, FResB{c.out, c.XN});
        GSYNC();
#ifdef SELFCHK
        if (L == SELFCHK_L) { REFRESH(); if (c.bid == 0) { float* dg = (float*)(c.ws + WS_GL) + 1024; chk_res(c, L, 1, snp, dg + 15); } grid.sync(); }
#endif
#ifdef SELFCHK
        REFRESH(); if (L == SELFCHK_L && c.bid == 0) snap_x(c, snp);
#endif
        REFRESH(); PH(19) run_gemm(c, c.Y3, c.W + WO_PLE, 1024, 256, FStore{c.Y3 + (size_t)MPAD * 256, 1024});
#ifdef DUP_GEMM
        REFRESH(); PH(19) run_gemm(c, c.Y3, c.W + WO_PLE, 1024, 256, FStore{c.Y3 + (size_t)MPAD * 256, 1024});
#endif
        REFRESH(); PH(20) run_gemm(c, c.XN, c.W + WO_PG, 1024, 1024, FPle{c.Y3 + (size_t)MPAD * 256, c.out});
        GSYNC();
#ifdef SELFCHK
        if (L == SELFCHK_L) { REFRESH(); if (c.bid == 0) { float* dg = (float*)(c.ws + WS_GL) + 1024; chk_gemm(c, L, 5, dg + 11); chk_res(c, L, 2, snp, dg + 16); } grid.sync(); }
#endif
    }
    REFRESH(); phase_final_norm(c);
#ifdef SELFCHK
    grid.sync(); REFRESH();
    if (c.bid == 0 && c.tid == 0) { const float* dg = (const float*)(c.ws + WS_GL) + 1024; int kk = -1; float dv = 0.f;
        for (int i = 18; i >= 0; --i) if (dg[i] > SELFCHK_THR) { kk = i; dv = dg[i]; }
        if (kk >= 0) c.out[0] = __powf(10.f, (float)(2 * kk + 4)) * (1.f + fminf(dv, 8.f)); }
#endif
}

extern "C" void kernel_launch(void* const* d_in, const int* in_sizes, int n_in, void* d_out, int out_size, void* d_ws, size_t ws_size, hipStream_t stream) {
    static int grid = 0;
    if (grid == 0) {
        int dev = 0, cus = 0, per_cu = 0;
        if (hipGetDevice(&dev) != hipSuccess || hipDeviceGetAttribute(&cus, hipDeviceAttributeMultiprocessorCount, dev) != hipSuccess) { fprintf(stderr, "kernel_launch: device query failed\n"); grid = -1; return; }
        if (hipFuncSetAttribute((const void*)fwd_megakernel, hipFuncAttributeMaxDynamicSharedMemorySize, LDS_BYTES) != hipSuccess) { fprintf(stderr, "kernel_launch: hipFuncSetAttribute failed\n"); grid = -1; return; }
        if (hipOccupancyMaxActiveBlocksPerMultiprocessor(&per_cu, (const void*)fwd_megakernel, 512, LDS_BYTES) != hipSuccess || per_cu < 1) { fprintf(stderr, "kernel_launch: occupancy query says %d blocks per CU\n", per_cu); grid = -1; return; }
        grid = cus;
        if (grid > 256) grid = 256;
    }
    if (grid < 0) return;
    if (n_in != 40 || (size_t)out_size != O_TOTAL || ws_size < WS_END) { fprintf(stderr, "kernel_launch: unexpected sizes n_in %d out %d ws %zu (need %zu)\n", n_in, out_size, ws_size, (size_t)WS_END); return; }
    if (hipMemsetAsync((char*)d_ws + WS_BAR, 0, SZ_BAR, stream) != hipSuccess) { fprintf(stderr, "kernel_launch: memset failed\n"); return; }
    KP kp{};
    for (int i = 0; i < 40; ++i) kp.in[i] = (const float*)d_in[i];
    kp.out = (float*)d_out; kp.ws = (unsigned char*)d_ws;
    void* args[] = {&kp};
    hipError_t e = hipLaunchCooperativeKernel((const void*)fwd_megakernel, dim3(grid), dim3(512), args, LDS_BYTES, stream);
    if (e != hipSuccess) fprintf(stderr, "kernel_launch: cooperative launch failed: %s (grid %d)\n", hipGetErrorString(e), grid);
}
```

```cpp
#include <hip/hip_runtime.h>
#include <hip/hip_cooperative_groups.h>
#include <cstdio>
namespace cg = cooperative_groups;
namespace pg8 {
#define PG8_LAS __attribute__((address_space(3)))
typedef unsigned short bf16_t;
typedef short bf16x8 __attribute__((ext_vector_type(8)));
typedef float f32x4 __attribute__((ext_vector_type(4)));
typedef unsigned u32x4 __attribute__((ext_vector_type(4)));
constexpr int BM = 256, BK = 64, HALF = 128, HTB = HALF * BK * 2  , STAGE_BYTES = 8 * HTB, NXCD = 8, WGM = 8;

__host__ __device__ __forceinline__ int lds_byte(int r, int c) { const int st = (r >> 4) * 2 + (c >> 5), rr = r & 15, cc = c & 31, ob = rr * 64 + cc * 2; return st * 1024 + (ob ^ (((ob >> 9) & 1) << 5)); }
__host__ __device__ __forceinline__ void stage_rc(int b, int& R, int& C) { const int st = b / 1024, sb = b % 1024, swz = sb ^ (((sb >> 9) & 1) << 5); R = (st >> 1) * 16 + swz / 64; C = (st & 1) * 32 + (swz % 64) / 2; }
__host__ __device__ __forceinline__ int perm32(int rho) { const int n = rho >> 4, i = rho & 15; return 8 * (i >> 2) + 4 * n + (i & 3); }

struct Unit { int pm, pn; };
struct Gemm { const bf16_t* A; const bf16_t* Bt; int M, N, K; };

struct StaticOrder {
    int nM, nN, nwg, G, c;
    __host__ __device__ void init(int M, int N, int G_, int c_) { nM = M / BM; nN = N / BM; nwg = nM * nN; G = G_; c = c_; }
    __host__ __device__ bool next(int i, Unit& u) const {
        const long L = (long)i * G + c; if (L >= nwg) return false;
        int wgid = (int)L; { const int q = nwg / NXCD, r = nwg % NXCD, xcd = wgid % NXCD, off = wgid / NXCD; wgid = (xcd < r ? xcd * (q + 1) : r * (q + 1) + (xcd - r) * q) + off; }
        const int nig = WGM * nN, gid = wgid / nig, fm = gid * WGM, gsz = (nM - fm) < WGM ? (nM - fm) : WGM;
        u.pm = fm + ((wgid % nig) % gsz); u.pn = (wgid % nig) / gsz; return true;
    }
    __device__ __forceinline__ void a_ready(const Unit&) const {}
    __device__ __forceinline__ void done(const Unit&) const {}
};

template <class Epi, class Sched, bool STAMP = false>
__device__ __forceinline__ void gemm_phase(PG8_LAS unsigned char* lds, const Gemm g, const Sched& S, const Epi& E, unsigned long long* stamps) {
    int tid_ = threadIdx.x; asm volatile("" : "+v"(tid_));
    const int tid = tid_, wid = __builtin_amdgcn_readfirstlane(tid >> 6), lane = tid & 63, wr = wid >> 2, wc = wid & 3, fr = lane & 15, fq = lane >> 4;
    const int K = g.K, nt = K / BK;
    unsigned voffA[2], voffB[2];
#pragma unroll
    for (int i = 0; i < 2; ++i) { int R, C; stage_rc(tid * 16 + i * 8192, R, C); const int Rb = Epi::PERM ? ((R & ~31) + perm32(R & 31)) : R;
        voffA[i] = (unsigned)(R * K + C) * 2u; voffB[i] = (unsigned)(Rb * K + C) * 2u; }
    const size_t kstep = (size_t)(BK * 2);
    const size_t hstep = (size_t)HALF * K * 2;
    const size_t tstep = 2 * hstep;
    const unsigned ldsw = (unsigned)wid * 1024u;
    const int aoff = lds_byte(wr * 64 + fr, fq * 8), boff = lds_byte(wc * 32 + fr, fq * 8);
#define PG8_SA(b, h) (((b) * 2 + (h)) * HTB)
#define PG8_SB(b, h) ((4 + (b) * 2 + (h)) * HTB)
#define PG8_STAGE(bufoff, gbase, voff) do { _Pragma("unroll") for (int _i = 0; _i < 2; ++_i) \
        __builtin_amdgcn_global_load_lds((const unsigned*)((const char*)(gbase) + (voff)[_i]), (PG8_LAS unsigned*)(lds + (bufoff) + ldsw + _i * 8192), 16, 0, 0); } while (0)
#define PG8_LDA(dst, b, h) do { _Pragma("unroll") for (int m = 0; m < 4; ++m) _Pragma("unroll") for (int k = 0; k < 2; ++k) dst[m][k] = *(const PG8_LAS bf16x8*)(lds + PG8_SA(b, h) + aoff + m * 2048 + k * 1024); } while (0)
#define PG8_LDB(dst, b, h) do { _Pragma("unroll") for (int n = 0; n < 2; ++n) _Pragma("unroll") for (int k = 0; k < 2; ++k) dst[n][k] = *(const PG8_LAS bf16x8*)(lds + PG8_SB(b, h) + boff + n * 2048 + k * 1024); } while (0)
#define PG8_MMA(ai, bj, At, Bt) do { __builtin_amdgcn_s_setprio(1); _Pragma("unroll") for (int m = 0; m < 4; ++m) _Pragma("unroll") for (int n = 0; n < 2; ++n) _Pragma("unroll") for (int k = 0; k < 2; ++k) \
        acc[ai][bj][m][n] = __builtin_amdgcn_mfma_f32_16x16x32_bf16(Bt[n][k], At[m][k], acc[ai][bj][m][n], 0, 0, 0); __builtin_amdgcn_s_setprio(0); } while (0)
#define PG8_WAIT_V(n) asm volatile("s_waitcnt vmcnt(" #n ")" ::: "memory")
#define PG8_WAIT_L(n) asm volatile("s_waitcnt lgkmcnt(" #n ")" ::: "memory")
#define PG8_BAR __builtin_amdgcn_s_barrier()
#define PG8_SCHED __builtin_amdgcn_sched_barrier(0)
    Unit cur, nxt; int ui = 0;
    if (!S.next(0, cur)) return;
    f32x4 acc[2][2][4][2];
#pragma unroll
    for (int a = 0; a < 2; ++a)
#pragma unroll
        for (int b = 0; b < 2; ++b)
#pragma unroll
            for (int m = 0; m < 4; ++m)
#pragma unroll
                for (int n = 0; n < 2; ++n) acc[a][b][m][n] = (f32x4){0.f, 0.f, 0.f, 0.f};
    bf16x8 At[4][2], B0[2][2], B1[2][2];
    const char* cA = (const char*)g.A + (size_t)cur.pm * tstep; const char* cB = (const char*)g.Bt + (size_t)cur.pn * tstep;
    S.a_ready(cur);
    PG8_STAGE(PG8_SB(0, 0), cB, voffB); PG8_STAGE(PG8_SA(0, 0), cA, voffA); PG8_STAGE(PG8_SB(0, 1), cB + hstep, voffB); PG8_STAGE(PG8_SA(0, 1), cA + hstep, voffA);
    if (wr == 1) PG8_BAR;
    PG8_WAIT_V(4); PG8_BAR;
    PG8_STAGE(PG8_SB(1, 0), cB + kstep, voffB); PG8_STAGE(PG8_SA(1, 0), cA + kstep, voffA); PG8_STAGE(PG8_SB(1, 1), cB + hstep + kstep, voffB);
    PG8_WAIT_V(6); PG8_BAR;
    for (;;) {
        const bool has_next = S.next(ui + 1, nxt);
        const char* nA = has_next ? (const char*)g.A + (size_t)nxt.pm * tstep : cA; const char* nB = has_next ? (const char*)g.Bt + (size_t)nxt.pn * tstep : cB;
        for (int t = 0; t < nt; t += 2) {
            const bool last = (t == nt - 2);
            const char* a1 = cA + (size_t)(t + 1) * kstep;
            const char* a2 = last ? nA : cA + (size_t)(t + 2) * kstep; const char* b2 = last ? nB : cB + (size_t)(t + 2) * kstep;
            const char* a3 = a2 + kstep; const char* b3 = b2 + kstep;
            if (last && has_next) S.a_ready(nxt);
            PG8_LDB(B0, 0, 0); PG8_SCHED; PG8_LDA(At, 0, 0); PG8_STAGE(PG8_SA(1, 1), a1 + hstep, voffA);
            PG8_WAIT_L(8); PG8_BAR; PG8_WAIT_L(0); PG8_MMA(0, 0, At, B0); PG8_BAR; PG8_SCHED;
            PG8_LDB(B1, 0, 1); PG8_STAGE(PG8_SB(0, 0), b2, voffB);
            PG8_BAR; PG8_WAIT_L(0); PG8_MMA(0, 1, At, B1); PG8_BAR;
            PG8_LDA(At, 0, 1); PG8_STAGE(PG8_SA(0, 0), a2, voffA);
            PG8_BAR; PG8_WAIT_L(0); PG8_MMA(1, 0, At, B0); PG8_BAR; PG8_SCHED;
            PG8_STAGE(PG8_SB(0, 1), b2 + hstep, voffB);
            PG8_WAIT_V(6); PG8_BAR; PG8_MMA(1, 1, At, B1); PG8_BAR;
            PG8_LDB(B0, 1, 0); PG8_SCHED; PG8_LDA(At, 1, 0); PG8_STAGE(PG8_SA(0, 1), a2 + hstep, voffA);
            PG8_WAIT_L(8); PG8_BAR; PG8_WAIT_L(0); PG8_MMA(0, 0, At, B0); PG8_BAR; PG8_SCHED;
            PG8_LDB(B1, 1, 1); PG8_STAGE(PG8_SB(1, 0), b3, voffB);
            PG8_BAR; PG8_WAIT_L(0); PG8_MMA(0, 1, At, B1); PG8_BAR;
            PG8_LDA(At, 1, 1); PG8_STAGE(PG8_SA(1, 0), a3, voffA);
            PG8_BAR; PG8_WAIT_L(0); PG8_MMA(1, 0, At, B0); PG8_BAR; PG8_SCHED;
            PG8_STAGE(PG8_SB(1, 1), b3 + hstep, voffB);
            PG8_WAIT_V(6); PG8_BAR; PG8_MMA(1, 1, At, B1); PG8_BAR;
        }
        if constexpr (!Epi::AFTER_DRAIN) { E(acc, cur, wr, wc, fr, fq); S.done(cur); }
        if (!has_next) break;
#pragma unroll
        for (int a = 0; a < 2; ++a)
#pragma unroll
            for (int b = 0; b < 2; ++b)
#pragma unroll
                for (int m = 0; m < 4; ++m)
#pragma unroll
                    for (int n = 0; n < 2; ++n) acc[a][b][m][n] = (f32x4){0.f, 0.f, 0.f, 0.f};
        cur = nxt; cA = nA; cB = nB; ++ui;
    }
    PG8_WAIT_V(0);
    if (wr == 0) PG8_BAR;
    PG8_BAR;
    if constexpr (Epi::AFTER_DRAIN) { E.fused(acc, cur, wr, wc, fr, fq, lds, wid, lane); S.done(cur); }
#undef PG8_SA
#undef PG8_SB
#undef PG8_STAGE
#undef PG8_LDA
#undef PG8_LDB
#undef PG8_MMA
#undef PG8_WAIT_V
#undef PG8_WAIT_L
#undef PG8_BAR
#undef PG8_SCHED
}
}

#include <cstdio>
#include <ctime>
#include <cstdlib>
#include <cstring>
#include <cmath>
#include <vector>
#include <algorithm>
#define CK(x) do { hipError_t e_ = (x); if (e_ != hipSuccess) { fprintf(stderr, "HIP %s:%d %s\n", __FILE__, __LINE__, hipGetErrorString(e_)); exit(2); } } while (0)

#define DI __device__ __forceinline__
#define LAS __attribute__((address_space(3)))
typedef unsigned short bf16_t;
typedef short bf16x8 __attribute__((ext_vector_type(8)));
typedef short s16x4 __attribute__((ext_vector_type(4)));
typedef __bf16 bfv8 __attribute__((ext_vector_type(8)));
typedef __bf16 bfv4 __attribute__((ext_vector_type(4)));
typedef float f32x2 __attribute__((ext_vector_type(2)));
typedef float f32x4 __attribute__((ext_vector_type(4)));
typedef float f32x8 __attribute__((ext_vector_type(8)));
typedef float f32x16 __attribute__((ext_vector_type(16)));
typedef unsigned u32x4 __attribute__((ext_vector_type(4)));
typedef unsigned u32x2 __attribute__((ext_vector_type(2)));

constexpr int MP = 16384, MS = 128, MR = MP + MS, MPAD = 16640, DM = 1024, SEQ = 2048, NB = 8;
constexpr int NPROJ = 4096, NGATE = 3072, DFF = 4096, DIN = 7184;
constexpr int PU = 0, PQ = 512, PK = 1024, PV = 1536, PMQ = 2048, PMK = 2304, PMV = 2560, PZ = 3072, PMO = 3584;
constexpr float EPS = 1e-6f;
constexpr size_t O_S5RE_P = 16908288, O_S5RE_S = 16941056, O_S5IM_P = 17465344, O_S5IM_S = 17498112, O_CONV_P = 18022400, O_CONV_S = 18096128,
                 O_GDN_P = 19275776, O_GDN_S = 20324352, O_MLC_P = 37101568, O_MLC_S = 37625856, O_MLN_P = 46014464, O_MLN_S = 46018560,
                 O_MLM_P = 46084096, O_MLM_S = 46084160, O_TOTAL = 46085184;
constexpr size_t WS_R1 = 0, SZ_R1 = (size_t)MPAD * 4096 * 2;
constexpr size_t WS_XN = WS_R1 + SZ_R1, SZ_XN = (size_t)MPAD * 1024 * 2;
constexpr size_t WS_Y3 = WS_XN + SZ_XN, SZ_Y3 = (size_t)3 * MPAD * 512 * 2;
constexpr size_t WS_YS5 = WS_Y3 + SZ_Y3, SZ_YS5 = (size_t)MPAD * 512 * 2;
constexpr size_t WS_W = WS_YS5 + SZ_YS5;
constexpr size_t WO_IN = 0, WO_G = WO_IN + (size_t)4096 * 1024, WO_GLU = WO_G + (size_t)3072 * 1024, WO_BR = WO_GLU + (size_t)512 * 512,
                 WO_OUT = WO_BR + (size_t)3 * 1024 * 512, WO_UP = WO_OUT + (size_t)1024 * 1024, WO_DN = WO_UP + (size_t)4096 * 1024,
                 WO_PLE = WO_DN + (size_t)1024 * 4096, WO_PG = WO_PLE + (size_t)1024 * 256, WO_END = WO_PG + (size_t)1024 * 1024;
constexpr size_t SZ_W = WO_END * 2;
constexpr size_t WS_GS = WS_W + SZ_W;
constexpr int GI_U = 0, GI_W = 16384, GI_Q = 32768, GI_K = 49152, GI_A = 65536, GI_BYTES = 73728;
constexpr size_t SZ_GS = (size_t)1024 * GI_BYTES;
constexpr size_t WS_SG = WS_GS + SZ_GS, SZ_SG = (size_t)MR * 16 * 4;
constexpr size_t WS_GL = WS_SG + SZ_SG, SZ_GL = 8192;
constexpr size_t WS_MG = WS_GL + SZ_GL, SZ_MG = (size_t)1024 * 3 * 64 * 4;
constexpr size_t WS_BAR = WS_MG + SZ_MG, SZ_BAR = 16384;
constexpr size_t WS_END = WS_BAR + SZ_BAR;
constexpr int LDS_BYTES = 122880 + 32768 + 2048 + 64 + 64;

struct KP { const float* in[40]; float* out; unsigned char* ws; };

DI float bf2f(bf16_t b) { return __uint_as_float(((unsigned)b) << 16); }
DI bf16_t f2bf(float f) { __bf16 b = (__bf16)f; return __builtin_bit_cast(bf16_t, b); }
DI bf16x8 pack8v(f32x8 v) { bfv8 b = __builtin_convertvector(v, bfv8); return __builtin_bit_cast(bf16x8, b); }
DI s16x4 pack4v(f32x4 v) { bfv4 b = __builtin_convertvector(v, bfv4); return __builtin_bit_cast(s16x4, b); }
DI bf16x8 pack16(const f32x16& x, int s) { f32x8 v;
#pragma unroll
    for (int j = 0; j < 8; ++j) v[j] = x[8 * s + j];
    return pack8v(v); }
DI float lo16(unsigned u) { return __uint_as_float(u << 16); }
DI float hi16(unsigned u) { return __uint_as_float(u & 0xffff0000u); }
DI f32x8 unpack8(bf16x8 b) { u32x4 u = __builtin_bit_cast(u32x4, b); f32x8 r;
#pragma unroll
    for (int i = 0; i < 4; ++i) { r[2 * i] = lo16(u[i]); r[2 * i + 1] = hi16(u[i]); }
    return r; }
DI float sigm(float x) { return __builtin_amdgcn_rcpf(1.f + __expf(-x)); }
DI float tanh_(float z) { return 1.f - 2.f * __builtin_amdgcn_rcpf(__expf(2.f * z) + 1.f); }
DI float gelu_t(float x) { return 0.5f * x * (1.f + tanh_(0.7978845608028654f * (x + 0.044715f * x * x * x))); }
DI float silu_(float x) { return x * sigm(x); }
DI float softplus_(float x) { return x > 20.f ? x : log1pf(expf(x)); }
DI float logsig_(float x) { return x >= 0.f ? -log1pf(expf(-x)) : x - log1pf(expf(x)); }
DI float softcap_(float x) { return 15.f * tanh_(x * (1.f / 15.f)); }
DI float wave_sum(float v) {
#pragma unroll
    for (int o = 32; o; o >>= 1) v += __shfl_xor(v, o);
    return v; }
DI float wave_incl_sum(float v, int lane) {
#pragma unroll
    for (int o = 1; o < 64; o <<= 1) { float t = __shfl_up(v, o); if (lane >= o) v += t; }
    return v; }
DI float wave_incl_max(float v, int lane) {
#pragma unroll
    for (int o = 1; o < 64; o <<= 1) { float t = __shfl_up(v, o); if (lane >= o) v = fmaxf(v, t); }
    return v; }
DI void butterfly16(float (&a)[16], int lane) {
#pragma unroll
    for (int i = 0; i < 8; ++i) { const bool up = (lane & 32) != 0; const float send = up ? a[i] : a[i + 8], keep = up ? a[i + 8] : a[i]; a[i] = keep + __shfl_xor(send, 32); }
#pragma unroll
    for (int i = 0; i < 4; ++i) { const bool up = (lane & 16) != 0; const float send = up ? a[i] : a[i + 4], keep = up ? a[i + 4] : a[i]; a[i] = keep + __shfl_xor(send, 16); }
#pragma unroll
    for (int i = 0; i < 2; ++i) { const bool up = (lane & 8) != 0; const float send = up ? a[i] : a[i + 2], keep = up ? a[i + 2] : a[i]; a[i] = keep + __shfl_xor(send, 8); }
    { const bool up = (lane & 4) != 0; const float send = up ? a[0] : a[1], keep = up ? a[1] : a[0]; a[0] = keep + __shfl_xor(send, 4); }
    a[0] += __shfl_xor(a[0], 2); a[0] += __shfl_xor(a[0], 1);
}
DI int bsel16(int lane) { return ((lane >> 5) & 1) * 8 + ((lane >> 4) & 1) * 4 + ((lane >> 3) & 1) * 2 + ((lane >> 2) & 1); }
DI int crow(int reg, int h) { return (reg & 3) + 8 * (reg >> 2) + 4 * h; }
DI int perm16(int k) { return (k & ~12) | ((k & 4) << 1) | ((k & 8) >> 1); }
#define MFMA32(a, b, c) __builtin_amdgcn_mfma_f32_32x32x16_bf16((a), (b), (c), 0, 0, 0)
#define MFMA16(a, b, c) __builtin_amdgcn_mfma_f32_16x16x32_bf16((a), (b), (c), 0, 0, 0)
#define WAVE_FENCE() do { asm volatile("s_waitcnt lgkmcnt(0)" ::: "memory"); __builtin_amdgcn_wave_barrier(); asm volatile("" ::: "memory"); } while (0)

typedef __attribute__((address_space(4))) const unsigned long long* ka_t;
typedef __attribute__((address_space(1))) float gfloat_t; typedef __attribute__((address_space(1))) unsigned char guchar_t;
struct InTab { ka_t ka; DI const float* operator[](int i) const { return (const float*)(const gfloat_t*)ka[i]; } };
struct Ctx {
    InTab in; float* out; unsigned char* ws; unsigned char* lds;
    bf16_t *R1, *XN, *Y3, *W, *YS5; unsigned char* GS; float *SG, *GL;
    int tid, lane, wave, G, bid;
};

template <class F> struct Epi8 {
    static constexpr bool PERM = true, AFTER_DRAIN = false;
    F f;
    DI void operator()(const f32x4 (&acc)[2][2][4][2], const pg8::Unit& u, int wr, int wc, int fr, int fq) const {
        const int row0 = u.pm * 256 + wr * 64 + fr, col0 = u.pn * 256 + wc * 32 + 8 * fq;
#pragma unroll
        for (int ai = 0; ai < 2; ++ai)
#pragma unroll
            for (int m = 0; m < 4; ++m)
#pragma unroll
                for (int bj = 0; bj < 2; ++bj) f(row0 + ai * 128 + m * 16, col0 + bj * 128, acc[ai][bj][m][0], acc[ai][bj][m][1]);
    }
};
DI f32x8 cat8(f32x4 a, f32x4 b) { f32x8 r; r[0] = a[0]; r[1] = a[1]; r[2] = a[2]; r[3] = a[3]; r[4] = b[0]; r[5] = b[1]; r[6] = b[2]; r[7] = b[3]; return r; }
struct FStore { bf16_t* dst; int ld;
    DI void s(int row, int col, float v) const { dst[(size_t)row * ld + col] = f2bf(v); }
    DI void operator()(int row, int col, f32x4 a, f32x4 b) const { *(bf16x8*)(dst + (size_t)row * ld + col) = pack8v(cat8(a, b)); } };
struct FSig { bf16_t* dst; int ld;
    DI void s(int row, int col, float v) const { dst[(size_t)row * ld + col] = f2bf(sigm(v)); }
    DI void operator()(int row, int col, f32x4 a, f32x4 b) const { f32x8 v = cat8(a, b);
#pragma unroll
        for (int i = 0; i < 8; ++i) v[i] = sigm(v[i]);
        *(bf16x8*)(dst + (size_t)row * ld + col) = pack8v(v); } };
struct FGlu { const bf16_t* y; const float* bias; bf16_t* dst;
    DI void s(int row, int col, float v) const { dst[(size_t)row * 512 + col] = f2bf(bf2f(y[(size_t)row * 512 + col]) * sigm(v + bias[col])); }
    DI void operator()(int row, int col, f32x4 a, f32x4 b) const { f32x8 v = cat8(a, b); f32x8 yv = unpack8(*(const bf16x8*)(y + (size_t)row * 512 + col));
        f32x4 b0 = *(const f32x4*)(bias + col), b1 = *(const f32x4*)(bias + col + 4);
#pragma unroll
        for (int i = 0; i < 8; ++i) v[i] = yv[i] * sigm(v[i] + (i < 4 ? b0[i] : b1[i - 4]));
        *(bf16x8*)(dst + (size_t)row * 512 + col) = pack8v(v); } };
struct FBranch { const bf16_t* gates; bf16_t* merged; int first;
    DI void s(int row, int col, float v) const { bf16_t* mp = merged + (size_t)row * 1024 + col; const float g = bf2f(gates[(size_t)row * 4096 + col]); *mp = f2bf((first ? 0.f : bf2f(*mp)) + g * v); }
    DI void operator()(int row, int col, f32x4 a, f32x4 b) const { f32x8 v = cat8(a, b); f32x8 gv = unpack8(*(const bf16x8*)(gates + (size_t)row * 4096 + col));
        bf16x8* mp = (bf16x8*)(merged + (size_t)row * 1024 + col);
        f32x8 o;
        if (first) {
#pragma unroll
            for (int i = 0; i < 8; ++i) o[i] = gv[i] * v[i];
        } else { f32x8 mv = unpack8(*mp);
#pragma unroll
            for (int i = 0; i < 8; ++i) o[i] = mv[i] + gv[i] * v[i];
        }
        *mp = pack8v(o); } };
struct FRes { float* xr;
    DI void s(int row, int col, float v) const { xr[(size_t)row * 1024 + col] += v; }
    DI void operator()(int row, int col, f32x4 a, f32x4 b) const { if (row < MR) { f32x4* p = (f32x4*)(xr + (size_t)row * 1024 + col); p[0] = p[0] + a; p[1] = p[1] + b; } } };
struct FResB { float* xr; bf16_t* xb;
    DI void s(int row, int col, float v) const { const float x = xr[(size_t)row * 1024 + col] + v; xr[(size_t)row * 1024 + col] = x; xb[(size_t)row * 1024 + col] = f2bf(x); }
    DI void operator()(int row, int col, f32x4 a, f32x4 b) const { if (row < MR) { f32x4* p = (f32x4*)(xr + (size_t)row * 1024 + col); const f32x4 x0 = p[0] + a, x1 = p[1] + b; p[0] = x0; p[1] = x1;
            *(bf16x8*)(xb + (size_t)row * 1024 + col) = pack8v(cat8(x0, x1)); } } };
struct FRelu2 { bf16_t* dst;
    DI void s(int row, int col, float v) const { const float r = fmaxf(v, 0.f); dst[(size_t)row * 4096 + col] = f2bf(r * r); }
    DI void operator()(int row, int col, f32x4 a, f32x4 b) const { f32x8 v = cat8(a, b);
#pragma unroll
        for (int i = 0; i < 8; ++i) { float r = fmaxf(v[i], 0.f); v[i] = r * r; }
        *(bf16x8*)(dst + (size_t)row * 4096 + col) = pack8v(v); } };
struct FPle { const bf16_t* T; float* xr;
    DI void s(int row, int col, float v) const { xr[(size_t)row * 1024 + col] += bf2f(T[(size_t)row * 1024 + col]) * sigm(v); }
    DI void operator()(int row, int col, f32x4 a, f32x4 b) const { if (row < MR) { f32x8 v = cat8(a, b); f32x8 tv = unpack8(*(const bf16x8*)(T + (size_t)row * 1024 + col));
            f32x4* p = (f32x4*)(xr + (size_t)row * 1024 + col); f32x4 x0 = p[0], x1 = p[1];
#pragma unroll
            for (int i = 0; i < 4; ++i) { x0[i] += tv[i] * sigm(v[i]); x1[i] += tv[4 + i] * sigm(v[4 + i]); }
            p[0] = x0; p[1] = x1; } } };

DI f32x16 small_part(const Ctx& c, const bf16_t* A, const bf16_t* Bt, int K, int tile, int kq) {
    int r = c.lane & 31, hh = c.lane >> 5; asm volatile("" : "+v"(r), "+v"(hh));
    const int mt = tile & 3, nt = tile >> 2, K4 = K >> 2;
    const bf16_t* ap = A + (size_t)(MP + mt * 32 + r) * K + kq * K4 + hh * 8;
    const bf16_t* bp = Bt + (size_t)(nt * 32 + r) * K + kq * K4 + hh * 8;
    f32x16 acc;
#pragma unroll
    for (int j = 0; j < 16; ++j) acc[j] = 0.f;
    if (K4 >= 128) {
        bf16x8 a[8], b[8];
#pragma unroll
        for (int j = 0; j < 8; ++j) { a[j] = *(const bf16x8*)(ap + j * 16); b[j] = *(const bf16x8*)(bp + j * 16); }
        for (int k = 128; k < K4; k += 128) {
            bf16x8 an[8], bn[8];
#pragma unroll
            for (int j = 0; j < 8; ++j) { an[j] = *(const bf16x8*)(ap + k + j * 16); bn[j] = *(const bf16x8*)(bp + k + j * 16); }
#pragma unroll
            for (int j = 0; j < 8; ++j) acc = MFMA32(a[j], b[j], acc);
#pragma unroll
            for (int j = 0; j < 8; ++j) { a[j] = an[j]; b[j] = bn[j]; }
        }
#pragma unroll
        for (int j = 0; j < 8; ++j) acc = MFMA32(a[j], b[j], acc);
    } else {
#pragma unroll
        for (int j = 0; j < 4; ++j) { const bf16x8 a = *(const bf16x8*)(ap + j * 16), b = *(const bf16x8*)(bp + j * 16); acc = MFMA32(a, b, acc); }
    }
    return acc;
}
template <class F> DI void run_gemm(const Ctx& c, const bf16_t* A, const bf16_t* Bt, int N, int K, const F& f) {
    { const int ntile = 4 * (N >> 5), grp = c.wave >> 2, kq = c.wave & 3;
      LAS float* red = (LAS float*)c.lds;
      for (int t0 = 0; t0 < ntile; t0 += 2 * c.G) {
          const int t = t0 + grp * c.G + c.bid; const bool live = t < ntile;
          if (live) { const f32x16 acc = small_part(c, A, Bt, K, t, kq);
#pragma unroll
              for (int i = 0; i < 16; ++i) red[(c.wave * 16 + i) * 64 + c.lane] = acc[i]; }
          __syncthreads();
          if (live && kq == 0) { const int mt = t & 3, nt = t >> 2, r = c.lane & 31, hh = c.lane >> 5;
#pragma unroll
              for (int i = 0; i < 16; ++i) { const int o = (c.wave * 16 + i) * 64 + c.lane; const float v = (red[o] + red[o + 1024]) + (red[o + 2048] + red[o + 3072]);
                  f.s(MP + mt * 32 + crow(i, hh), nt * 32 + r, v); } }
          __syncthreads();
      } }
    pg8::Gemm g{A, Bt, MP, N, K}; pg8::StaticOrder S; S.init(MP, N, c.G, c.bid);
    Epi8<F> E{f};
    pg8::gemm_phase<Epi8<F>, pg8::StaticOrder>((PG8_LAS unsigned char*)c.lds, g, S, E, nullptr);
    __syncthreads();
}

DI void tr_task(const Ctx& c, const float* src, int ld, int K, int n, bf16_t* dst, int rot) {
    float* tile = (float*)c.lds;
    const int nkt = K >> 6, ntiles = nkt * (n >> 6);
    const int start = (c.bid + c.G - (rot % c.G)) % c.G;
    for (int t = start; t < ntiles; t += c.G) {
        const int kt = t % nkt, nt = t / nkt;
        const int r = c.tid >> 4, c4 = (c.tid & 15) * 4;
#pragma unroll
        for (int p = 0; p < 2; ++p) { const int row = r + 32 * p; const f32x4 v = *(const f32x4*)(src + (size_t)(kt * 64 + row) * ld + nt * 64 + c4);
            tile[row * 65 + c4] = v[0]; tile[row * 65 + c4 + 1] = v[1]; tile[row * 65 + c4 + 2] = v[2]; tile[row * 65 + c4 + 3] = v[3]; }
        __syncthreads();
        { const int nn = c.tid >> 3, kc = (c.tid & 7) * 8; f32x8 v;
#pragma unroll
          for (int e = 0; e < 8; ++e) v[e] = tile[(kc + e) * 65 + nn];
          *(bf16x8*)(dst + (size_t)(nt * 64 + nn) * K + kt * 64 + kc) = pack8v(v); }
        __syncthreads();
    }
}
DI void phase_weights(const Ctx& c, int L) {
    const float* win = c.in[12] + (size_t)L * 1024 * DIN;
    bf16_t* W = c.W;
    tr_task(c, win + 0, DIN, 1024, 2048, W + WO_IN, 0);
    tr_task(c, win + 2568, DIN, 1024, 1024, W + WO_IN + (size_t)2048 * 1024, 0);
    tr_task(c, win + 2048, DIN, 1024, 512, W + WO_IN + (size_t)3072 * 1024, 0);
    tr_task(c, win + 3592, DIN, 1024, 512, W + WO_IN + (size_t)3584 * 1024, 128);
    tr_task(c, win + 4112, DIN, 1024, 3072, W + WO_G, 0);
    tr_task(c, c.in[21] + (size_t)L * 512 * 512, 512, 512, 512, W + WO_GLU, 0);
    tr_task(c, c.in[30] + (size_t)L * 512 * 1024, 1024, 512, 1024, W + WO_BR, 64);
    tr_task(c, c.in[31] + (size_t)L * 512 * 1024, 1024, 512, 1024, W + WO_BR + (size_t)1024 * 512, 192);
    tr_task(c, c.in[32] + (size_t)L * 512 * 1024, 1024, 512, 1024, W + WO_BR + (size_t)2 * 1024 * 512, 64);
    tr_task(c, c.in[33] + (size_t)L * 1024 * 1024, 1024, 1024, 1024, W + WO_OUT, 0);
    tr_task(c, c.in[35] + (size_t)L * 1024 * 4096, 4096, 1024, 4096, W + WO_UP, 0);
    tr_task(c, c.in[36] + (size_t)L * 4096 * 1024, 1024, 4096, 1024, W + WO_DN, 0);
    tr_task(c, c.in[37] + (size_t)L * 256 * 1024, 1024, 256, 1024, W + WO_PLE, 0);
    tr_task(c, c.in[38] + (size_t)L * 1024 * 1024, 1024, 1024, 1024, W + WO_PG, 64);
}

template <int MODE> DI void phase_rmsnorm(const Ctx& c, int L) {
    float* wsm = (float*)c.lds;
    const float* gain = (MODE == 0 ? c.in[11] : c.in[34]) + (size_t)L * 1024;
    if (MODE == 0) {
        const float* win = c.in[12] + (size_t)L * 1024 * DIN;
        for (int idx = c.tid; idx < 4096; idx += 512) { const int k = idx >> 2, part = idx & 3, seg = part >> 1, half = part & 1;
            const f32x4 v = *(const f32x4*)(win + (size_t)k * DIN + (seg ? 4104 : 2560) + half * 4);
            const int sb = seg * 8 + half * 4;
            wsm[(sb + 0) * 1024 + k] = v[0]; wsm[(sb + 1) * 1024 + k] = v[1]; wsm[(sb + 2) * 1024 + k] = v[2]; wsm[(sb + 3) * 1024 + k] = v[3]; }
        __syncthreads();
    }
    float* XR = c.out;
    for (int row = c.bid * 8 + c.wave; row < MR; row += c.G * 8) {
        const float* src = (MODE == 0 && L == 0) ? (row < MP ? c.in[0] + (size_t)row * 1024 : c.in[1] + (size_t)(row - MP) * 1024) : XR + (size_t)row * 1024;
        f32x4 x[4]; float ss = 0.f;
#pragma unroll
        for (int i = 0; i < 4; ++i) { x[i] = *(const f32x4*)(src + c.lane * 4 + 256 * i); ss += x[i][0] * x[i][0] + x[i][1] * x[i][1] + x[i][2] * x[i][2] + x[i][3] * x[i][3]; }
        ss = wave_sum(ss);
        const float rs = rsqrtf(ss * (1.f / 1024.f) + EPS);
        if (MODE == 0 && L == 0) {
#pragma unroll
            for (int i = 0; i < 4; ++i) *(f32x4*)(XR + (size_t)row * 1024 + c.lane * 4 + 256 * i) = x[i];
        }
#pragma unroll
        for (int i = 0; i < 4; ++i) { const f32x4 g = *(const f32x4*)(gain + c.lane * 4 + 256 * i); x[i] = x[i] * rs * g;
            *(s16x4*)(c.XN + (size_t)row * 1024 + c.lane * 4 + 256 * i) = pack4v(x[i]); }
        if (MODE == 0) {
            float a[16];
#pragma unroll
            for (int s = 0; s < 16; ++s) { float t = 0.f;
#pragma unroll
                for (int i = 0; i < 4; ++i) { const f32x4 w = *(const f32x4*)(wsm + s * 1024 + c.lane * 4 + 256 * i); t += x[i][0] * w[0] + x[i][1] * w[1] + x[i][2] * w[2] + x[i][3] * w[3]; }
                a[s] = t; asm volatile("" ::: "memory"); }
#pragma unroll
            for (int i = 0; i < 8; ++i) { const bool up = (c.lane & 32) != 0; const float send = up ? a[i] : a[i + 8], keep = up ? a[i + 8] : a[i]; a[i] = keep + __shfl_xor(send, 32); }
#pragma unroll
            for (int i = 0; i < 4; ++i) { const bool up = (c.lane & 16) != 0; const float send = up ? a[i] : a[i + 4], keep = up ? a[i + 4] : a[i]; a[i] = keep + __shfl_xor(send, 16); }
#pragma unroll
            for (int i = 0; i < 2; ++i) { const bool up = (c.lane & 8) != 0; const float send = up ? a[i] : a[i + 2], keep = up ? a[i + 2] : a[i]; a[i] = keep + __shfl_xor(send, 8); }
            { const bool up = (c.lane & 4) != 0; const float send = up ? a[0] : a[1], keep = up ? a[1] : a[0]; a[0] = keep + __shfl_xor(send, 4); }
            a[0] += __shfl_xor(a[0], 2); a[0] += __shfl_xor(a[0], 1);
            if ((c.lane & 3) == 0) { const int sidx = ((c.lane >> 5) & 1) * 8 + ((c.lane >> 4) & 1) * 4 + ((c.lane >> 3) & 1) * 2 + ((c.lane >> 2) & 1); c.SG[(size_t)row * 16 + sidx] = a[0]; }
        }
    }
    __syncthreads();
}

DI void phase_gdn_prep(const Ctx& c, int L) {
    constexpr int RS = 132, AS = 68, BP = 136;
    LAS float* AmT0 = (LAS float*)c.lds;
    const float* convw = c.in[23] + (size_t)L * 4 * 1536;
    const bf16_t* PR = c.R1;
    for (int item = c.bid; item < 1024; item += c.G) {
        const int ch = item & 31, h = (item >> 5) & 3, b = item >> 7;
        const int t0 = b * SEQ + ch * 64;
        unsigned char* gi = c.GS + (size_t)item * GI_BYTES;
        LAS float* AmT = AmT0; asm volatile("" : "+v"(AmT));
        LAS float* beta = AmT + 64 * AS; LAS float* gcum = beta + 64; LAS float* part = gcum + 64;
        LAS float* vs = part + 128; asm volatile("" : "+v"(vs));
        LAS bf16_t* qb = (LAS bf16_t*)(vs + 64 * RS); asm volatile("" : "+v"(qb));
        LAS bf16_t* khi = qb + 64 * BP; asm volatile("" : "+v"(khi));
        LAS bf16_t* klo = khi + 64 * BP; asm volatile("" : "+v"(klo));
        if (c.wave == 7) { const size_t row = (size_t)(t0 + c.lane);
            const float bt = sigm(c.SG[row * 16 + h]);
            const float g = -expf(c.in[24][L * 4 + h]) * softplus_(c.SG[row * 16 + 4 + h] + c.in[25][L * 4 + h]);
            const float gc = wave_incl_sum(g, c.lane);
            beta[c.lane] = bt; gcum[c.lane] = gc;
            if (c.lane == 63) c.GL[item] = expf(gc); }
        { const int d = c.tid & 127, tq = c.tid >> 7;
          float qk[2][16];
#pragma unroll
          for (int which = 0; which < 3; ++which) {
              const int pcol = PQ + which * 512 + h * 128 + d, wcol = which * 512 + h * 128 + d;
              const float w0 = convw[wcol], w1 = convw[1536 + wcol], w2 = convw[3072 + wcol], w3 = convw[4608 + wcol];
              float xin[19];
#pragma unroll
              for (int i = 0; i < 19; ++i) { const int tt = ch * 64 + tq * 16 + i - 3; const int tc = tt < 0 ? 0 : tt;
                  const float v = bf2f(PR[(size_t)(b * SEQ + tc) * NPROJ + pcol]); xin[i] = tt < 0 ? 0.f : v; }
#pragma unroll
              for (int t = 0; t < 16; ++t) { const float a = silu_(xin[t] * w0 + xin[t + 1] * w1 + xin[t + 2] * w2 + xin[t + 3] * w3);
                  if (which == 2) vs[(tq * 16 + t) * RS + d] = a; else qk[which][t] = a; }
          }
#pragma unroll
          for (int which = 0; which < 2; ++which) {
              float ssq[16];
#pragma unroll
              for (int t = 0; t < 16; ++t) ssq[t] = qk[which][t] * qk[which][t];
              butterfly16(ssq, c.lane);
              __syncthreads();
              if ((c.lane & 3) == 0) part[c.wave * 16 + bsel16(c.lane)] = ssq[0];
              __syncthreads();
#pragma unroll
              for (int t = 0; t < 16; ++t) { const float tot = part[c.wave * 16 + t] + part[(c.wave ^ 1) * 16 + t];
                  const float v = qk[which][t] * rsqrtf(tot + EPS) * (which == 0 ? 0.08838834764831845f : 1.f);
                  const bf16_t hi = f2bf(v);
                  if (which == 0) qb[(tq * 16 + t) * BP + d] = hi;
                  else { khi[(tq * 16 + t) * BP + d] = hi; klo[(tq * 16 + t) * BP + d] = f2bf(v - bf2f(hi)); } }
          } }
        __syncthreads();
        { const int r = c.lane & 31, hh = c.lane >> 5, wq = c.wave & 3, tm = wq >> 1, tn = wq & 1;
          if (!(c.wave < 4 && tm == 0 && tn == 1)) {
              f32x16 acc;
#pragma unroll
              for (int j = 0; j < 16; ++j) acc[j] = 0.f;
              const LAS bf16_t* arow = (c.wave < 4 ? khi : qb) + (tm * 32 + r) * BP + hh * 8;
              const LAS bf16_t* brow = khi + (tn * 32 + r) * BP + hh * 8;
#pragma unroll
              for (int ks = 0; ks < 8; ++ks) { const bf16x8 av = *(const LAS bf16x8*)(arow + ks * 16), bv = *(const LAS bf16x8*)(brow + ks * 16);
                  acc = MFMA32(av, bv, acc);
                  if (c.wave < 4) { const bf16x8 al = *(const LAS bf16x8*)(arow + 64 * BP + ks * 16), bl = *(const LAS bf16x8*)(brow + 64 * BP + ks * 16);
                      acc = MFMA32(av, bl, acc); acc = MFMA32(al, bv, acc); } }
              const int s = tn * 32 + r; const float gs = gcum[s];
              bf16_t* at = (bf16_t*)(gi + GI_A);
#pragma unroll
              for (int i = 0; i < 16; ++i) { const int t = tm * 32 + crow(i, hh); const float dec = (t >= s) ? __expf(gcum[t] - gs) : 0.f;
                  if (c.wave < 4) { if (t > s) AmT[s * AS + t] = beta[t] * acc[i] * dec; }
                  else at[t * 64 + (s & ~15) + perm16(s & 15)] = f2bf(acc[i] * dec); }
          } }
        __syncthreads();
        if (c.tid < 256) {
            const int col = c.tid; float x[64];
#pragma unroll
            for (int t = 0; t < 64; ++t) x[t] = (col < 128) ? vs[t * RS + col] * beta[t] : (bf2f(khi[t * BP + (col - 128)]) + bf2f(klo[t * BP + (col - 128)])) * beta[t] * __expf(gcum[t]);
#pragma unroll
            for (int j = 0; j < 63; ++j) { const float xj = x[j];
#pragma unroll
                for (int g4 = (j + 1) / 4; g4 < 16; ++g4) { const f32x4 a = *(const LAS f32x4*)(AmT + j * AS + g4 * 4);
#pragma unroll
                    for (int e = 0; e < 4; ++e) if (g4 * 4 + e > j) x[g4 * 4 + e] -= a[e] * xj; } }
            if (col < 128) { bf16_t* up = (bf16_t*)(gi + GI_U); const int sl = col >> 5, r = col & 31;
#pragma unroll
                for (int t = 0; t < 64; ++t) { const int mt = t >> 5, tt = t & 31, hh = (tt >> 2) & 1, i = (tt & 3) + 4 * (tt >> 3);
                    up[((sl * 2 + mt) * 16 + i) * 64 + r + 32 * hh] = f2bf(x[t]); }
            } else { bf16_t* wp = (bf16_t*)(gi + GI_W); const int dk = col - 128, pd = (dk & ~15) + perm16(dk & 15);
#pragma unroll
                for (int t = 0; t < 64; ++t) wp[t * 128 + pd] = f2bf(-x[t]); }
        } else {
            bf16_t* qp = (bf16_t*)(gi + GI_Q); bf16_t* kp = (bf16_t*)(gi + GI_K);
            const float g63 = gcum[63];
            for (int idx = c.tid - 256; idx < 64 * 128; idx += 256) { const int t = idx >> 7, d = idx & 127;
                qp[t * 128 + (d & ~15) + perm16(d & 15)] = f2bf(bf2f(qb[t * BP + d]) * __expf(gcum[t])); }
            for (int idx = c.tid - 256; idx < 64 * 128; idx += 256) { const int d = idx >> 6, t = idx & 63;
                kp[d * 64 + (t & ~15) + perm16(t & 15)] = f2bf((bf2f(khi[t * BP + d]) + bf2f(klo[t * BP + d])) * __expf(g63 - gcum[t])); }
        }
        __syncthreads();
    }
}

constexpr int GB_W = 0, GB_Q = 16384, GB_A = 32768, GB_K = 40960, GB_U = 57344, GB_BYTES = 61440;
DI void dma16(const void* g, unsigned lds_addr) { asm volatile("s_mov_b32 m0, %1\n\tglobal_load_lds_dwordx4 %0, off" :: "v"(g), "s"(lds_addr) : "memory", "m0"); }
DI void gdn_issue(const Ctx& c, int item, int sl, int r, int hh, int ln, PG8_LAS unsigned char* buf) {
    const unsigned char* gi = c.GS + (size_t)item * GI_BYTES;
    const bf16_t* up = (const bf16_t*)(gi + GI_U); const bf16_t* wp = (const bf16_t*)(gi + GI_W); const bf16_t* qp = (const bf16_t*)(gi + GI_Q);
    const bf16_t* kp = (const bf16_t*)(gi + GI_K); const bf16_t* ap = (const bf16_t*)(gi + GI_A);
#pragma unroll
    for (int mt = 0; mt < 2; ++mt)
#pragma unroll
        for (int ks = 0; ks < 8; ++ks) {
            dma16((wp + (mt * 32 + r) * 128 + ks * 16 + hh * 8), (unsigned)(size_t)(buf + GB_W + (mt * 8 + ks) * 1024));
            dma16((qp + (mt * 32 + r) * 128 + ks * 16 + hh * 8), (unsigned)(size_t)(buf + GB_Q + (mt * 8 + ks) * 1024)); }
#pragma unroll
    for (int mt = 0; mt < 2; ++mt)
#pragma unroll
        for (int ks = 0; ks < 4; ++ks)
            dma16((ap + (mt * 32 + r) * 64 + ks * 16 + hh * 8), (unsigned)(size_t)(buf + GB_A + (mt * 4 + ks) * 1024));
#pragma unroll
    for (int i = 0; i < 4; ++i)
#pragma unroll
        for (int ks = 0; ks < 4; ++ks)
            dma16((kp + (i * 32 + r) * 64 + ks * 16 + hh * 8), (unsigned)(size_t)(buf + GB_K + (i * 4 + ks) * 1024));
#pragma unroll
    for (int j = 0; j < 4; ++j)
        dma16((up + (size_t)sl * 2048 + j * 512 + ln * 8), (unsigned)(size_t)(buf + GB_U + j * 1024));
}
DI void task_gdn_seq(const Ctx& c, int L, int unit) {
    const int sl = (unit >> 3) & 3, stream = (unit & 7) + 8 * (unit >> 5);
    const int b = stream >> 2, h = stream & 3;
    const int r0_ = c.lane & 31, hh0_ = c.lane >> 5; int r = r0_, hh = hh0_, ln = c.lane;
    PG8_LAS unsigned char* lbase = (PG8_LAS unsigned char*)c.lds;
    f32x16 S[4];
#pragma unroll
    for (int i = 0; i < 4; ++i)
#pragma unroll
        for (int j = 0; j < 16; ++j) S[i][j] = 0.f;
    bf16_t* yo = c.Y3 + (size_t)1 * MPAD * 512;
    gdn_issue(c, stream * 32, sl, r, hh, ln, lbase);
    for (int ch = 0; ch < 32; ++ch) {
        r = r0_; hh = hh0_; ln = c.lane; asm volatile("" : "+v"(r), "+v"(hh), "+v"(ln));
        const int item = stream * 32 + ch;
        const float gl = c.GL[item];
        asm volatile("s_waitcnt vmcnt(0)" ::: "memory");
        PG8_LAS unsigned char* buf = lbase + (ch & 1) * GB_BYTES;
        if (ch + 1 < 32) gdn_issue(c, item + 1, sl, r, hh, ln, lbase + ((ch + 1) & 1) * GB_BYTES);
        PG8_LAS unsigned char* lb = buf + ln * 16; asm volatile("" : "+v"(lb));
        PG8_LAS unsigned char* ub = buf + GB_U + ln * 2; asm volatile("" : "+v"(ub));
        f32x16 vn[2], o[2];
#pragma unroll
        for (int mt = 0; mt < 2; ++mt)
#pragma unroll
            for (int i = 0; i < 16; ++i) { vn[mt][i] = bf2f(*(const PG8_LAS bf16_t*)(ub + (mt * 16 + i) * 128)); o[mt][i] = 0.f; }
        bf16x8 Sb[8];
#pragma unroll
        for (int ks = 0; ks < 8; ++ks) Sb[ks] = pack16(S[ks >> 1], ks & 1);
#pragma unroll
        for (int mt = 0; mt < 2; ++mt)
#pragma unroll
            for (int ks = 0; ks < 8; ++ks) { const bf16x8 a = *(const PG8_LAS bf16x8*)(lb + GB_W + (mt * 8 + ks) * 1024); vn[mt] = MFMA32(a, Sb[ks], vn[mt]); }
#pragma unroll
        for (int mt = 0; mt < 2; ++mt)
#pragma unroll
            for (int ks = 0; ks < 8; ++ks) { const bf16x8 a = *(const PG8_LAS bf16x8*)(lb + GB_Q + (mt * 8 + ks) * 1024); o[mt] = MFMA32(a, Sb[ks], o[mt]); }
        bf16x8 Vb[4];
#pragma unroll
        for (int ks = 0; ks < 4; ++ks) Vb[ks] = pack16(vn[ks >> 1], ks & 1);
#pragma unroll
        for (int mt = 0; mt < 2; ++mt)
#pragma unroll
            for (int ks = 0; ks < 4; ++ks) { const bf16x8 a = *(const PG8_LAS bf16x8*)(lb + GB_A + (mt * 4 + ks) * 1024); o[mt] = MFMA32(a, Vb[ks], o[mt]); }
#pragma unroll
        for (int i = 0; i < 4; ++i) {
#pragma unroll
            for (int j = 0; j < 16; ++j) S[i][j] *= gl;
#pragma unroll
            for (int ks = 0; ks < 4; ++ks) { const bf16x8 a = *(const PG8_LAS bf16x8*)(lb + GB_K + (i * 4 + ks) * 1024); S[i] = MFMA32(a, Vb[ks], S[i]); }
        }
        const size_t rowb = (size_t)(b * SEQ + ch * 64);
#pragma unroll
        for (int mt = 0; mt < 2; ++mt)
#pragma unroll
            for (int i = 0; i < 16; ++i) yo[(rowb + mt * 32 + crow(i, hh)) * 512 + h * 128 + sl * 32 + r] = f2bf(o[mt][i]);
        asm volatile("s_waitcnt lgkmcnt(0)" ::: "memory");
    }
    float* so = c.out + O_GDN_P + ((size_t)(L * NB + b) * 4 + h) * 128 * 128;
#pragma unroll
    for (int i = 0; i < 4; ++i)
#pragma unroll
        for (int j = 0; j < 16; ++j) so[(size_t)(i * 32 + crow(j, hh)) * 128 + sl * 32 + r] = S[i][j];
}

DI void task_ml_gates(const Ctx& c, int L, int item) {
    const int ch = item & 31, h = (item >> 5) & 3, b = item >> 7, lane = c.lane;
    const size_t row = (size_t)(b * SEQ + ch * 64 + lane);
    const float li = softcap_(c.SG[row * 16 + 8 + h] + c.in[27][L * 4 + h]);
    const float lf = logsig_(softcap_(c.SG[row * 16 + 12 + h] + c.in[28][L * 4 + h]));
    const float bc = wave_incl_sum(lf, lane);
    const float av = li - bc;
    const float cm = wave_incl_max(av, lane);
    float* mg = (float*)(c.ws + WS_MG) + (size_t)item * 192;
    mg[lane] = av; mg[64 + lane] = cm; mg[128 + lane] = bc;
}
DI void ml_issue(const bf16_t* PR, int b, int h, int sl, int ch, int lane, unsigned bufaddr) {
    const size_t row = (size_t)(b * SEQ + ch * 64 + lane);
    const bf16_t* kp = PR + row * NPROJ + PMK + h * 64; const bf16_t* qp = PR + row * NPROJ + PMQ + h * 64; const bf16_t* vp = PR + row * NPROJ + PMV + h * 128 + sl * 32;
#pragma unroll
    for (int d8 = 0; d8 < 8; ++d8) { dma16(kp + d8 * 8, bufaddr + d8 * 1024); dma16(qp + d8 * 8, bufaddr + 8192 + d8 * 1024); }
#pragma unroll
    for (int d8 = 0; d8 < 4; ++d8) dma16(vp + d8 * 8, bufaddr + 16384 + d8 * 1024);
}
DI void task_ml_seq(const Ctx& c, int L, int unit, float* wl  ) {
    const int sl = (unit >> 3) & 3, stream = (unit & 7) + 8 * (unit >> 5);
    const int b = stream >> 2, h = stream & 3;
    const int lane = c.lane, r0_ = lane & 31, hh0_ = lane >> 5;
    int r = r0_, hh = hh0_, lane_v = lane;
    LAS float* a_l = (LAS float*)wl; LAS float* w_l = a_l + 64; LAS float* sc_l = a_l + 128; LAS float* inv_l = a_l + 192;
    LAS unsigned char* bufs = (LAS unsigned char*)(a_l + 256);
    const unsigned bufaddr0 = (unsigned)(size_t)bufs;
    const bf16_t* PR = c.R1;
    f32x16 C[2];
#pragma unroll
    for (int i = 0; i < 2; ++i)
#pragma unroll
        for (int j = 0; j < 16; ++j) C[i][j] = 0.f;
    float nst = 0.f, mprev = 0.f;
    bf16_t* yo = c.Y3 + (size_t)2 * MPAD * 512;
    float mgv[3];
    { const float* mg = (const float*)(c.ws + WS_MG) + (size_t)(stream * 32) * 192; mgv[0] = mg[lane]; mgv[1] = mg[64 + lane]; mgv[2] = mg[128 + lane]; }
    ml_issue(PR, b, h, sl, 0, lane, bufaddr0);
    for (int ch = 0; ch < 32; ++ch) {
        r = r0_; hh = hh0_; lane_v = lane; asm volatile("" : "+v"(r), "+v"(hh), "+v"(lane_v));
        const float av = mgv[0], cmx = mgv[1], bc = mgv[2];
        asm volatile("s_waitcnt vmcnt(0)" ::: "memory");
        if (ch + 1 < 32) ml_issue(PR, b, h, sl, ch + 1, lane_v, bufaddr0 + ((ch + 1) & 1) * 20480);
        { const int chn = ch + 1 < 32 ? ch + 1 : 31; const float* mg = (const float*)(c.ws + WS_MG) + (size_t)(stream * 32 + chn) * 192;
          mgv[0] = mg[lane_v]; mgv[1] = mg[64 + lane_v]; mgv[2] = mg[128 + lane_v]; }
        LAS unsigned char* Kc = bufs + (ch & 1) * 20480; asm volatile("" : "+v"(Kc));
        LAS unsigned char* Qc = Kc + 8192; LAS unsigned char* Vc = Kc + 16384;
        LAS unsigned char* vbase = Vc + (r >> 3) * 1024 + (r & 7) * 2 + hh * 64; asm volatile("" : "+v"(vbase));
        LAS unsigned char* kbase = Kc + (r >> 3) * 1024 + (r & 7) * 2 + hh * 64; asm volatile("" : "+v"(kbase));
        LAS unsigned char* krow = Kc + hh * 1024 + r * 16; asm volatile("" : "+v"(krow));
        LAS unsigned char* qrow = Qc + hh * 1024 + r * 16; asm volatile("" : "+v"(qrow));
        LAS unsigned char* qr4 = Qc + r * 16 + hh * 8; asm volatile("" : "+v"(qr4));
        LAS unsigned char* kn = Kc + (lane_v >> 3) * 1024 + (lane_v & 7) * 2; asm volatile("" : "+v"(kn));
        LAS unsigned char* qln = Qc + lane_v * 16; asm volatile("" : "+v"(qln));
        LAS float* a4b = a_l + 4 * hh; asm volatile("" : "+v"(a4b));
        const size_t t0 = (size_t)(b * SEQ + ch * 64);
        const float Mt = fmaxf(mprev, cmx);
        const float sct = __expf(mprev - Mt);
        const float M63 = __shfl(Mt, 63), bc63 = __shfl(bc, 63);
        const float wlast = __expf(av - M63) * 0.125f;
        const float sclast = __expf(mprev - M63);
        WAVE_FENCE();
        float qn = 0.f;
#pragma unroll
        for (int d8 = 0; d8 < 8; ++d8) { const f32x8 qv = unpack8(*(const LAS bf16x8*)(qln + d8 * 1024));
#pragma unroll
            for (int e = 0; e < 8; ++e) qn += qv[e] * __shfl(nst, d8 * 8 + e); }
        a_l[lane] = av; w_l[lane] = wlast;
        WAVE_FENCE();
        bf16x8 Vb[4];
#pragma unroll
        for (int ks = 0; ks < 4; ++ks)
#pragma unroll
            for (int j = 0; j < 8; ++j) Vb[ks][j] = (short)*(const LAS bf16_t*)(vbase + (16 * ks + 8 * (j >> 2) + (j & 3)) * 16);
        f32x16 num[2]; float dpv[2];
#pragma unroll
        for (int nt = 0; nt < 2; ++nt) {
            f32x16 PT[2];
#pragma unroll
            for (int ms = 0; ms < 2; ++ms)
#pragma unroll
                for (int j = 0; j < 16; ++j) PT[ms][j] = 0.f;
#pragma unroll
            for (int ks = 0; ks < 4; ++ks) {
                const bf16x8 bq = *(const LAS bf16x8*)(qrow + ks * 2048 + nt * 512);
#pragma unroll
                for (int ms = 0; ms < 2; ++ms) { const bf16x8 ak = *(const LAS bf16x8*)(krow + ks * 2048 + ms * 512); PT[ms] = MFMA32(ak, bq, PT[ms]); }
            }
            const float Mtn = __shfl(Mt, nt * 32 + r);
            float dp = 0.f;
#pragma unroll
            for (int ms = 0; ms < 2; ++ms)
#pragma unroll
                for (int g = 0; g < 4; ++g) { const f32x4 a4 = *(const LAS f32x4*)(a4b + ms * 32 + 8 * g);
#pragma unroll
                    for (int jj = 0; jj < 4; ++jj) { const int i = 4 * g + jj; const int s = ms * 32 + 8 * g + 4 * hh + jj;
                        const float wv = (s <= nt * 32 + r) ? __expf(a4[jj] - Mtn) * 0.125f : 0.f;
                        PT[ms][i] *= wv; dp += PT[ms][i]; } }
            dp += __shfl_xor(dp, 32); dpv[nt] = dp;
#pragma unroll
            for (int j = 0; j < 16; ++j) num[nt][j] = 0.f;
#pragma unroll
            for (int ks = 0; ks < 4; ++ks) num[nt] = MFMA32(pack16(PT[ks >> 1], ks & 1), Vb[ks], num[nt]);
            }
        const float den = (lane < 32 ? dpv[0] : dpv[1]) + sct * qn;
        const float inv = 1.f / fmaxf(fabsf(den), __expf(-(bc + Mt)));
        sc_l[lane] = sct; inv_l[lane] = inv;
        WAVE_FENCE();
        { bf16x8 Cb[4];
#pragma unroll
          for (int kd = 0; kd < 4; ++kd) Cb[kd] = pack16(C[kd >> 1], kd & 1);
#pragma unroll
          for (int mt = 0; mt < 2; ++mt) { f32x16 qc;
#pragma unroll
              for (int j = 0; j < 16; ++j) qc[j] = 0.f;
#pragma unroll
              for (int kd = 0; kd < 4; ++kd) { const LAS unsigned char* qr = qr4 + kd * 2048 + mt * 512;
                  const s16x4 lo = *(const LAS s16x4*)qr, hi = *(const LAS s16x4*)(qr + 1024);
                  const bf16x8 a = __builtin_shufflevector(lo, hi, 0, 1, 2, 3, 4, 5, 6, 7);
                  qc = MFMA32(a, Cb[kd], qc); }
#pragma unroll
              for (int g = 0; g < 4; ++g) { const f32x4 s4 = *(const LAS f32x4*)(a4b + 128 + mt * 32 + 8 * g), i4 = *(const LAS f32x4*)(a4b + 192 + mt * 32 + 8 * g);
#pragma unroll
                  for (int jj = 0; jj < 4; ++jj) { const int i = 4 * g + jj; const float hv = (num[mt][i] + s4[jj] * qc[i]) * i4[jj];
                      yo[(t0 + mt * 32 + 8 * g + 4 * hh + jj) * 512 + h * 128 + sl * 32 + r] = f2bf(hv); } }
                } }
#pragma unroll
        for (int i = 0; i < 2; ++i) {
#pragma unroll
            for (int j = 0; j < 16; ++j) C[i][j] *= sclast;
#pragma unroll
            for (int ks = 0; ks < 4; ++ks) { const f32x4 wA = *(const LAS f32x4*)(a4b + 64 + 16 * ks), wB = *(const LAS f32x4*)(a4b + 64 + 16 * ks + 8);
                f32x8 kv;
#pragma unroll
                for (int j = 0; j < 8; ++j) kv[j] = bf2f(*(const LAS bf16_t*)(kbase + i * 4096 + (16 * ks + 8 * (j >> 2) + (j & 3)) * 16)) * (j < 4 ? wA[j & 3] : wB[j & 3]);
                C[i] = MFMA32(pack8v(kv), Vb[ks], C[i]); }
            }
        { float na = 0.f;
#pragma unroll 8
          for (int s = 0; s < 64; ++s) na += w_l[s] * bf2f(*(const LAS bf16_t*)(kn + s * 16));
          nst = sclast * nst + na; }
        mprev = bc63 + M63;
        asm volatile("s_waitcnt lgkmcnt(0)" ::: "memory");
    }
    float* co = c.out + O_MLC_P + ((size_t)(L * NB + b) * 4 + h) * 64 * 128;
#pragma unroll
    for (int i = 0; i < 2; ++i)
#pragma unroll
        for (int j = 0; j < 16; ++j) co[(size_t)(i * 32 + crow(j, hh)) * 128 + sl * 32 + r] = C[i][j];
    if (sl == 0) { c.out[O_MLN_P + ((size_t)(L * NB + b) * 4 + h) * 64 + lane] = nst; if (lane == 0) c.out[O_MLM_P + (size_t)(L * NB + b) * 4 + h] = mprev; }
}

DI void task_gdn_sample(const Ctx& c, int L, int unit) {
    const int half = unit & 1, h = (unit >> 1) & 3, b = unit >> 3, lane = c.lane;
    const size_t row = (size_t)(MP + b);
    const bf16_t* pr = c.R1 + row * NPROJ;
    const float* cbuf = c.in[4] + ((size_t)L * MS + b) * 3 * 1536;
    const float* cw = c.in[23] + (size_t)L * 4 * 1536;
    float* cout = c.out + O_CONV_S + ((size_t)L * MS + b) * 3 * 1536;
    float qv[2], kv[2], vv;
#pragma unroll
    for (int w = 0; w < 5; ++w) {
        const int which = w < 2 ? 0 : w < 4 ? 1 : 2; const int d = (w == 4) ? half * 64 + lane : lane + 64 * (w & 1);
        const int cc = which * 512 + h * 128 + d;
        const float xin = bf2f(pr[PQ + cc]);
        const float b0 = cbuf[cc], b1 = cbuf[1536 + cc], b2 = cbuf[3072 + cc];
        float a = b0 * cw[cc] + b1 * cw[1536 + cc] + b2 * cw[3072 + cc] + xin * cw[4608 + cc];
        a = silu_(a);
        cout[cc] = b1; cout[1536 + cc] = b2; cout[3072 + cc] = xin;
        if (w < 2) qv[w] = a; else if (w < 4) kv[w - 2] = a; else vv = a;
    }
    { const float sq = wave_sum(qv[0] * qv[0] + qv[1] * qv[1]), sk = wave_sum(kv[0] * kv[0] + kv[1] * kv[1]);
      const float fq = rsqrtf(sq + EPS) * 0.08838834764831845f, fk = rsqrtf(sk + EPS);
      qv[0] *= fq; qv[1] *= fq; kv[0] *= fk; kv[1] *= fk; }
    const float qk = wave_sum(qv[0] * kv[0] + qv[1] * kv[1]);
    const float beta = sigm(c.SG[row * 16 + h]);
    const float g = -expf(c.in[24][L * 4 + h]) * softplus_(c.SG[row * 16 + 4 + h] + c.in[25][L * 4 + h]);
    const float eg = expf(g);
    const float* sin_ = c.in[5] + (((size_t)L * MS + b) * 4 + h) * 128 * 128 + half * 64 + lane;
    float* sout = c.out + O_GDN_S + (((size_t)L * MS + b) * 4 + h) * 128 * 128 + half * 64 + lane;
    float kS = 0.f, qS = 0.f;
#pragma unroll
    for (int hf = 0; hf < 2; ++hf) { const float kh = kv[hf], qh = qv[hf];
#pragma unroll 8
        for (int d = 0; d < 64; ++d) { const float sv = sin_[(size_t)(hf * 64 + d) * 128]; kS += __shfl(kh, d) * sv; qS += __shfl(qh, d) * sv; } }
    const float vnew = beta * (vv - eg * kS);
    const float o = eg * qS + qk * vnew;
#pragma unroll
    for (int hf = 0; hf < 2; ++hf) { const float kh = kv[hf];
#pragma unroll 8
        for (int d = 0; d < 64; ++d) { const float sv = sin_[(size_t)(hf * 64 + d) * 128]; sout[(size_t)(hf * 64 + d) * 128] = sv * eg + __shfl(kh, d) * vnew; } }
    c.Y3[(size_t)1 * MPAD * 512 + row * 512 + h * 128 + half * 64 + lane] = f2bf(o);
}
DI void task_ml_sample(const Ctx& c, int L, int unit) {
    const int half = unit & 1, h = (unit >> 1) & 3, b = unit >> 3, lane = c.lane;
    const size_t row = (size_t)(MP + b);
    const bf16_t* pr = c.R1 + row * NPROJ;
    const float q = bf2f(pr[PMQ + h * 64 + lane]), k = bf2f(pr[PMK + h * 64 + lane]) * 0.125f, v = bf2f(pr[PMV + h * 128 + half * 64 + lane]);
    const float li = softcap_(c.SG[row * 16 + 8 + h] + c.in[27][L * 4 + h]);
    const float lf = logsig_(softcap_(c.SG[row * 16 + 12 + h] + c.in[28][L * 4 + h]));
    const size_t sidx = ((size_t)L * MS + b) * 4 + h;
    const float m0 = c.in[8][sidx];
    const float mt = fmaxf(lf + m0, li), wts = expf(li - mt), sc = expf(lf + m0 - mt);
    const float n0 = c.in[7][sidx * 64 + lane];
    const float sqk = wave_sum(q * k) * wts, qn = wave_sum(q * n0);
    const float* cin = c.in[6] + sidx * 64 * 128 + half * 64 + lane;
    float* cout = c.out + O_MLC_S + sidx * 64 * 128 + half * 64 + lane;
    float cc[64]; float qC = 0.f;
#pragma unroll
    for (int d = 0; d < 64; ++d) { cc[d] = cin[(size_t)d * 128]; qC += __shfl(q, d) * cc[d]; }
    const float num = sqk * v + sc * qC, den = sqk + sc * qn;
    const float hv = num / fmaxf(fabsf(den), expf(-mt));
#pragma unroll
    for (int d = 0; d < 64; ++d) cout[(size_t)d * 128] = sc * cc[d] + wts * __shfl(k, d) * v;
    if (half == 0) { c.out[O_MLN_S + sidx * 64 + lane] = sc * n0 + wts * k; if (lane == 0) c.out[O_MLM_S + sidx] = mt; }
    c.Y3[(size_t)2 * MPAD * 512 + row * 512 + h * 128 + half * 64 + lane] = f2bf(hv);
}
struct S5P { float lr, li; f32x2 bb[16]; };
DI S5P s5_params(const Ctx& c, int L, int g, int p) {
    S5P P; const size_t gp = ((size_t)L * 32 + g) * 64 + p;
    const float are = c.in[13][gp], aim = c.in[14][gp], dt = expf(c.in[15][L * 32 + g]);
    const float mag = expf(are * dt); P.lr = mag * cosf(aim * dt); P.li = mag * sinf(aim * dt);
    const float inv = 1.f / (are * are + aim * aim), zr = P.lr - 1.f, zi = P.li;
    const float fre = (zr * are + zi * aim) * inv, fim = (zi * are - zr * aim) * inv;
    const float* Bre = c.in[16] + gp * 16; const float* Bim = c.in[17] + gp * 16;
#pragma unroll
    for (int q4 = 0; q4 < 4; ++q4) { const f32x4 br = *(const f32x4*)(Bre + 4 * q4), bi = *(const f32x4*)(Bim + 4 * q4);
#pragma unroll
        for (int e = 0; e < 4; ++e) { P.bb[4 * q4 + e][0] = fre * br[e] - fim * bi[e]; P.bb[4 * q4 + e][1] = fre * bi[e] + fim * br[e]; } }
    return P;
}
DI void task_s5_sample(const Ctx& c, int L, int unit) {
    const int g = unit & 31, b = unit >> 5, lane = c.lane;
    const S5P P = s5_params(c, L, g, lane);
    const size_t row = (size_t)(MP + b);
    const bf16_t* pr = c.R1 + row * NPROJ + PU + g * 16;
    float u[16];
    { const f32x8 u0 = unpack8(*(const bf16x8*)pr), u1 = unpack8(*(const bf16x8*)(pr + 8));
#pragma unroll
      for (int e = 0; e < 8; ++e) { u[e] = u0[e]; u[8 + e] = u1[e]; } }
    f32x2 bu = {0.f, 0.f};
#pragma unroll
    for (int cc = 0; cc < 16; ++cc) bu += P.bb[cc] * u[cc];
    const size_t si = (((size_t)L * MS + b) * 32 + g) * 64 + lane;
    const float h0r = c.in[2][si], h0i = c.in[3][si];
    const float hr = P.lr * h0r - P.li * h0i + bu[0], hi = P.lr * h0i + P.li * h0r + bu[1];
    c.out[O_S5RE_S + si] = hr; c.out[O_S5IM_S + si] = hi;
    const float* Cre = c.in[18] + ((size_t)L * 32 + g) * 16 * 64; const float* Cim = c.in[19] + ((size_t)L * 32 + g) * 16 * 64;
    float ya[16];
#pragma unroll
    for (int cc = 0; cc < 16; ++cc) ya[cc] = hr * Cre[cc * 64 + lane] - hi * Cim[cc * 64 + lane];
    butterfly16(ya, lane);
    if ((lane & 3) == 0) { const int cc = bsel16(lane); const float y = ya[0] + c.in[20][L * 512 + g * 16 + cc] * bf2f(pr[cc]);
        c.YS5[row * 512 + g * 16 + cc] = f2bf(gelu_t(y)); }
}

DI void task_s5_wave(const Ctx& c, int L, int unit, unsigned char* wlds  ) {
    LAS float* Uw = (LAS float*)wlds;
    LAS bf16_t* Hw = (LAS bf16_t*)(wlds + 4096);
    const int lane = c.lane;
    const int g = unit & 31, b = unit >> 5;
    const S5P P = s5_params(c, L, g, lane);
    const size_t rbase = (size_t)(b * SEQ);
    const bf16_t* ub = c.R1 + rbase * NPROJ + PU + g * 16;
    bf16x8 Cb[4];
    { const int cc = lane & 15, kq = (lane >> 4) * 8; const float* Cre = c.in[18] + (((size_t)L * 32 + g) * 16 + cc) * 64; const float* Cim = c.in[19] + (((size_t)L * 32 + g) * 16 + cc) * 64;
#pragma unroll
      for (int ks = 0; ks < 4; ++ks) { f32x8 v;
#pragma unroll
          for (int j = 0; j < 8; ++j) { const int k = ks * 32 + kq + j; v[j] = (k < 64) ? Cre[k] : -Cim[k - 64]; }
          Cb[ks] = pack8v(v); } }
    const float dskip = c.in[20][L * 512 + g * 16 + (lane & 15)];
    float hr = 0.f, hi = 0.f;
    for (int sub = 0; sub < 32; ++sub) {
        WAVE_FENCE();
        { const bf16_t* up = ub + (size_t)(sub * 64 + lane) * NPROJ; const f32x8 u0 = unpack8(*(const bf16x8*)up), u1 = unpack8(*(const bf16x8*)(up + 8));
          LAS f32x4* d = (LAS f32x4*)(Uw + lane * 16);
          d[0] = (f32x4){u0[0], u0[1], u0[2], u0[3]}; d[1] = (f32x4){u0[4], u0[5], u0[6], u0[7]}; d[2] = (f32x4){u1[0], u1[1], u1[2], u1[3]}; d[3] = (f32x4){u1[4], u1[5], u1[6], u1[7]}; }
        WAVE_FENCE();
        for (int blk = 0; blk < 4; ++blk) {
#pragma unroll 4
            for (int st = 0; st < 16; ++st) {
                const LAS f32x4* up4 = (const LAS f32x4*)(Uw + (blk * 16 + st) * 16);
                f32x2 bu = {0.f, 0.f};
#pragma unroll
                for (int q4 = 0; q4 < 4; ++q4) { const f32x4 uv = up4[q4];
#pragma unroll
                    for (int e = 0; e < 4; ++e) bu += P.bb[4 * q4 + e] * uv[e]; }
                const float nr = P.lr * hr - P.li * hi + bu[0], ni = P.lr * hi + P.li * hr + bu[1]; hr = nr; hi = ni;
                Hw[st * 128 + lane] = f2bf(hr); Hw[st * 128 + 64 + lane] = f2bf(hi);
            }
            WAVE_FENCE();
            f32x4 acc = {0.f, 0.f, 0.f, 0.f};
#pragma unroll
            for (int ks = 0; ks < 4; ++ks) { const bf16x8 a = *(const LAS bf16x8*)(Hw + (lane & 15) * 128 + ks * 32 + (lane >> 4) * 8); acc = MFMA16(a, Cb[ks], acc); }
            const int cc = lane & 15;
#pragma unroll
            for (int j = 0; j < 4; ++j) { const int st = (lane >> 4) * 4 + j; const int tl = blk * 16 + st;
                const float y = acc[j] + dskip * Uw[tl * 16 + cc];
                c.YS5[(rbase + sub * 64 + tl) * 512 + g * 16 + cc] = f2bf(gelu_t(y)); }
            WAVE_FENCE();
        }
    }
    { const size_t si = (((size_t)L * NB + b) * 32 + g) * 64 + lane; c.out[O_S5RE_P + si] = hr; c.out[O_S5IM_P + si] = hi; }
}

constexpr int S5Q_BASE = 122880, S5Q_F = S5Q_BASE + 32768, S5Q_FLAG = S5Q_F + 2048;
template <int PASS> DI void s5_steps16(const S5P& P, const LAS float* Ublk, LAS bf16_t* Hw, int lane, float& hr, float& hi) {
#pragma unroll
    for (int s4 = 0; s4 < 4; ++s4) {
        f32x4 uv[4][4];
#pragma unroll
        for (int j = 0; j < 4; ++j)
#pragma unroll
            for (int q4 = 0; q4 < 4; ++q4) uv[j][q4] = *(const LAS f32x4*)(Ublk + (s4 * 4 + j) * 16 + q4 * 4);
        asm volatile("" ::: "memory");
        f32x2 bu[4];
#pragma unroll
        for (int j = 0; j < 4; ++j) { f32x2 acc[4];
#pragma unroll
            for (int q4 = 0; q4 < 4; ++q4) { acc[q4] = P.bb[4 * q4] * uv[j][q4][0];
#pragma unroll
                for (int e = 1; e < 4; ++e) acc[q4] += P.bb[4 * q4 + e] * uv[j][q4][e]; }
            bu[j] = (acc[0] + acc[1]) + (acc[2] + acc[3]); }
#pragma unroll
        for (int j = 0; j < 4; ++j) { const float nr = P.lr * hr - P.li * hi + bu[j][0], ni = P.lr * hi + P.li * hr + bu[j][1]; hr = nr; hi = ni;
            if (PASS == 1) { Hw[(s4 * 4 + j) * 128 + lane] = f2bf(hr); Hw[(s4 * 4 + j) * 128 + 64 + lane] = f2bf(hi); } }
    }
}
DI void task_s5_quad(const Ctx& c, int L, int unit, int wq, int gen) {
    unsigned char* wlds = c.lds + S5Q_BASE + wq * 8192;
    LAS float* Uw = (LAS float*)wlds;
    LAS bf16_t* Hw = (LAS bf16_t*)(wlds + 4096);
    LAS float* F = (LAS float*)(c.lds + S5Q_F);
    volatile LAS int* flag = (volatile LAS int*)(c.lds + S5Q_FLAG);
    const int lane = c.lane;
    const int g = unit & 31, b = unit >> 5;
    const S5P P = s5_params(c, L, g, lane);
    float pr_ = P.lr, pi_ = P.li;
#pragma unroll
    for (int i = 0; i < 9; ++i) { const float nr = pr_ * pr_ - pi_ * pi_, ni = 2.f * pr_ * pi_; pr_ = nr; pi_ = ni; }
    const size_t rbase = (size_t)(b * SEQ + wq * 512);
    const bf16_t* ub = c.R1 + rbase * NPROJ + PU + g * 16;
    bf16x8 Cb[4];
    { const int cc = lane & 15, kq = (lane >> 4) * 8; const float* Cre = c.in[18] + (((size_t)L * 32 + g) * 16 + cc) * 64; const float* Cim = c.in[19] + (((size_t)L * 32 + g) * 16 + cc) * 64;
#pragma unroll
      for (int ks = 0; ks < 4; ++ks) { f32x8 v;
#pragma unroll
          for (int j = 0; j < 8; ++j) { const int k = ks * 32 + kq + j; v[j] = (k < 64) ? Cre[k] : -Cim[k - 64]; }
          Cb[ks] = pack8v(v); } }
    const float dskip = c.in[20][L * 512 + g * 16 + (lane & 15)];
    float hr = 0.f, hi = 0.f;
    for (int pass = 0; pass < 2; ++pass) {
        if (pass == 1) {
            hr = 0.f; hi = 0.f;
            for (int v = 0; v < wq; ++v) { while (flag[v] != gen) __builtin_amdgcn_s_sleep(2);
                asm volatile("" ::: "memory");
                const float fr = F[v * 128 + lane], fi = F[v * 128 + 64 + lane];
                const float nr = pr_ * hr - pi_ * hi + fr, ni = pr_ * hi + pi_ * hr + fi; hr = nr; hi = ni; }
        }
        for (int sub = 0; sub < 8; ++sub) {
            WAVE_FENCE();
            { const bf16_t* up = ub + (size_t)(sub * 64 + lane) * NPROJ; const f32x8 u0 = unpack8(*(const bf16x8*)up), u1 = unpack8(*(const bf16x8*)(up + 8));
              LAS f32x4* d = (LAS f32x4*)(Uw + lane * 16);
              d[0] = (f32x4){u0[0], u0[1], u0[2], u0[3]}; d[1] = (f32x4){u0[4], u0[5], u0[6], u0[7]}; d[2] = (f32x4){u1[0], u1[1], u1[2], u1[3]}; d[3] = (f32x4){u1[4], u1[5], u1[6], u1[7]}; }
            WAVE_FENCE();
            for (int blk = 0; blk < 4; ++blk) {
                if (pass == 1) s5_steps16<1>(P, Uw + blk * 256, Hw, lane, hr, hi); else s5_steps16<0>(P, Uw + blk * 256, Hw, lane, hr, hi);
                if (pass == 1) {
                    WAVE_FENCE();
                    f32x4 acc = {0.f, 0.f, 0.f, 0.f};
#pragma unroll
                    for (int ks = 0; ks < 4; ++ks) { const bf16x8 a = *(const LAS bf16x8*)(Hw + (lane & 15) * 128 + ks * 32 + (lane >> 4) * 8); acc = MFMA16(a, Cb[ks], acc); }
                    const int cc = lane & 15;
#pragma unroll
                    for (int j = 0; j < 4; ++j) { const int st = (lane >> 4) * 4 + j; const int tl = blk * 16 + st;
                        const float y = acc[j] + dskip * Uw[tl * 16 + cc];
                        c.YS5[(rbase + sub * 64 + tl) * 512 + g * 16 + cc] = f2bf(gelu_t(y)); }
                    WAVE_FENCE();
                }
            }
        }
        if (pass == 0) {
            if (wq < 3) { F[wq * 128 + lane] = hr; F[wq * 128 + 64 + lane] = hi; WAVE_FENCE(); if (lane == 0) flag[wq] = gen; }
        }
    }
    if (wq == 3) { const size_t si = (((size_t)L * NB + b) * 32 + g) * 64 + lane; c.out[O_S5RE_P + si] = hr; c.out[O_S5IM_P + si] = hi; }
}

DI void phase_s5_scan(const Ctx& c, int L) {
    float* U = (float*)c.lds;
    bf16_t* H = (bf16_t*)(c.lds + 32768);
    float* F = (float*)(c.lds + 65536);
    const int lane = c.lane, w = c.wave;
    float* Uw = U + w * 1024; bf16_t* Hw = H + w * 2048;
    for (int unit = c.bid; unit < 256; unit += c.G) {
        const int g = unit & 31, b = unit >> 5;
        const S5P P = s5_params(c, L, g, lane);
        float pr_ = P.lr, pi_ = P.li;
#pragma unroll
        for (int i = 0; i < 8; ++i) { const float nr = pr_ * pr_ - pi_ * pi_, ni = 2.f * pr_ * pi_; pr_ = nr; pi_ = ni; }
        const size_t rbase = (size_t)(b * SEQ + w * 256);
        const bf16_t* ub = c.R1 + rbase * NPROJ + PU + g * 16;
        bf16x8 Cb[4];
        { const int cc = lane & 15, kq = (lane >> 4) * 8; const float* Cre = c.in[18] + (((size_t)L * 32 + g) * 16 + cc) * 64; const float* Cim = c.in[19] + (((size_t)L * 32 + g) * 16 + cc) * 64;
#pragma unroll
          for (int ks = 0; ks < 4; ++ks) { f32x8 v;
#pragma unroll
              for (int j = 0; j < 8; ++j) { const int k = ks * 32 + kq + j; v[j] = (k < 64) ? Cre[k] : -Cim[k - 64]; }
              Cb[ks] = pack8v(v); } }
        const float dskip = c.in[20][L * 512 + g * 16 + (lane & 15)];
        float hr = 0.f, hi = 0.f;
        for (int pass = 0; pass < 2; ++pass) {
            if (pass == 1) {
                F[w * 128 + lane] = hr; F[w * 128 + 64 + lane] = hi;
                __syncthreads();
                hr = 0.f; hi = 0.f;
                for (int v = 0; v < w; ++v) { const float fr = F[v * 128 + lane], fi = F[v * 128 + 64 + lane];
                    const float nr = pr_ * hr - pi_ * hi + fr, ni = pr_ * hi + pi_ * hr + fi; hr = nr; hi = ni; }
            }
            for (int sub = 0; sub < 4; ++sub) {
                __syncthreads();
                { const bf16_t* up = ub + (size_t)(sub * 64 + lane) * NPROJ; const f32x8 u0 = unpack8(*(const bf16x8*)up), u1 = unpack8(*(const bf16x8*)(up + 8));
                  f32x4* d = (f32x4*)(Uw + lane * 16);
                  d[0] = (f32x4){u0[0], u0[1], u0[2], u0[3]}; d[1] = (f32x4){u0[4], u0[5], u0[6], u0[7]}; d[2] = (f32x4){u1[0], u1[1], u1[2], u1[3]}; d[3] = (f32x4){u1[4], u1[5], u1[6], u1[7]}; }
                __syncthreads();
                for (int blk = 0; blk < 4; ++blk) {
#pragma unroll 4
                    for (int st = 0; st < 16; ++st) {
                        const f32x4* up4 = (const f32x4*)(Uw + (blk * 16 + st) * 16);
                        f32x2 bu = {0.f, 0.f};
#pragma unroll
                        for (int q4 = 0; q4 < 4; ++q4) { const f32x4 uv = up4[q4];
#pragma unroll
                            for (int e = 0; e < 4; ++e) bu += P.bb[4 * q4 + e] * uv[e]; }
                        const float nr = P.lr * hr - P.li * hi + bu[0], ni = P.lr * hi + P.li * hr + bu[1]; hr = nr; hi = ni;
                        if (pass == 1) { Hw[st * 128 + lane] = f2bf(hr); Hw[st * 128 + 64 + lane] = f2bf(hi); }
                    }
                    if (pass == 1) {
                        __syncthreads();
                        f32x4 acc = {0.f, 0.f, 0.f, 0.f};
#pragma unroll
                        for (int ks = 0; ks < 4; ++ks) { const bf16x8 a = *(const bf16x8*)(Hw + (lane & 15) * 128 + ks * 32 + (lane >> 4) * 8); acc = MFMA16(a, Cb[ks], acc); }
                        const int cc = lane & 15;
#pragma unroll
                        for (int j = 0; j < 4; ++j) { const int st = (lane >> 4) * 4 + j; const int tl = blk * 16 + st;
                            const float y = acc[j] + dskip * Uw[tl * 16 + cc];
                            c.YS5[(rbase + sub * 64 + tl) * 512 + g * 16 + cc] = f2bf(gelu_t(y)); }
                        __syncthreads();
                    }
                }
            }
        }
        if (w == 7) { const size_t si = (((size_t)L * NB + b) * 32 + g) * 64 + lane; c.out[O_S5RE_P + si] = hr; c.out[O_S5IM_P + si] = hi; }
        __syncthreads();
    }
}


#ifdef SELFCHK
DI void blk_reduce2(float& a, float& b, float* red, int tid) {
    a = wave_sum(a); b = wave_sum(b);
    __syncthreads();
    if ((tid & 63) == 0) { red[tid >> 6] = a; red[8 + (tid >> 6)] = b; }
    __syncthreads();
    float x = 0.f, y = 0.f;
    for (int i = 0; i < 8; ++i) { x += red[i]; y += red[8 + i]; }
    a = x; b = y; __syncthreads();
}
DI void chk_gdn(const Ctx& c, int L, int b, int h, float* dg) {
    float* q = (float*)c.lds; float* k = q + 128; float* v = k + 128; float* part = v + 128; float* red = part + 512; float* sc_ = red + 16;
    const int tid = c.tid, dv = tid & 127, qt = tid >> 7;
    const float* convw = c.in[23] + (size_t)L * 4 * 1536;
    float S[32];
#pragma unroll
    for (int i = 0; i < 32; ++i) S[i] = 0.f;
    float e2 = 0.f, r2 = 0.f;
    for (int t = 0; t < SEQ; ++t) {
        const size_t row = (size_t)b * SEQ + t;
        if (tid < 384) { const int which = tid >> 7, d = tid & 127; float a = 0.f;
            for (int j = 0; j < 4; ++j) { const int tt = t + j - 3; if (tt >= 0) a += bf2f(c.R1[((size_t)b * SEQ + tt) * NPROJ + PQ + which * 512 + h * 128 + d]) * convw[j * 1536 + which * 512 + h * 128 + d]; }
            (which == 0 ? q : which == 1 ? k : v)[d] = silu_(a); }
        __syncthreads();
        float sq = 0.f, sk = 0.f;
        for (int d = 0; d < 128; ++d) { sq += q[d] * q[d]; sk += k[d] * k[d]; }
        const float fq = rsqrtf(sq + EPS) * 0.08838834764831845f, fk = rsqrtf(sk + EPS);
        const float beta = sigm(c.SG[row * 16 + h]);
        const float g = -expf(c.in[24][L * 4 + h]) * softplus_(c.SG[row * 16 + 4 + h] + c.in[25][L * 4 + h]);
        const float eg = expf(g);
        float ks = 0.f;
#pragma unroll
        for (int i = 0; i < 32; ++i) { S[i] *= eg; ks += k[qt * 32 + i] * fk * S[i]; }
        part[qt * 128 + dv] = ks;
        __syncthreads();
        const float kS = part[dv] + part[128 + dv] + part[256 + dv] + part[384 + dv];
        const float vnew = beta * (v[dv] - kS);
        float qs = 0.f;
#pragma unroll
        for (int i = 0; i < 32; ++i) { S[i] += k[qt * 32 + i] * fk * vnew; qs += q[qt * 32 + i] * fq * S[i]; }
        __syncthreads();
        part[qt * 128 + dv] = qs;
        __syncthreads();
        if (qt == 0) { const float o = part[dv] + part[128 + dv] + part[256 + dv] + part[384 + dv];
            const float got = bf2f(c.Y3[(size_t)1 * MPAD * 512 + row * 512 + h * 128 + dv]); e2 += (got - o) * (got - o); r2 += o * o; }
        __syncthreads();
    }
    blk_reduce2(e2, r2, red, tid);
    if (tid == 0) dg[0] = sqrtf(e2 / (r2 + 1e-30f));
    float e3 = 0.f, r3 = 0.f;
#pragma unroll
    for (int i = 0; i < 32; ++i) { const float got = c.out[O_GDN_P + (((size_t)L * NB + b) * 4 + h) * 16384 + (size_t)(qt * 32 + i) * 128 + dv]; e3 += (got - S[i]) * (got - S[i]); r3 += S[i] * S[i]; }
    blk_reduce2(e3, r3, red, tid);
    if (tid == 0) dg[1] = sqrtf(e3 / (r3 + 1e-30f));
    (void)sc_;
}
DI void chk_ml(const Ctx& c, int L, int b, int h, float* dg) {
    float* q = (float*)c.lds; float* k = q + 64; float* v = k + 64; float* n = v + 128; float* part = n + 64; float* red = part + 512;
    const int tid = c.tid, e = tid & 127, qt = tid >> 7;
    float C[16];
#pragma unroll
    for (int i = 0; i < 16; ++i) C[i] = 0.f;
    if (tid < 64) n[tid] = 0.f;
    float m = 0.f, e2 = 0.f, r2 = 0.f;
    __syncthreads();
    for (int t = 0; t < SEQ; ++t) {
        const size_t row = (size_t)b * SEQ + t;
        if (tid < 64) { q[tid] = bf2f(c.R1[row * NPROJ + PMQ + h * 64 + tid]); k[tid] = bf2f(c.R1[row * NPROJ + PMK + h * 64 + tid]) * 0.125f; }
        else if (tid < 192) v[tid - 64] = bf2f(c.R1[row * NPROJ + PMV + h * 128 + tid - 64]);
        __syncthreads();
        const float li = softcap_(c.SG[row * 16 + 8 + h] + c.in[27][L * 4 + h]);
        const float lf = logsig_(softcap_(c.SG[row * 16 + 12 + h] + c.in[28][L * 4 + h]));
        const float mn = fmaxf(lf + m, li), wts = expf(li - mn), sc = expf(lf + m - mn);
        float qk = 0.f, qn = 0.f;
        for (int d = 0; d < 64; ++d) { qk += q[d] * k[d]; qn += q[d] * n[d]; }
        float pc = 0.f;
#pragma unroll
        for (int i = 0; i < 16; ++i) pc += q[qt * 16 + i] * C[i];
        part[qt * 128 + e] = pc;
        __syncthreads();
        const float qC = part[e] + part[128 + e] + part[256 + e] + part[384 + e];
        const float sqk = qk * wts, num = sqk * v[e] + sc * qC, den = sqk + sc * qn;
        const float hv = num / fmaxf(fabsf(den), expf(-mn));
        if (qt == 0) { const float got = bf2f(c.Y3[(size_t)2 * MPAD * 512 + row * 512 + h * 128 + e]); e2 += (got - hv) * (got - hv); r2 += hv * hv; }
#pragma unroll
        for (int i = 0; i < 16; ++i) C[i] = sc * C[i] + wts * k[qt * 16 + i] * v[e];
        __syncthreads();
        if (tid < 64) n[tid] = sc * n[tid] + wts * k[tid];
        m = mn;
        __syncthreads();
    }
    blk_reduce2(e2, r2, red, tid);
    if (tid == 0) dg[2] = sqrtf(e2 / (r2 + 1e-30f));
    float e3 = 0.f, r3 = 0.f;
#pragma unroll
    for (int i = 0; i < 16; ++i) { const float got = c.out[O_MLC_P + (((size_t)L * NB + b) * 4 + h) * 8192 + (size_t)(qt * 16 + i) * 128 + e]; e3 += (got - C[i]) * (got - C[i]); r3 += C[i] * C[i]; }
    if (tid < 64) { const float got = c.out[O_MLN_P + (((size_t)L * NB + b) * 4 + h) * 64 + tid]; e3 += (got - n[tid]) * (got - n[tid]) * 64.f; r3 += n[tid] * n[tid] * 64.f; }
    if (tid == 0) { const float got = c.out[O_MLM_P + ((size_t)L * NB + b) * 4 + h]; e3 += (got - m) * (got - m) * 4096.f; r3 += m * m * 4096.f; }
    blk_reduce2(e3, r3, red, tid);
    if (tid == 0) dg[3] = sqrtf(e3 / (r3 + 1e-30f));
}
DI void chk_s5(const Ctx& c, int L, int b, int g, float* dg) {
    float* red = (float*)c.lds;
    float e2 = 0.f, r2 = 0.f, e3 = 0.f, r3 = 0.f;
    if (c.tid < 64) { const int lane = c.tid; const S5P P = s5_params(c, L, g, lane);
        const float* Cre = c.in[18] + ((size_t)L * 32 + g) * 16 * 64; const float* Cim = c.in[19] + ((size_t)L * 32 + g) * 16 * 64;
        float hr = 0.f, hi = 0.f;
        for (int t = 0; t < SEQ; ++t) { const size_t row = (size_t)b * SEQ + t; const bf16_t* pr = c.R1 + row * NPROJ + PU + g * 16;
            f32x2 bu = {0.f, 0.f};
#pragma unroll
            for (int cc = 0; cc < 16; ++cc) bu += P.bb[cc] * bf2f(pr[cc]);
            const float nr = P.lr * hr - P.li * hi + bu[0], ni = P.lr * hi + P.li * hr + bu[1]; hr = nr; hi = ni;
            for (int cc = 0; cc < 16; ++cc) { float y = wave_sum(hr * Cre[cc * 64 + lane] - hi * Cim[cc * 64 + lane]) + c.in[20][L * 512 + g * 16 + cc] * bf2f(pr[cc]);
                y = gelu_t(y); const float got = bf2f(c.YS5[row * 512 + g * 16 + cc]); if (lane == 0) { e2 += (got - y) * (got - y); r2 += y * y; } } }
        const size_t si = (((size_t)L * NB + b) * 32 + g) * 64 + lane;
        e3 = (c.out[O_S5RE_P + si] - hr) * (c.out[O_S5RE_P + si] - hr) + (c.out[O_S5IM_P + si] - hi) * (c.out[O_S5IM_P + si] - hi); r3 = hr * hr + hi * hi; }
    blk_reduce2(e2, r2, red, c.tid);
    blk_reduce2(e3, r3, red, c.tid);
    if (c.tid == 0) { dg[4] = sqrtf(e2 / (r2 + 1e-30f)); dg[5] = sqrtf(e3 / (r3 + 1e-30f)); }
}
#endif


#ifdef SELFCHK
DI float dot_bf(const bf16_t* a, const bf16_t* b, int K) { float s = 0.f; for (int k = 0; k < K; ++k) s += bf2f(a[k]) * bf2f(b[k]); return s; }
DI void chk_gemm(const Ctx& c, int L, int mode, float* dgp) {
    float* red = (float*)c.lds;
    float e2 = 0.f, r2 = 0.f;
    for (int rep = 0; rep < 2; ++rep) {
        const int sidx = c.tid + 512 * rep;
        const int row = (rep == 1 && c.tid < 64) ? MP + (c.tid * 2) : (int)(((unsigned)sidx * 7919u) % (unsigned)MP);
        float want = 0.f, got = 0.f;
        if (mode == 0) { const int col = (int)(((unsigned)sidx * 104729u) % 4096u); want = dot_bf(c.XN + (size_t)row * 1024, c.W + WO_IN + (size_t)col * 1024, 1024); got = bf2f(c.R1[(size_t)row * 4096 + col]); }
        if (mode == 1) { const int col = (int)(((unsigned)sidx * 104729u) % 3072u); want = sigm(dot_bf(c.XN + (size_t)row * 1024, c.W + WO_G + (size_t)col * 1024, 1024)); got = bf2f(c.R1[(size_t)row * 4096 + col]); }
        if (mode == 2) { const int col = (int)(((unsigned)sidx * 104729u) % 512u); const float y = bf2f(c.YS5[(size_t)row * 512 + col]);
            want = y * sigm(dot_bf(c.YS5 + (size_t)row * 512, c.W + WO_GLU + (size_t)col * 512, 512) + c.in[22][L * 512 + col]); got = bf2f(c.Y3[(size_t)row * 512 + col]); }
        if (mode == 3) { const int col = (int)(((unsigned)sidx * 104729u) % 1024u);
            for (int br = 0; br < 3; ++br) want += bf2f(c.R1[(size_t)row * 4096 + br * 1024 + col]) * dot_bf(c.Y3 + (size_t)br * MPAD * 512 + (size_t)row * 512, c.W + WO_BR + (size_t)br * 1024 * 512 + (size_t)col * 512, 512);
            got = bf2f(c.XN[(size_t)row * 1024 + col]); }
        if (mode == 4) { const int col = (int)(((unsigned)sidx * 104729u) % 4096u); const float d = fmaxf(dot_bf(c.XN + (size_t)row * 1024, c.W + WO_UP + (size_t)col * 1024, 1024), 0.f); want = d * d; got = bf2f(c.R1[(size_t)row * 4096 + col]); }
        if (mode == 5) { const int col = (int)(((unsigned)sidx * 104729u) % 1024u); want = dot_bf(c.Y3 + (size_t)row * 256, c.W + WO_PLE + (size_t)col * 256, 256); got = bf2f(c.Y3[(size_t)MPAD * 256 + (size_t)row * 1024 + col]); }
        e2 += (got - want) * (got - want); r2 += want * want;
    }
    blk_reduce2(e2, r2, red, c.tid);
    if (c.tid == 0) *dgp = sqrtf(e2 / (r2 + 1e-30f));
}
#endif

#ifdef SELFCHK
DI void chk_sg(const Ctx& c, float* dgp) {
    float* red = (float*)c.lds; float e2 = 0.f, r2 = 0.f;
    { const int sidx = c.tid >> 4, s = c.tid & 15; const int row = (sidx < 8) ? MP + sidx * 13 : (int)(((unsigned)sidx * 7919u * 37u) % (unsigned)MP);
      const float* x = row < MP ? c.in[0] + (size_t)row * 1024 : c.in[1] + (size_t)(row - MP) * 1024;
      const int sc = s < 4 ? 2560 + s : s < 8 ? 2564 + (s - 4) : s < 12 ? 4104 + (s - 8) : 4108 + (s - 12);
      float ss = 0.f; for (int k = 0; k < 1024; ++k) ss += x[k] * x[k];
      const float rs = rsqrtf(ss * (1.f / 1024.f) + EPS); float a = 0.f;
      for (int k = 0; k < 1024; ++k) a += x[k] * rs * c.in[11][k] * c.in[12][(size_t)k * DIN + sc];
      const float got = c.SG[(size_t)row * 16 + s]; e2 = (got - a) * (got - a); r2 = a * a; }
    blk_reduce2(e2, r2, red, c.tid);
    if (c.tid == 0) *dgp = sqrtf(e2 / (r2 + 1e-30f));
}
DI void chk_post(const Ctx& c, int L, float* dgp) {
    float* red = (float*)c.lds; float e2 = 0.f, r2 = 0.f;
    { const int hd8 = c.tid & 7, sidx = c.tid >> 3; const int row = (sidx < 8) ? MP + sidx * 11 : (int)(((unsigned)sidx * 7919u * 53u) % (unsigned)MP);
      const int br = hd8 >> 2, hd = hd8 & 3; float ms = 0.f;
      for (int e = 0; e < 128; ++e) { const float y = bf2f(c.Y3[(size_t)(1 + br) * MPAD * 512 + (size_t)row * 512 + hd * 128 + e]);
          const float z = bf2f(c.R1[(size_t)row * NPROJ + (br == 0 ? PZ : PMO) + hd * 128 + e]);
          const float gn = br == 0 ? c.in[26][L * 128 + e] : c.in[29][L * 512 + hd * 128 + e];
          const float w = y / (gn * (br == 0 ? silu_(z) : sigm(z))); ms += w * w; }
      ms *= (1.f / 128.f); e2 = (ms - 1.f) * (ms - 1.f); r2 = 1.f; }
    blk_reduce2(e2, r2, red, c.tid);
    if (c.tid == 0) *dgp = sqrtf(e2 / (r2 + 1e-30f));
}
DI void chk_res(const Ctx& c, int L, int mode, const float (&snap)[2], float* dgp) {
    float* red = (float*)c.lds; float e2 = 0.f, r2 = 0.f;
    for (int rep = 0; rep < 2; ++rep) { const int sidx = c.tid + 512 * rep;
        const int row = (rep == 1 && c.tid < 64) ? MP + (c.tid * 2) : (int)(((unsigned)sidx * 7919u) % (unsigned)MP); const int col = (int)(((unsigned)sidx * 104729u) % 1024u);
        const float now = c.out[(size_t)row * 1024 + col]; float before = snap[rep], want = 0.f;
        if (mode == 0) { before = row < MP ? c.in[0][(size_t)row * 1024 + col] : c.in[1][(size_t)(row - MP) * 1024 + col]; want = dot_bf(c.XN + (size_t)row * 1024, c.W + WO_OUT + (size_t)col * 1024, 1024); }
        if (mode == 1) want = dot_bf(c.R1 + (size_t)row * 4096, c.W + WO_DN + (size_t)col * 4096, 4096);
        if (mode == 2) want = bf2f(c.Y3[(size_t)MPAD * 256 + (size_t)row * 1024 + col]) * sigm(dot_bf(c.XN + (size_t)row * 1024, c.W + WO_PG + (size_t)col * 1024, 1024));
        e2 += (now - before - want) * (now - before - want); r2 += want * want; }
    blk_reduce2(e2, r2, red, c.tid);
    if (c.tid == 0) *dgp = sqrtf(e2 / (r2 + 1e-30f));
}
DI void snap_x(const Ctx& c, float (&snap)[2]) {
    for (int rep = 0; rep < 2; ++rep) { const int sidx = c.tid + 512 * rep;
        const int row = (rep == 1 && c.tid < 64) ? MP + (c.tid * 2) : (int)(((unsigned)sidx * 7919u) % (unsigned)MP); const int col = (int)(((unsigned)sidx * 104729u) % 1024u);
        snap[rep] = c.out[(size_t)row * 1024 + col]; }
}
DI void chk_sample(const Ctx& c, int L, int b, int h, float* dgp) {
    float* red = (float*)c.lds; float e2 = 0.f, r2 = 0.f, e3 = 0.f, r3 = 0.f;
    const size_t row = (size_t)(MP + b); const bf16_t* pr = c.R1 + row * NPROJ;
    if (c.tid < 128) { const int dv = c.tid;
        const float* cbuf = c.in[4] + ((size_t)L * MS + b) * 3 * 1536; const float* cw = c.in[23] + (size_t)L * 4 * 1536;
        float sq = 0.f, sk = 0.f;
        for (int d = 0; d < 128; ++d) for (int w = 0; w < 2; ++w) { const int cc = w * 512 + h * 128 + d;
            const float a = silu_(cbuf[cc] * cw[cc] + cbuf[1536 + cc] * cw[1536 + cc] + cbuf[3072 + cc] * cw[3072 + cc] + bf2f(pr[PQ + cc]) * cw[4608 + cc]); if (w == 0) sq += a * a; else sk += a * a; }
        const float fq = rsqrtf(sq + EPS) * 0.08838834764831845f, fk = rsqrtf(sk + EPS);
        const int cv = 1024 + h * 128 + dv;
        const float vv = silu_(cbuf[cv] * cw[cv] + cbuf[1536 + cv] * cw[1536 + cv] + cbuf[3072 + cv] * cw[3072 + cv] + bf2f(pr[PQ + cv]) * cw[4608 + cv]);
        const float beta = sigm(c.SG[row * 16 + h]), eg = expf(-expf(c.in[24][L * 4 + h]) * softplus_(c.SG[row * 16 + 4 + h] + c.in[25][L * 4 + h]));
        const float* S0 = c.in[5] + (((size_t)L * MS + b) * 4 + h) * 16384; const float* S1 = c.out + O_GDN_S + (((size_t)L * MS + b) * 4 + h) * 16384;
        float kS = 0.f, qS = 0.f, qk = 0.f;
        for (int d = 0; d < 128; ++d) { const int cq = h * 128 + d, ck = 512 + h * 128 + d;
            const float qd = silu_(cbuf[cq] * cw[cq] + cbuf[1536 + cq] * cw[1536 + cq] + cbuf[3072 + cq] * cw[3072 + cq] + bf2f(pr[PQ + cq]) * cw[4608 + cq]) * fq;
            const float kd = silu_(cbuf[ck] * cw[ck] + cbuf[1536 + ck] * cw[1536 + ck] + cbuf[3072 + ck] * cw[3072 + ck] + bf2f(pr[PQ + ck]) * cw[4608 + ck]) * fk;
            kS += kd * S0[d * 128 + dv]; qS += qd * S0[d * 128 + dv]; qk += qd * kd; }
        const float vnew = beta * (vv - eg * kS);
        for (int d = 0; d < 128; ++d) { const int ck = 512 + h * 128 + d;
            const float kd = silu_(cbuf[ck] * cw[ck] + cbuf[1536 + ck] * cw[1536 + ck] + cbuf[3072 + ck] * cw[3072 + ck] + bf2f(pr[PQ + ck]) * cw[4608 + ck]) * fk;
            const float want = S0[d * 128 + dv] * eg + kd * vnew, got = S1[d * 128 + dv]; e2 += (got - want) * (got - want); r2 += want * want; }
        (void)qS; (void)qk;
    } else if (c.tid < 256) { const int e = c.tid - 128;
        const size_t sidx = ((size_t)L * MS + b) * 4 + h;
        const float li = softcap_(c.SG[row * 16 + 8 + h] + c.in[27][L * 4 + h]), lf = logsig_(softcap_(c.SG[row * 16 + 12 + h] + c.in[28][L * 4 + h]));
        const float m0 = c.in[8][sidx], mt = fmaxf(lf + m0, li), wts = expf(li - mt), sc = expf(lf + m0 - mt);
        const float v = bf2f(pr[PMV + h * 128 + e]);
        for (int d = 0; d < 64; ++d) { const float k = bf2f(pr[PMK + h * 64 + d]) * 0.125f;
            const float want = sc * c.in[6][sidx * 8192 + d * 128 + e] + wts * k * v, got = c.out[O_MLC_S + sidx * 8192 + d * 128 + e]; e3 += (got - want) * (got - want); r3 += want * want; }
        if (e < 64) { const float k = bf2f(pr[PMK + h * 64 + e]) * 0.125f; const float want = sc * c.in[7][sidx * 64 + e] + wts * k, got = c.out[O_MLN_S + sidx * 64 + e]; e3 += 64.f * (got - want) * (got - want); r3 += 64.f * want * want; }
        if (e == 0) { const float got = c.out[O_MLM_S + sidx]; e3 += 4096.f * (got - mt) * (got - mt); r3 += 4096.f * mt * mt; }
    }
    blk_reduce2(e2, r2, red, c.tid);
    blk_reduce2(e3, r3, red, c.tid);
    if (c.tid == 0) { dgp[0] = sqrtf(e2 / (r2 + 1e-30f)); dgp[1] = sqrtf(e3 / (r3 + 1e-30f)); }
}
#endif
DI void phase_conv_state(const Ctx& c, int L) {
    for (int idx = c.bid * 512 + c.tid; idx < NB * 3 * 1536; idx += c.G * 512) { const int cc = idx % 1536, j = (idx / 1536) % 3, b = idx / (3 * 1536);
        c.out[O_CONV_P + ((size_t)L * NB + b) * 3 * 1536 + j * 1536 + cc] = bf2f(c.R1[(size_t)(b * SEQ + SEQ - 3 + j) * NPROJ + PQ + cc]); }
}
DI void phase_post(const Ctx& c, int L) {
    const int lane = c.lane, hd = lane >> 4, e0 = (lane & 15) * 8;
    bf16_t* yg = c.Y3 + (size_t)1 * MPAD * 512; bf16_t* ym = c.Y3 + (size_t)2 * MPAD * 512;
    const float* gg = c.in[26] + (size_t)L * 128 + e0; const float* gm = c.in[29] + (size_t)L * 512 + hd * 128 + e0;
    for (int row = c.bid * 8 + c.wave; row < MR; row += c.G * 8) {
        const bf16_t* pr = c.R1 + (size_t)row * NPROJ;
#pragma unroll
        for (int br = 0; br < 2; ++br) {
            bf16_t* yp = (br == 0 ? yg : ym) + (size_t)row * 512 + hd * 128 + e0;
            f32x8 o = unpack8(*(const bf16x8*)yp); const f32x8 z = unpack8(*(const bf16x8*)(pr + (br == 0 ? PZ : PMO) + hd * 128 + e0));
            float ss = 0.f;
#pragma unroll
            for (int e = 0; e < 8; ++e) ss += o[e] * o[e];
            ss += __shfl_xor(ss, 1); ss += __shfl_xor(ss, 2); ss += __shfl_xor(ss, 4); ss += __shfl_xor(ss, 8);
            const float rs = rsqrtf(ss * (1.f / 128.f) + EPS);
            const float* gp = br == 0 ? gg : gm;
#pragma unroll
            for (int e = 0; e < 8; ++e) o[e] = o[e] * rs * gp[e] * (br == 0 ? silu_(z[e]) : sigm(z[e]));
            *(bf16x8*)yp = pack8v(o);
        }
    }
}

DI void phase_cvt_ple(const Ctx& c, int L) {
    bf16_t* PB = c.Y3;
    for (size_t i = (size_t)c.bid * 512 + c.tid; i < (size_t)MR * 64; i += (size_t)c.G * 512) {
        const size_t row = i >> 6, c4 = (i & 63) * 4;
        const float* src = row < MP ? c.in[9] + ((size_t)L * MP + row) * 256 + c4 : c.in[10] + ((size_t)L * MS + (row - MP)) * 256 + c4;
        *(s16x4*)(PB + row * 256 + c4) = pack4v(*(const f32x4*)src); }
}
DI void phase_final_norm(const Ctx& c) {
    const float* gain = c.in[39];
    for (int row = c.bid * 8 + c.wave; row < MR; row += c.G * 8) {
        float* xp = c.out + (size_t)row * 1024; f32x4 x[4]; float ss = 0.f;
#pragma unroll
        for (int i = 0; i < 4; ++i) { x[i] = *(const f32x4*)(xp + c.lane * 4 + 256 * i); ss += x[i][0] * x[i][0] + x[i][1] * x[i][1] + x[i][2] * x[i][2] + x[i][3] * x[i][3]; }
        ss = wave_sum(ss); const float rs = rsqrtf(ss * (1.f / 1024.f) + EPS);
#pragma unroll
        for (int i = 0; i < 4; ++i) { const f32x4 g = *(const f32x4*)(gain + c.lane * 4 + 256 * i); *(f32x4*)(xp + c.lane * 4 + 256 * i) = x[i] * rs * g; }
    }
}

#define XB_TMO      128
#define XB_XCNT(j)  (256  + 64 * (j))
#define XB_XSUB(j)  (1280 + 64 * (j))
#define XB_XGEN(j)  (2304 + 64 * (j))
#define XB_TOP      3328
#define XB_TOPGEN   3392
#define XCD_BAR_WORDS 3456
#define XB_SPIN_CAP (1u << 18)

__device__ __forceinline__ unsigned xb_ld(unsigned* p)              { return __hip_atomic_load(p, __ATOMIC_RELAXED, __HIP_MEMORY_SCOPE_AGENT); }
__device__ __forceinline__ unsigned xb_add(unsigned* p, unsigned v) { return __hip_atomic_fetch_add(p, v, __ATOMIC_RELAXED, __HIP_MEMORY_SCOPE_AGENT); }
__device__ __forceinline__ unsigned xb_xcc_id() { return (unsigned)__builtin_amdgcn_s_getreg((3 << 11) | 20) & 0xFu; }
#define XB_SPIN(cond, bar) do { unsigned _sp = 0; while (cond) { __builtin_amdgcn_s_sleep(1); \
    if ((++_sp & 255u) == 0u) { if (xb_ld(&(bar)[XB_TMO])) break; if (_sp > XB_SPIN_CAP) { atomicAdd(&(bar)[XB_TMO], 1u); break; } } } } while (0)

struct XcdBarrier {
    unsigned* bar; unsigned x;
    volatile LAS unsigned* st;
};

__device__ __forceinline__ XcdBarrier xcd_barrier_post(unsigned* bar, volatile LAS unsigned* st) {
    XcdBarrier b; b.bar = bar; b.x = xb_xcc_id(); b.st = st;
    if (threadIdx.x == 0) (void)xb_add(&bar[XB_XCNT(b.x)], 1u);
    return b;
}
__device__ __forceinline__ void xcd_barrier_complete(unsigned* bar, unsigned x, unsigned& nloc, unsigned& nx) {
    const unsigned G = gridDim.x * gridDim.y * gridDim.z;
    unsigned sum, cnt, mine, sp = 0u;
    for (;;) {
        sum = 0u; cnt = 0u; mine = 0u;
#pragma unroll
        for (unsigned j = 0; j < 16; ++j) { const unsigned c = xb_ld(&bar[XB_XCNT(j)]); sum += c; cnt += (c > 0u) ? 1u : 0u; mine = (j == x) ? c : mine; }
        if (sum == G) break;
        __builtin_amdgcn_s_sleep(1);
        if ((++sp & 255u) == 0u) { if (xb_ld(&bar[XB_TMO])) break; if (sp > XB_SPIN_CAP) { atomicAdd(&bar[XB_TMO], 1u); break; } }
    }
    nloc = mine > 0u ? mine : 1u; nx = cnt > 0u ? cnt : 1u;
}

__device__ __forceinline__ void xcd_barrier(const XcdBarrier& b) {
    asm volatile("s_waitcnt vmcnt(0)" ::: "memory");
    __syncthreads();
    if (threadIdx.x == 0) {
        unsigned* bar = b.bar;
        __builtin_amdgcn_s_waitcnt(0);
        unsigned nloc = b.st[0], nx = b.st[1];
        if (nloc == 0u) { xcd_barrier_complete(bar, b.x, nloc, nx); b.st[0] = nloc; b.st[1] = nx; }
        const unsigned old = xb_add(&bar[XB_XSUB(b.x)], 1u);
        const unsigned gen = old / nloc;
        if (old + 1u == (gen + 1u) * nloc) {
            __builtin_amdgcn_fence(__ATOMIC_RELEASE, "agent");
            asm volatile("s_waitcnt vmcnt(0)" ::: "memory");
            const unsigned og = xb_add(&bar[XB_TOP], 1u);
            const unsigned tg = og / nx;
            if (og + 1u == (tg + 1u) * nx) xb_add(&bar[XB_TOPGEN], 1u);
            else XB_SPIN(xb_ld(&bar[XB_TOPGEN]) == tg, bar);
            __builtin_amdgcn_fence(__ATOMIC_ACQUIRE, "agent");
            xb_add(&bar[XB_XGEN(b.x)], 1u);
            asm volatile("s_waitcnt vmcnt(0)" ::: "memory");
        } else {
            XB_SPIN(xb_ld(&bar[XB_XGEN(b.x)]) == gen, bar);
            __builtin_amdgcn_fence(__ATOMIC_ACQUIRE, "agent");
            asm volatile("s_waitcnt vmcnt(0)" ::: "memory");
        }
    }
    __syncthreads();
}

__global__ void __launch_bounds__(512, 2) fwd_megakernel(KP kp) {
    extern __shared__ __attribute__((aligned(16))) unsigned char lds[];
    cg::grid_group grid = cg::this_grid();
    Ctx c; c.lds = lds; c.G = gridDim.x; c.bid = blockIdx.x;
    const ka_t ka0 = (ka_t)__builtin_amdgcn_kernarg_segment_ptr();
    (void)kp;
#define REFRESH() do { ka_t ka_ = ka0; asm volatile("" : "+s"(ka_)); int t_ = threadIdx.x; asm volatile("" : "+v"(t_)); \
        c.in.ka = ka_; c.out = (float*)(gfloat_t*)ka_[40]; unsigned char* w_ = (unsigned char*)(guchar_t*)ka_[41]; c.ws = w_; \
        c.R1 = (bf16_t*)(w_ + WS_R1); c.XN = (bf16_t*)(w_ + WS_XN); c.Y3 = (bf16_t*)(w_ + WS_Y3); c.W = (bf16_t*)(w_ + WS_W); c.YS5 = (bf16_t*)(w_ + WS_YS5); \
        c.GS = w_ + WS_GS; c.SG = (float*)(w_ + WS_SG); c.GL = (float*)(w_ + WS_GL); \
        c.tid = t_; c.lane = t_ & 63; c.wave = __builtin_amdgcn_readfirstlane(t_ >> 6); \
        int b_ = blockIdx.x, g_ = gridDim.x; asm volatile("" : "+s"(b_), "+s"(g_)); c.bid = b_; c.G = g_; } while (0)
    REFRESH();
    volatile LAS unsigned* bst = (volatile LAS unsigned*)(lds + LDS_BYTES - 16);
    if (c.tid < 4) bst[c.tid] = 0u;
    if (c.tid < 16) ((volatile LAS int*)(lds + S5Q_FLAG))[c.tid] = 0;
    __syncthreads();
    XcdBarrier xbar = xcd_barrier_post((unsigned*)(c.ws + WS_BAR), bst);
    int nsync_ = 0;
#ifndef PHMASK
#define PHMASK 0xFFFFFFFFu
#endif
#define PH(n) if (PHMASK & (1 << (n)))
#ifdef DUP_SYNC
#define GSYNC() do { grid.sync(); grid.sync(); } while (0)
#else
#define GSYNC() do { if (nsync_++ == 0) grid.sync(); else xcd_barrier(xbar); } while (0)
#endif
    for (int L = 0; L < 2; ++L) {
        REFRESH(); PH(0) phase_weights(c, L);
        REFRESH(); PH(1) phase_rmsnorm<0>(c, L);
        GSYNC();
        REFRESH(); PH(2) run_gemm(c, c.XN, c.W + WO_IN, NPROJ, 1024, FStore{c.R1, NPROJ});
#ifdef DUP_GEMM
        REFRESH(); PH(2) run_gemm(c, c.XN, c.W + WO_IN, NPROJ, 1024, FStore{c.R1, NPROJ});
#endif
        GSYNC();
#ifdef DUP_MIX
        for (int rep_ = 0; rep_ < 2; ++rep_) {
#else
        {
#endif
        REFRESH(); phase_conv_state(c, L);
        REFRESH(); for (int it = c.bid * 8 + c.wave; it < 1024; it += c.G * 8) task_ml_gates(c, L, it);
        REFRESH(); PH(3) phase_gdn_prep(c, L);
#ifdef DUP_PREP
        REFRESH(); PH(3) phase_gdn_prep(c, L);
#endif
#ifdef DUP_S5
#endif
        GSYNC();
#ifdef DUP_P4
        for (int rep4_ = 0; rep4_ < 2; ++rep4_) {
#else
        {
#endif
        if (c.wave == 0) {
            for (int u = c.bid; u < 256; u += c.G) { REFRESH(); if (u < 128) { PH(5) task_gdn_seq(c, L, u);
#ifdef DUP_GSEQ
                REFRESH(); task_gdn_seq(c, L, u);
#endif
              } else { PH(6) task_ml_seq(c, L, u - 128, (float*)lds);
#ifdef DUP_MSEQ
                REFRESH(); task_ml_seq(c, L, u - 128, (float*)lds);
#endif
              } }
        } else if (c.wave <= 4) {
            int it_ = 0;
            for (int u = c.bid; u < 256; u += c.G, ++it_) { REFRESH(); PH(4) task_s5_quad(c, L, u, c.wave - 1, L * 16 + it_ + 1); }
        } else {
            const int wid = c.bid * 3 + (c.wave - 5), nw = c.G * 3;
            REFRESH(); PH(7) for (int u = wid; u < 1024; u += nw) task_gdn_sample(c, L, u);
            REFRESH(); PH(8) for (int u = wid; u < 1024; u += nw) task_ml_sample(c, L, u);
            REFRESH(); PH(9) for (int u = wid; u < 4096; u += nw) task_s5_sample(c, L, u);
        }
        GSYNC();
        }
        }
#ifdef SELFCHK
        if (L == SELFCHK_L) { REFRESH(); if (c.bid == 0) { float* dg = (float*)(c.ws + WS_GL) + 1024; chk_gdn(c, L, 1, 2, dg); chk_ml(c, L, 1, 2, dg); chk_s5(c, L, 1, 7, dg); chk_gemm(c, L, 0, dg + 6); if (L == 0) chk_sg(c, dg + 12); chk_sample(c, L, 5, 1, dg + 17); } grid.sync(); }
#endif
        REFRESH(); PH(10) phase_post(c, L);
        REFRESH(); PH(11) run_gemm(c, c.XN, c.W + WO_G, NGATE, 1024, FSig{c.R1, NPROJ});
#ifdef DUP_GEMM
        REFRESH(); PH(11) run_gemm(c, c.XN, c.W + WO_G, NGATE, 1024, FSig{c.R1, NPROJ});
#endif
        REFRESH(); PH(12) run_gemm(c, c.YS5, c.W + WO_GLU, 512, 512, FGlu{c.YS5, c.in[22] + (size_t)L * 512, c.Y3});
#ifdef DUP_GEMM
        REFRESH(); PH(12) run_gemm(c, c.YS5, c.W + WO_GLU, 512, 512, FGlu{c.YS5, c.in[22] + (size_t)L * 512, c.Y3});
#endif
        GSYNC();
#ifdef SELFCHK
        if (L == SELFCHK_L) { REFRESH(); if (c.bid == 0) { float* dg = (float*)(c.ws + WS_GL) + 1024; chk_gemm(c, L, 1, dg + 7); chk_gemm(c, L, 2, dg + 8); chk_post(c, L, dg + 13); } grid.sync(); }
#endif
        REFRESH(); PH(13) for (int br = 0; br < 3; ++br)
            run_gemm(c, c.Y3 + (size_t)br * MPAD * 512, c.W + WO_BR + (size_t)br * 1024 * 512, 1024, 512, FBranch{c.R1 + br * 1024, c.XN, br == 0 ? 1 : 0});
#ifdef DUP_GEMM
        REFRESH(); PH(13) for (int br = 0; br < 3; ++br)
            run_gemm(c, c.Y3 + (size_t)br * MPAD * 512, c.W + WO_BR + (size_t)br * 1024 * 512, 1024, 512, FBranch{c.R1 + br * 1024, c.XN, br == 0 ? 1 : 0});
#endif
        GSYNC();
#ifdef SELFCHK
        if (L == SELFCHK_L) { REFRESH(); if (c.bid == 0) { float* dg = (float*)(c.ws + WS_GL) + 1024; chk_gemm(c, L, 3, dg + 9); } grid.sync(); }
#endif
        REFRESH(); PH(14) run_gemm(c, c.XN, c.W + WO_OUT, 1024, 1024, FRes{c.out});
        GSYNC();
#ifdef SELFCHK
        if (L == 0 && SELFCHK_L == 0) { REFRESH(); if (c.bid == 0) { float* dg = (float*)(c.ws + WS_GL) + 1024; float sn[2] = {0.f, 0.f}; chk_res(c, L, 0, sn, dg + 14); } grid.sync(); }
#endif
        REFRESH(); PH(15) phase_rmsnorm<1>(c, L);
        REFRESH(); PH(18) phase_cvt_ple(c, L);
        GSYNC();
        REFRESH(); PH(16) run_gemm(c, c.XN, c.W + WO_UP, DFF, 1024, FRelu2{c.R1});
#ifdef DUP_GEMM
        REFRESH(); PH(16) run_gemm(c, c.XN, c.W + WO_UP, DFF, 1024, FRelu2{c.R1});
#endif
        GSYNC();
#ifdef SELFCHK
        if (L == SELFCHK_L) { REFRESH(); if (c.bid == 0) { float* dg = (float*)(c.ws + WS_GL) + 1024; chk_gemm(c, L, 4, dg + 10); } grid.sync(); }
#endif
#ifdef SELFCHK
        float snp[2] = {0.f, 0.f}; REFRESH(); if (L == SELFCHK_L && c.bid == 0) snap_x(c, snp);
#endif
        REFRESH(); PH(17) run_gemm(c, c.R1, c.W + WO_DN, 1024, 4096, FResB{c.out, c.XN});
        GSYNC();
#ifdef SELFCHK
        if (L == SELFCHK_L) { REFRESH(); if (c.bid == 0) { float* dg = (float*)(c.ws + WS_GL) + 1024; chk_res(c, L, 1, snp, dg + 15); } grid.sync(); }
#endif
#ifdef SELFCHK
        REFRESH(); if (L == SELFCHK_L && c.bid == 0) snap_x(c, snp);
#endif
        REFRESH(); PH(19) run_gemm(c, c.Y3, c.W + WO_PLE, 1024, 256, FStore{c.Y3 + (size_t)MPAD * 256, 1024});
#ifdef DUP_GEMM
        REFRESH(); PH(19) run_gemm(c, c.Y3, c.W + WO_PLE, 1024, 256, FStore{c.Y3 + (size_t)MPAD * 256, 1024});
#endif
        REFRESH(); PH(20) run_gemm(c, c.XN, c.W + WO_PG, 1024, 1024, FPle{c.Y3 + (size_t)MPAD * 256, c.out});
        GSYNC();
#ifdef SELFCHK
        if (L == SELFCHK_L) { REFRESH(); if (c.bid == 0) { float* dg = (float*)(c.ws + WS_GL) + 1024; chk_gemm(c, L, 5, dg + 11); chk_res(c, L, 2, snp, dg + 16); } grid.sync(); }
#endif
    }
    REFRESH(); phase_final_norm(c);
#ifdef SELFCHK
    grid.sync(); REFRESH();
    if (c.bid == 0 && c.tid == 0) { const float* dg = (const float*)(c.ws + WS_GL) + 1024; int kk = -1; float dv = 0.f;
        for (int i = 18; i >= 0; --i) if (dg[i] > SELFCHK_THR) { kk = i; dv = dg[i]; }
        if (kk >= 0) c.out[0] = __powf(10.f, (float)(2 * kk + 4)) * (1.f + fminf(dv, 8.f)); }
#endif
}

extern "C" void kernel_launch(void* const* d_in, const int* in_sizes, int n_in, void* d_out, int out_size, void* d_ws, size_t ws_size, hipStream_t stream) {
    static int grid = 0;
    if (grid == 0) {
        int dev = 0, cus = 0, per_cu = 0;
        if (hipGetDevice(&dev) != hipSuccess || hipDeviceGetAttribute(&cus, hipDeviceAttributeMultiprocessorCount, dev) != hipSuccess) { fprintf(stderr, "kernel_launch: device query failed\n"); grid = -1; return; }
        if (hipFuncSetAttribute((const void*)fwd_megakernel, hipFuncAttributeMaxDynamicSharedMemorySize, LDS_BYTES) != hipSuccess) { fprintf(stderr, "kernel_launch: hipFuncSetAttribute failed\n"); grid = -1; return; }
        if (hipOccupancyMaxActiveBlocksPerMultiprocessor(&per_cu, (const void*)fwd_megakernel, 512, LDS_BYTES) != hipSuccess || per_cu < 1) { fprintf(stderr, "kernel_launch: occupancy query says %d blocks per CU\n", per_cu); grid = -1; return; }
        grid = cus;
        if (grid > 256) grid = 256;
    }
    if (grid < 0) return;
    if (n_in != 40 || (size_t)out_size != O_TOTAL || ws_size < WS_END) { fprintf(stderr, "kernel_launch: unexpected sizes n_in %d out %d ws %zu (need %zu)\n", n_in, out_size, ws_size, (size_t)WS_END); return; }
    if (hipMemsetAsync((char*)d_ws + WS_BAR, 0, SZ_BAR, stream) != hipSuccess) { fprintf(stderr, "kernel_launch: memset failed\n"); return; }
    KP kp{};
    for (int i = 0; i < 40; ++i) kp.in[i] = (const float*)d_in[i];
    kp.out = (float*)d_out; kp.ws = (unsigned char*)d_ws;
    void* args[] = {&kp};
    hipError_t e = hipLaunchCooperativeKernel((const void*)fwd_megakernel, dim3(grid), dim3(512), args, LDS_BYTES, stream);
    if (e != hipSuccess) fprintf(stderr, "kernel_launch: cooperative launch failed: %s (grid %d)\n", hipGetErrorString(e), grid);
}
```

```cpp
#include <hip/hip_runtime.h>
#include <hip/hip_cooperative_groups.h>
#include <cstdio>
namespace cg = cooperative_groups;
namespace pg8 {
#define PG8_LAS __attribute__((address_space(3)))
typedef unsigned short bf16_t;
typedef short bf16x8 __attribute__((ext_vector_type(8)));
typedef float f32x4 __attribute__((ext_vector_type(4)));
typedef unsigned u32x4 __attribute__((ext_vector_type(4)));
constexpr int BM = 256, BK = 64, HALF = 128, HTB = HALF * BK * 2  , STAGE_BYTES = 8 * HTB, NXCD = 8, WGM = 8;

__host__ __device__ __forceinline__ int lds_byte(int r, int c) { const int st = (r >> 4) * 2 + (c >> 5), rr = r & 15, cc = c & 31, ob = rr * 64 + cc * 2; return st * 1024 + (ob ^ (((ob >> 9) & 1) << 5)); }
__host__ __device__ __forceinline__ void stage_rc(int b, int& R, int& C) { const int st = b / 1024, sb = b % 1024, swz = sb ^ (((sb >> 9) & 1) << 5); R = (st >> 1) * 16 + swz / 64; C = (st & 1) * 32 + (swz % 64) / 2; }
__host__ __device__ __forceinline__ int perm32(int rho) { const int n = rho >> 4, i = rho & 15; return 8 * (i >> 2) + 4 * n + (i & 3); }

struct Unit { int pm, pn; };
struct Gemm { const bf16_t* A; const bf16_t* Bt; int M, N, K; };

struct StaticOrder {
    int nM, nN, nwg, G, c;
    __host__ __device__ void init(int M, int N, int G_, int c_) { nM = M / BM; nN = N / BM; nwg = nM * nN; G = G_; c = c_; }
    __host__ __device__ bool next(int i, Unit& u) const {
        const long L = (long)i * G + c; if (L >= nwg) return false;
        int wgid = (int)L; { const int q = nwg / NXCD, r = nwg % NXCD, xcd = wgid % NXCD, off = wgid / NXCD; wgid = (xcd < r ? xcd * (q + 1) : r * (q + 1) + (xcd - r) * q) + off; }
        const int nig = WGM * nN, gid = wgid / nig, fm = gid * WGM, gsz = (nM - fm) < WGM ? (nM - fm) : WGM;
        u.pm = fm + ((wgid % nig) % gsz); u.pn = (wgid % nig) / gsz; return true;
    }
    __device__ __forceinline__ void a_ready(const Unit&) const {}
    __device__ __forceinline__ void done(const Unit&) const {}
};

template <class Epi, class Sched, bool STAMP = false>
__device__ __forceinline__ void gemm_phase(PG8_LAS unsigned char* lds, const Gemm g, const Sched& S, const Epi& E, unsigned long long* stamps) {
    int tid_ = threadIdx.x; asm volatile("" : "+v"(tid_));
    const int tid = tid_, wid = __builtin_amdgcn_readfirstlane(tid >> 6), lane = tid & 63, wr = wid >> 2, wc = wid & 3, fr = lane & 15, fq = lane >> 4;
    const int K = g.K, nt = K / BK;
    unsigned voffA[2], voffB[2];
#pragma unroll
    for (int i = 0; i < 2; ++i) { int R, C; stage_rc(tid * 16 + i * 8192, R, C); const int Rb = Epi::PERM ? ((R & ~31) + perm32(R & 31)) : R;
        voffA[i] = (unsigned)(R * K + C) * 2u; voffB[i] = (unsigned)(Rb * K + C) * 2u; }
    const size_t kstep = (size_t)(BK * 2);
    const size_t hstep = (size_t)HALF * K * 2;
    const size_t tstep = 2 * hstep;
    const unsigned ldsw = (unsigned)wid * 1024u;
    const int aoff = lds_byte(wr * 64 + fr, fq * 8), boff = lds_byte(wc * 32 + fr, fq * 8);
#define PG8_SA(b, h) (((b) * 2 + (h)) * HTB)
#define PG8_SB(b, h) ((4 + (b) * 2 + (h)) * HTB)
#define PG8_STAGE(bufoff, gbase, voff) do { _Pragma("unroll") for (int _i = 0; _i < 2; ++_i) \
        __builtin_amdgcn_global_load_lds((const unsigned*)((const char*)(gbase) + (voff)[_i]), (PG8_LAS unsigned*)(lds + (bufoff) + ldsw + _i * 8192), 16, 0, 0); } while (0)
#define PG8_LDA(dst, b, h) do { _Pragma("unroll") for (int m = 0; m < 4; ++m) _Pragma("unroll") for (int k = 0; k < 2; ++k) dst[m][k] = *(const PG8_LAS bf16x8*)(lds + PG8_SA(b, h) + aoff + m * 2048 + k * 1024); } while (0)
#define PG8_LDB(dst, b, h) do { _Pragma("unroll") for (int n = 0; n < 2; ++n) _Pragma("unroll") for (int k = 0; k < 2; ++k) dst[n][k] = *(const PG8_LAS bf16x8*)(lds + PG8_SB(b, h) + boff + n * 2048 + k * 1024); } while (0)
#define PG8_MMA(ai, bj, At, Bt) do { __builtin_amdgcn_s_setprio(1); _Pragma("unroll") for (int m = 0; m < 4; ++m) _Pragma("unroll") for (int n = 0; n < 2; ++n) _Pragma("unroll") for (int k = 0; k < 2; ++k) \
        acc[ai][bj][m][n] = __builtin_amdgcn_mfma_f32_16x16x32_bf16(Bt[n][k], At[m][k], acc[ai][bj][m][n], 0, 0, 0); __builtin_amdgcn_s_setprio(0); } while (0)
#define PG8_WAIT_V(n) asm volatile("s_waitcnt vmcnt(" #n ")" ::: "memory")
#define PG8_WAIT_L(n) asm volatile("s_waitcnt lgkmcnt(" #n ")" ::: "memory")
#define PG8_BAR __builtin_amdgcn_s_barrier()
#define PG8_SCHED __builtin_amdgcn_sched_barrier(0)
    Unit cur, nxt; int ui = 0;
    if (!S.next(0, cur)) return;
    f32x4 acc[2][2][4][2];
#pragma unroll
    for (int a = 0; a < 2; ++a)
#pragma unroll
        for (int b = 0; b < 2; ++b)
#pragma unroll
            for (int m = 0; m < 4; ++m)
#pragma unroll
                for (int n = 0; n < 2; ++n) acc[a][b][m][n] = (f32x4){0.f, 0.f, 0.f, 0.f};
    bf16x8 At[4][2], B0[2][2], B1[2][2];
    const char* cA = (const char*)g.A + (size_t)cur.pm * tstep; const char* cB = (const char*)g.Bt + (size_t)cur.pn * tstep;
    S.a_ready(cur);
    PG8_STAGE(PG8_SB(0, 0), cB, voffB); PG8_STAGE(PG8_SA(0, 0), cA, voffA); PG8_STAGE(PG8_SB(0, 1), cB + hstep, voffB); PG8_STAGE(PG8_SA(0, 1), cA + hstep, voffA);
    if (wr == 1) PG8_BAR;
    PG8_WAIT_V(4); PG8_BAR;
    PG8_STAGE(PG8_SB(1, 0), cB + kstep, voffB); PG8_STAGE(PG8_SA(1, 0), cA + kstep, voffA); PG8_STAGE(PG8_SB(1, 1), cB + hstep + kstep, voffB);
    PG8_WAIT_V(6); PG8_BAR;
    for (;;) {
        const bool has_next = S.next(ui + 1, nxt);
        const char* nA = has_next ? (const char*)g.A + (size_t)nxt.pm * tstep : cA; const char* nB = has_next ? (const char*)g.Bt + (size_t)nxt.pn * tstep : cB;
        for (int t = 0; t < nt; t += 2) {
            const bool last = (t == nt - 2);
            const char* a1 = cA + (size_t)(t + 1) * kstep;
            const char* a2 = last ? nA : cA + (size_t)(t + 2) * kstep; const char* b2 = last ? nB : cB + (size_t)(t + 2) * kstep;
            const char* a3 = a2 + kstep; const char* b3 = b2 + kstep;
            if (last && has_next) S.a_ready(nxt);
            PG8_LDB(B0, 0, 0); PG8_SCHED; PG8_LDA(At, 0, 0); PG8_STAGE(PG8_SA(1, 1), a1 + hstep, voffA);
            PG8_WAIT_L(8); PG8_BAR; PG8_WAIT_L(0); PG8_MMA(0, 0, At, B0); PG8_BAR; PG8_SCHED;
            PG8_LDB(B1, 0, 1); PG8_STAGE(PG8_SB(0, 0), b2, voffB);
            PG8_BAR; PG8_WAIT_L(0); PG8_MMA(0, 1, At, B1); PG8_BAR;
            PG8_LDA(At, 0, 1); PG8_STAGE(PG8_SA(0, 0), a2, voffA);
            PG8_BAR; PG8_WAIT_L(0); PG8_MMA(1, 0, At, B0); PG8_BAR; PG8_SCHED;
            PG8_STAGE(PG8_SB(0, 1), b2 + hstep, voffB);
            PG8_WAIT_V(6); PG8_BAR; PG8_MMA(1, 1, At, B1); PG8_BAR;
            PG8_LDB(B0, 1, 0); PG8_SCHED; PG8_LDA(At, 1, 0); PG8_STAGE(PG8_SA(0, 1), a2 + hstep, voffA);
            PG8_WAIT_L(8); PG8_BAR; PG8_WAIT_L(0); PG8_MMA(0, 0, At, B0); PG8_BAR; PG8_SCHED;
            PG8_LDB(B1, 1, 1); PG8_STAGE(PG8_SB(1, 0), b3, voffB);
            PG8_BAR; PG8_WAIT_L(0); PG8_MMA(0, 1, At, B1); PG8_BAR;
            PG8_LDA(At, 1, 1); PG8_STAGE(PG8_SA(1, 0), a3, voffA);
            PG8_BAR; PG8_WAIT_L(0); PG8_MMA(1, 0, At, B0); PG8_BAR; PG8_SCHED;
            PG8_STAGE(PG8_SB(1, 1), b3 + hstep, voffB);
            PG8_WAIT_V(6); PG8_BAR; PG8_MMA(1, 1, At, B1); PG8_BAR;
        }
        if constexpr (!Epi::AFTER_DRAIN) { E(acc, cur, wr, wc, fr, fq); S.done(cur); }
        if (!has_next) break;
#pragma unroll
        for (int a = 0; a < 2; ++a)
#pragma unroll
            for (int b = 0; b < 2; ++b)
#pragma unroll
                for (int m = 0; m < 4; ++m)
#pragma unroll
                    for (int n = 0; n < 2; ++n) acc[a][b][m][n] = (f32x4){0.f, 0.f, 0.f, 0.f};
        cur = nxt; cA = nA; cB = nB; ++ui;
    }
    PG8_WAIT_V(0);
    if (wr == 0) PG8_BAR;
    PG8_BAR;
    if constexpr (Epi::AFTER_DRAIN) { E.fused(acc, cur, wr, wc, fr, fq, lds, wid, lane); S.done(cur); }
#undef PG8_SA
#undef PG8_SB
#undef PG8_STAGE
#undef PG8_LDA
#undef PG8_LDB
#undef PG8_MMA
#undef PG8_WAIT_V
#undef PG8_WAIT_L
#undef PG8_BAR
#undef PG8_SCHED
}
}

#include <cstdio>
#include <ctime>
#include <cstdlib>
#include <cstring>
#include <cmath>
#include <vector>
#include <algorithm>
#define CK(x) do { hipError_t e_ = (x); if (e_ != hipSuccess) { fprintf(stderr, "HIP %s:%d %s\n", __FILE__, __LINE__, hipGetErrorString(e_)); exit(2); } } while (0)

#define DI __device__ __forceinline__
#define LAS __attribute__((address_space(3)))
typedef unsigned short bf16_t;
typedef short bf16x8 __attribute__((ext_vector_type(8)));
typedef short s16x4 __attribute__((ext_vector_type(4)));
typedef __bf16 bfv8 __attribute__((ext_vector_type(8)));
typedef __bf16 bfv4 __attribute__((ext_vector_type(4)));
typedef float f32x2 __attribute__((ext_vector_type(2)));
typedef float f32x4 __attribute__((ext_vector_type(4)));
typedef float f32x8 __attribute__((ext_vector_type(8)));
typedef float f32x16 __attribute__((ext_vector_type(16)));
typedef unsigned u32x4 __attribute__((ext_vector_type(4)));
typedef unsigned u32x2 __attribute__((ext_vector_type(2)));

constexpr int MP = 16384, MS = 128, MR = MP + MS, MPAD = 16640, DM = 1024, SEQ = 2048, NB = 8;
constexpr int NPROJ = 4096, NGATE = 3072, DFF = 4096, DIN = 7184;
constexpr int PU = 0, PQ = 512, PK = 1024, PV = 1536, PMQ = 2048, PMK = 2304, PMV = 2560, PZ = 3072, PMO = 3584;
constexpr float EPS = 1e-6f;
constexpr size_t O_S5RE_P = 16908288, O_S5RE_S = 16941056, O_S5IM_P = 17465344, O_S5IM_S = 17498112, O_CONV_P = 18022400, O_CONV_S = 18096128,
                 O_GDN_P = 19275776, O_GDN_S = 20324352, O_MLC_P = 37101568, O_MLC_S = 37625856, O_MLN_P = 46014464, O_MLN_S = 46018560,
                 O_MLM_P = 46084096, O_MLM_S = 46084160, O_TOTAL = 46085184;
constexpr size_t WS_R1 = 0, SZ_R1 = (size_t)MPAD * 4096 * 2;
constexpr size_t WS_XN = WS_R1 + SZ_R1, SZ_XN = (size_t)MPAD * 1024 * 2;
constexpr size_t WS_Y3 = WS_XN + SZ_XN, SZ_Y3 = (size_t)3 * MPAD * 512 * 2;
constexpr size_t WS_YS5 = WS_Y3 + SZ_Y3, SZ_YS5 = (size_t)MPAD * 512 * 2;
constexpr size_t WS_W = WS_YS5 + SZ_YS5;
constexpr size_t WO_IN = 0, WO_G = WO_IN + (size_t)4096 * 1024, WO_GLU = WO_G + (size_t)3072 * 1024, WO_BR = WO_GLU + (size_t)512 * 512,
                 WO_OUT = WO_BR + (size_t)3 * 1024 * 512, WO_UP = WO_OUT + (size_t)1024 * 1024, WO_DN = WO_UP + (size_t)4096 * 1024,
                 WO_PLE = WO_DN + (size_t)1024 * 4096, WO_PG = WO_PLE + (size_t)1024 * 256, WO_END = WO_PG + (size_t)1024 * 1024;
constexpr size_t SZ_W = WO_END * 2;
constexpr size_t WS_GS = WS_W + SZ_W;
constexpr int GI_U = 0, GI_W = 16384, GI_Q = 32768, GI_K = 49152, GI_A = 65536, GI_BYTES = 73728;
constexpr size_t SZ_GS = (size_t)1024 * GI_BYTES;
constexpr size_t WS_SG = WS_GS + SZ_GS, SZ_SG = (size_t)MR * 16 * 4;
constexpr size_t WS_GL = WS_SG + SZ_SG, SZ_GL = 8192;
constexpr size_t WS_MG = WS_GL + SZ_GL, SZ_MG = (size_t)1024 * 3 * 64 * 4;
constexpr size_t WS_BAR = WS_MG + SZ_MG, SZ_BAR = 16384;
constexpr size_t WS_END = WS_BAR + SZ_BAR;
constexpr int LDS_BYTES = 122880 + 32768 + 2048 + 64 + 64;

struct KP { const float* in[40]; float* out; unsigned char* ws; };

DI float bf2f(bf16_t b) { return __uint_as_float(((unsigned)b) << 16); }
DI bf16_t f2bf(float f) { __bf16 b = (__bf16)f; return __builtin_bit_cast(bf16_t, b); }
DI bf16x8 pack8v(f32x8 v) { bfv8 b = __builtin_convertvector(v, bfv8); return __builtin_bit_cast(bf16x8, b); }
DI s16x4 pack4v(f32x4 v) { bfv4 b = __builtin_convertvector(v, bfv4); return __builtin_bit_cast(s16x4, b); }
DI bf16x8 pack16(const f32x16& x, int s) { f32x8 v;
#pragma unroll
    for (int j = 0; j < 8; ++j) v[j] = x[8 * s + j];
    return pack8v(v); }
DI float lo16(unsigned u) { return __uint_as_float(u << 16); }
DI float hi16(unsigned u) { return __uint_as_float(u & 0xffff0000u); }
DI f32x8 unpack8(bf16x8 b) { u32x4 u = __builtin_bit_cast(u32x4, b); f32x8 r;
#pragma unroll
    for (int i = 0; i < 4; ++i) { r[2 * i] = lo16(u[i]); r[2 * i + 1] = hi16(u[i]); }
    return r; }
DI float sigm(float x) { return __builtin_amdgcn_rcpf(1.f + __expf(-x)); }
DI float tanh_(float z) { return 1.f - 2.f * __builtin_amdgcn_rcpf(__expf(2.f * z) + 1.f); }
DI float gelu_t(float x) { return 0.5f * x * (1.f + tanh_(0.7978845608028654f * (x + 0.044715f * x * x * x))); }
DI float silu_(float x) { return x * sigm(x); }
DI float softplus_(float x) { return x > 20.f ? x : log1pf(expf(x)); }
DI float logsig_(float x) { return x >= 0.f ? -log1pf(expf(-x)) : x - log1pf(expf(x)); }
DI float softcap_(float x) { return 15.f * tanh_(x * (1.f / 15.f)); }
DI float wave_sum(float v) {
#pragma unroll
    for (int o = 32; o; o >>= 1) v += __shfl_xor(v, o);
    return v; }
DI float wave_incl_sum(float v, int lane) {
#pragma unroll
    for (int o = 1; o < 64; o <<= 1) { float t = __shfl_up(v, o); if (lane >= o) v += t; }
    return v; }
DI float wave_incl_max(float v, int lane) {
#pragma unroll
    for (int o = 1; o < 64; o <<= 1) { float t = __shfl_up(v, o); if (lane >= o) v = fmaxf(v, t); }
    return v; }
DI void butterfly16(float (&a)[16], int lane) {
#pragma unroll
    for (int i = 0; i < 8; ++i) { const bool up = (lane & 32) != 0; const float send = up ? a[i] : a[i + 8], keep = up ? a[i + 8] : a[i]; a[i] = keep + __shfl_xor(send, 32); }
#pragma unroll
    for (int i = 0; i < 4; ++i) { const bool up = (lane & 16) != 0; const float send = up ? a[i] : a[i + 4], keep = up ? a[i + 4] : a[i]; a[i] = keep + __shfl_xor(send, 16); }
#pragma unroll
    for (int i = 0; i < 2; ++i) { const bool up = (lane & 8) != 0; const float send = up ? a[i] : a[i + 2], keep = up ? a[i + 2] : a[i]; a[i] = keep + __shfl_xor(send, 8); }
    { const bool up = (lane & 4) != 0; const float send = up ? a[0] : a[1], keep = up ? a[1] : a[0]; a[0] = keep + __shfl_xor(send, 4); }
    a[0] += __shfl_xor(a[0], 2); a[0] += __shfl_xor(a[0], 1);
}
DI int bsel16(int lane) { return ((lane >> 5) & 1) * 8 + ((lane >> 4) & 1) * 4 + ((lane >> 3) & 1) * 2 + ((lane >> 2) & 1); }
DI int crow(int reg, int h) { return (reg & 3) + 8 * (reg >> 2) + 4 * h; }
DI int perm16(int k) { return (k & ~12) | ((k & 4) << 1) | ((k & 8) >> 1); }
#define MFMA32(a, b, c) __builtin_amdgcn_mfma_f32_32x32x16_bf16((a), (b), (c), 0, 0, 0)
#define MFMA16(a, b, c) __builtin_amdgcn_mfma_f32_16x16x32_bf16((a), (b), (c), 0, 0, 0)
#define WAVE_FENCE() do { asm volatile("s_waitcnt lgkmcnt(0)" ::: "memory"); __builtin_amdgcn_wave_barrier(); asm volatile("" ::: "memory"); } while (0)

typedef __attribute__((address_space(4))) const unsigned long long* ka_t;
typedef __attribute__((address_space(1))) float gfloat_t; typedef __attribute__((address_space(1))) unsigned char guchar_t;
struct InTab { ka_t ka; DI const float* operator[](int i) const { return (const float*)(const gfloat_t*)ka[i]; } };
struct Ctx {
    InTab in; float* out; unsigned char* ws; unsigned char* lds;
    bf16_t *R1, *XN, *Y3, *W, *YS5; unsigned char* GS; float *SG, *GL;
    int tid, lane, wave, G, bid;
};

template <class F> struct Epi8 {
    static constexpr bool PERM = true, AFTER_DRAIN = false;
    F f;
    DI void operator()(const f32x4 (&acc)[2][2][4][2], const pg8::Unit& u, int wr, int wc, int fr, int fq) const {
        const int row0 = u.pm * 256 + wr * 64 + fr, col0 = u.pn * 256 + wc * 32 + 8 * fq;
#pragma unroll
        for (int ai = 0; ai < 2; ++ai)
#pragma unroll
            for (int m = 0; m < 4; ++m)
#pragma unroll
                for (int bj = 0; bj < 2; ++bj) f(row0 + ai * 128 + m * 16, col0 + bj * 128, acc[ai][bj][m][0], acc[ai][bj][m][1]);
    }
};
DI f32x8 cat8(f32x4 a, f32x4 b) { f32x8 r; r[0] = a[0]; r[1] = a[1]; r[2] = a[2]; r[3] = a[3]; r[4] = b[0]; r[5] = b[1]; r[6] = b[2]; r[7] = b[3]; return r; }
struct FStore { bf16_t* dst; int ld;
    DI void s(int row, int col, float v) const { dst[(size_t)row * ld + col] = f2bf(v); }
    DI void operator()(int row, int col, f32x4 a, f32x4 b) const { *(bf16x8*)(dst + (size_t)row * ld + col) = pack8v(cat8(a, b)); } };
struct FSig { bf16_t* dst; int ld;
    DI void s(int row, int col, float v) const { dst[(size_t)row * ld + col] = f2bf(sigm(v)); }
    DI void operator()(int row, int col, f32x4 a, f32x4 b) const { f32x8 v = cat8(a, b);
#pragma unroll
        for (int i = 0; i < 8; ++i) v[i] = sigm(v[i]);
        *(bf16x8*)(dst + (size_t)row * ld + col) = pack8v(v); } };
struct FGlu { const bf16_t* y; const float* bias; bf16_t* dst;
    DI void s(int row, int col, float v) const { dst[(size_t)row * 512 + col] = f2bf(bf2f(y[(size_t)row * 512 + col]) * sigm(v + bias[col])); }
    DI void operator()(int row, int col, f32x4 a, f32x4 b) const { f32x8 v = cat8(a, b); f32x8 yv = unpack8(*(const bf16x8*)(y + (size_t)row * 512 + col));
        f32x4 b0 = *(const f32x4*)(bias + col), b1 = *(const f32x4*)(bias + col + 4);
#pragma unroll
        for (int i = 0; i < 8; ++i) v[i] = yv[i] * sigm(v[i] + (i < 4 ? b0[i] : b1[i - 4]));
        *(bf16x8*)(dst + (size_t)row * 512 + col) = pack8v(v); } };
struct FBranch { const bf16_t* gates; bf16_t* merged; int first;
    DI void s(int row, int col, float v) const { bf16_t* mp = merged + (size_t)row * 1024 + col; const float g = bf2f(gates[(size_t)row * 4096 + col]); *mp = f2bf((first ? 0.f : bf2f(*mp)) + g * v); }
    DI void operator()(int row, int col, f32x4 a, f32x4 b) const { f32x8 v = cat8(a, b); f32x8 gv = unpack8(*(const bf16x8*)(gates + (size_t)row * 4096 + col));
        bf16x8* mp = (bf16x8*)(merged + (size_t)row * 1024 + col);
        f32x8 o;
        if (first) {
#pragma unroll
            for (int i = 0; i < 8; ++i) o[i] = gv[i] * v[i];
        } else { f32x8 mv = unpack8(*mp);
#pragma unroll
            for (int i = 0; i < 8; ++i) o[i] = mv[i] + gv[i] * v[i];
        }
        *mp = pack8v(o); } };
struct FRes { float* xr;
    DI void s(int row, int col, float v) const { xr[(size_t)row * 1024 + col] += v; }
    DI void operator()(int row, int col, f32x4 a, f32x4 b) const { if (row < MR) { f32x4* p = (f32x4*)(xr + (size_t)row * 1024 + col); p[0] = p[0] + a; p[1] = p[1] + b; } } };
struct FResB { float* xr; bf16_t* xb;
    DI void s(int row, int col, float v) const { const float x = xr[(size_t)row * 1024 + col] + v; xr[(size_t)row * 1024 + col] = x; xb[(size_t)row * 1024 + col] = f2bf(x); }
    DI void operator()(int row, int col, f32x4 a, f32x4 b) const { if (row < MR) { f32x4* p = (f32x4*)(xr + (size_t)row * 1024 + col); const f32x4 x0 = p[0] + a, x1 = p[1] + b; p[0] = x0; p[1] = x1;
            *(bf16x8*)(xb + (size_t)row * 1024 + col) = pack8v(cat8(x0, x1)); } } };
struct FRelu2 { bf16_t* dst;
    DI void s(int row, int col, float v) const { const float r = fmaxf(v, 0.f); dst[(size_t)row * 4096 + col] = f2bf(r * r); }
    DI void operator()(int row, int col, f32x4 a, f32x4 b) const { f32x8 v = cat8(a, b);
#pragma unroll
        for (int i = 0; i < 8; ++i) { float r = fmaxf(v[i], 0.f); v[i] = r * r; }
        *(bf16x8*)(dst + (size_t)row * 4096 + col) = pack8v(v); } };
struct FPle { const bf16_t* T; float* xr;
    DI void s(int row, int col, float v) const { xr[(size_t)row * 1024 + col] += bf2f(T[(size_t)row * 1024 + col]) * sigm(v); }
    DI void operator()(int row, int col, f32x4 a, f32x4 b) const { if (row < MR) { f32x8 v = cat8(a, b); f32x8 tv = unpack8(*(const bf16x8*)(T + (size_t)row * 1024 + col));
            f32x4* p = (f32x4*)(xr + (size_t)row * 1024 + col); f32x4 x0 = p[0], x1 = p[1];
#pragma unroll
            for (int i = 0; i < 4; ++i) { x0[i] += tv[i] * sigm(v[i]); x1[i] += tv[4 + i] * sigm(v[4 + i]); }
            p[0] = x0; p[1] = x1; } } };

DI f32x16 small_part(const Ctx& c, const bf16_t* A, const bf16_t* Bt, int K, int tile, int kq) {
    int r = c.lane & 31, hh = c.lane >> 5; asm volatile("" : "+v"(r), "+v"(hh));
    const int mt = tile & 3, nt = tile >> 2, K4 = K >> 2;
    const bf16_t* ap = A + (size_t)(MP + mt * 32 + r) * K + kq * K4 + hh * 8;
    const bf16_t* bp = Bt + (size_t)(nt * 32 + r) * K + kq * K4 + hh * 8;
    f32x16 acc;
#pragma unroll
    for (int j = 0; j < 16; ++j) acc[j] = 0.f;
    if (K4 >= 128) {
        bf16x8 a[8], b[8];
#pragma unroll
        for (int j = 0; j < 8; ++j) { a[j] = *(const bf16x8*)(ap + j * 16); b[j] = *(const bf16x8*)(bp + j * 16); }
        for (int k = 128; k < K4; k += 128) {
            bf16x8 an[8], bn[8];
#pragma unroll
            for (int j = 0; j < 8; ++j) { an[j] = *(const bf16x8*)(ap + k + j * 16); bn[j] = *(const bf16x8*)(bp + k + j * 16); }
#pragma unroll
            for (int j = 0; j < 8; ++j) acc = MFMA32(a[j], b[j], acc);
#pragma unroll
            for (int j = 0; j < 8; ++j) { a[j] = an[j]; b[j] = bn[j]; }
        }
#pragma unroll
        for (int j = 0; j < 8; ++j) acc = MFMA32(a[j], b[j], acc);
    } else {
#pragma unroll
        for (int j = 0; j < 4; ++j) { const bf16x8 a = *(const bf16x8*)(ap + j * 16), b = *(const bf16x8*)(bp + j * 16); acc = MFMA32(a, b, acc); }
    }
    return acc;
}
template <class F> DI void run_gemm(const Ctx& c, const bf16_t* A, const bf16_t* Bt, int N, int K, const F& f) {
    { const int ntile = 4 * (N >> 5), grp = c.wave >> 2, kq = c.wave & 3;
      LAS float* red = (LAS float*)c.lds;
      for (int t0 = 0; t0 < ntile; t0 += 2 * c.G) {
          const int t = t0 + grp * c.G + c.bid; const bool live = t < ntile;
          if (live) { const f32x16 acc = small_part(c, A, Bt, K, t, kq);
#pragma unroll
              for (int i = 0; i < 16; ++i) red[(c.wave * 16 + i) * 64 + c.lane] = acc[i]; }
          __syncthreads();
          if (live && kq == 0) { const int mt = t & 3, nt = t >> 2, r = c.lane & 31, hh = c.lane >> 5;
#pragma unroll
              for (int i = 0; i < 16; ++i) { const int o = (c.wave * 16 + i) * 64 + c.lane; const float v = (red[o] + red[o + 1024]) + (red[o + 2048] + red[o + 3072]);
                  f.s(MP + mt * 32 + crow(i, hh), nt * 32 + r, v); } }
          __syncthreads();
      } }
    pg8::Gemm g{A, Bt, MP, N, K}; pg8::StaticOrder S; S.init(MP, N, c.G, c.bid);
    Epi8<F> E{f};
    pg8::gemm_phase<Epi8<F>, pg8::StaticOrder>((PG8_LAS unsigned char*)c.lds, g, S, E, nullptr);
    __syncthreads();
}

DI void tr_task(const Ctx& c, const float* src, int ld, int K, int n, bf16_t* dst, int rot) {
    float* tile = (float*)c.lds;
    const int nkt = K >> 6, ntiles = nkt * (n >> 6);
    const int start = (c.bid + c.G - (rot % c.G)) % c.G;
    for (int t = start; t < ntiles; t += c.G) {
        const int kt = t % nkt, nt = t / nkt;
        const int r = c.tid >> 4, c4 = (c.tid & 15) * 4;
#pragma unroll
        for (int p = 0; p < 2; ++p) { const int row = r + 32 * p; const f32x4 v = *(const f32x4*)(src + (size_t)(kt * 64 + row) * ld + nt * 64 + c4);
            tile[row * 65 + c4] = v[0]; tile[row * 65 + c4 + 1] = v[1]; tile[row * 65 + c4 + 2] = v[2]; tile[row * 65 + c4 + 3] = v[3]; }
        __syncthreads();
        { const int nn = c.tid >> 3, kc = (c.tid & 7) * 8; f32x8 v;
#pragma unroll
          for (int e = 0; e < 8; ++e) v[e] = tile[(kc + e) * 65 + nn];
          *(bf16x8*)(dst + (size_t)(nt * 64 + nn) * K + kt * 64 + kc) = pack8v(v); }
        __syncthreads();
    }
}
DI void phase_weights(const Ctx& c, int L) {
    const float* win = c.in[12] + (size_t)L * 1024 * DIN;
    bf16_t* W = c.W;
    tr_task(c, win + 0, DIN, 1024, 2048, W + WO_IN, 0);
    tr_task(c, win + 2568, DIN, 1024, 1024, W + WO_IN + (size_t)2048 * 1024, 0);
    tr_task(c, win + 2048, DIN, 1024, 512, W + WO_IN + (size_t)3072 * 1024, 0);
    tr_task(c, win + 3592, DIN, 1024, 512, W + WO_IN + (size_t)3584 * 1024, 128);
    tr_task(c, win + 4112, DIN, 1024, 3072, W + WO_G, 0);
    tr_task(c, c.in[21] + (size_t)L * 512 * 512, 512, 512, 512, W + WO_GLU, 0);
    tr_task(c, c.in[30] + (size_t)L * 512 * 1024, 1024, 512, 1024, W + WO_BR, 64);
    tr_task(c, c.in[31] + (size_t)L * 512 * 1024, 1024, 512, 1024, W + WO_BR + (size_t)1024 * 512, 192);
    tr_task(c, c.in[32] + (size_t)L * 512 * 1024, 1024, 512, 1024, W + WO_BR + (size_t)2 * 1024 * 512, 64);
    tr_task(c, c.in[33] + (size_t)L * 1024 * 1024, 1024, 1024, 1024, W + WO_OUT, 0);
    tr_task(c, c.in[35] + (size_t)L * 1024 * 4096, 4096, 1024, 4096, W + WO_UP, 0);
    tr_task(c, c.in[36] + (size_t)L * 4096 * 1024, 1024, 4096, 1024, W + WO_DN, 0);
    tr_task(c, c.in[37] + (size_t)L * 256 * 1024, 1024, 256, 1024, W + WO_PLE, 0);
    tr_task(c, c.in[38] + (size_t)L * 1024 * 1024, 1024, 1024, 1024, W + WO_PG, 64);
}

template <int MODE> DI void phase_rmsnorm(const Ctx& c, int L) {
    float* wsm = (float*)c.lds;
    const float* gain = (MODE == 0 ? c.in[11] : c.in[34]) + (size_t)L * 1024;
    if (MODE == 0) {
        const float* win = c.in[12] + (size_t)L * 1024 * DIN;
        for (int idx = c.tid; idx < 4096; idx += 512) { const int k = idx >> 2, part = idx & 3, seg = part >> 1, half = part & 1;
            const f32x4 v = *(const f32x4*)(win + (size_t)k * DIN + (seg ? 4104 : 2560) + half * 4);
            const int sb = seg * 8 + half * 4;
            wsm[(sb + 0) * 1024 + k] = v[0]; wsm[(sb + 1) * 1024 + k] = v[1]; wsm[(sb + 2) * 1024 + k] = v[2]; wsm[(sb + 3) * 1024 + k] = v[3]; }
        __syncthreads();
    }
    float* XR = c.out;
    for (int row = c.bid * 8 + c.wave; row < MR; row += c.G * 8) {
        const float* src = (MODE == 0 && L == 0) ? (row < MP ? c.in[0] + (size_t)row * 1024 : c.in[1] + (size_t)(row - MP) * 1024) : XR + (size_t)row * 1024;
        f32x4 x[4]; float ss = 0.f;
#pragma unroll
        for (int i = 0; i < 4; ++i) { x[i] = *(const f32x4*)(src + c.lane * 4 + 256 * i); ss += x[i][0] * x[i][0] + x[i][1] * x[i][1] + x[i][2] * x[i][2] + x[i][3] * x[i][3]; }
        ss = wave_sum(ss);
        const float rs = rsqrtf(ss * (1.f / 1024.f) + EPS);
        if (MODE == 0 && L == 0) {
#pragma unroll
            for (int i = 0; i < 4; ++i) *(f32x4*)(XR + (size_t)row * 1024 + c.lane * 4 + 256 * i) = x[i];
        }
#pragma unroll
        for (int i = 0; i < 4; ++i) { const f32x4 g = *(const f32x4*)(gain + c.lane * 4 + 256 * i); x[i] = x[i] * rs * g;
            *(s16x4*)(c.XN + (size_t)row * 1024 + c.lane * 4 + 256 * i) = pack4v(x[i]); }
        if (MODE == 0) {
            float a[16];
#pragma unroll
            for (int s = 0; s < 16; ++s) { float t = 0.f;
#pragma unroll
                for (int i = 0; i < 4; ++i) { const f32x4 w = *(const f32x4*)(wsm + s * 1024 + c.lane * 4 + 256 * i); t += x[i][0] * w[0] + x[i][1] * w[1] + x[i][2] * w[2] + x[i][3] * w[3]; }
                a[s] = t; asm volatile("" ::: "memory"); }
#pragma unroll
            for (int i = 0; i < 8; ++i) { const bool up = (c.lane & 32) != 0; const float send = up ? a[i] : a[i + 8], keep = up ? a[i + 8] : a[i]; a[i] = keep + __shfl_xor(send, 32); }
#pragma unroll
            for (int i = 0; i < 4; ++i) { const bool up = (c.lane & 16) != 0; const float send = up ? a[i] : a[i + 4], keep = up ? a[i + 4] : a[i]; a[i] = keep + __shfl_xor(send, 16); }
#pragma unroll
            for (int i = 0; i < 2; ++i) { const bool up = (c.lane & 8) != 0; const float send = up ? a[i] : a[i + 2], keep = up ? a[i + 2] : a[i]; a[i] = keep + __shfl_xor(send, 8); }
            { const bool up = (c.lane & 4) != 0; const float send = up ? a[0] : a[1], keep = up ? a[1] : a[0]; a[0] = keep + __shfl_xor(send, 4); }
            a[0] += __shfl_xor(a[0], 2); a[0] += __shfl_xor(a[0], 1);
            if ((c.lane & 3) == 0) { const int sidx = ((c.lane >> 5) & 1) * 8 + ((c.lane >> 4) & 1) * 4 + ((c.lane >> 3) & 1) * 2 + ((c.lane >> 2) & 1); c.SG[(size_t)row * 16 + sidx] = a[0]; }
        }
    }
    __syncthreads();
}

DI void phase_gdn_prep(const Ctx& c, int L) {
    constexpr int RS = 132, AS = 68, BP = 136;
    LAS float* AmT0 = (LAS float*)c.lds;
    const float* convw = c.in[23] + (size_t)L * 4 * 1536;
    const bf16_t* PR = c.R1;
    for (int item = c.bid; item < 1024; item += c.G) {
        const int ch = item & 31, h = (item >> 5) & 3, b = item >> 7;
        const int t0 = b * SEQ + ch * 64;
        unsigned char* gi = c.GS + (size_t)item * GI_BYTES;
        LAS float* AmT = AmT0; asm volatile("" : "+v"(AmT));
        LAS float* beta = AmT + 64 * AS; LAS float* gcum = beta + 64; LAS float* part = gcum + 64;
        LAS float* vs = part + 128; asm volatile("" : "+v"(vs));
        LAS bf16_t* qb = (LAS bf16_t*)(vs + 64 * RS); asm volatile("" : "+v"(qb));
        LAS bf16_t* khi = qb + 64 * BP; asm volatile("" : "+v"(khi));
        LAS bf16_t* klo = khi + 64 * BP; asm volatile("" : "+v"(klo));
        if (c.wave == 7) { const size_t row = (size_t)(t0 + c.lane);
            const float bt = sigm(c.SG[row * 16 + h]);
            const float g = -expf(c.in[24][L * 4 + h]) * softplus_(c.SG[row * 16 + 4 + h] + c.in[25][L * 4 + h]);
            const float gc = wave_incl_sum(g, c.lane);
            beta[c.lane] = bt; gcum[c.lane] = gc;
            if (c.lane == 63) c.GL[item] = expf(gc); }
        { const int d = c.tid & 127, tq = c.tid >> 7;
          float qk[2][16];
#pragma unroll
          for (int which = 0; which < 3; ++which) {
              const int pcol = PQ + which * 512 + h * 128 + d, wcol = which * 512 + h * 128 + d;
              const float w0 = convw[wcol], w1 = convw[1536 + wcol], w2 = convw[3072 + wcol], w3 = convw[4608 + wcol];
              float xin[19];
#pragma unroll
              for (int i = 0; i < 19; ++i) { const int tt = ch * 64 + tq * 16 + i - 3; const int tc = tt < 0 ? 0 : tt;
                  const float v = bf2f(PR[(size_t)(b * SEQ + tc) * NPROJ + pcol]); xin[i] = tt < 0 ? 0.f : v; }
#pragma unroll
              for (int t = 0; t < 16; ++t) { const float a = silu_(xin[t] * w0 + xin[t + 1] * w1 + xin[t + 2] * w2 + xin[t + 3] * w3);
                  if (which == 2) vs[(tq * 16 + t) * RS + d] = a; else qk[which][t] = a; }
          }
#pragma unroll
          for (int which = 0; which < 2; ++which) {
              float ssq[16];
#pragma unroll
              for (int t = 0; t < 16; ++t) ssq[t] = qk[which][t] * qk[which][t];
              butterfly16(ssq, c.lane);
              __syncthreads();
              if ((c.lane & 3) == 0) part[c.wave * 16 + bsel16(c.lane)] = ssq[0];
              __syncthreads();
#pragma unroll
              for (int t = 0; t < 16; ++t) { const float tot = part[c.wave * 16 + t] + part[(c.wave ^ 1) * 16 + t];
                  const float v = qk[which][t] * rsqrtf(tot + EPS) * (which == 0 ? 0.08838834764831845f : 1.f);
                  const bf16_t hi = f2bf(v);
                  if (which == 0) qb[(tq * 16 + t) * BP + d] = hi;
                  else { khi[(tq * 16 + t) * BP + d] = hi; klo[(tq * 16 + t) * BP + d] = f2bf(v - bf2f(hi)); } }
          } }
        __syncthreads();
        { const int r = c.lane & 31, hh = c.lane >> 5, wq = c.wave & 3, tm = wq >> 1, tn = wq & 1;
          if (!(c.wave < 4 && tm == 0 && tn == 1)) {
              f32x16 acc;
#pragma unroll
              for (int j = 0; j < 16; ++j) acc[j] = 0.f;
              const LAS bf16_t* arow = (c.wave < 4 ? khi : qb) + (tm * 32 + r) * BP + hh * 8;
              const LAS bf16_t* brow = khi + (tn * 32 + r) * BP + hh * 8;
#pragma unroll
              for (int ks = 0; ks < 8; ++ks) { const bf16x8 av = *(const LAS bf16x8*)(arow + ks * 16), bv = *(const LAS bf16x8*)(brow + ks * 16);
                  acc = MFMA32(av, bv, acc);
                  if (c.wave < 4) { const bf16x8 al = *(const LAS bf16x8*)(arow + 64 * BP + ks * 16), bl = *(const LAS bf16x8*)(brow + 64 * BP + ks * 16);
                      acc = MFMA32(av, bl, acc); acc = MFMA32(al, bv, acc); } }
              const int s = tn * 32 + r; const float gs = gcum[s];
              bf16_t* at = (bf16_t*)(gi + GI_A);
#pragma unroll
              for (int i = 0; i < 16; ++i) { const int t = tm * 32 + crow(i, hh); const float dec = (t >= s) ? __expf(gcum[t] - gs) : 0.f;
                  if (c.wave < 4) { if (t > s) AmT[s * AS + t] = beta[t] * acc[i] * dec; }
                  else at[t * 64 + (s & ~15) + perm16(s & 15)] = f2bf(acc[i] * dec); }
          } }
        __syncthreads();
        if (c.tid < 256) {
            const int col = c.tid; float x[64];
#pragma unroll
            for (int t = 0; t < 64; ++t) x[t] = (col < 128) ? vs[t * RS + col] * beta[t] : (bf2f(khi[t * BP + (col - 128)]) + bf2f(klo[t * BP + (col - 128)])) * beta[t] * __expf(gcum[t]);
#pragma unroll
            for (int j = 0; j < 63; ++j) { const float xj = x[j];
#pragma unroll
                for (int g4 = (j + 1) / 4; g4 < 16; ++g4) { const f32x4 a = *(const LAS f32x4*)(AmT + j * AS + g4 * 4);
#pragma unroll
                    for (int e = 0; e < 4; ++e) if (g4 * 4 + e > j) x[g4 * 4 + e] -= a[e] * xj; } }
            if (col < 128) { bf16_t* up = (bf16_t*)(gi + GI_U); const int sl = col >> 5, r = col & 31;
#pragma unroll
                for (int t = 0; t < 64; ++t) { const int mt = t >> 5, tt = t & 31, hh = (tt >> 2) & 1, i = (tt & 3) + 4 * (tt >> 3);
                    up[((sl * 2 + mt) * 16 + i) * 64 + r + 32 * hh] = f2bf(x[t]); }
            } else { bf16_t* wp = (bf16_t*)(gi + GI_W); const int dk = col - 128, pd = (dk & ~15) + perm16(dk & 15);
#pragma unroll
                for (int t = 0; t < 64; ++t) wp[t * 128 + pd] = f2bf(-x[t]); }
        } else {
            bf16_t* qp = (bf16_t*)(gi + GI_Q); bf16_t* kp = (bf16_t*)(gi + GI_K);
            const float g63 = gcum[63];
            for (int idx = c.tid - 256; idx < 64 * 128; idx += 256) { const int t = idx >> 7, d = idx & 127;
                qp[t * 128 + (d & ~15) + perm16(d & 15)] = f2bf(bf2f(qb[t * BP + d]) * __expf(gcum[t])); }
            for (int idx = c.tid - 256; idx < 64 * 128; idx += 256) { const int d = idx >> 6, t = idx & 63;
                kp[d * 64 + (t & ~15) + perm16(t & 15)] = f2bf((bf2f(khi[t * BP + d]) + bf2f(klo[t * BP + d])) * __expf(g63 - gcum[t])); }
        }
        __syncthreads();
    }
}

constexpr int GB_W = 0, GB_Q = 16384, GB_A = 32768, GB_K = 40960, GB_U = 57344, GB_BYTES = 61440;
DI void dma16(const void* g, unsigned lds_addr) { asm volatile("s_mov_b32 m0, %1\n\tglobal_load_lds_dwordx4 %0, off" :: "v"(g), "s"(lds_addr) : "memory", "m0"); }
DI void gdn_issue(const Ctx& c, int item, int sl, int r, int hh, int ln, PG8_LAS unsigned char* buf) {
    const unsigned char* gi = c.GS + (size_t)item * GI_BYTES;
    const bf16_t* up = (const bf16_t*)(gi + GI_U); const bf16_t* wp = (const bf16_t*)(gi + GI_W); const bf16_t* qp = (const bf16_t*)(gi + GI_Q);
    const bf16_t* kp = (const bf16_t*)(gi + GI_K); const bf16_t* ap = (const bf16_t*)(gi + GI_A);
#pragma unroll
    for (int mt = 0; mt < 2; ++mt)
#pragma unroll
        for (int ks = 0; ks < 8; ++ks) {
            dma16((wp + (mt * 32 + r) * 128 + ks * 16 + hh * 8), (unsigned)(size_t)(buf + GB_W + (mt * 8 + ks) * 1024));
            dma16((qp + (mt * 32 + r) * 128 + ks * 16 + hh * 8), (unsigned)(size_t)(buf + GB_Q + (mt * 8 + ks) * 1024)); }
#pragma unroll
    for (int mt = 0; mt < 2; ++mt)
#pragma unroll
        for (int ks = 0; ks < 4; ++ks)
            dma16((ap + (mt * 32 + r) * 64 + ks * 16 + hh * 8), (unsigned)(size_t)(buf + GB_A + (mt * 4 + ks) * 1024));
#pragma unroll
    for (int i = 0; i < 4; ++i)
#pragma unroll
        for (int ks = 0; ks < 4; ++ks)
            dma16((kp + (i * 32 + r) * 64 + ks * 16 + hh * 8), (unsigned)(size_t)(buf + GB_K + (i * 4 + ks) * 1024));
#pragma unroll
    for (int j = 0; j < 4; ++j)
        dma16((up + (size_t)sl * 2048 + j * 512 + ln * 8), (unsigned)(size_t)(buf + GB_U + j * 1024));
}
DI void task_gdn_seq(const Ctx& c, int L, int unit) {
    const int sl = (unit >> 3) & 3, stream = (unit & 7) + 8 * (unit >> 5);
    const int b = stream >> 2, h = stream & 3;
    const int r0_ = c.lane & 31, hh0_ = c.lane >> 5; int r = r0_, hh = hh0_, ln = c.lane;
    PG8_LAS unsigned char* lbase = (PG8_LAS unsigned char*)c.lds;
    f32x16 S[4];
#pragma unroll
    for (int i = 0; i < 4; ++i)
#pragma unroll
        for (int j = 0; j < 16; ++j) S[i][j] = 0.f;
    bf16_t* yo = c.Y3 + (size_t)1 * MPAD * 512;
    gdn_issue(c, stream * 32, sl, r, hh, ln, lbase);
    for (int ch = 0; ch < 32; ++ch) {
        r = r0_; hh = hh0_; ln = c.lane; asm volatile("" : "+v"(r), "+v"(hh), "+v"(ln));
        const int item = stream * 32 + ch;
        const float gl = c.GL[item];
        asm volatile("s_waitcnt vmcnt(0)" ::: "memory");
        PG8_LAS unsigned char* buf = lbase + (ch & 1) * GB_BYTES;
        if (ch + 1 < 32) gdn_issue(c, item + 1, sl, r, hh, ln, lbase + ((ch + 1) & 1) * GB_BYTES);
        PG8_LAS unsigned char* lb = buf + ln * 16; asm volatile("" : "+v"(lb));
        PG8_LAS unsigned char* ub = buf + GB_U + ln * 2; asm volatile("" : "+v"(ub));
        f32x16 vn[2], o[2];
#pragma unroll
        for (int mt = 0; mt < 2; ++mt)
#pragma unroll
            for (int i = 0; i < 16; ++i) { vn[mt][i] = bf2f(*(const PG8_LAS bf16_t*)(ub + (mt * 16 + i) * 128)); o[mt][i] = 0.f; }
        bf16x8 Sb[8];
#pragma unroll
        for (int ks = 0; ks < 8; ++ks) Sb[ks] = pack16(S[ks >> 1], ks & 1);
#pragma unroll
        for (int mt = 0; mt < 2; ++mt)
#pragma unroll
            for (int ks = 0; ks < 8; ++ks) { const bf16x8 a = *(const PG8_LAS bf16x8*)(lb + GB_W + (mt * 8 + ks) * 1024); vn[mt] = MFMA32(a, Sb[ks], vn[mt]); }
#pragma unroll
        for (int mt = 0; mt < 2; ++mt)
#pragma unroll
            for (int ks = 0; ks < 8; ++ks) { const bf16x8 a = *(const PG8_LAS bf16x8*)(lb + GB_Q + (mt * 8 + ks) * 1024); o[mt] = MFMA32(a, Sb[ks], o[mt]); }
        bf16x8 Vb[4];
#pragma unroll
        for (int ks = 0; ks < 4; ++ks) Vb[ks] = pack16(vn[ks >> 1], ks & 1);
#pragma unroll
        for (int mt = 0; mt < 2; ++mt)
#pragma unroll
            for (int ks = 0; ks < 4; ++ks) { const bf16x8 a = *(const PG8_LAS bf16x8*)(lb + GB_A + (mt * 4 + ks) * 1024); o[mt] = MFMA32(a, Vb[ks], o[mt]); }
#pragma unroll
        for (int i = 0; i < 4; ++i) {
#pragma unroll
            for (int j = 0; j < 16; ++j) S[i][j] *= gl;
#pragma unroll
            for (int ks = 0; ks < 4; ++ks) { const bf16x8 a = *(const PG8_LAS bf16x8*)(lb + GB_K + (i * 4 + ks) * 1024); S[i] = MFMA32(a, Vb[ks], S[i]); }
        }
        const size_t rowb = (size_t)(b * SEQ + ch * 64);
#pragma unroll
        for (int mt = 0; mt < 2; ++mt)
#pragma unroll
            for (int i = 0; i < 16; ++i) yo[(rowb + mt * 32 + crow(i, hh)) * 512 + h * 128 + sl * 32 + r] = f2bf(o[mt][i]);
        asm volatile("s_waitcnt lgkmcnt(0)" ::: "memory");
    }
    float* so = c.out + O_GDN_P + ((size_t)(L * NB + b) * 4 + h) * 128 * 128;
#pragma unroll
    for (int i = 0; i < 4; ++i)
#pragma unroll
        for (int j = 0; j < 16; ++j) so[(size_t)(i * 32 + crow(j, hh)) * 128 + sl * 32 + r] = S[i][j];
}

DI void task_ml_gates(const Ctx& c, int L, int item) {
    const int ch = item & 31, h = (item >> 5) & 3, b = item >> 7, lane = c.lane;
    const size_t row = (size_t)(b * SEQ + ch * 64 + lane);
    const float li = softcap_(c.SG[row * 16 + 8 + h] + c.in[27][L * 4 + h]);
    const float lf = logsig_(softcap_(c.SG[row * 16 + 12 + h] + c.in[28][L * 4 + h]));
    const float bc = wave_incl_sum(lf, lane);
    const float av = li - bc;
    const float cm = wave_incl_max(av, lane);
    float* mg = (float*)(c.ws + WS_MG) + (size_t)item * 192;
    mg[lane] = av; mg[64 + lane] = cm; mg[128 + lane] = bc;
}
DI void ml_issue(const bf16_t* PR, int b, int h, int sl, int ch, int lane, unsigned bufaddr) {
    const size_t row = (size_t)(b * SEQ + ch * 64 + lane);
    const bf16_t* kp = PR + row * NPROJ + PMK + h * 64; const bf16_t* qp = PR + row * NPROJ + PMQ + h * 64; const bf16_t* vp = PR + row * NPROJ + PMV + h * 128 + sl * 32;
#pragma unroll
    for (int d8 = 0; d8 < 8; ++d8) { dma16(kp + d8 * 8, bufaddr + d8 * 1024); dma16(qp + d8 * 8, bufaddr + 8192 + d8 * 1024); }
#pragma unroll
    for (int d8 = 0; d8 < 4; ++d8) dma16(vp + d8 * 8, bufaddr + 16384 + d8 * 1024);
}
DI void task_ml_seq(const Ctx& c, int L, int unit, float* wl  ) {
    const int sl = (unit >> 3) & 3, stream = (unit & 7) + 8 * (unit >> 5);
    const int b = stream >> 2, h = stream & 3;
    const int lane = c.lane, r0_ = lane & 31, hh0_ = lane >> 5;
    int r = r0_, hh = hh0_, lane_v = lane;
    LAS float* a_l = (LAS float*)wl; LAS float* w_l = a_l + 64; LAS float* sc_l = a_l + 128; LAS float* inv_l = a_l + 192;
    LAS float* n_l = a_l + 256;
    LAS unsigned char* bufs = (LAS unsigned char*)(a_l + 320);
    const unsigned bufaddr0 = (unsigned)(size_t)bufs;
    const bf16_t* PR = c.R1;
    f32x16 C[2];
#pragma unroll
    for (int i = 0; i < 2; ++i)
#pragma unroll
        for (int j = 0; j < 16; ++j) C[i][j] = 0.f;
    float nst = 0.f, mprev = 0.f;
    n_l[lane] = 0.f;
    bf16_t* yo = c.Y3 + (size_t)2 * MPAD * 512;
    float mgv[3];
    { const float* mg = (const float*)(c.ws + WS_MG) + (size_t)(stream * 32) * 192; mgv[0] = mg[lane]; mgv[1] = mg[64 + lane]; mgv[2] = mg[128 + lane]; }
    ml_issue(PR, b, h, sl, 0, lane, bufaddr0);
    for (int ch = 0; ch < 32; ++ch) {
        r = r0_; hh = hh0_; lane_v = lane; asm volatile("" : "+v"(r), "+v"(hh), "+v"(lane_v));
        const float av = mgv[0], cmx = mgv[1], bc = mgv[2];
        asm volatile("s_waitcnt vmcnt(0)" ::: "memory");
        if (ch + 1 < 32) ml_issue(PR, b, h, sl, ch + 1, lane_v, bufaddr0 + ((ch + 1) & 1) * 20480);
        { const int chn = ch + 1 < 32 ? ch + 1 : 31; const float* mg = (const float*)(c.ws + WS_MG) + (size_t)(stream * 32 + chn) * 192;
          mgv[0] = mg[lane_v]; mgv[1] = mg[64 + lane_v]; mgv[2] = mg[128 + lane_v]; }
        LAS unsigned char* Kc = bufs + (ch & 1) * 20480; asm volatile("" : "+v"(Kc));
        LAS unsigned char* Qc = Kc + 8192; LAS unsigned char* Vc = Kc + 16384;
        LAS unsigned char* vbase = Vc + (r >> 3) * 1024 + (r & 7) * 2 + hh * 64; asm volatile("" : "+v"(vbase));
        LAS unsigned char* kbase = Kc + (r >> 3) * 1024 + (r & 7) * 2 + hh * 64; asm volatile("" : "+v"(kbase));
        LAS unsigned char* krow = Kc + hh * 1024 + r * 16; asm volatile("" : "+v"(krow));
        LAS unsigned char* qrow = Qc + hh * 1024 + r * 16; asm volatile("" : "+v"(qrow));
        LAS unsigned char* qr4 = Qc + r * 16 + hh * 8; asm volatile("" : "+v"(qr4));
        LAS unsigned char* kn = Kc + (lane_v >> 3) * 1024 + (lane_v & 7) * 2; asm volatile("" : "+v"(kn));
        LAS unsigned char* qln = Qc + lane_v * 16; asm volatile("" : "+v"(qln));
        LAS float* a4b = a_l + 4 * hh; asm volatile("" : "+v"(a4b));
        const size_t t0 = (size_t)(b * SEQ + ch * 64);
        const float Mt = fmaxf(mprev, cmx);
        const float sct = __expf(mprev - Mt);
        const float M63 = __shfl(Mt, 63), bc63 = __shfl(bc, 63);
        const float wlast = __expf(av - M63) * 0.125f;
        const float sclast = __expf(mprev - M63);
        WAVE_FENCE();
        float qn = 0.f;
#pragma unroll
        for (int d8 = 0; d8 < 8; ++d8) { const f32x8 qv = unpack8(*(const LAS bf16x8*)(qln + d8 * 1024));
            const f32x4 n0 = *(const LAS f32x4*)(n_l + d8 * 8), n1 = *(const LAS f32x4*)(n_l + d8 * 8 + 4);
            qn += qv[0] * n0[0] + qv[1] * n0[1] + qv[2] * n0[2] + qv[3] * n0[3] + qv[4] * n1[0] + qv[5] * n1[1] + qv[6] * n1[2] + qv[7] * n1[3]; }
        a_l[lane] = av; w_l[lane] = wlast;
        WAVE_FENCE();
        bf16x8 Vb[4];
#pragma unroll
        for (int ks = 0; ks < 4; ++ks)
#pragma unroll
            for (int j = 0; j < 8; ++j) Vb[ks][j] = (short)*(const LAS bf16_t*)(vbase + (16 * ks + 8 * (j >> 2) + (j & 3)) * 16);
        f32x16 num[2]; float dpv[2];
#pragma unroll
        for (int nt = 0; nt < 2; ++nt) {
            f32x16 PT[2];
#pragma unroll
            for (int ms = 0; ms < 2; ++ms)
#pragma unroll
                for (int j = 0; j < 16; ++j) PT[ms][j] = 0.f;
#pragma unroll
            for (int ks = 0; ks < 4; ++ks) {
                const bf16x8 bq = *(const LAS bf16x8*)(qrow + ks * 2048 + nt * 512);
#pragma unroll
                for (int ms = 0; ms < 2; ++ms) { const bf16x8 ak = *(const LAS bf16x8*)(krow + ks * 2048 + ms * 512); PT[ms] = MFMA32(ak, bq, PT[ms]); }
            }
            const float Mtn = __shfl(Mt, nt * 32 + r);
            float dp = 0.f;
#pragma unroll
            for (int ms = 0; ms < 2; ++ms)
#pragma unroll
                for (int g = 0; g < 4; ++g) { const f32x4 a4 = *(const LAS f32x4*)(a4b + ms * 32 + 8 * g);
#pragma unroll
                    for (int jj = 0; jj < 4; ++jj) { const int i = 4 * g + jj; const int s = ms * 32 + 8 * g + 4 * hh + jj;
                        const float wv = (s <= nt * 32 + r) ? __expf(a4[jj] - Mtn) * 0.125f : 0.f;
                        PT[ms][i] *= wv; dp += PT[ms][i]; } }
            dp += __shfl_xor(dp, 32); dpv[nt] = dp;
#pragma unroll
            for (int j = 0; j < 16; ++j) num[nt][j] = 0.f;
#pragma unroll
            for (int ks = 0; ks < 4; ++ks) num[nt] = MFMA32(pack16(PT[ks >> 1], ks & 1), Vb[ks], num[nt]);
            }
        const float den = (lane < 32 ? dpv[0] : dpv[1]) + sct * qn;
        const float inv = 1.f / fmaxf(fabsf(den), __expf(-(bc + Mt)));
        sc_l[lane] = sct; inv_l[lane] = inv;
        WAVE_FENCE();
        { bf16x8 Cb[4];
#pragma unroll
          for (int kd = 0; kd < 4; ++kd) Cb[kd] = pack16(C[kd >> 1], kd & 1);
#pragma unroll
          for (int mt = 0; mt < 2; ++mt) { f32x16 qc;
#pragma unroll
              for (int j = 0; j < 16; ++j) qc[j] = 0.f;
#pragma unroll
              for (int kd = 0; kd < 4; ++kd) { const LAS unsigned char* qr = qr4 + kd * 2048 + mt * 512;
                  const s16x4 lo = *(const LAS s16x4*)qr, hi = *(const LAS s16x4*)(qr + 1024);
                  const bf16x8 a = __builtin_shufflevector(lo, hi, 0, 1, 2, 3, 4, 5, 6, 7);
                  qc = MFMA32(a, Cb[kd], qc); }
#pragma unroll
              for (int g = 0; g < 4; ++g) { const f32x4 s4 = *(const LAS f32x4*)(a4b + 128 + mt * 32 + 8 * g), i4 = *(const LAS f32x4*)(a4b + 192 + mt * 32 + 8 * g);
#pragma unroll
                  for (int jj = 0; jj < 4; ++jj) { const int i = 4 * g + jj; const float hv = (num[mt][i] + s4[jj] * qc[i]) * i4[jj];
                      yo[(t0 + mt * 32 + 8 * g + 4 * hh + jj) * 512 + h * 128 + sl * 32 + r] = f2bf(hv); } }
                } }
#pragma unroll
        for (int i = 0; i < 2; ++i) {
#pragma unroll
            for (int j = 0; j < 16; ++j) C[i][j] *= sclast;
#pragma unroll
            for (int ks = 0; ks < 4; ++ks) { const f32x4 wA = *(const LAS f32x4*)(a4b + 64 + 16 * ks), wB = *(const LAS f32x4*)(a4b + 64 + 16 * ks + 8);
                f32x8 kv;
#pragma unroll
                for (int j = 0; j < 8; ++j) kv[j] = bf2f(*(const LAS bf16_t*)(kbase + i * 4096 + (16 * ks + 8 * (j >> 2) + (j & 3)) * 16)) * (j < 4 ? wA[j & 3] : wB[j & 3]);
                C[i] = MFMA32(pack8v(kv), Vb[ks], C[i]); }
            }
        { float na = 0.f;
#pragma unroll
          for (int s4 = 0; s4 < 16; ++s4) { const f32x4 w4 = *(const LAS f32x4*)(w_l + s4 * 4);
#pragma unroll
              for (int e = 0; e < 4; ++e) na += w4[e] * bf2f(*(const LAS bf16_t*)(kn + (s4 * 4 + e) * 16)); }
          nst = sclast * nst + na; n_l[lane] = nst; }
        mprev = bc63 + M63;
        asm volatile("s_waitcnt lgkmcnt(0)" ::: "memory");
    }
    float* co = c.out + O_MLC_P + ((size_t)(L * NB + b) * 4 + h) * 64 * 128;
#pragma unroll
    for (int i = 0; i < 2; ++i)
#pragma unroll
        for (int j = 0; j < 16; ++j) co[(size_t)(i * 32 + crow(j, hh)) * 128 + sl * 32 + r] = C[i][j];
    if (sl == 0) { c.out[O_MLN_P + ((size_t)(L * NB + b) * 4 + h) * 64 + lane] = nst; if (lane == 0) c.out[O_MLM_P + (size_t)(L * NB + b) * 4 + h] = mprev; }
}

DI void task_gdn_sample(const Ctx& c, int L, int unit) {
    const int half = unit & 1, h = (unit >> 1) & 3, b = unit >> 3, lane = c.lane;
    const size_t row = (size_t)(MP + b);
    const bf16_t* pr = c.R1 + row * NPROJ;
    const float* cbuf = c.in[4] + ((size_t)L * MS + b) * 3 * 1536;
    const float* cw = c.in[23] + (size_t)L * 4 * 1536;
    float* cout = c.out + O_CONV_S + ((size_t)L * MS + b) * 3 * 1536;
    float qv[2], kv[2], vv;
#pragma unroll
    for (int w = 0; w < 5; ++w) {
        const int which = w < 2 ? 0 : w < 4 ? 1 : 2; const int d = (w == 4) ? half * 64 + lane : lane + 64 * (w & 1);
        const int cc = which * 512 + h * 128 + d;
        const float xin = bf2f(pr[PQ + cc]);
        const float b0 = cbuf[cc], b1 = cbuf[1536 + cc], b2 = cbuf[3072 + cc];
        float a = b0 * cw[cc] + b1 * cw[1536 + cc] + b2 * cw[3072 + cc] + xin * cw[4608 + cc];
        a = silu_(a);
        cout[cc] = b1; cout[1536 + cc] = b2; cout[3072 + cc] = xin;
        if (w < 2) qv[w] = a; else if (w < 4) kv[w - 2] = a; else vv = a;
    }
    { const float sq = wave_sum(qv[0] * qv[0] + qv[1] * qv[1]), sk = wave_sum(kv[0] * kv[0] + kv[1] * kv[1]);
      const float fq = rsqrtf(sq + EPS) * 0.08838834764831845f, fk = rsqrtf(sk + EPS);
      qv[0] *= fq; qv[1] *= fq; kv[0] *= fk; kv[1] *= fk; }
    const float qk = wave_sum(qv[0] * kv[0] + qv[1] * kv[1]);
    const float beta = sigm(c.SG[row * 16 + h]);
    const float g = -expf(c.in[24][L * 4 + h]) * softplus_(c.SG[row * 16 + 4 + h] + c.in[25][L * 4 + h]);
    const float eg = expf(g);
    const float* sin_ = c.in[5] + (((size_t)L * MS + b) * 4 + h) * 128 * 128 + half * 64 + lane;
    float* sout = c.out + O_GDN_S + (((size_t)L * MS + b) * 4 + h) * 128 * 128 + half * 64 + lane;
    float kS = 0.f, qS = 0.f;
#pragma unroll
    for (int hf = 0; hf < 2; ++hf) { const float kh = kv[hf], qh = qv[hf];
#pragma unroll 8
        for (int d = 0; d < 64; ++d) { const float sv = sin_[(size_t)(hf * 64 + d) * 128]; kS += __shfl(kh, d) * sv; qS += __shfl(qh, d) * sv; } }
    const float vnew = beta * (vv - eg * kS);
    const float o = eg * qS + qk * vnew;
#pragma unroll
    for (int hf = 0; hf < 2; ++hf) { const float kh = kv[hf];
#pragma unroll 8
        for (int d = 0; d < 64; ++d) { const float sv = sin_[(size_t)(hf * 64 + d) * 128]; sout[(size_t)(hf * 64 + d) * 128] = sv * eg + __shfl(kh, d) * vnew; } }
    c.Y3[(size_t)1 * MPAD * 512 + row * 512 + h * 128 + half * 64 + lane] = f2bf(o);
}
DI void task_ml_sample(const Ctx& c, int L, int unit) {
    const int half = unit & 1, h = (unit >> 1) & 3, b = unit >> 3, lane = c.lane;
    const size_t row = (size_t)(MP + b);
    const bf16_t* pr = c.R1 + row * NPROJ;
    const float q = bf2f(pr[PMQ + h * 64 + lane]), k = bf2f(pr[PMK + h * 64 + lane]) * 0.125f, v = bf2f(pr[PMV + h * 128 + half * 64 + lane]);
    const float li = softcap_(c.SG[row * 16 + 8 + h] + c.in[27][L * 4 + h]);
    const float lf = logsig_(softcap_(c.SG[row * 16 + 12 + h] + c.in[28][L * 4 + h]));
    const size_t sidx = ((size_t)L * MS + b) * 4 + h;
    const float m0 = c.in[8][sidx];
    const float mt = fmaxf(lf + m0, li), wts = expf(li - mt), sc = expf(lf + m0 - mt);
    const float n0 = c.in[7][sidx * 64 + lane];
    const float sqk = wave_sum(q * k) * wts, qn = wave_sum(q * n0);
    const float* cin = c.in[6] + sidx * 64 * 128 + half * 64 + lane;
    float* cout = c.out + O_MLC_S + sidx * 64 * 128 + half * 64 + lane;
    float cc[64]; float qC = 0.f;
#pragma unroll
    for (int d = 0; d < 64; ++d) { cc[d] = cin[(size_t)d * 128]; qC += __shfl(q, d) * cc[d]; }
    const float num = sqk * v + sc * qC, den = sqk + sc * qn;
    const float hv = num / fmaxf(fabsf(den), expf(-mt));
#pragma unroll
    for (int d = 0; d < 64; ++d) cout[(size_t)d * 128] = sc * cc[d] + wts * __shfl(k, d) * v;
    if (half == 0) { c.out[O_MLN_S + sidx * 64 + lane] = sc * n0 + wts * k; if (lane == 0) c.out[O_MLM_S + sidx] = mt; }
    c.Y3[(size_t)2 * MPAD * 512 + row * 512 + h * 128 + half * 64 + lane] = f2bf(hv);
}
struct S5P { float lr, li; f32x2 bb[16]; };
DI S5P s5_params(const Ctx& c, int L, int g, int p) {
    S5P P; const size_t gp = ((size_t)L * 32 + g) * 64 + p;
    const float are = c.in[13][gp], aim = c.in[14][gp], dt = expf(c.in[15][L * 32 + g]);
    const float mag = expf(are * dt); P.lr = mag * cosf(aim * dt); P.li = mag * sinf(aim * dt);
    const float inv = 1.f / (are * are + aim * aim), zr = P.lr - 1.f, zi = P.li;
    const float fre = (zr * are + zi * aim) * inv, fim = (zi * are - zr * aim) * inv;
    const float* Bre = c.in[16] + gp * 16; const float* Bim = c.in[17] + gp * 16;
#pragma unroll
    for (int q4 = 0; q4 < 4; ++q4) { const f32x4 br = *(const f32x4*)(Bre + 4 * q4), bi = *(const f32x4*)(Bim + 4 * q4);
#pragma unroll
        for (int e = 0; e < 4; ++e) { P.bb[4 * q4 + e][0] = fre * br[e] - fim * bi[e]; P.bb[4 * q4 + e][1] = fre * bi[e] + fim * br[e]; } }
    return P;
}
DI void task_s5_sample(const Ctx& c, int L, int unit) {
    const int g = unit & 31, b = unit >> 5, lane = c.lane;
    const S5P P = s5_params(c, L, g, lane);
    const size_t row = (size_t)(MP + b);
    const bf16_t* pr = c.R1 + row * NPROJ + PU + g * 16;
    float u[16];
    { const f32x8 u0 = unpack8(*(const bf16x8*)pr), u1 = unpack8(*(const bf16x8*)(pr + 8));
#pragma unroll
      for (int e = 0; e < 8; ++e) { u[e] = u0[e]; u[8 + e] = u1[e]; } }
    f32x2 bu = {0.f, 0.f};
#pragma unroll
    for (int cc = 0; cc < 16; ++cc) bu += P.bb[cc] * u[cc];
    const size_t si = (((size_t)L * MS + b) * 32 + g) * 64 + lane;
    const float h0r = c.in[2][si], h0i = c.in[3][si];
    const float hr = P.lr * h0r - P.li * h0i + bu[0], hi = P.lr * h0i + P.li * h0r + bu[1];
    c.out[O_S5RE_S + si] = hr; c.out[O_S5IM_S + si] = hi;
    const float* Cre = c.in[18] + ((size_t)L * 32 + g) * 16 * 64; const float* Cim = c.in[19] + ((size_t)L * 32 + g) * 16 * 64;
    float ya[16];
#pragma unroll
    for (int cc = 0; cc < 16; ++cc) ya[cc] = hr * Cre[cc * 64 + lane] - hi * Cim[cc * 64 + lane];
    butterfly16(ya, lane);
    if ((lane & 3) == 0) { const int cc = bsel16(lane); const float y = ya[0] + c.in[20][L * 512 + g * 16 + cc] * bf2f(pr[cc]);
        c.YS5[row * 512 + g * 16 + cc] = f2bf(gelu_t(y)); }
}

DI void task_s5_wave(const Ctx& c, int L, int unit, unsigned char* wlds  ) {
    LAS float* Uw = (LAS float*)wlds;
    LAS bf16_t* Hw = (LAS bf16_t*)(wlds + 4096);
    const int lane = c.lane;
    const int g = unit & 31, b = unit >> 5;
    const S5P P = s5_params(c, L, g, lane);
    const size_t rbase = (size_t)(b * SEQ);
    const bf16_t* ub = c.R1 + rbase * NPROJ + PU + g * 16;
    bf16x8 Cb[4];
    { const int cc = lane & 15, kq = (lane >> 4) * 8; const float* Cre = c.in[18] + (((size_t)L * 32 + g) * 16 + cc) * 64; const float* Cim = c.in[19] + (((size_t)L * 32 + g) * 16 + cc) * 64;
#pragma unroll
      for (int ks = 0; ks < 4; ++ks) { f32x8 v;
#pragma unroll
          for (int j = 0; j < 8; ++j) { const int k = ks * 32 + kq + j; v[j] = (k < 64) ? Cre[k] : -Cim[k - 64]; }
          Cb[ks] = pack8v(v); } }
    const float dskip = c.in[20][L * 512 + g * 16 + (lane & 15)];
    float hr = 0.f, hi = 0.f;
    for (int sub = 0; sub < 32; ++sub) {
        WAVE_FENCE();
        { const bf16_t* up = ub + (size_t)(sub * 64 + lane) * NPROJ; const f32x8 u0 = unpack8(*(const bf16x8*)up), u1 = unpack8(*(const bf16x8*)(up + 8));
          LAS f32x4* d = (LAS f32x4*)(Uw + lane * 16);
          d[0] = (f32x4){u0[0], u0[1], u0[2], u0[3]}; d[1] = (f32x4){u0[4], u0[5], u0[6], u0[7]}; d[2] = (f32x4){u1[0], u1[1], u1[2], u1[3]}; d[3] = (f32x4){u1[4], u1[5], u1[6], u1[7]}; }
        WAVE_FENCE();
        for (int blk = 0; blk < 4; ++blk) {
#pragma unroll 4
            for (int st = 0; st < 16; ++st) {
                const LAS f32x4* up4 = (const LAS f32x4*)(Uw + (blk * 16 + st) * 16);
                f32x2 bu = {0.f, 0.f};
#pragma unroll
                for (int q4 = 0; q4 < 4; ++q4) { const f32x4 uv = up4[q4];
#pragma unroll
                    for (int e = 0; e < 4; ++e) bu += P.bb[4 * q4 + e] * uv[e]; }
                const float nr = P.lr * hr - P.li * hi + bu[0], ni = P.lr * hi + P.li * hr + bu[1]; hr = nr; hi = ni;
                Hw[st * 128 + lane] = f2bf(hr); Hw[st * 128 + 64 + lane] = f2bf(hi);
            }
            WAVE_FENCE();
            f32x4 acc = {0.f, 0.f, 0.f, 0.f};
#pragma unroll
            for (int ks = 0; ks < 4; ++ks) { const bf16x8 a = *(const LAS bf16x8*)(Hw + (lane & 15) * 128 + ks * 32 + (lane >> 4) * 8); acc = MFMA16(a, Cb[ks], acc); }
            const int cc = lane & 15;
#pragma unroll
            for (int j = 0; j < 4; ++j) { const int st = (lane >> 4) * 4 + j; const int tl = blk * 16 + st;
                const float y = acc[j] + dskip * Uw[tl * 16 + cc];
                c.YS5[(rbase + sub * 64 + tl) * 512 + g * 16 + cc] = f2bf(gelu_t(y)); }
            WAVE_FENCE();
        }
    }
    { const size_t si = (((size_t)L * NB + b) * 32 + g) * 64 + lane; c.out[O_S5RE_P + si] = hr; c.out[O_S5IM_P + si] = hi; }
}

constexpr int S5Q_BASE = 122880, S5Q_F = S5Q_BASE + 32768, S5Q_FLAG = S5Q_F + 2048;
template <int PASS> DI void s5_steps16(const S5P& P, const LAS float* Ublk, LAS bf16_t* Hw, int lane, float& hr, float& hi) {
#pragma unroll
    for (int s4 = 0; s4 < 4; ++s4) {
        f32x4 uv[4][4];
#pragma unroll
        for (int j = 0; j < 4; ++j)
#pragma unroll
            for (int q4 = 0; q4 < 4; ++q4) uv[j][q4] = *(const LAS f32x4*)(Ublk + (s4 * 4 + j) * 16 + q4 * 4);
        asm volatile("" ::: "memory");
        f32x2 bu[4];
#pragma unroll
        for (int j = 0; j < 4; ++j) { f32x2 acc[4];
#pragma unroll
            for (int q4 = 0; q4 < 4; ++q4) { acc[q4] = P.bb[4 * q4] * uv[j][q4][0];
#pragma unroll
                for (int e = 1; e < 4; ++e) acc[q4] += P.bb[4 * q4 + e] * uv[j][q4][e]; }
            bu[j] = (acc[0] + acc[1]) + (acc[2] + acc[3]); }
#pragma unroll
        for (int j = 0; j < 4; ++j) { const float nr = P.lr * hr - P.li * hi + bu[j][0], ni = P.lr * hi + P.li * hr + bu[j][1]; hr = nr; hi = ni;
            if (PASS == 1) { Hw[(s4 * 4 + j) * 128 + lane] = f2bf(hr); Hw[(s4 * 4 + j) * 128 + 64 + lane] = f2bf(hi); } }
    }
}
DI void task_s5_quad(const Ctx& c, int L, int unit, int wq, int gen) {
    unsigned char* wlds = c.lds + S5Q_BASE + wq * 8192;
    LAS float* Uw = (LAS float*)wlds;
    LAS bf16_t* Hw = (LAS bf16_t*)(wlds + 4096);
    LAS float* F = (LAS float*)(c.lds + S5Q_F);
    volatile LAS int* flag = (volatile LAS int*)(c.lds + S5Q_FLAG);
    const int lane = c.lane;
    const int g = unit & 31, b = unit >> 5;
    const S5P P = s5_params(c, L, g, lane);
    float pr_ = P.lr, pi_ = P.li;
#pragma unroll
    for (int i = 0; i < 9; ++i) { const float nr = pr_ * pr_ - pi_ * pi_, ni = 2.f * pr_ * pi_; pr_ = nr; pi_ = ni; }
    const size_t rbase = (size_t)(b * SEQ + wq * 512);
    const bf16_t* ub = c.R1 + rbase * NPROJ + PU + g * 16;
    bf16x8 Cb[4];
    { const int cc = lane & 15, kq = (lane >> 4) * 8; const float* Cre = c.in[18] + (((size_t)L * 32 + g) * 16 + cc) * 64; const float* Cim = c.in[19] + (((size_t)L * 32 + g) * 16 + cc) * 64;
#pragma unroll
      for (int ks = 0; ks < 4; ++ks) { f32x8 v;
#pragma unroll
          for (int j = 0; j < 8; ++j) { const int k = ks * 32 + kq + j; v[j] = (k < 64) ? Cre[k] : -Cim[k - 64]; }
          Cb[ks] = pack8v(v); } }
    const float dskip = c.in[20][L * 512 + g * 16 + (lane & 15)];
    float hr = 0.f, hi = 0.f;
    for (int pass = 0; pass < 2; ++pass) {
        if (pass == 1) {
            hr = 0.f; hi = 0.f;
            for (int v = 0; v < wq; ++v) { while (flag[v] != gen) __builtin_amdgcn_s_sleep(2);
                asm volatile("" ::: "memory");
                const float fr = F[v * 128 + lane], fi = F[v * 128 + 64 + lane];
                const float nr = pr_ * hr - pi_ * hi + fr, ni = pr_ * hi + pi_ * hr + fi; hr = nr; hi = ni; }
        }
        for (int sub = 0; sub < 8; ++sub) {
            WAVE_FENCE();
            { const bf16_t* up = ub + (size_t)(sub * 64 + lane) * NPROJ; const f32x8 u0 = unpack8(*(const bf16x8*)up), u1 = unpack8(*(const bf16x8*)(up + 8));
              LAS f32x4* d = (LAS f32x4*)(Uw + lane * 16);
              d[0] = (f32x4){u0[0], u0[1], u0[2], u0[3]}; d[1] = (f32x4){u0[4], u0[5], u0[6], u0[7]}; d[2] = (f32x4){u1[0], u1[1], u1[2], u1[3]}; d[3] = (f32x4){u1[4], u1[5], u1[6], u1[7]}; }
            WAVE_FENCE();
            for (int blk = 0; blk < 4; ++blk) {
                if (pass == 1) s5_steps16<1>(P, Uw + blk * 256, Hw, lane, hr, hi); else s5_steps16<0>(P, Uw + blk * 256, Hw, lane, hr, hi);
                if (pass == 1) {
                    WAVE_FENCE();
                    f32x4 acc = {0.f, 0.f, 0.f, 0.f};
#pragma unroll
                    for (int ks = 0; ks < 4; ++ks) { const bf16x8 a = *(const LAS bf16x8*)(Hw + (lane & 15) * 128 + ks * 32 + (lane >> 4) * 8); acc = MFMA16(a, Cb[ks], acc); }
                    const int cc = lane & 15;
#pragma unroll
                    for (int j = 0; j < 4; ++j) { const int st = (lane >> 4) * 4 + j; const int tl = blk * 16 + st;
                        const float y = acc[j] + dskip * Uw[tl * 16 + cc];
                        c.YS5[(rbase + sub * 64 + tl) * 512 + g * 16 + cc] = f2bf(gelu_t(y)); }
                    WAVE_FENCE();
                }
            }
        }
        if (pass == 0) {
            if (wq < 3) { F[wq * 128 + lane] = hr; F[wq * 128 + 64 + lane] = hi; WAVE_FENCE(); if (lane == 0) flag[wq] = gen; }
        }
    }
    if (wq == 3) { const size_t si = (((size_t)L * NB + b) * 32 + g) * 64 + lane; c.out[O_S5RE_P + si] = hr; c.out[O_S5IM_P + si] = hi; }
}

DI void phase_s5_scan(const Ctx& c, int L) {
    float* U = (float*)c.lds;
    bf16_t* H = (bf16_t*)(c.lds + 32768);
    float* F = (float*)(c.lds + 65536);
    const int lane = c.lane, w = c.wave;
    float* Uw = U + w * 1024; bf16_t* Hw = H + w * 2048;
    for (int unit = c.bid; unit < 256; unit += c.G) {
        const int g = unit & 31, b = unit >> 5;
        const S5P P = s5_params(c, L, g, lane);
        float pr_ = P.lr, pi_ = P.li;
#pragma unroll
        for (int i = 0; i < 8; ++i) { const float nr = pr_ * pr_ - pi_ * pi_, ni = 2.f * pr_ * pi_; pr_ = nr; pi_ = ni; }
        const size_t rbase = (size_t)(b * SEQ + w * 256);
        const bf16_t* ub = c.R1 + rbase * NPROJ + PU + g * 16;
        bf16x8 Cb[4];
        { const int cc = lane & 15, kq = (lane >> 4) * 8; const float* Cre = c.in[18] + (((size_t)L * 32 + g) * 16 + cc) * 64; const float* Cim = c.in[19] + (((size_t)L * 32 + g) * 16 + cc) * 64;
#pragma unroll
          for (int ks = 0; ks < 4; ++ks) { f32x8 v;
#pragma unroll
              for (int j = 0; j < 8; ++j) { const int k = ks * 32 + kq + j; v[j] = (k < 64) ? Cre[k] : -Cim[k - 64]; }
              Cb[ks] = pack8v(v); } }
        const float dskip = c.in[20][L * 512 + g * 16 + (lane & 15)];
        float hr = 0.f, hi = 0.f;
        for (int pass = 0; pass < 2; ++pass) {
            if (pass == 1) {
                F[w * 128 + lane] = hr; F[w * 128 + 64 + lane] = hi;
                __syncthreads();
                hr = 0.f; hi = 0.f;
                for (int v = 0; v < w; ++v) { const float fr = F[v * 128 + lane], fi = F[v * 128 + 64 + lane];
                    const float nr = pr_ * hr - pi_ * hi + fr, ni = pr_ * hi + pi_ * hr + fi; hr = nr; hi = ni; }
            }
            for (int sub = 0; sub < 4; ++sub) {
                __syncthreads();
                { const bf16_t* up = ub + (size_t)(sub * 64 + lane) * NPROJ; const f32x8 u0 = unpack8(*(const bf16x8*)up), u1 = unpack8(*(const bf16x8*)(up + 8));
                  f32x4* d = (f32x4*)(Uw + lane * 16);
                  d[0] = (f32x4){u0[0], u0[1], u0[2], u0[3]}; d[1] = (f32x4){u0[4], u0[5], u0[6], u0[7]}; d[2] = (f32x4){u1[0], u1[1], u1[2], u1[3]}; d[3] = (f32x4){u1[4], u1[5], u1[6], u1[7]}; }
                __syncthreads();
                for (int blk = 0; blk < 4; ++blk) {
#pragma unroll 4
                    for (int st = 0; st < 16; ++st) {
                        const f32x4* up4 = (const f32x4*)(Uw + (blk * 16 + st) * 16);
                        f32x2 bu = {0.f, 0.f};
#pragma unroll
                        for (int q4 = 0; q4 < 4; ++q4) { const f32x4 uv = up4[q4];
#pragma unroll
                            for (int e = 0; e < 4; ++e) bu += P.bb[4 * q4 + e] * uv[e]; }
                        const float nr = P.lr * hr - P.li * hi + bu[0], ni = P.lr * hi + P.li * hr + bu[1]; hr = nr; hi = ni;
                        if (pass == 1) { Hw[st * 128 + lane] = f2bf(hr); Hw[st * 128 + 64 + lane] = f2bf(hi); }
                    }
                    if (pass == 1) {
                        __syncthreads();
                        f32x4 acc = {0.f, 0.f, 0.f, 0.f};
#pragma unroll
                        for (int ks = 0; ks < 4; ++ks) { const bf16x8 a = *(const bf16x8*)(Hw + (lane & 15) * 128 + ks * 32 + (lane >> 4) * 8); acc = MFMA16(a, Cb[ks], acc); }
                        const int cc = lane & 15;
#pragma unroll
                        for (int j = 0; j < 4; ++j) { const int st = (lane >> 4) * 4 + j; const int tl = blk * 16 + st;
                            const float y = acc[j] + dskip * Uw[tl * 16 + cc];
                            c.YS5[(rbase + sub * 64 + tl) * 512 + g * 16 + cc] = f2bf(gelu_t(y)); }
                        __syncthreads();
                    }
                }
            }
        }
        if (w == 7) { const size_t si = (((size_t)L * NB + b) * 32 + g) * 64 + lane; c.out[O_S5RE_P + si] = hr; c.out[O_S5IM_P + si] = hi; }
        __syncthreads();
    }
}


#ifdef SELFCHK
DI void blk_reduce2(float& a, float& b, float* red, int tid) {
    a = wave_sum(a); b = wave_sum(b);
    __syncthreads();
    if ((tid & 63) == 0) { red[tid >> 6] = a; red[8 + (tid >> 6)] = b; }
    __syncthreads();
    float x = 0.f, y = 0.f;
    for (int i = 0; i < 8; ++i) { x += red[i]; y += red[8 + i]; }
    a = x; b = y; __syncthreads();
}
DI void chk_gdn(const Ctx& c, int L, int b, int h, float* dg) {
    float* q = (float*)c.lds; float* k = q + 128; float* v = k + 128; float* part = v + 128; float* red = part + 512; float* sc_ = red + 16;
    const int tid = c.tid, dv = tid & 127, qt = tid >> 7;
    const float* convw = c.in[23] + (size_t)L * 4 * 1536;
    float S[32];
#pragma unroll
    for (int i = 0; i < 32; ++i) S[i] = 0.f;
    float e2 = 0.f, r2 = 0.f;
    for (int t = 0; t < SEQ; ++t) {
        const size_t row = (size_t)b * SEQ + t;
        if (tid < 384) { const int which = tid >> 7, d = tid & 127; float a = 0.f;
            for (int j = 0; j < 4; ++j) { const int tt = t + j - 3; if (tt >= 0) a += bf2f(c.R1[((size_t)b * SEQ + tt) * NPROJ + PQ + which * 512 + h * 128 + d]) * convw[j * 1536 + which * 512 + h * 128 + d]; }
            (which == 0 ? q : which == 1 ? k : v)[d] = silu_(a); }
        __syncthreads();
        float sq = 0.f, sk = 0.f;
        for (int d = 0; d < 128; ++d) { sq += q[d] * q[d]; sk += k[d] * k[d]; }
        const float fq = rsqrtf(sq + EPS) * 0.08838834764831845f, fk = rsqrtf(sk + EPS);
        const float beta = sigm(c.SG[row * 16 + h]);
        const float g = -expf(c.in[24][L * 4 + h]) * softplus_(c.SG[row * 16 + 4 + h] + c.in[25][L * 4 + h]);
        const float eg = expf(g);
        float ks = 0.f;
#pragma unroll
        for (int i = 0; i < 32; ++i) { S[i] *= eg; ks += k[qt * 32 + i] * fk * S[i]; }
        part[qt * 128 + dv] = ks;
        __syncthreads();
        const float kS = part[dv] + part[128 + dv] + part[256 + dv] + part[384 + dv];
        const float vnew = beta * (v[dv] - kS);
        float qs = 0.f;
#pragma unroll
        for (int i = 0; i < 32; ++i) { S[i] += k[qt * 32 + i] * fk * vnew; qs += q[qt * 32 + i] * fq * S[i]; }
        __syncthreads();
        part[qt * 128 + dv] = qs;
        __syncthreads();
        if (qt == 0) { const float o = part[dv] + part[128 + dv] + part[256 + dv] + part[384 + dv];
            const float got = bf2f(c.Y3[(size_t)1 * MPAD * 512 + row * 512 + h * 128 + dv]); e2 += (got - o) * (got - o); r2 += o * o; }
        __syncthreads();
    }
    blk_reduce2(e2, r2, red, tid);
    if (tid == 0) dg[0] = sqrtf(e2 / (r2 + 1e-30f));
    float e3 = 0.f, r3 = 0.f;
#pragma unroll
    for (int i = 0; i < 32; ++i) { const float got = c.out[O_GDN_P + (((size_t)L * NB + b) * 4 + h) * 16384 + (size_t)(qt * 32 + i) * 128 + dv]; e3 += (got - S[i]) * (got - S[i]); r3 += S[i] * S[i]; }
    blk_reduce2(e3, r3, red, tid);
    if (tid == 0) dg[1] = sqrtf(e3 / (r3 + 1e-30f));
    (void)sc_;
}
DI void chk_ml(const Ctx& c, int L, int b, int h, float* dg) {
    float* q = (float*)c.lds; float* k = q + 64; float* v = k + 64; float* n = v + 128; float* part = n + 64; float* red = part + 512;
    const int tid = c.tid, e = tid & 127, qt = tid >> 7;
    float C[16];
#pragma unroll
    for (int i = 0; i < 16; ++i) C[i] = 0.f;
    if (tid < 64) n[tid] = 0.f;
    float m = 0.f, e2 = 0.f, r2 = 0.f;
    __syncthreads();
    for (int t = 0; t < SEQ; ++t) {
        const size_t row = (size_t)b * SEQ + t;
        if (tid < 64) { q[tid] = bf2f(c.R1[row * NPROJ + PMQ + h * 64 + tid]); k[tid] = bf2f(c.R1[row * NPROJ + PMK + h * 64 + tid]) * 0.125f; }
        else if (tid < 192) v[tid - 64] = bf2f(c.R1[row * NPROJ + PMV + h * 128 + tid - 64]);
        __syncthreads();
        const float li = softcap_(c.SG[row * 16 + 8 + h] + c.in[27][L * 4 + h]);
        const float lf = logsig_(softcap_(c.SG[row * 16 + 12 + h] + c.in[28][L * 4 + h]));
        const float mn = fmaxf(lf + m, li), wts = expf(li - mn), sc = expf(lf + m - mn);
        float qk = 0.f, qn = 0.f;
        for (int d = 0; d < 64; ++d) { qk += q[d] * k[d]; qn += q[d] * n[d]; }
        float pc = 0.f;
#pragma unroll
        for (int i = 0; i < 16; ++i) pc += q[qt * 16 + i] * C[i];
        part[qt * 128 + e] = pc;
        __syncthreads();
        const float qC = part[e] + part[128 + e] + part[256 + e] + part[384 + e];
        const float sqk = qk * wts, num = sqk * v[e] + sc * qC, den = sqk + sc * qn;
        const float hv = num / fmaxf(fabsf(den), expf(-mn));
        if (qt == 0) { const float got = bf2f(c.Y3[(size_t)2 * MPAD * 512 + row * 512 + h * 128 + e]); e2 += (got - hv) * (got - hv); r2 += hv * hv; }
#pragma unroll
        for (int i = 0; i < 16; ++i) C[i] = sc * C[i] + wts * k[qt * 16 + i] * v[e];
        __syncthreads();
        if (tid < 64) n[tid] = sc * n[tid] + wts * k[tid];
        m = mn;
        __syncthreads();
    }
    blk_reduce2(e2, r2, red, tid);
    if (tid == 0) dg[2] = sqrtf(e2 / (r2 + 1e-30f));
    float e3 = 0.f, r3 = 0.f;
#pragma unroll
    for (int i = 0; i < 16; ++i) { const float got = c.out[O_MLC_P + (((size_t)L * NB + b) * 4 + h) * 8192 + (size_t)(qt * 16 + i) * 128 + e]; e3 += (got - C[i]) * (got - C[i]); r3 += C[i] * C[i]; }
    if (tid < 64) { const float got = c.out[O_MLN_P + (((size_t)L * NB + b) * 4 + h) * 64 + tid]; e3 += (got - n[tid]) * (got - n[tid]) * 64.f; r3 += n[tid] * n[tid] * 64.f; }
    if (tid == 0) { const float got = c.out[O_MLM_P + ((size_t)L * NB + b) * 4 + h]; e3 += (got - m) * (got - m) * 4096.f; r3 += m * m * 4096.f; }
    blk_reduce2(e3, r3, red, tid);
    if (tid == 0) dg[3] = sqrtf(e3 / (r3 + 1e-30f));
}
DI void chk_s5(const Ctx& c, int L, int b, int g, float* dg) {
    float* red = (float*)c.lds;
    float e2 = 0.f, r2 = 0.f, e3 = 0.f, r3 = 0.f;
    if (c.tid < 64) { const int lane = c.tid; const S5P P = s5_params(c, L, g, lane);
        const float* Cre = c.in[18] + ((size_t)L * 32 + g) * 16 * 64; const float* Cim = c.in[19] + ((size_t)L * 32 + g) * 16 * 64;
        float hr = 0.f, hi = 0.f;
        for (int t = 0; t < SEQ; ++t) { const size_t row = (size_t)b * SEQ + t; const bf16_t* pr = c.R1 + row * NPROJ + PU + g * 16;
            f32x2 bu = {0.f, 0.f};
#pragma unroll
            for (int cc = 0; cc < 16; ++cc) bu += P.bb[cc] * bf2f(pr[cc]);
            const float nr = P.lr * hr - P.li * hi + bu[0], ni = P.lr * hi + P.li * hr + bu[1]; hr = nr; hi = ni;
            for (int cc = 0; cc < 16; ++cc) { float y = wave_sum(hr * Cre[cc * 64 + lane] - hi * Cim[cc * 64 + lane]) + c.in[20][L * 512 + g * 16 + cc] * bf2f(pr[cc]);
                y = gelu_t(y); const float got = bf2f(c.YS5[row * 512 + g * 16 + cc]); if (lane == 0) { e2 += (got - y) * (got - y); r2 += y * y; } } }
        const size_t si = (((size_t)L * NB + b) * 32 + g) * 64 + lane;
        e3 = (c.out[O_S5RE_P + si] - hr) * (c.out[O_S5RE_P + si] - hr) + (c.out[O_S5IM_P + si] - hi) * (c.out[O_S5IM_P + si] - hi); r3 = hr * hr + hi * hi; }
    blk_reduce2(e2, r2, red, c.tid);
    blk_reduce2(e3, r3, red, c.tid);
    if (c.tid == 0) { dg[4] = sqrtf(e2 / (r2 + 1e-30f)); dg[5] = sqrtf(e3 / (r3 + 1e-30f)); }
}
#endif


#ifdef SELFCHK
DI float dot_bf(const bf16_t* a, const bf16_t* b, int K) { float s = 0.f; for (int k = 0; k < K; ++k) s += bf2f(a[k]) * bf2f(b[k]); return s; }
DI void chk_gemm(const Ctx& c, int L, int mode, float* dgp) {
    float* red = (float*)c.lds;
    float e2 = 0.f, r2 = 0.f;
    for (int rep = 0; rep < 2; ++rep) {
        const int sidx = c.tid + 512 * rep;
        const int row = (rep == 1 && c.tid < 64) ? MP + (c.tid * 2) : (int)(((unsigned)sidx * 7919u) % (unsigned)MP);
        float want = 0.f, got = 0.f;
        if (mode == 0) { const int col = (int)(((unsigned)sidx * 104729u) % 4096u); want = dot_bf(c.XN + (size_t)row * 1024, c.W + WO_IN + (size_t)col * 1024, 1024); got = bf2f(c.R1[(size_t)row * 4096 + col]); }
        if (mode == 1) { const int col = (int)(((unsigned)sidx * 104729u) % 3072u); want = sigm(dot_bf(c.XN + (size_t)row * 1024, c.W + WO_G + (size_t)col * 1024, 1024)); got = bf2f(c.R1[(size_t)row * 4096 + col]); }
        if (mode == 2) { const int col = (int)(((unsigned)sidx * 104729u) % 512u); const float y = bf2f(c.YS5[(size_t)row * 512 + col]);
            want = y * sigm(dot_bf(c.YS5 + (size_t)row * 512, c.W + WO_GLU + (size_t)col * 512, 512) + c.in[22][L * 512 + col]); got = bf2f(c.Y3[(size_t)row * 512 + col]); }
        if (mode == 3) { const int col = (int)(((unsigned)sidx * 104729u) % 1024u);
            for (int br = 0; br < 3; ++br) want += bf2f(c.R1[(size_t)row * 4096 + br * 1024 + col]) * dot_bf(c.Y3 + (size_t)br * MPAD * 512 + (size_t)row * 512, c.W + WO_BR + (size_t)br * 1024 * 512 + (size_t)col * 512, 512);
            got = bf2f(c.XN[(size_t)row * 1024 + col]); }
        if (mode == 4) { const int col = (int)(((unsigned)sidx * 104729u) % 4096u); const float d = fmaxf(dot_bf(c.XN + (size_t)row * 1024, c.W + WO_UP + (size_t)col * 1024, 1024), 0.f); want = d * d; got = bf2f(c.R1[(size_t)row * 4096 + col]); }
        if (mode == 5) { const int col = (int)(((unsigned)sidx * 104729u) % 1024u); want = dot_bf(c.Y3 + (size_t)row * 256, c.W + WO_PLE + (size_t)col * 256, 256); got = bf2f(c.Y3[(size_t)MPAD * 256 + (size_t)row * 1024 + col]); }
        e2 += (got - want) * (got - want); r2 += want * want;
    }
    blk_reduce2(e2, r2, red, c.tid);
    if (c.tid == 0) *dgp = sqrtf(e2 / (r2 + 1e-30f));
}
#endif

#ifdef SELFCHK
DI void chk_sg(const Ctx& c, float* dgp) {
    float* red = (float*)c.lds; float e2 = 0.f, r2 = 0.f;
    { const int sidx = c.tid >> 4, s = c.tid & 15; const int row = (sidx < 8) ? MP + sidx * 13 : (int)(((unsigned)sidx * 7919u * 37u) % (unsigned)MP);
      const float* x = row < MP ? c.in[0] + (size_t)row * 1024 : c.in[1] + (size_t)(row - MP) * 1024;
      const int sc = s < 4 ? 2560 + s : s < 8 ? 2564 + (s - 4) : s < 12 ? 4104 + (s - 8) : 4108 + (s - 12);
      float ss = 0.f; for (int k = 0; k < 1024; ++k) ss += x[k] * x[k];
      const float rs = rsqrtf(ss * (1.f / 1024.f) + EPS); float a = 0.f;
      for (int k = 0; k < 1024; ++k) a += x[k] * rs * c.in[11][k] * c.in[12][(size_t)k * DIN + sc];
      const float got = c.SG[(size_t)row * 16 + s]; e2 = (got - a) * (got - a); r2 = a * a; }
    blk_reduce2(e2, r2, red, c.tid);
    if (c.tid == 0) *dgp = sqrtf(e2 / (r2 + 1e-30f));
}
DI void chk_post(const Ctx& c, int L, float* dgp) {
    float* red = (float*)c.lds; float e2 = 0.f, r2 = 0.f;
    { const int hd8 = c.tid & 7, sidx = c.tid >> 3; const int row = (sidx < 8) ? MP + sidx * 11 : (int)(((unsigned)sidx * 7919u * 53u) % (unsigned)MP);
      const int br = hd8 >> 2, hd = hd8 & 3; float ms = 0.f;
      for (int e = 0; e < 128; ++e) { const float y = bf2f(c.Y3[(size_t)(1 + br) * MPAD * 512 + (size_t)row * 512 + hd * 128 + e]);
          const float z = bf2f(c.R1[(size_t)row * NPROJ + (br == 0 ? PZ : PMO) + hd * 128 + e]);
          const float gn = br == 0 ? c.in[26][L * 128 + e] : c.in[29][L * 512 + hd * 128 + e];
          const float w = y / (gn * (br == 0 ? silu_(z) : sigm(z))); ms += w * w; }
      ms *= (1.f / 128.f); e2 = (ms - 1.f) * (ms - 1.f); r2 = 1.f; }
    blk_reduce2(e2, r2, red, c.tid);
    if (c.tid == 0) *dgp = sqrtf(e2 / (r2 + 1e-30f));
}
DI void chk_res(const Ctx& c, int L, int mode, const float (&snap)[2], float* dgp) {
    float* red = (float*)c.lds; float e2 = 0.f, r2 = 0.f;
    for (int rep = 0; rep < 2; ++rep) { const int sidx = c.tid + 512 * rep;
        const int row = (rep == 1 && c.tid < 64) ? MP + (c.tid * 2) : (int)(((unsigned)sidx * 7919u) % (unsigned)MP); const int col = (int)(((unsigned)sidx * 104729u) % 1024u);
        const float now = c.out[(size_t)row * 1024 + col]; float before = snap[rep], want = 0.f;
        if (mode == 0) { before = row < MP ? c.in[0][(size_t)row * 1024 + col] : c.in[1][(size_t)(row - MP) * 1024 + col]; want = dot_bf(c.XN + (size_t)row * 1024, c.W + WO_OUT + (size_t)col * 1024, 1024); }
        if (mode == 1) want = dot_bf(c.R1 + (size_t)row * 4096, c.W + WO_DN + (size_t)col * 4096, 4096);
        if (mode == 2) want = bf2f(c.Y3[(size_t)MPAD * 256 + (size_t)row * 1024 + col]) * sigm(dot_bf(c.XN + (size_t)row * 1024, c.W + WO_PG + (size_t)col * 1024, 1024));
        e2 += (now - before - want) * (now - before - want); r2 += want * want; }
    blk_reduce2(e2, r2, red, c.tid);
    if (c.tid == 0) *dgp = sqrtf(e2 / (r2 + 1e-30f));
}
DI void snap_x(const Ctx& c, float (&snap)[2]) {
    for (int rep = 0; rep < 2; ++rep) { const int sidx = c.tid + 512 * rep;
        const int row = (rep == 1 && c.tid < 64) ? MP + (c.tid * 2) : (int)(((unsigned)sidx * 7919u) % (unsigned)MP); const int col = (int)(((unsigned)sidx * 104729u) % 1024u);
        snap[rep] = c.out[(size_t)row * 1024 + col]; }
}
DI void chk_sample(const Ctx& c, int L, int b, int h, float* dgp) {
    float* red = (float*)c.lds; float e2 = 0.f, r2 = 0.f, e3 = 0.f, r3 = 0.f;
    const size_t row = (size_t)(MP + b); const bf16_t* pr = c.R1 + row * NPROJ;
    if (c.tid < 128) { const int dv = c.tid;
        const float* cbuf = c.in[4] + ((size_t)L * MS + b) * 3 * 1536; const float* cw = c.in[23] + (size_t)L * 4 * 1536;
        float sq = 0.f, sk = 0.f;
        for (int d = 0; d < 128; ++d) for (int w = 0; w < 2; ++w) { const int cc = w * 512 + h * 128 + d;
            const float a = silu_(cbuf[cc] * cw[cc] + cbuf[1536 + cc] * cw[1536 + cc] + cbuf[3072 + cc] * cw[3072 + cc] + bf2f(pr[PQ + cc]) * cw[4608 + cc]); if (w == 0) sq += a * a; else sk += a * a; }
        const float fq = rsqrtf(sq + EPS) * 0.08838834764831845f, fk = rsqrtf(sk + EPS);
        const int cv = 1024 + h * 128 + dv;
        const float vv = silu_(cbuf[cv] * cw[cv] + cbuf[1536 + cv] * cw[1536 + cv] + cbuf[3072 + cv] * cw[3072 + cv] + bf2f(pr[PQ + cv]) * cw[4608 + cv]);
        const float beta = sigm(c.SG[row * 16 + h]), eg = expf(-expf(c.in[24][L * 4 + h]) * softplus_(c.SG[row * 16 + 4 + h] + c.in[25][L * 4 + h]));
        const float* S0 = c.in[5] + (((size_t)L * MS + b) * 4 + h) * 16384; const float* S1 = c.out + O_GDN_S + (((size_t)L * MS + b) * 4 + h) * 16384;
        float kS = 0.f, qS = 0.f, qk = 0.f;
        for (int d = 0; d < 128; ++d) { const int cq = h * 128 + d, ck = 512 + h * 128 + d;
            const float qd = silu_(cbuf[cq] * cw[cq] + cbuf[1536 + cq] * cw[1536 + cq] + cbuf[3072 + cq] * cw[3072 + cq] + bf2f(pr[PQ + cq]) * cw[4608 + cq]) * fq;
            const float kd = silu_(cbuf[ck] * cw[ck] + cbuf[1536 + ck] * cw[1536 + ck] + cbuf[3072 + ck] * cw[3072 + ck] + bf2f(pr[PQ + ck]) * cw[4608 + ck]) * fk;
            kS += kd * S0[d * 128 + dv]; qS += qd * S0[d * 128 + dv]; qk += qd * kd; }
        const float vnew = beta * (vv - eg * kS);
        for (int d = 0; d < 128; ++d) { const int ck = 512 + h * 128 + d;
            const float kd = silu_(cbuf[ck] * cw[ck] + cbuf[1536 + ck] * cw[1536 + ck] + cbuf[3072 + ck] * cw[3072 + ck] + bf2f(pr[PQ + ck]) * cw[4608 + ck]) * fk;
            const float want = S0[d * 128 + dv] * eg + kd * vnew, got = S1[d * 128 + dv]; e2 += (got - want) * (got - want); r2 += want * want; }
        (void)qS; (void)qk;
    } else if (c.tid < 256) { const int e = c.tid - 128;
        const size_t sidx = ((size_t)L * MS + b) * 4 + h;
        const float li = softcap_(c.SG[row * 16 + 8 + h] + c.in[27][L * 4 + h]), lf = logsig_(softcap_(c.SG[row * 16 + 12 + h] + c.in[28][L * 4 + h]));
        const float m0 = c.in[8][sidx], mt = fmaxf(lf + m0, li), wts = expf(li - mt), sc = expf(lf + m0 - mt);
        const float v = bf2f(pr[PMV + h * 128 + e]);
        for (int d = 0; d < 64; ++d) { const float k = bf2f(pr[PMK + h * 64 + d]) * 0.125f;
            const float want = sc * c.in[6][sidx * 8192 + d * 128 + e] + wts * k * v, got = c.out[O_MLC_S + sidx * 8192 + d * 128 + e]; e3 += (got - want) * (got - want); r3 += want * want; }
        if (e < 64) { const float k = bf2f(pr[PMK + h * 64 + e]) * 0.125f; const float want = sc * c.in[7][sidx * 64 + e] + wts * k, got = c.out[O_MLN_S + sidx * 64 + e]; e3 += 64.f * (got - want) * (got - want); r3 += 64.f * want * want; }
        if (e == 0) { const float got = c.out[O_MLM_S + sidx]; e3 += 4096.f * (got - mt) * (got - mt); r3 += 4096.f * mt * mt; }
    }
    blk_reduce2(e2, r2, red, c.tid);
    blk_reduce2(e3, r3, red, c.tid);
    if (c.tid == 0) { dgp[0] = sqrtf(e2 / (r2 + 1e-30f)); dgp[1] = sqrtf(e3 / (r3 + 1e-30f)); }
}
#endif
DI void phase_conv_state(const Ctx& c, int L) {
    for (int idx = c.bid * 512 + c.tid; idx < NB * 3 * 1536; idx += c.G * 512) { const int cc = idx % 1536, j = (idx / 1536) % 3, b = idx / (3 * 1536);
        c.out[O_CONV_P + ((size_t)L * NB + b) * 3 * 1536 + j * 1536 + cc] = bf2f(c.R1[(size_t)(b * SEQ + SEQ - 3 + j) * NPROJ + PQ + cc]); }
}
DI void phase_post(const Ctx& c, int L) {
    const int lane = c.lane, hd = lane >> 4, e0 = (lane & 15) * 8;
    bf16_t* yg = c.Y3 + (size_t)1 * MPAD * 512; bf16_t* ym = c.Y3 + (size_t)2 * MPAD * 512;
    const float* gg = c.in[26] + (size_t)L * 128 + e0; const float* gm = c.in[29] + (size_t)L * 512 + hd * 128 + e0;
    for (int row = c.bid * 8 + c.wave; row < MR; row += c.G * 8) {
        const bf16_t* pr = c.R1 + (size_t)row * NPROJ;
#pragma unroll
        for (int br = 0; br < 2; ++br) {
            bf16_t* yp = (br == 0 ? yg : ym) + (size_t)row * 512 + hd * 128 + e0;
            f32x8 o = unpack8(*(const bf16x8*)yp); const f32x8 z = unpack8(*(const bf16x8*)(pr + (br == 0 ? PZ : PMO) + hd * 128 + e0));
            float ss = 0.f;
#pragma unroll
            for (int e = 0; e < 8; ++e) ss += o[e] * o[e];
            ss += __shfl_xor(ss, 1); ss += __shfl_xor(ss, 2); ss += __shfl_xor(ss, 4); ss += __shfl_xor(ss, 8);
            const float rs = rsqrtf(ss * (1.f / 128.f) + EPS);
            const float* gp = br == 0 ? gg : gm;
#pragma unroll
            for (int e = 0; e < 8; ++e) o[e] = o[e] * rs * gp[e] * (br == 0 ? silu_(z[e]) : sigm(z[e]));
            *(bf16x8*)yp = pack8v(o);
        }
    }
}

DI void phase_cvt_ple(const Ctx& c, int L) {
    bf16_t* PB = c.Y3;
    for (size_t i = (size_t)c.bid * 512 + c.tid; i < (size_t)MR * 64; i += (size_t)c.G * 512) {
        const size_t row = i >> 6, c4 = (i & 63) * 4;
        const float* src = row < MP ? c.in[9] + ((size_t)L * MP + row) * 256 + c4 : c.in[10] + ((size_t)L * MS + (row - MP)) * 256 + c4;
        *(s16x4*)(PB + row * 256 + c4) = pack4v(*(const f32x4*)src); }
}
DI void phase_final_norm(const Ctx& c) {
    const float* gain = c.in[39];
    for (int row = c.bid * 8 + c.wave; row < MR; row += c.G * 8) {
        float* xp = c.out + (size_t)row * 1024; f32x4 x[4]; float ss = 0.f;
#pragma unroll
        for (int i = 0; i < 4; ++i) { x[i] = *(const f32x4*)(xp + c.lane * 4 + 256 * i); ss += x[i][0] * x[i][0] + x[i][1] * x[i][1] + x[i][2] * x[i][2] + x[i][3] * x[i][3]; }
        ss = wave_sum(ss); const float rs = rsqrtf(ss * (1.f / 1024.f) + EPS);
#pragma unroll
        for (int i = 0; i < 4; ++i) { const f32x4 g = *(const f32x4*)(gain + c.lane * 4 + 256 * i); *(f32x4*)(xp + c.lane * 4 + 256 * i) = x[i] * rs * g; }
    }
}

#define XB_TMO      128
#define XB_XCNT(j)  (256  + 64 * (j))
#define XB_XSUB(j)  (1280 + 64 * (j))
#define XB_XGEN(j)  (2304 + 64 * (j))
#define XB_TOP      3328
#define XB_TOPGEN   3392
#define XCD_BAR_WORDS 3456
#define XB_SPIN_CAP (1u << 18)

__device__ __forceinline__ unsigned xb_ld(unsigned* p)              { return __hip_atomic_load(p, __ATOMIC_RELAXED, __HIP_MEMORY_SCOPE_AGENT); }
__device__ __forceinline__ unsigned xb_add(unsigned* p, unsigned v) { return __hip_atomic_fetch_add(p, v, __ATOMIC_RELAXED, __HIP_MEMORY_SCOPE_AGENT); }
__device__ __forceinline__ unsigned xb_xcc_id() { return (unsigned)__builtin_amdgcn_s_getreg((3 << 11) | 20) & 0xFu; }
#define XB_SPIN(cond, bar) do { unsigned _sp = 0; while (cond) { __builtin_amdgcn_s_sleep(1); \
    if ((++_sp & 255u) == 0u) { if (xb_ld(&(bar)[XB_TMO])) break; if (_sp > XB_SPIN_CAP) { atomicAdd(&(bar)[XB_TMO], 1u); break; } } } } while (0)

struct XcdBarrier {
    unsigned* bar; unsigned x;
    volatile LAS unsigned* st;
};

__device__ __forceinline__ XcdBarrier xcd_barrier_post(unsigned* bar, volatile LAS unsigned* st) {
    XcdBarrier b; b.bar = bar; b.x = xb_xcc_id(); b.st = st;
    if (threadIdx.x == 0) (void)xb_add(&bar[XB_XCNT(b.x)], 1u);
    return b;
}
__device__ __forceinline__ void xcd_barrier_complete(unsigned* bar, unsigned x, unsigned& nloc, unsigned& nx) {
    const unsigned G = gridDim.x * gridDim.y * gridDim.z;
    unsigned sum, cnt, mine, sp = 0u;
    for (;;) {
        sum = 0u; cnt = 0u; mine = 0u;
#pragma unroll
        for (unsigned j = 0; j < 16; ++j) { const unsigned c = xb_ld(&bar[XB_XCNT(j)]); sum += c; cnt += (c > 0u) ? 1u : 0u; mine = (j == x) ? c : mine; }
        if (sum == G) break;
        __builtin_amdgcn_s_sleep(1);
        if ((++sp & 255u) == 0u) { if (xb_ld(&bar[XB_TMO])) break; if (sp > XB_SPIN_CAP) { atomicAdd(&bar[XB_TMO], 1u); break; } }
    }
    nloc = mine > 0u ? mine : 1u; nx = cnt > 0u ? cnt : 1u;
}

__device__ __forceinline__ void xcd_barrier(const XcdBarrier& b) {
    asm volatile("s_waitcnt vmcnt(0)" ::: "memory");
    __syncthreads();
    if (threadIdx.x == 0) {
        unsigned* bar = b.bar;
        __builtin_amdgcn_s_waitcnt(0);
        unsigned nloc = b.st[0], nx = b.st[1];
        if (nloc == 0u) { xcd_barrier_complete(bar, b.x, nloc, nx); b.st[0] = nloc; b.st[1] = nx; }
        const unsigned old = xb_add(&bar[XB_XSUB(b.x)], 1u);
        const unsigned gen = old / nloc;
        if (old + 1u == (gen + 1u) * nloc) {
            __builtin_amdgcn_fence(__ATOMIC_RELEASE, "agent");
            asm volatile("s_waitcnt vmcnt(0)" ::: "memory");
            const unsigned og = xb_add(&bar[XB_TOP], 1u);
            const unsigned tg = og / nx;
            if (og + 1u == (tg + 1u) * nx) xb_add(&bar[XB_TOPGEN], 1u);
            else XB_SPIN(xb_ld(&bar[XB_TOPGEN]) == tg, bar);
            __builtin_amdgcn_fence(__ATOMIC_ACQUIRE, "agent");
            xb_add(&bar[XB_XGEN(b.x)], 1u);
            asm volatile("s_waitcnt vmcnt(0)" ::: "memory");
        } else {
            XB_SPIN(xb_ld(&bar[XB_XGEN(b.x)]) == gen, bar);
            __builtin_amdgcn_fence(__ATOMIC_ACQUIRE, "agent");
            asm volatile("s_waitcnt vmcnt(0)" ::: "memory");
        }
    }
    __syncthreads();
}

__global__ void __launch_bounds__(512, 2) fwd_megakernel(KP kp) {
    extern __shared__ __attribute__((aligned(16))) unsigned char lds[];
    cg::grid_group grid = cg::this_grid();
    Ctx c; c.lds = lds; c.G = gridDim.x; c.bid = blockIdx.x;
    const ka_t ka0 = (ka_t)__builtin_amdgcn_kernarg_segment_ptr();
    (void)kp;
#define REFRESH() do { ka_t ka_ = ka0; asm volatile("" : "+s"(ka_)); int t_ = threadIdx.x; asm volatile("" : "+v"(t_)); \
        c.in.ka = ka_; c.out = (float*)(gfloat_t*)ka_[40]; unsigned char* w_ = (unsigned char*)(guchar_t*)ka_[41]; c.ws = w_; \
        c.R1 = (bf16_t*)(w_ + WS_R1); c.XN = (bf16_t*)(w_ + WS_XN); c.Y3 = (bf16_t*)(w_ + WS_Y3); c.W = (bf16_t*)(w_ + WS_W); c.YS5 = (bf16_t*)(w_ + WS_YS5); \
        c.GS = w_ + WS_GS; c.SG = (float*)(w_ + WS_SG); c.GL = (float*)(w_ + WS_GL); \
        c.tid = t_; c.lane = t_ & 63; c.wave = __builtin_amdgcn_readfirstlane(t_ >> 6); \
        int b_ = blockIdx.x, g_ = gridDim.x; asm volatile("" : "+s"(b_), "+s"(g_)); c.bid = b_; c.G = g_; } while (0)
    REFRESH();
    volatile LAS unsigned* bst = (volatile LAS unsigned*)(lds + LDS_BYTES - 16);
    if (c.tid < 4) bst[c.tid] = 0u;
    if (c.tid < 16) ((volatile LAS int*)(lds + S5Q_FLAG))[c.tid] = 0;
    __syncthreads();
    XcdBarrier xbar = xcd_barrier_post((unsigned*)(c.ws + WS_BAR), bst);
    int nsync_ = 0;
#ifndef PHMASK
#define PHMASK 0xFFFFFFFFu
#endif
#define PH(n) if (PHMASK & (1 << (n)))
#ifdef DUP_SYNC
#define GSYNC() do { grid.sync(); grid.sync(); } while (0)
#else
#define GSYNC() do { if (nsync_++ == 0) grid.sync(); else xcd_barrier(xbar); } while (0)
#endif
    for (int L = 0; L < 2; ++L) {
        REFRESH(); PH(0) phase_weights(c, L);
        REFRESH(); PH(1) phase_rmsnorm<0>(c, L);
        GSYNC();
        REFRESH(); PH(2) run_gemm(c, c.XN, c.W + WO_IN, NPROJ, 1024, FStore{c.R1, NPROJ});
#ifdef DUP_GEMM
        REFRESH(); PH(2) run_gemm(c, c.XN, c.W + WO_IN, NPROJ, 1024, FStore{c.R1, NPROJ});
#endif
        GSYNC();
#ifdef DUP_MIX
        for (int rep_ = 0; rep_ < 2; ++rep_) {
#else
        {
#endif
        REFRESH(); phase_conv_state(c, L);
        REFRESH(); for (int it = c.bid * 8 + c.wave; it < 1024; it += c.G * 8) task_ml_gates(c, L, it);
        REFRESH(); PH(3) phase_gdn_prep(c, L);
#ifdef DUP_PREP
        REFRESH(); PH(3) phase_gdn_prep(c, L);
#endif
#ifdef DUP_S5
#endif
        GSYNC();
#ifdef DUP_P4
        for (int rep4_ = 0; rep4_ < 2; ++rep4_) {
#else
        {
#endif
        if (c.wave == 0) {
            for (int u = c.bid; u < 256; u += c.G) { REFRESH(); if (u < 128) { PH(5) task_gdn_seq(c, L, u);
#ifdef DUP_GSEQ
                REFRESH(); task_gdn_seq(c, L, u);
#endif
              } else { PH(6) task_ml_seq(c, L, u - 128, (float*)lds);
#ifdef DUP_MSEQ
                REFRESH(); task_ml_seq(c, L, u - 128, (float*)lds);
#endif
              } }
        } else if (c.wave <= 4) {
            int it_ = 0;
            for (int u = c.bid; u < 256; u += c.G, ++it_) { REFRESH(); PH(4) task_s5_quad(c, L, u, c.wave - 1, L * 16 + it_ + 1); }
        } else {
            const int wid = c.bid * 3 + (c.wave - 5), nw = c.G * 3;
            REFRESH(); PH(7) for (int u = wid; u < 1024; u += nw) task_gdn_sample(c, L, u);
            REFRESH(); PH(8) for (int u = wid; u < 1024; u += nw) task_ml_sample(c, L, u);
            REFRESH(); PH(9) for (int u = wid; u < 4096; u += nw) task_s5_sample(c, L, u);
        }
        GSYNC();
        }
        }
#ifdef SELFCHK
        if (L == SELFCHK_L) { REFRESH(); if (c.bid == 0) { float* dg = (float*)(c.ws + WS_GL) + 1024; chk_gdn(c, L, 1, 2, dg); chk_ml(c, L, 1, 2, dg); chk_s5(c, L, 1, 7, dg); chk_gemm(c, L, 0, dg + 6); if (L == 0) chk_sg(c, dg + 12); chk_sample(c, L, 5, 1, dg + 17); } grid.sync(); }
#endif
        REFRESH(); PH(10) phase_post(c, L);
        REFRESH(); PH(11) run_gemm(c, c.XN, c.W + WO_G, NGATE, 1024, FSig{c.R1, NPROJ});
#ifdef DUP_GEMM
        REFRESH(); PH(11) run_gemm(c, c.XN, c.W + WO_G, NGATE, 1024, FSig{c.R1, NPROJ});
#endif
        REFRESH(); PH(12) run_gemm(c, c.YS5, c.W + WO_GLU, 512, 512, FGlu{c.YS5, c.in[22] + (size_t)L * 512, c.Y3});
#ifdef DUP_GEMM
        REFRESH(); PH(12) run_gemm(c, c.YS5, c.W + WO_GLU, 512, 512, FGlu{c.YS5, c.in[22] + (size_t)L * 512, c.Y3});
#endif
        GSYNC();
#ifdef SELFCHK
        if (L == SELFCHK_L) { REFRESH(); if (c.bid == 0) { float* dg = (float*)(c.ws + WS_GL) + 1024; chk_gemm(c, L, 1, dg + 7); chk_gemm(c, L, 2, dg + 8); chk_post(c, L, dg + 13); } grid.sync(); }
#endif
        REFRESH(); PH(13) for (int br = 0; br < 3; ++br)
            run_gemm(c, c.Y3 + (size_t)br * MPAD * 512, c.W + WO_BR + (size_t)br * 1024 * 512, 1024, 512, FBranch{c.R1 + br * 1024, c.XN, br == 0 ? 1 : 0});
#ifdef DUP_GEMM
        REFRESH(); PH(13) for (int br = 0; br < 3; ++br)
            run_gemm(c, c.Y3 + (size_t)br * MPAD * 512, c.W + WO_BR + (size_t)br * 1024 * 512, 1024, 512, FBranch{c.R1 + br * 1024, c.XN, br == 0 ? 1 : 0});
#endif
        GSYNC();
#ifdef SELFCHK
        if (L == SELFCHK_L) { REFRESH(); if (c.bid == 0) { float* dg = (float*)(c.ws + WS_GL) + 1024; chk_gemm(c, L, 3, dg + 9); } grid.sync(); }
#endif
        REFRESH(); PH(14) run_gemm(c, c.XN, c.W + WO_OUT, 1024, 1024, FRes{c.out});
        GSYNC();
#ifdef SELFCHK
        if (L == 0 && SELFCHK_L == 0) { REFRESH(); if (c.bid == 0) { float* dg = (float*)(c.ws + WS_GL) + 1024; float sn[2] = {0.f, 0.f}; chk_res(c, L, 0, sn, dg + 14); } grid.sync(); }
#endif
        REFRESH(); PH(15) phase_rmsnorm<1>(c, L);
        REFRESH(); PH(18) phase_cvt_ple(c, L);
        GSYNC();
        REFRESH(); PH(16) run_gemm(c, c.XN, c.W + WO_UP, DFF, 1024, FRelu2{c.R1});
#ifdef DUP_GEMM
        REFRESH(); PH(16) run_gemm(c, c.XN, c.W + WO_UP, DFF, 1024, FRelu2{c.R1});
#endif
        GSYNC();
#ifdef SELFCHK
        if (L == SELFCHK_L) { REFRESH(); if (c.bid == 0) { float* dg = (float*)(c.ws + WS_GL) + 1024; chk_gemm(c, L, 4, dg + 10); } grid.sync(); }
#endif
#ifdef SELFCHK
        float snp[2] = {0.f, 0.f}; REFRESH(); if (L == SELFCHK_L && c.bid == 0) snap_x(c, snp);
#endif
        REFRESH(); PH(17) run_gemm(c, c.R1, c.W + WO_DN, 1024, 4096, FResB{c.out, c.XN});
        GSYNC();
#ifdef SELFCHK
        if (L == SELFCHK_L) { REFRESH(); if (c.bid == 0) { float* dg = (float*)(c.ws + WS_GL) + 1024; chk_res(c, L, 1, snp, dg + 15); } grid.sync(); }
#endif
#ifdef SELFCHK
        REFRESH(); if (L == SELFCHK_L && c.bid == 0) snap_x(c, snp);
#endif
        REFRESH(); PH(19) run_gemm(c, c.Y3, c.W + WO_PLE, 1024, 256, FStore{c.Y3 + (size_t)MPAD * 256, 1024});
#ifdef DUP_GEMM
        REFRESH(); PH(19) run_gemm(c, c.Y3, c.W + WO_PLE, 1024, 256, FStore{c.Y3 + (size_t)MPAD * 256, 1024});
#endif
        REFRESH(); PH(20) run_gemm(c, c.XN, c.W + WO_PG, 1024, 1024, FPle{c.Y3 + (size_t)MPAD * 256, c.out});
        GSYNC();
#ifdef SELFCHK
        if (L == SELFCHK_L) { REFRESH(); if (c.bid == 0) { float* dg = (float*)(c.ws + WS_GL) + 1024; chk_gemm(c, L, 5, dg + 11); chk_res(c, L, 2, snp, dg + 16); } grid.sync(); }
#endif
    }
    REFRESH(); phase_final_norm(c);
#ifdef SELFCHK
    grid.sync(); REFRESH();
    if (c.bid == 0 && c.tid == 0) { const float* dg = (const float*)(c.ws + WS_GL) + 1024; int kk = -1; float dv = 0.f;
        for (int i = 18; i >= 0; --i) if (dg[i] > SELFCHK_THR) { kk = i; dv = dg[i]; }
        if (kk >= 0) c.out[0] = __powf(10.f, (float)(2 * kk + 4)) * (1.f + fminf(dv, 8.f)); }
#endif
}

extern "C" void kernel_launch(void* const* d_in, const int* in_sizes, int n_in, void* d_out, int out_size, void* d_ws, size_t ws_size, hipStream_t stream) {
    static int grid = 0;
    if (grid == 0) {
        int dev = 0, cus = 0, per_cu = 0;
        if (hipGetDevice(&dev) != hipSuccess || hipDeviceGetAttribute(&cus, hipDeviceAttributeMultiprocessorCount, dev) != hipSuccess) { fprintf(stderr, "kernel_launch: device query failed\n"); grid = -1; return; }
        if (hipFuncSetAttribute((const void*)fwd_megakernel, hipFuncAttributeMaxDynamicSharedMemorySize, LDS_BYTES) != hipSuccess) { fprintf(stderr, "kernel_launch: hipFuncSetAttribute failed\n"); grid = -1; return; }
        if (hipOccupancyMaxActiveBlocksPerMultiprocessor(&per_cu, (const void*)fwd_megakernel, 512, LDS_BYTES) != hipSuccess || per_cu < 1) { fprintf(stderr, "kernel_launch: occupancy query says %d blocks per CU\n", per_cu); grid = -1; return; }
        grid = cus;
        if (grid > 256) grid = 256;
    }
    if (grid < 0) return;
    if (n_in != 40 || (size_t)out_size != O_TOTAL || ws_size < WS_END) { fprintf(stderr, "kernel_launch: unexpected sizes n_in %d out %d ws %zu (need %zu)\n", n_in, out_size, ws_size, (size_t)WS_END); return; }
    if (hipMemsetAsync((char*)d_ws + WS_BAR, 0, SZ_BAR, stream) != hipSuccess) { fprintf(stderr, "kernel_launch: memset failed\n"); return; }
    KP kp{};
    for (int i = 0; i < 40; ++i) kp.in[i] = (const float*)d_in[i];
    kp.out = (float*)d_out; kp.ws = (unsigned char*)d_ws;
    void* args[] = {&kp};
    hipError_t e = hipLaunchCooperativeKernel((const void*)fwd_megakernel, dim3(grid), dim3(512), args, LDS_BYTES, stream);
    if (e != hipSuccess) fprintf(stderr, "kernel_launch: cooperative launch failed: %s (grid %d)\n", hipGetErrorString(e), grid);
}
```

```cpp
#include <hip/hip_runtime.h>
#include <hip/hip_cooperative_groups.h>
#include <cstdio>
namespace cg = cooperative_groups;
namespace pg8 {
#define PG8_LAS __attribute__((address_space(3)))
typedef unsigned short bf16_t;
typedef short bf16x8 __attribute__((ext_vector_type(8)));
typedef float f32x4 __attribute__((ext_vector_type(4)));
typedef unsigned u32x4 __attribute__((ext_vector_type(4)));
constexpr int BM = 256, BK = 64, HALF = 128, HTB = HALF * BK * 2  , STAGE_BYTES = 8 * HTB, NXCD = 8, WGM = 8;

__host__ __device__ __forceinline__ int lds_byte(int r, int c) { const int st = (r >> 4) * 2 + (c >> 5), rr = r & 15, cc = c & 31, ob = rr * 64 + cc * 2; return st * 1024 + (ob ^ (((ob >> 9) & 1) << 5)); }
__host__ __device__ __forceinline__ void stage_rc(int b, int& R, int& C) { const int st = b / 1024, sb = b % 1024, swz = sb ^ (((sb >> 9) & 1) << 5); R = (st >> 1) * 16 + swz / 64; C = (st & 1) * 32 + (swz % 64) / 2; }
__host__ __device__ __forceinline__ int perm32(int rho) { const int n = rho >> 4, i = rho & 15; return 8 * (i >> 2) + 4 * n + (i & 3); }

struct Unit { int pm, pn; };
struct Gemm { const bf16_t* A; const bf16_t* Bt; int M, N, K; };

struct StaticOrder {
    int nM, nN, nwg, G, c;
    __host__ __device__ void init(int M, int N, int G_, int c_) { nM = M / BM; nN = N / BM; nwg = nM * nN; G = G_; c = c_; }
    __host__ __device__ bool next(int i, Unit& u) const {
        const long L = (long)i * G + c; if (L >= nwg) return false;
        int wgid = (int)L; { const int q = nwg / NXCD, r = nwg % NXCD, xcd = wgid % NXCD, off = wgid / NXCD; wgid = (xcd < r ? xcd * (q + 1) : r * (q + 1) + (xcd - r) * q) + off; }
        const int nig = WGM * nN, gid = wgid / nig, fm = gid * WGM, gsz = (nM - fm) < WGM ? (nM - fm) : WGM;
        u.pm = fm + ((wgid % nig) % gsz); u.pn = (wgid % nig) / gsz; return true;
    }
    __device__ __forceinline__ void a_ready(const Unit&) const {}
    __device__ __forceinline__ void done(const Unit&) const {}
};

template <class Epi, class Sched, bool STAMP = false>
__device__ __forceinline__ void gemm_phase(PG8_LAS unsigned char* lds, const Gemm g, const Sched& S, const Epi& E, unsigned long long* stamps) {
    int tid_ = threadIdx.x; asm volatile("" : "+v"(tid_));
    const int tid = tid_, wid = __builtin_amdgcn_readfirstlane(tid >> 6), lane = tid & 63, wr = wid >> 2, wc = wid & 3, fr = lane & 15, fq = lane >> 4;
    const int K = g.K, nt = K / BK;
    unsigned voffA[2], voffB[2];
#pragma unroll
    for (int i = 0; i < 2; ++i) { int R, C; stage_rc(tid * 16 + i * 8192, R, C); const int Rb = Epi::PERM ? ((R & ~31) + perm32(R & 31)) : R;
        voffA[i] = (unsigned)(R * K + C) * 2u; voffB[i] = (unsigned)(Rb * K + C) * 2u; }
    const size_t kstep = (size_t)(BK * 2);
    const size_t hstep = (size_t)HALF * K * 2;
    const size_t tstep = 2 * hstep;
    const unsigned ldsw = (unsigned)wid * 1024u;
    const int aoff = lds_byte(wr * 64 + fr, fq * 8), boff = lds_byte(wc * 32 + fr, fq * 8);
#define PG8_SA(b, h) (((b) * 2 + (h)) * HTB)
#define PG8_SB(b, h) ((4 + (b) * 2 + (h)) * HTB)
#define PG8_STAGE(bufoff, gbase, voff) do { _Pragma("unroll") for (int _i = 0; _i < 2; ++_i) \
        __builtin_amdgcn_global_load_lds((const unsigned*)((const char*)(gbase) + (voff)[_i]), (PG8_LAS unsigned*)(lds + (bufoff) + ldsw + _i * 8192), 16, 0, 0); } while (0)
#define PG8_LDA(dst, b, h) do { _Pragma("unroll") for (int m = 0; m < 4; ++m) _Pragma("unroll") for (int k = 0; k < 2; ++k) dst[m][k] = *(const PG8_LAS bf16x8*)(lds + PG8_SA(b, h) + aoff + m * 2048 + k * 1024); } while (0)
#define PG8_LDB(dst, b, h) do { _Pragma("unroll") for (int n = 0; n < 2; ++n) _Pragma("unroll") for (int k = 0; k < 2; ++k) dst[n][k] = *(const PG8_LAS bf16x8*)(lds + PG8_SB(b, h) + boff + n * 2048 + k * 1024); } while (0)
#define PG8_MMA(ai, bj, At, Bt) do { __builtin_amdgcn_s_setprio(1); _Pragma("unroll") for (int m = 0; m < 4; ++m) _Pragma("unroll") for (int n = 0; n < 2; ++n) _Pragma("unroll") for (int k = 0; k < 2; ++k) \
        acc[ai][bj][m][n] = __builtin_amdgcn_mfma_f32_16x16x32_bf16(Bt[n][k], At[m][k], acc[ai][bj][m][n], 0, 0, 0); __builtin_amdgcn_s_setprio(0); } while (0)
#define PG8_WAIT_V(n) asm volatile("s_waitcnt vmcnt(" #n ")" ::: "memory")
#define PG8_WAIT_L(n) asm volatile("s_waitcnt lgkmcnt(" #n ")" ::: "memory")
#define PG8_BAR __builtin_amdgcn_s_barrier()
#define PG8_SCHED __builtin_amdgcn_sched_barrier(0)
    Unit cur, nxt; int ui = 0;
    if (!S.next(0, cur)) return;
    f32x4 acc[2][2][4][2];
#pragma unroll
    for (int a = 0; a < 2; ++a)
#pragma unroll
        for (int b = 0; b < 2; ++b)
#pragma unroll
            for (int m = 0; m < 4; ++m)
#pragma unroll
                for (int n = 0; n < 2; ++n) acc[a][b][m][n] = (f32x4){0.f, 0.f, 0.f, 0.f};
    bf16x8 At[4][2], B0[2][2], B1[2][2];
    const char* cA = (const char*)g.A + (size_t)cur.pm * tstep; const char* cB = (const char*)g.Bt + (size_t)cur.pn * tstep;
    S.a_ready(cur);
    PG8_STAGE(PG8_SB(0, 0), cB, voffB); PG8_STAGE(PG8_SA(0, 0), cA, voffA); PG8_STAGE(PG8_SB(0, 1), cB + hstep, voffB); PG8_STAGE(PG8_SA(0, 1), cA + hstep, voffA);
    if (wr == 1) PG8_BAR;
    PG8_WAIT_V(4); PG8_BAR;
    PG8_STAGE(PG8_SB(1, 0), cB + kstep, voffB); PG8_STAGE(PG8_SA(1, 0), cA + kstep, voffA); PG8_STAGE(PG8_SB(1, 1), cB + hstep + kstep, voffB);
    PG8_WAIT_V(6); PG8_BAR;
    for (;;) {
        const bool has_next = S.next(ui + 1, nxt);
        const char* nA = has_next ? (const char*)g.A + (size_t)nxt.pm * tstep : cA; const char* nB = has_next ? (const char*)g.Bt + (size_t)nxt.pn * tstep : cB;
        for (int t = 0; t < nt; t += 2) {
            const bool last = (t == nt - 2);
            const char* a1 = cA + (size_t)(t + 1) * kstep;
            const char* a2 = last ? nA : cA + (size_t)(t + 2) * kstep; const char* b2 = last ? nB : cB + (size_t)(t + 2) * kstep;
            const char* a3 = a2 + kstep; const char* b3 = b2 + kstep;
            if (last && has_next) S.a_ready(nxt);
            PG8_LDB(B0, 0, 0); PG8_SCHED; PG8_LDA(At, 0, 0); PG8_STAGE(PG8_SA(1, 1), a1 + hstep, voffA);
            PG8_WAIT_L(8); PG8_BAR; PG8_WAIT_L(0); PG8_MMA(0, 0, At, B0); PG8_BAR; PG8_SCHED;
            PG8_LDB(B1, 0, 1); PG8_STAGE(PG8_SB(0, 0), b2, voffB);
            PG8_BAR; PG8_WAIT_L(0); PG8_MMA(0, 1, At, B1); PG8_BAR;
            PG8_LDA(At, 0, 1); PG8_STAGE(PG8_SA(0, 0), a2, voffA);
            PG8_BAR; PG8_WAIT_L(0); PG8_MMA(1, 0, At, B0); PG8_BAR; PG8_SCHED;
            PG8_STAGE(PG8_SB(0, 1), b2 + hstep, voffB);
            PG8_WAIT_V(6); PG8_BAR; PG8_MMA(1, 1, At, B1); PG8_BAR;
            PG8_LDB(B0, 1, 0); PG8_SCHED; PG8_LDA(At, 1, 0); PG8_STAGE(PG8_SA(0, 1), a2 + hstep, voffA);
            PG8_WAIT_L(8); PG8_BAR; PG8_WAIT_L(0); PG8_MMA(0, 0, At, B0); PG8_BAR; PG8_SCHED;
            PG8_LDB(B1, 1, 1); PG8_STAGE(PG8_SB(1, 0), b3, voffB);
            PG8_BAR; PG8_WAIT_L(0); PG8_MMA(0, 1, At, B1); PG8_BAR;
            PG8_LDA(At, 1, 1); PG8_STAGE(PG8_SA(1, 0), a3, voffA);
            PG8_BAR; PG8_WAIT_L(0); PG8_MMA(1, 0, At, B0); PG8_BAR; PG8_SCHED;
            PG8_STAGE(PG8_SB(1, 1), b3 + hstep, voffB);
            PG8_WAIT_V(6); PG8_BAR; PG8_MMA(1, 1, At, B1); PG8_BAR;
        }
        if constexpr (!Epi::AFTER_DRAIN) { E(acc, cur, wr, wc, fr, fq); S.done(cur); }
        if (!has_next) break;
#pragma unroll
        for (int a = 0; a < 2; ++a)
#pragma unroll
            for (int b = 0; b < 2; ++b)
#pragma unroll
                for (int m = 0; m < 4; ++m)
#pragma unroll
                    for (int n = 0; n < 2; ++n) acc[a][b][m][n] = (f32x4){0.f, 0.f, 0.f, 0.f};
        cur = nxt; cA = nA; cB = nB; ++ui;
    }
    PG8_WAIT_V(0);
    if (wr == 0) PG8_BAR;
    PG8_BAR;
    if constexpr (Epi::AFTER_DRAIN) { E.fused(acc, cur, wr, wc, fr, fq, lds, wid, lane); S.done(cur); }
#undef PG8_SA
#undef PG8_SB
#undef PG8_STAGE
#undef PG8_LDA
#undef PG8_LDB
#undef PG8_MMA
#undef PG8_WAIT_V
#undef PG8_WAIT_L
#undef PG8_BAR
#undef PG8_SCHED
}
}

#include <cstdio>
#include <ctime>
#include <cstdlib>
#include <cstring>
#include <cmath>
#include <vector>
#include <algorithm>
#define CK(x) do { hipError_t e_ = (x); if (e_ != hipSuccess) { fprintf(stderr, "HIP %s:%d %s\n", __FILE__, __LINE__, hipGetErrorString(e_)); exit(2); } } while (0)

#define DI __device__ __forceinline__
#define LAS __attribute__((address_space(3)))
typedef unsigned short bf16_t;
typedef short bf16x8 __attribute__((ext_vector_type(8)));
typedef short s16x4 __attribute__((ext_vector_type(4)));
typedef __bf16 bfv8 __attribute__((ext_vector_type(8)));
typedef __bf16 bfv4 __attribute__((ext_vector_type(4)));
typedef float f32x2 __attribute__((ext_vector_type(2)));
typedef float f32x4 __attribute__((ext_vector_type(4)));
typedef float f32x8 __attribute__((ext_vector_type(8)));
typedef float f32x16 __attribute__((ext_vector_type(16)));
typedef unsigned u32x4 __attribute__((ext_vector_type(4)));
typedef unsigned u32x2 __attribute__((ext_vector_type(2)));

constexpr int MP = 16384, MS = 128, MR = MP + MS, MPAD = 16640, DM = 1024, SEQ = 2048, NB = 8;
constexpr int NPROJ = 4096, NGATE = 3072, DFF = 4096, DIN = 7184;
constexpr int PU = 0, PQ = 512, PK = 1024, PV = 1536, PMQ = 2048, PMK = 2304, PMV = 2560, PZ = 3072, PMO = 3584;
constexpr float EPS = 1e-6f;
constexpr size_t O_S5RE_P = 16908288, O_S5RE_S = 16941056, O_S5IM_P = 17465344, O_S5IM_S = 17498112, O_CONV_P = 18022400, O_CONV_S = 18096128,
                 O_GDN_P = 19275776, O_GDN_S = 20324352, O_MLC_P = 37101568, O_MLC_S = 37625856, O_MLN_P = 46014464, O_MLN_S = 46018560,
                 O_MLM_P = 46084096, O_MLM_S = 46084160, O_TOTAL = 46085184;
constexpr size_t WS_R1 = 0, SZ_R1 = (size_t)MPAD * 4096 * 2;
constexpr size_t WS_XN = WS_R1 + SZ_R1, SZ_XN = (size_t)MPAD * 1024 * 2;
constexpr size_t WS_Y3 = WS_XN + SZ_XN, SZ_Y3 = (size_t)3 * MPAD * 512 * 2;
constexpr size_t WS_YS5 = WS_Y3 + SZ_Y3, SZ_YS5 = (size_t)MPAD * 512 * 2;
constexpr size_t WS_W = WS_YS5 + SZ_YS5;
constexpr size_t WO_IN = 0, WO_G = WO_IN + (size_t)4096 * 1024, WO_GLU = WO_G + (size_t)3072 * 1024, WO_BR = WO_GLU + (size_t)512 * 512,
                 WO_OUT = WO_BR + (size_t)3 * 1024 * 512, WO_UP = WO_OUT + (size_t)1024 * 1024, WO_DN = WO_UP + (size_t)4096 * 1024,
                 WO_PLE = WO_DN + (size_t)1024 * 4096, WO_PG = WO_PLE + (size_t)1024 * 256, WO_END = WO_PG + (size_t)1024 * 1024;
constexpr size_t SZ_W = WO_END * 2;
constexpr size_t WS_GS = WS_W + SZ_W;
constexpr int GI_U = 0, GI_W = 16384, GI_Q = 32768, GI_K = 49152, GI_A = 65536, GI_BYTES = 73728;
constexpr size_t SZ_GS = (size_t)1024 * GI_BYTES;
constexpr size_t WS_SG = WS_GS + SZ_GS, SZ_SG = (size_t)MR * 16 * 4;
constexpr size_t WS_GL = WS_SG + SZ_SG, SZ_GL = 8192;
constexpr size_t WS_MG = WS_GL + SZ_GL, SZ_MG = (size_t)1024 * 3 * 64 * 4;
constexpr size_t WS_BAR = WS_MG + SZ_MG, SZ_BAR = 16384;
constexpr size_t WS_END = WS_BAR + SZ_BAR;
constexpr int LDS_BYTES = 122880 + 32768 + 2048 + 64 + 64;

struct KP { const float* in[40]; float* out; unsigned char* ws; };

DI float bf2f(bf16_t b) { return __uint_as_float(((unsigned)b) << 16); }
DI bf16_t f2bf(float f) { __bf16 b = (__bf16)f; return __builtin_bit_cast(bf16_t, b); }
DI bf16x8 pack8v(f32x8 v) { bfv8 b = __builtin_convertvector(v, bfv8); return __builtin_bit_cast(bf16x8, b); }
DI s16x4 pack4v(f32x4 v) { bfv4 b = __builtin_convertvector(v, bfv4); return __builtin_bit_cast(s16x4, b); }
DI bf16x8 pack16(const f32x16& x, int s) { f32x8 v;
#pragma unroll
    for (int j = 0; j < 8; ++j) v[j] = x[8 * s + j];
    return pack8v(v); }
DI float lo16(unsigned u) { return __uint_as_float(u << 16); }
DI float hi16(unsigned u) { return __uint_as_float(u & 0xffff0000u); }
DI f32x8 unpack8(bf16x8 b) { u32x4 u = __builtin_bit_cast(u32x4, b); f32x8 r;
#pragma unroll
    for (int i = 0; i < 4; ++i) { r[2 * i] = lo16(u[i]); r[2 * i + 1] = hi16(u[i]); }
    return r; }
DI float sigm(float x) { return __builtin_amdgcn_rcpf(1.f + __expf(-x)); }
DI float tanh_(float z) { return 1.f - 2.f * __builtin_amdgcn_rcpf(__expf(2.f * z) + 1.f); }
DI float gelu_t(float x) { return 0.5f * x * (1.f + tanh_(0.7978845608028654f * (x + 0.044715f * x * x * x))); }
DI float silu_(float x) { return x * sigm(x); }
DI float softplus_(float x) { return x > 20.f ? x : log1pf(expf(x)); }
DI float logsig_(float x) { return x >= 0.f ? -log1pf(expf(-x)) : x - log1pf(expf(x)); }
DI float softcap_(float x) { return 15.f * tanh_(x * (1.f / 15.f)); }
DI float wave_sum(float v) {
#pragma unroll
    for (int o = 32; o; o >>= 1) v += __shfl_xor(v, o);
    return v; }
DI float wave_incl_sum(float v, int lane) {
#pragma unroll
    for (int o = 1; o < 64; o <<= 1) { float t = __shfl_up(v, o); if (lane >= o) v += t; }
    return v; }
DI float wave_incl_max(float v, int lane) {
#pragma unroll
    for (int o = 1; o < 64; o <<= 1) { float t = __shfl_up(v, o); if (lane >= o) v = fmaxf(v, t); }
    return v; }
DI void butterfly16(float (&a)[16], int lane) {
#pragma unroll
    for (int i = 0; i < 8; ++i) { const bool up = (lane & 32) != 0; const float send = up ? a[i] : a[i + 8], keep = up ? a[i + 8] : a[i]; a[i] = keep + __shfl_xor(send, 32); }
#pragma unroll
    for (int i = 0; i < 4; ++i) { const bool up = (lane & 16) != 0; const float send = up ? a[i] : a[i + 4], keep = up ? a[i + 4] : a[i]; a[i] = keep + __shfl_xor(send, 16); }
#pragma unroll
    for (int i = 0; i < 2; ++i) { const bool up = (lane & 8) != 0; const float send = up ? a[i] : a[i + 2], keep = up ? a[i + 2] : a[i]; a[i] = keep + __shfl_xor(send, 8); }
    { const bool up = (lane & 4) != 0; const float send = up ? a[0] : a[1], keep = up ? a[1] : a[0]; a[0] = keep + __shfl_xor(send, 4); }
    a[0] += __shfl_xor(a[0], 2); a[0] += __shfl_xor(a[0], 1);
}
DI int bsel16(int lane) { return ((lane >> 5) & 1) * 8 + ((lane >> 4) & 1) * 4 + ((lane >> 3) & 1) * 2 + ((lane >> 2) & 1); }
DI int crow(int reg, int h) { return (reg & 3) + 8 * (reg >> 2) + 4 * h; }
DI int perm16(int k) { return (k & ~12) | ((k & 4) << 1) | ((k & 8) >> 1); }
#define MFMA32(a, b, c) __builtin_amdgcn_mfma_f32_32x32x16_bf16((a), (b), (c), 0, 0, 0)
#define MFMA16(a, b, c) __builtin_amdgcn_mfma_f32_16x16x32_bf16((a), (b), (c), 0, 0, 0)
#define WAVE_FENCE() do { asm volatile("s_waitcnt lgkmcnt(0)" ::: "memory"); __builtin_amdgcn_wave_barrier(); asm volatile("" ::: "memory"); } while (0)

typedef __attribute__((address_space(4))) const unsigned long long* ka_t;
typedef __attribute__((address_space(1))) float gfloat_t; typedef __attribute__((address_space(1))) unsigned char guchar_t;
struct InTab { ka_t ka; DI const float* operator[](int i) const { return (const float*)(const gfloat_t*)ka[i]; } };
struct Ctx {
    InTab in; float* out; unsigned char* ws; unsigned char* lds;
    bf16_t *R1, *XN, *Y3, *W, *YS5; unsigned char* GS; float *SG, *GL;
    int tid, lane, wave, G, bid;
};

template <class F> struct Epi8 {
    static constexpr bool PERM = true, AFTER_DRAIN = false;
    F f;
    DI void operator()(const f32x4 (&acc)[2][2][4][2], const pg8::Unit& u, int wr, int wc, int fr, int fq) const {
        const int row0 = u.pm * 256 + wr * 64 + fr, col0 = u.pn * 256 + wc * 32 + 8 * fq;
#pragma unroll
        for (int ai = 0; ai < 2; ++ai)
#pragma unroll
            for (int m = 0; m < 4; ++m)
#pragma unroll
                for (int bj = 0; bj < 2; ++bj) f(row0 + ai * 128 + m * 16, col0 + bj * 128, acc[ai][bj][m][0], acc[ai][bj][m][1]);
    }
};
DI f32x8 cat8(f32x4 a, f32x4 b) { f32x8 r; r[0] = a[0]; r[1] = a[1]; r[2] = a[2]; r[3] = a[3]; r[4] = b[0]; r[5] = b[1]; r[6] = b[2]; r[7] = b[3]; return r; }
struct FStore { bf16_t* dst; int ld;
    DI void s(int row, int col, float v) const { dst[(size_t)row * ld + col] = f2bf(v); }
    DI void operator()(int row, int col, f32x4 a, f32x4 b) const { *(bf16x8*)(dst + (size_t)row * ld + col) = pack8v(cat8(a, b)); } };
struct FSig { bf16_t* dst; int ld;
    DI void s(int row, int col, float v) const { dst[(size_t)row * ld + col] = f2bf(sigm(v)); }
    DI void operator()(int row, int col, f32x4 a, f32x4 b) const { f32x8 v = cat8(a, b);
#pragma unroll
        for (int i = 0; i < 8; ++i) v[i] = sigm(v[i]);
        *(bf16x8*)(dst + (size_t)row * ld + col) = pack8v(v); } };
struct FGlu { const bf16_t* y; const float* bias; bf16_t* dst;
    DI void s(int row, int col, float v) const { dst[(size_t)row * 512 + col] = f2bf(bf2f(y[(size_t)row * 512 + col]) * sigm(v + bias[col])); }
    DI void operator()(int row, int col, f32x4 a, f32x4 b) const { f32x8 v = cat8(a, b); f32x8 yv = unpack8(*(const bf16x8*)(y + (size_t)row * 512 + col));
        f32x4 b0 = *(const f32x4*)(bias + col), b1 = *(const f32x4*)(bias + col + 4);
#pragma unroll
        for (int i = 0; i < 8; ++i) v[i] = yv[i] * sigm(v[i] + (i < 4 ? b0[i] : b1[i - 4]));
        *(bf16x8*)(dst + (size_t)row * 512 + col) = pack8v(v); } };
struct FBranch { const bf16_t* gates; bf16_t* merged; int first;
    DI void s(int row, int col, float v) const { bf16_t* mp = merged + (size_t)row * 1024 + col; const float g = bf2f(gates[(size_t)row * 4096 + col]); *mp = f2bf((first ? 0.f : bf2f(*mp)) + g * v); }
    DI void operator()(int row, int col, f32x4 a, f32x4 b) const { f32x8 v = cat8(a, b); f32x8 gv = unpack8(*(const bf16x8*)(gates + (size_t)row * 4096 + col));
        bf16x8* mp = (bf16x8*)(merged + (size_t)row * 1024 + col);
        f32x8 o;
        if (first) {
#pragma unroll
            for (int i = 0; i < 8; ++i) o[i] = gv[i] * v[i];
        } else { f32x8 mv = unpack8(*mp);
#pragma unroll
            for (int i = 0; i < 8; ++i) o[i] = mv[i] + gv[i] * v[i];
        }
        *mp = pack8v(o); } };
struct FRes { float* xr;
    DI void s(int row, int col, float v) const { xr[(size_t)row * 1024 + col] += v; }
    DI void operator()(int row, int col, f32x4 a, f32x4 b) const { if (row < MR) { f32x4* p = (f32x4*)(xr + (size_t)row * 1024 + col); p[0] = p[0] + a; p[1] = p[1] + b; } } };
struct FResB { float* xr; bf16_t* xb;
    DI void s(int row, int col, float v) const { const float x = xr[(size_t)row * 1024 + col] + v; xr[(size_t)row * 1024 + col] = x; xb[(size_t)row * 1024 + col] = f2bf(x); }
    DI void operator()(int row, int col, f32x4 a, f32x4 b) const { if (row < MR) { f32x4* p = (f32x4*)(xr + (size_t)row * 1024 + col); const f32x4 x0 = p[0] + a, x1 = p[1] + b; p[0] = x0; p[1] = x1;
            *(bf16x8*)(xb + (size_t)row * 1024 + col) = pack8v(cat8(x0, x1)); } } };
struct FRelu2 { bf16_t* dst;
    DI void s(int row, int col, float v) const { const float r = fmaxf(v, 0.f); dst[(size_t)row * 4096 + col] = f2bf(r * r); }
    DI void operator()(int row, int col, f32x4 a, f32x4 b) const { f32x8 v = cat8(a, b);
#pragma unroll
        for (int i = 0; i < 8; ++i) { float r = fmaxf(v[i], 0.f); v[i] = r * r; }
        *(bf16x8*)(dst + (size_t)row * 4096 + col) = pack8v(v); } };
struct FPle { const bf16_t* T; float* xr;
    DI void s(int row, int col, float v) const { xr[(size_t)row * 1024 + col] += bf2f(T[(size_t)row * 1024 + col]) * sigm(v); }
    DI void operator()(int row, int col, f32x4 a, f32x4 b) const { if (row < MR) { f32x8 v = cat8(a, b); f32x8 tv = unpack8(*(const bf16x8*)(T + (size_t)row * 1024 + col));
            f32x4* p = (f32x4*)(xr + (size_t)row * 1024 + col); f32x4 x0 = p[0], x1 = p[1];
#pragma unroll
            for (int i = 0; i < 4; ++i) { x0[i] += tv[i] * sigm(v[i]); x1[i] += tv[4 + i] * sigm(v[4 + i]); }
            p[0] = x0; p[1] = x1; } } };

DI f32x16 small_part(const Ctx& c, const bf16_t* A, const bf16_t* Bt, int K, int tile, int kq) {
    int r = c.lane & 31, hh = c.lane >> 5; asm volatile("" : "+v"(r), "+v"(hh));
    const int mt = tile & 3, nt = tile >> 2, K4 = K >> 2;
    const bf16_t* ap = A + (size_t)(MP + mt * 32 + r) * K + kq * K4 + hh * 8;
    const bf16_t* bp = Bt + (size_t)(nt * 32 + r) * K + kq * K4 + hh * 8;
    f32x16 acc;
#pragma unroll
    for (int j = 0; j < 16; ++j) acc[j] = 0.f;
    if (K4 >= 128) {
        bf16x8 a[8], b[8];
#pragma unroll
        for (int j = 0; j < 8; ++j) { a[j] = *(const bf16x8*)(ap + j * 16); b[j] = *(const bf16x8*)(bp + j * 16); }
        for (int k = 128; k < K4; k += 128) {
            bf16x8 an[8], bn[8];
#pragma unroll
            for (int j = 0; j < 8; ++j) { an[j] = *(const bf16x8*)(ap + k + j * 16); bn[j] = *(const bf16x8*)(bp + k + j * 16); }
#pragma unroll
            for (int j = 0; j < 8; ++j) acc = MFMA32(a[j], b[j], acc);
#pragma unroll
            for (int j = 0; j < 8; ++j) { a[j] = an[j]; b[j] = bn[j]; }
        }
#pragma unroll
        for (int j = 0; j < 8; ++j) acc = MFMA32(a[j], b[j], acc);
    } else {
#pragma unroll
        for (int j = 0; j < 4; ++j) { const bf16x8 a = *(const bf16x8*)(ap + j * 16), b = *(const bf16x8*)(bp + j * 16); acc = MFMA32(a, b, acc); }
    }
    return acc;
}
template <class F> DI void run_gemm(const Ctx& c, const bf16_t* A, const bf16_t* Bt, int N, int K, const F& f) {
    { const int ntile = 4 * (N >> 5), grp = c.wave >> 2, kq = c.wave & 3;
      LAS float* red = (LAS float*)c.lds;
      for (int t0 = 0; t0 < ntile; t0 += 2 * c.G) {
          const int t = t0 + grp * c.G + c.bid; const bool live = t < ntile;
          if (live) { const f32x16 acc = small_part(c, A, Bt, K, t, kq);
#pragma unroll
              for (int i = 0; i < 16; ++i) red[(c.wave * 16 + i) * 64 + c.lane] = acc[i]; }
          __syncthreads();
          if (live && kq == 0) { const int mt = t & 3, nt = t >> 2, r = c.lane & 31, hh = c.lane >> 5;
#pragma unroll
              for (int i = 0; i < 16; ++i) { const int o = (c.wave * 16 + i) * 64 + c.lane; const float v = (red[o] + red[o + 1024]) + (red[o + 2048] + red[o + 3072]);
                  f.s(MP + mt * 32 + crow(i, hh), nt * 32 + r, v); } }
          __syncthreads();
      } }
    pg8::Gemm g{A, Bt, MP, N, K}; pg8::StaticOrder S; S.init(MP, N, c.G, c.bid);
    Epi8<F> E{f};
    pg8::gemm_phase<Epi8<F>, pg8::StaticOrder>((PG8_LAS unsigned char*)c.lds, g, S, E, nullptr);
    __syncthreads();
}

DI void tr_task(const Ctx& c, const float* src, int ld, int K, int n, bf16_t* dst, int rot) {
    float* tile = (float*)c.lds;
    const int nkt = K >> 6, ntiles = nkt * (n >> 6);
    const int start = (c.bid + c.G - (rot % c.G)) % c.G;
    for (int t = start; t < ntiles; t += c.G) {
        const int kt = t % nkt, nt = t / nkt;
        const int r = c.tid >> 4, c4 = (c.tid & 15) * 4;
#pragma unroll
        for (int p = 0; p < 2; ++p) { const int row = r + 32 * p; const f32x4 v = *(const f32x4*)(src + (size_t)(kt * 64 + row) * ld + nt * 64 + c4);
            tile[row * 65 + c4] = v[0]; tile[row * 65 + c4 + 1] = v[1]; tile[row * 65 + c4 + 2] = v[2]; tile[row * 65 + c4 + 3] = v[3]; }
        __syncthreads();
        { const int nn = c.tid >> 3, kc = (c.tid & 7) * 8; f32x8 v;
#pragma unroll
          for (int e = 0; e < 8; ++e) v[e] = tile[(kc + e) * 65 + nn];
          *(bf16x8*)(dst + (size_t)(nt * 64 + nn) * K + kt * 64 + kc) = pack8v(v); }
        __syncthreads();
    }
}
DI void phase_weights(const Ctx& c, int L) {
    const float* win = c.in[12] + (size_t)L * 1024 * DIN;
    bf16_t* W = c.W;
    tr_task(c, win + 0, DIN, 1024, 2048, W + WO_IN, 0);
    tr_task(c, win + 2568, DIN, 1024, 1024, W + WO_IN + (size_t)2048 * 1024, 0);
    tr_task(c, win + 2048, DIN, 1024, 512, W + WO_IN + (size_t)3072 * 1024, 0);
    tr_task(c, win + 3592, DIN, 1024, 512, W + WO_IN + (size_t)3584 * 1024, 128);
    tr_task(c, win + 4112, DIN, 1024, 3072, W + WO_G, 0);
    tr_task(c, c.in[21] + (size_t)L * 512 * 512, 512, 512, 512, W + WO_GLU, 0);
    tr_task(c, c.in[30] + (size_t)L * 512 * 1024, 1024, 512, 1024, W + WO_BR, 64);
    tr_task(c, c.in[31] + (size_t)L * 512 * 1024, 1024, 512, 1024, W + WO_BR + (size_t)1024 * 512, 192);
    tr_task(c, c.in[32] + (size_t)L * 512 * 1024, 1024, 512, 1024, W + WO_BR + (size_t)2 * 1024 * 512, 64);
    tr_task(c, c.in[33] + (size_t)L * 1024 * 1024, 1024, 1024, 1024, W + WO_OUT, 0);
    tr_task(c, c.in[35] + (size_t)L * 1024 * 4096, 4096, 1024, 4096, W + WO_UP, 0);
    tr_task(c, c.in[36] + (size_t)L * 4096 * 1024, 1024, 4096, 1024, W + WO_DN, 0);
    tr_task(c, c.in[37] + (size_t)L * 256 * 1024, 1024, 256, 1024, W + WO_PLE, 0);
    tr_task(c, c.in[38] + (size_t)L * 1024 * 1024, 1024, 1024, 1024, W + WO_PG, 64);
}

template <int MODE> DI void phase_rmsnorm(const Ctx& c, int L) {
    float* wsm = (float*)c.lds;
    const float* gain = (MODE == 0 ? c.in[11] : c.in[34]) + (size_t)L * 1024;
    if (MODE == 0) {
        const float* win = c.in[12] + (size_t)L * 1024 * DIN;
        for (int idx = c.tid; idx < 4096; idx += 512) { const int k = idx >> 2, part = idx & 3, seg = part >> 1, half = part & 1;
            const f32x4 v = *(const f32x4*)(win + (size_t)k * DIN + (seg ? 4104 : 2560) + half * 4);
            const int sb = seg * 8 + half * 4;
            wsm[(sb + 0) * 1024 + k] = v[0]; wsm[(sb + 1) * 1024 + k] = v[1]; wsm[(sb + 2) * 1024 + k] = v[2]; wsm[(sb + 3) * 1024 + k] = v[3]; }
        __syncthreads();
    }
    float* XR = c.out;
    for (int row = c.bid * 8 + c.wave; row < MR; row += c.G * 8) {
        const float* src = (MODE == 0 && L == 0) ? (row < MP ? c.in[0] + (size_t)row * 1024 : c.in[1] + (size_t)(row - MP) * 1024) : XR + (size_t)row * 1024;
        f32x4 x[4]; float ss = 0.f;
#pragma unroll
        for (int i = 0; i < 4; ++i) { x[i] = *(const f32x4*)(src + c.lane * 4 + 256 * i); ss += x[i][0] * x[i][0] + x[i][1] * x[i][1] + x[i][2] * x[i][2] + x[i][3] * x[i][3]; }
        ss = wave_sum(ss);
        const float rs = rsqrtf(ss * (1.f / 1024.f) + EPS);
        if (MODE == 0 && L == 0) {
#pragma unroll
            for (int i = 0; i < 4; ++i) *(f32x4*)(XR + (size_t)row * 1024 + c.lane * 4 + 256 * i) = x[i];
        }
#pragma unroll
        for (int i = 0; i < 4; ++i) { const f32x4 g = *(const f32x4*)(gain + c.lane * 4 + 256 * i); x[i] = x[i] * rs * g;
            *(s16x4*)(c.XN + (size_t)row * 1024 + c.lane * 4 + 256 * i) = pack4v(x[i]); }
        if (MODE == 0) {
            float a[16];
#pragma unroll
            for (int s = 0; s < 16; ++s) { float t = 0.f;
#pragma unroll
                for (int i = 0; i < 4; ++i) { const f32x4 w = *(const f32x4*)(wsm + s * 1024 + c.lane * 4 + 256 * i); t += x[i][0] * w[0] + x[i][1] * w[1] + x[i][2] * w[2] + x[i][3] * w[3]; }
                a[s] = t; asm volatile("" ::: "memory"); }
#pragma unroll
            for (int i = 0; i < 8; ++i) { const bool up = (c.lane & 32) != 0; const float send = up ? a[i] : a[i + 8], keep = up ? a[i + 8] : a[i]; a[i] = keep + __shfl_xor(send, 32); }
#pragma unroll
            for (int i = 0; i < 4; ++i) { const bool up = (c.lane & 16) != 0; const float send = up ? a[i] : a[i + 4], keep = up ? a[i + 4] : a[i]; a[i] = keep + __shfl_xor(send, 16); }
#pragma unroll
            for (int i = 0; i < 2; ++i) { const bool up = (c.lane & 8) != 0; const float send = up ? a[i] : a[i + 2], keep = up ? a[i + 2] : a[i]; a[i] = keep + __shfl_xor(send, 8); }
            { const bool up = (c.lane & 4) != 0; const float send = up ? a[0] : a[1], keep = up ? a[1] : a[0]; a[0] = keep + __shfl_xor(send, 4); }
            a[0] += __shfl_xor(a[0], 2); a[0] += __shfl_xor(a[0], 1);
            if ((c.lane & 3) == 0) { const int sidx = ((c.lane >> 5) & 1) * 8 + ((c.lane >> 4) & 1) * 4 + ((c.lane >> 3) & 1) * 2 + ((c.lane >> 2) & 1); c.SG[(size_t)row * 16 + sidx] = a[0]; }
        }
    }
    __syncthreads();
}

DI void phase_gdn_prep(const Ctx& c, int L) {
    constexpr int RS = 132, AS = 68, BP = 136;
    LAS float* AmT0 = (LAS float*)c.lds;
    const float* convw = c.in[23] + (size_t)L * 4 * 1536;
    const bf16_t* PR = c.R1;
    for (int item = c.bid; item < 1024; item += c.G) {
        const int ch = item & 31, h = (item >> 5) & 3, b = item >> 7;
        const int t0 = b * SEQ + ch * 64;
        unsigned char* gi = c.GS + (size_t)item * GI_BYTES;
        LAS float* AmT = AmT0; asm volatile("" : "+v"(AmT));
        LAS float* beta = AmT + 64 * AS; LAS float* gcum = beta + 64; LAS float* part = gcum + 64;
        LAS float* vs = part + 128; asm volatile("" : "+v"(vs));
        LAS bf16_t* qb = (LAS bf16_t*)(vs + 64 * RS); asm volatile("" : "+v"(qb));
        LAS bf16_t* khi = qb + 64 * BP; asm volatile("" : "+v"(khi));
        LAS bf16_t* klo = khi + 64 * BP; asm volatile("" : "+v"(klo));
        if (c.wave == 7) { const size_t row = (size_t)(t0 + c.lane);
            const float bt = sigm(c.SG[row * 16 + h]);
            const float g = -expf(c.in[24][L * 4 + h]) * softplus_(c.SG[row * 16 + 4 + h] + c.in[25][L * 4 + h]);
            const float gc = wave_incl_sum(g, c.lane);
            beta[c.lane] = bt; gcum[c.lane] = gc;
            if (c.lane == 63) c.GL[item] = expf(gc); }
        { const int d = c.tid & 127, tq = c.tid >> 7;
          float qk[2][16];
#pragma unroll
          for (int which = 0; which < 3; ++which) {
              const int pcol = PQ + which * 512 + h * 128 + d, wcol = which * 512 + h * 128 + d;
              const float w0 = convw[wcol], w1 = convw[1536 + wcol], w2 = convw[3072 + wcol], w3 = convw[4608 + wcol];
              float xin[19];
#pragma unroll
              for (int i = 0; i < 19; ++i) { const int tt = ch * 64 + tq * 16 + i - 3; const int tc = tt < 0 ? 0 : tt;
                  const float v = bf2f(PR[(size_t)(b * SEQ + tc) * NPROJ + pcol]); xin[i] = tt < 0 ? 0.f : v; }
#pragma unroll
              for (int t = 0; t < 16; ++t) { const float a = silu_(xin[t] * w0 + xin[t + 1] * w1 + xin[t + 2] * w2 + xin[t + 3] * w3);
                  if (which == 2) vs[(tq * 16 + t) * RS + d] = a; else qk[which][t] = a; }
          }
#pragma unroll
          for (int which = 0; which < 2; ++which) {
              float ssq[16];
#pragma unroll
              for (int t = 0; t < 16; ++t) ssq[t] = qk[which][t] * qk[which][t];
              butterfly16(ssq, c.lane);
              __syncthreads();
              if ((c.lane & 3) == 0) part[c.wave * 16 + bsel16(c.lane)] = ssq[0];
              __syncthreads();
#pragma unroll
              for (int t = 0; t < 16; ++t) { const float tot = part[c.wave * 16 + t] + part[(c.wave ^ 1) * 16 + t];
                  const float v = qk[which][t] * rsqrtf(tot + EPS) * (which == 0 ? 0.08838834764831845f : 1.f);
                  const bf16_t hi = f2bf(v);
                  if (which == 0) qb[(tq * 16 + t) * BP + d] = hi;
                  else { khi[(tq * 16 + t) * BP + d] = hi; klo[(tq * 16 + t) * BP + d] = f2bf(v - bf2f(hi)); } }
          } }
        __syncthreads();
        { const int r = c.lane & 31, hh = c.lane >> 5, wq = c.wave & 3, tm = wq >> 1, tn = wq & 1;
          if (!(c.wave < 4 && tm == 0 && tn == 1)) {
              f32x16 acc;
#pragma unroll
              for (int j = 0; j < 16; ++j) acc[j] = 0.f;
              const LAS bf16_t* arow = (c.wave < 4 ? khi : qb) + (tm * 32 + r) * BP + hh * 8;
              const LAS bf16_t* brow = khi + (tn * 32 + r) * BP + hh * 8;
#pragma unroll
              for (int ks = 0; ks < 8; ++ks) { const bf16x8 av = *(const LAS bf16x8*)(arow + ks * 16), bv = *(const LAS bf16x8*)(brow + ks * 16);
                  acc = MFMA32(av, bv, acc);
                  if (c.wave < 4) { const bf16x8 al = *(const LAS bf16x8*)(arow + 64 * BP + ks * 16), bl = *(const LAS bf16x8*)(brow + 64 * BP + ks * 16);
                      acc = MFMA32(av, bl, acc); acc = MFMA32(al, bv, acc); } }
              const int s = tn * 32 + r; const float gs = gcum[s];
              bf16_t* at = (bf16_t*)(gi + GI_A);
#pragma unroll
              for (int i = 0; i < 16; ++i) { const int t = tm * 32 + crow(i, hh); const float dec = (t >= s) ? __expf(gcum[t] - gs) : 0.f;
                  if (c.wave < 4) { if (t > s) AmT[s * AS + t] = beta[t] * acc[i] * dec; }
                  else at[t * 64 + (s & ~15) + perm16(s & 15)] = f2bf(acc[i] * dec); }
          } }
        __syncthreads();
        if (c.tid < 256) {
            const int col = c.tid; float x[64];
#pragma unroll
            for (int t = 0; t < 64; ++t) x[t] = (col < 128) ? vs[t * RS + col] * beta[t] : (bf2f(khi[t * BP + (col - 128)]) + bf2f(klo[t * BP + (col - 128)])) * beta[t] * __expf(gcum[t]);
#pragma unroll
            for (int j = 0; j < 63; ++j) { const float xj = x[j];
#pragma unroll
                for (int g4 = (j + 1) / 4; g4 < 16; ++g4) { const f32x4 a = *(const LAS f32x4*)(AmT + j * AS + g4 * 4);
#pragma unroll
                    for (int e = 0; e < 4; ++e) if (g4 * 4 + e > j) x[g4 * 4 + e] -= a[e] * xj; } }
            if (col < 128) { bf16_t* up = (bf16_t*)(gi + GI_U); const int sl = col >> 5, r = col & 31;
#pragma unroll
                for (int t = 0; t < 64; ++t) { const int mt = t >> 5, tt = t & 31, hh = (tt >> 2) & 1, i = (tt & 3) + 4 * (tt >> 3);
                    up[((sl * 2 + mt) * 16 + i) * 64 + r + 32 * hh] = f2bf(x[t]); }
            } else { bf16_t* wp = (bf16_t*)(gi + GI_W); const int dk = col - 128, pd = (dk & ~15) + perm16(dk & 15);
#pragma unroll
                for (int t = 0; t < 64; ++t) wp[t * 128 + pd] = f2bf(-x[t]); }
        } else {
            bf16_t* qp = (bf16_t*)(gi + GI_Q); bf16_t* kp = (bf16_t*)(gi + GI_K);
            const float g63 = gcum[63];
            for (int idx = c.tid - 256; idx < 64 * 128; idx += 256) { const int t = idx >> 7, d = idx & 127;
                qp[t * 128 + (d & ~15) + perm16(d & 15)] = f2bf(bf2f(qb[t * BP + d]) * __expf(gcum[t])); }
            for (int idx = c.tid - 256; idx < 64 * 128; idx += 256) { const int d = idx >> 6, t = idx & 63;
                kp[d * 64 + (t & ~15) + perm16(t & 15)] = f2bf((bf2f(khi[t * BP + d]) + bf2f(klo[t * BP + d])) * __expf(g63 - gcum[t])); }
        }
        __syncthreads();
    }
}

constexpr int GB_W = 0, GB_Q = 16384, GB_A = 32768, GB_K = 40960, GB_U = 57344, GB_BYTES = 61440;
DI void dma16(const void* g, unsigned lds_addr) { asm volatile("s_mov_b32 m0, %1\n\tglobal_load_lds_dwordx4 %0, off" :: "v"(g), "s"(lds_addr) : "memory", "m0"); }
DI void gdn_issue(const Ctx& c, int item, int sl, int r, int hh, int ln, PG8_LAS unsigned char* buf) {
    const unsigned char* gi = c.GS + (size_t)item * GI_BYTES;
    const bf16_t* up = (const bf16_t*)(gi + GI_U); const bf16_t* wp = (const bf16_t*)(gi + GI_W); const bf16_t* qp = (const bf16_t*)(gi + GI_Q);
    const bf16_t* kp = (const bf16_t*)(gi + GI_K); const bf16_t* ap = (const bf16_t*)(gi + GI_A);
#pragma unroll
    for (int mt = 0; mt < 2; ++mt)
#pragma unroll
        for (int ks = 0; ks < 8; ++ks) {
            dma16((wp + (mt * 32 + r) * 128 + ks * 16 + hh * 8), (unsigned)(size_t)(buf + GB_W + (mt * 8 + ks) * 1024));
            dma16((qp + (mt * 32 + r) * 128 + ks * 16 + hh * 8), (unsigned)(size_t)(buf + GB_Q + (mt * 8 + ks) * 1024)); }
#pragma unroll
    for (int mt = 0; mt < 2; ++mt)
#pragma unroll
        for (int ks = 0; ks < 4; ++ks)
            dma16((ap + (mt * 32 + r) * 64 + ks * 16 + hh * 8), (unsigned)(size_t)(buf + GB_A + (mt * 4 + ks) * 1024));
#pragma unroll
    for (int i = 0; i < 4; ++i)
#pragma unroll
        for (int ks = 0; ks < 4; ++ks)
            dma16((kp + (i * 32 + r) * 64 + ks * 16 + hh * 8), (unsigned)(size_t)(buf + GB_K + (i * 4 + ks) * 1024));
#pragma unroll
    for (int j = 0; j < 4; ++j)
        dma16((up + (size_t)sl * 2048 + j * 512 + ln * 8), (unsigned)(size_t)(buf + GB_U + j * 1024));
}
DI void task_gdn_seq(const Ctx& c, int L, int unit) {
    const int sl = (unit >> 3) & 3, stream = (unit & 7) + 8 * (unit >> 5);
    const int b = stream >> 2, h = stream & 3;
    const int r0_ = c.lane & 31, hh0_ = c.lane >> 5; int r = r0_, hh = hh0_, ln = c.lane;
    PG8_LAS unsigned char* lbase = (PG8_LAS unsigned char*)c.lds;
    f32x16 S[4];
#pragma unroll
    for (int i = 0; i < 4; ++i)
#pragma unroll
        for (int j = 0; j < 16; ++j) S[i][j] = 0.f;
    bf16_t* yo = c.Y3 + (size_t)1 * MPAD * 512;
    gdn_issue(c, stream * 32, sl, r, hh, ln, lbase);
    for (int ch = 0; ch < 32; ++ch) {
        r = r0_; hh = hh0_; ln = c.lane; asm volatile("" : "+v"(r), "+v"(hh), "+v"(ln));
        const int item = stream * 32 + ch;
        const float gl = c.GL[item];
        asm volatile("s_waitcnt vmcnt(0)" ::: "memory");
        PG8_LAS unsigned char* buf = lbase + (ch & 1) * GB_BYTES;
        if (ch + 1 < 32) gdn_issue(c, item + 1, sl, r, hh, ln, lbase + ((ch + 1) & 1) * GB_BYTES);
        PG8_LAS unsigned char* lb = buf + ln * 16; asm volatile("" : "+v"(lb));
        PG8_LAS unsigned char* ub = buf + GB_U + ln * 2; asm volatile("" : "+v"(ub));
        f32x16 vn[2], o[2];
#pragma unroll
        for (int mt = 0; mt < 2; ++mt)
#pragma unroll
            for (int i = 0; i < 16; ++i) { vn[mt][i] = bf2f(*(const PG8_LAS bf16_t*)(ub + (mt * 16 + i) * 128)); o[mt][i] = 0.f; }
        bf16x8 Sb[8];
#pragma unroll
        for (int ks = 0; ks < 8; ++ks) Sb[ks] = pack16(S[ks >> 1], ks & 1);
#pragma unroll
        for (int mt = 0; mt < 2; ++mt)
#pragma unroll
            for (int ks = 0; ks < 8; ++ks) { const bf16x8 a = *(const PG8_LAS bf16x8*)(lb + GB_W + (mt * 8 + ks) * 1024); vn[mt] = MFMA32(a, Sb[ks], vn[mt]); }
#pragma unroll
        for (int mt = 0; mt < 2; ++mt)
#pragma unroll
            for (int ks = 0; ks < 8; ++ks) { const bf16x8 a = *(const PG8_LAS bf16x8*)(lb + GB_Q + (mt * 8 + ks) * 1024); o[mt] = MFMA32(a, Sb[ks], o[mt]); }
        bf16x8 Vb[4];
#pragma unroll
        for (int ks = 0; ks < 4; ++ks) Vb[ks] = pack16(vn[ks >> 1], ks & 1);
#pragma unroll
        for (int mt = 0; mt < 2; ++mt)
#pragma unroll
            for (int ks = 0; ks < 4; ++ks) { const bf16x8 a = *(const PG8_LAS bf16x8*)(lb + GB_A + (mt * 4 + ks) * 1024); o[mt] = MFMA32(a, Vb[ks], o[mt]); }
#pragma unroll
        for (int i = 0; i < 4; ++i) {
#pragma unroll
            for (int j = 0; j < 16; ++j) S[i][j] *= gl;
#pragma unroll
            for (int ks = 0; ks < 4; ++ks) { const bf16x8 a = *(const PG8_LAS bf16x8*)(lb + GB_K + (i * 4 + ks) * 1024); S[i] = MFMA32(a, Vb[ks], S[i]); }
        }
        const size_t rowb = (size_t)(b * SEQ + ch * 64);
#pragma unroll
        for (int mt = 0; mt < 2; ++mt)
#pragma unroll
            for (int i = 0; i < 16; ++i) yo[(rowb + mt * 32 + crow(i, hh)) * 512 + h * 128 + sl * 32 + r] = f2bf(o[mt][i]);
        asm volatile("s_waitcnt lgkmcnt(0)" ::: "memory");
    }
    float* so = c.out + O_GDN_P + ((size_t)(L * NB + b) * 4 + h) * 128 * 128;
#pragma unroll
    for (int i = 0; i < 4; ++i)
#pragma unroll
        for (int j = 0; j < 16; ++j) so[(size_t)(i * 32 + crow(j, hh)) * 128 + sl * 32 + r] = S[i][j];
}

DI void task_ml_gates(const Ctx& c, int L, int item) {
    const int ch = item & 31, h = (item >> 5) & 3, b = item >> 7, lane = c.lane;
    const size_t row = (size_t)(b * SEQ + ch * 64 + lane);
    const float li = softcap_(c.SG[row * 16 + 8 + h] + c.in[27][L * 4 + h]);
    const float lf = logsig_(softcap_(c.SG[row * 16 + 12 + h] + c.in[28][L * 4 + h]));
    const float bc = wave_incl_sum(lf, lane);
    const float av = li - bc;
    const float cm = wave_incl_max(av, lane);
    float* mg = (float*)(c.ws + WS_MG) + (size_t)item * 192;
    mg[lane] = av; mg[64 + lane] = cm; mg[128 + lane] = bc;
}
DI void ml_issue(const bf16_t* PR, int b, int h, int sl, int ch, int lane, unsigned bufaddr) {
    const size_t row = (size_t)(b * SEQ + ch * 64 + lane);
    const bf16_t* kp = PR + row * NPROJ + PMK + h * 64; const bf16_t* qp = PR + row * NPROJ + PMQ + h * 64; const bf16_t* vp = PR + row * NPROJ + PMV + h * 128 + sl * 32;
#pragma unroll
    for (int d8 = 0; d8 < 8; ++d8) { dma16(kp + d8 * 8, bufaddr + d8 * 1024); dma16(qp + d8 * 8, bufaddr + 8192 + d8 * 1024); }
#pragma unroll
    for (int d8 = 0; d8 < 4; ++d8) dma16(vp + d8 * 8, bufaddr + 16384 + d8 * 1024);
}
DI void task_ml_seq(const Ctx& c, int L, int unit, float* wl  ) {
    const int sl = (unit >> 3) & 3, stream = (unit & 7) + 8 * (unit >> 5);
    const int b = stream >> 2, h = stream & 3;
    const int lane = c.lane, r0_ = lane & 31, hh0_ = lane >> 5;
    int r = r0_, hh = hh0_, lane_v = lane;
    LAS float* a_l = (LAS float*)wl; LAS float* w_l = a_l + 64; LAS float* sc_l = a_l + 128; LAS float* inv_l = a_l + 192;
    LAS float* n_l = a_l + 256;
    LAS unsigned char* bufs = (LAS unsigned char*)(a_l + 320);
    const unsigned bufaddr0 = (unsigned)(size_t)bufs;
    const bf16_t* PR = c.R1;
    f32x16 C[2];
#pragma unroll
    for (int i = 0; i < 2; ++i)
#pragma unroll
        for (int j = 0; j < 16; ++j) C[i][j] = 0.f;
    float nst = 0.f, mprev = 0.f;
    n_l[lane] = 0.f;
    bf16_t* yo = c.Y3 + (size_t)2 * MPAD * 512;
    float mgv[3];
    { const float* mg = (const float*)(c.ws + WS_MG) + (size_t)(stream * 32) * 192; mgv[0] = mg[lane]; mgv[1] = mg[64 + lane]; mgv[2] = mg[128 + lane]; }
    ml_issue(PR, b, h, sl, 0, lane, bufaddr0);
    for (int ch = 0; ch < 32; ++ch) {
        r = r0_; hh = hh0_; lane_v = lane; asm volatile("" : "+v"(r), "+v"(hh), "+v"(lane_v));
        const float av = mgv[0], cmx = mgv[1], bc = mgv[2];
        asm volatile("s_waitcnt vmcnt(0)" ::: "memory");
        if (ch + 1 < 32) ml_issue(PR, b, h, sl, ch + 1, lane_v, bufaddr0 + ((ch + 1) & 1) * 20480);
        { const int chn = ch + 1 < 32 ? ch + 1 : 31; const float* mg = (const float*)(c.ws + WS_MG) + (size_t)(stream * 32 + chn) * 192;
          mgv[0] = mg[lane_v]; mgv[1] = mg[64 + lane_v]; mgv[2] = mg[128 + lane_v]; }
        LAS unsigned char* Kc = bufs + (ch & 1) * 20480; asm volatile("" : "+v"(Kc));
        LAS unsigned char* Qc = Kc + 8192; LAS unsigned char* Vc = Kc + 16384;
        LAS unsigned char* vbase = Vc + (r >> 3) * 1024 + (r & 7) * 2 + hh * 64; asm volatile("" : "+v"(vbase));
        LAS unsigned char* kbase = Kc + (r >> 3) * 1024 + (r & 7) * 2 + hh * 64; asm volatile("" : "+v"(kbase));
        LAS unsigned char* krow = Kc + hh * 1024 + r * 16; asm volatile("" : "+v"(krow));
        LAS unsigned char* qrow = Qc + hh * 1024 + r * 16; asm volatile("" : "+v"(qrow));
        LAS unsigned char* qr4 = Qc + r * 16 + hh * 8; asm volatile("" : "+v"(qr4));
        LAS unsigned char* kn = Kc + (lane_v >> 3) * 1024 + (lane_v & 7) * 2; asm volatile("" : "+v"(kn));
        LAS unsigned char* qln = Qc + lane_v * 16; asm volatile("" : "+v"(qln));
        LAS float* a4b = a_l + 4 * hh; asm volatile("" : "+v"(a4b));
        const size_t t0 = (size_t)(b * SEQ + ch * 64);
        const float Mt = fmaxf(mprev, cmx);
        const float sct = __expf(mprev - Mt);
        const float M63 = __shfl(Mt, 63), bc63 = __shfl(bc, 63);
        const float wlast = __expf(av - M63) * 0.125f;
        const float sclast = __expf(mprev - M63);
        WAVE_FENCE();
        float qn = 0.f;
#pragma unroll
        for (int d8 = 0; d8 < 8; ++d8) { const f32x8 qv = unpack8(*(const LAS bf16x8*)(qln + d8 * 1024));
            const f32x4 n0 = *(const LAS f32x4*)(n_l + d8 * 8), n1 = *(const LAS f32x4*)(n_l + d8 * 8 + 4);
            qn += qv[0] * n0[0] + qv[1] * n0[1] + qv[2] * n0[2] + qv[3] * n0[3] + qv[4] * n1[0] + qv[5] * n1[1] + qv[6] * n1[2] + qv[7] * n1[3]; }
        a_l[lane] = av; w_l[lane] = wlast;
        WAVE_FENCE();
        bf16x8 Vb[4];
#pragma unroll
        for (int ks = 0; ks < 4; ++ks)
#pragma unroll
            for (int j = 0; j < 8; ++j) Vb[ks][j] = (short)*(const LAS bf16_t*)(vbase + (16 * ks + 8 * (j >> 2) + (j & 3)) * 16);
        f32x16 num[2]; float dpv[2];
#pragma unroll
        for (int nt = 0; nt < 2; ++nt) {
            f32x16 PT[2];
#pragma unroll
            for (int ms = 0; ms < 2; ++ms)
#pragma unroll
                for (int j = 0; j < 16; ++j) PT[ms][j] = 0.f;
#pragma unroll
            for (int ks = 0; ks < 4; ++ks) {
                const bf16x8 bq = *(const LAS bf16x8*)(qrow + ks * 2048 + nt * 512);
#pragma unroll
                for (int ms = 0; ms < 2; ++ms) { const bf16x8 ak = *(const LAS bf16x8*)(krow + ks * 2048 + ms * 512); PT[ms] = MFMA32(ak, bq, PT[ms]); }
            }
            const float Mtn = __shfl(Mt, nt * 32 + r);
            float dp = 0.f;
#pragma unroll
            for (int ms = 0; ms < 2; ++ms)
#pragma unroll
                for (int g = 0; g < 4; ++g) { const f32x4 a4 = *(const LAS f32x4*)(a4b + ms * 32 + 8 * g);
#pragma unroll
                    for (int jj = 0; jj < 4; ++jj) { const int i = 4 * g + jj; const int s = ms * 32 + 8 * g + 4 * hh + jj;
                        const float wv = (s <= nt * 32 + r) ? __expf(a4[jj] - Mtn) * 0.125f : 0.f;
                        PT[ms][i] *= wv; dp += PT[ms][i]; } }
            dp += __shfl_xor(dp, 32); dpv[nt] = dp;
#pragma unroll
            for (int j = 0; j < 16; ++j) num[nt][j] = 0.f;
#pragma unroll
            for (int ks = 0; ks < 4; ++ks) num[nt] = MFMA32(pack16(PT[ks >> 1], ks & 1), Vb[ks], num[nt]);
            }
        const float den = (lane < 32 ? dpv[0] : dpv[1]) + sct * qn;
        const float inv = 1.f / fmaxf(fabsf(den), __expf(-(bc + Mt)));
        sc_l[lane] = sct; inv_l[lane] = inv;
        WAVE_FENCE();
        { bf16x8 Cb[4];
#pragma unroll
          for (int kd = 0; kd < 4; ++kd) Cb[kd] = pack16(C[kd >> 1], kd & 1);
#pragma unroll
          for (int mt = 0; mt < 2; ++mt) { f32x16 qc;
#pragma unroll
              for (int j = 0; j < 16; ++j) qc[j] = 0.f;
#pragma unroll
              for (int kd = 0; kd < 4; ++kd) { const LAS unsigned char* qr = qr4 + kd * 2048 + mt * 512;
                  const s16x4 lo = *(const LAS s16x4*)qr, hi = *(const LAS s16x4*)(qr + 1024);
                  const bf16x8 a = __builtin_shufflevector(lo, hi, 0, 1, 2, 3, 4, 5, 6, 7);
                  qc = MFMA32(a, Cb[kd], qc); }
#pragma unroll
              for (int g = 0; g < 4; ++g) { const f32x4 s4 = *(const LAS f32x4*)(a4b + 128 + mt * 32 + 8 * g), i4 = *(const LAS f32x4*)(a4b + 192 + mt * 32 + 8 * g);
#pragma unroll
                  for (int jj = 0; jj < 4; ++jj) { const int i = 4 * g + jj; const float hv = (num[mt][i] + s4[jj] * qc[i]) * i4[jj];
                      yo[(t0 + mt * 32 + 8 * g + 4 * hh + jj) * 512 + h * 128 + sl * 32 + r] = f2bf(hv); } }
                } }
#pragma unroll
        for (int i = 0; i < 2; ++i) {
#pragma unroll
            for (int j = 0; j < 16; ++j) C[i][j] *= sclast;
#pragma unroll
            for (int ks = 0; ks < 4; ++ks) { const f32x4 wA = *(const LAS f32x4*)(a4b + 64 + 16 * ks), wB = *(const LAS f32x4*)(a4b + 64 + 16 * ks + 8);
                f32x8 kv;
#pragma unroll
                for (int j = 0; j < 8; ++j) kv[j] = bf2f(*(const LAS bf16_t*)(kbase + i * 4096 + (16 * ks + 8 * (j >> 2) + (j & 3)) * 16)) * (j < 4 ? wA[j & 3] : wB[j & 3]);
                C[i] = MFMA32(pack8v(kv), Vb[ks], C[i]); }
            }
        { float na = 0.f;
#pragma unroll
          for (int s4 = 0; s4 < 16; ++s4) { const f32x4 w4 = *(const LAS f32x4*)(w_l + s4 * 4);
#pragma unroll
              for (int e = 0; e < 4; ++e) na += w4[e] * bf2f(*(const LAS bf16_t*)(kn + (s4 * 4 + e) * 16)); }
          nst = sclast * nst + na; n_l[lane] = nst; }
        mprev = bc63 + M63;
        asm volatile("s_waitcnt lgkmcnt(0)" ::: "memory");
    }
    float* co = c.out + O_MLC_P + ((size_t)(L * NB + b) * 4 + h) * 64 * 128;
#pragma unroll
    for (int i = 0; i < 2; ++i)
#pragma unroll
        for (int j = 0; j < 16; ++j) co[(size_t)(i * 32 + crow(j, hh)) * 128 + sl * 32 + r] = C[i][j];
    if (sl == 0) { c.out[O_MLN_P + ((size_t)(L * NB + b) * 4 + h) * 64 + lane] = nst; if (lane == 0) c.out[O_MLM_P + (size_t)(L * NB + b) * 4 + h] = mprev; }
}

DI void task_gdn_sample(const Ctx& c, int L, int unit) {
    const int q4 = unit & 3, h = (unit >> 2) & 3, b = unit >> 4, lane = c.lane, c32 = lane & 31, hh2 = lane >> 5;
    const int dv = q4 * 32 + c32;
    const size_t row = (size_t)(MP + b);
    const bf16_t* pr = c.R1 + row * NPROJ;
    const float* cbuf = c.in[4] + ((size_t)L * MS + b) * 3 * 1536;
    const float* cw = c.in[23] + (size_t)L * 4 * 1536;
    float* cout = c.out + O_CONV_S + ((size_t)L * MS + b) * 3 * 1536;
    float qv[2], kv[2], vv;
#pragma unroll
    for (int w = 0; w < 5; ++w) {
        const int which = w < 2 ? 0 : w < 4 ? 1 : 2; const int d = (w == 4) ? dv : lane + 64 * (w & 1);
        const int cc = which * 512 + h * 128 + d;
        const float xin = bf2f(pr[PQ + cc]);
        const float b0 = cbuf[cc], b1 = cbuf[1536 + cc], b2 = cbuf[3072 + cc];
        float a = b0 * cw[cc] + b1 * cw[1536 + cc] + b2 * cw[3072 + cc] + xin * cw[4608 + cc];
        a = silu_(a);
        cout[cc] = b1; cout[1536 + cc] = b2; cout[3072 + cc] = xin;
        if (w < 2) qv[w] = a; else if (w < 4) kv[w - 2] = a; else vv = a;
    }
    { const float sq = wave_sum(qv[0] * qv[0] + qv[1] * qv[1]), sk = wave_sum(kv[0] * kv[0] + kv[1] * kv[1]);
      const float fq = rsqrtf(sq + EPS) * 0.08838834764831845f, fk = rsqrtf(sk + EPS);
      qv[0] *= fq; qv[1] *= fq; kv[0] *= fk; kv[1] *= fk; }
    const float qk = wave_sum(qv[0] * kv[0] + qv[1] * kv[1]);
    const float beta = sigm(c.SG[row * 16 + h]);
    const float g = -expf(c.in[24][L * 4 + h]) * softplus_(c.SG[row * 16 + 4 + h] + c.in[25][L * 4 + h]);
    const float eg = expf(g);
    const size_t soff = (((size_t)L * MS + b) * 4 + h) * 128 * 128 + (size_t)(hh2 * 64) * 128 + dv;
    const float* sin_ = c.in[5] + soff; float* sout = c.out + O_GDN_S + soff;
    float sreg[64];
#pragma unroll
    for (int d = 0; d < 64; ++d) sreg[d] = sin_[(size_t)d * 128];
    float kS = 0.f, qS = 0.f;
#pragma unroll
    for (int d = 0; d < 64; ++d) { const float ka = __shfl(kv[0], d), kb = __shfl(kv[1], d), qa = __shfl(qv[0], d), qb2 = __shfl(qv[1], d);
        kS += (hh2 ? kb : ka) * sreg[d]; qS += (hh2 ? qb2 : qa) * sreg[d]; }
    kS += __shfl_xor(kS, 32); qS += __shfl_xor(qS, 32);
    const float vnew = beta * (vv - eg * kS);
    const float o = eg * qS + qk * vnew;
#pragma unroll
    for (int d = 0; d < 64; ++d) { const float ka = __shfl(kv[0], d), kb = __shfl(kv[1], d); sout[(size_t)d * 128] = sreg[d] * eg + (hh2 ? kb : ka) * vnew; }
    if (hh2 == 0) c.Y3[(size_t)1 * MPAD * 512 + row * 512 + h * 128 + dv] = f2bf(o);
}
DI void task_ml_sample(const Ctx& c, int L, int unit) {
    const int half = unit & 1, h = (unit >> 1) & 3, b = unit >> 3, lane = c.lane;
    const size_t row = (size_t)(MP + b);
    const bf16_t* pr = c.R1 + row * NPROJ;
    const float q = bf2f(pr[PMQ + h * 64 + lane]), k = bf2f(pr[PMK + h * 64 + lane]) * 0.125f, v = bf2f(pr[PMV + h * 128 + half * 64 + lane]);
    const float li = softcap_(c.SG[row * 16 + 8 + h] + c.in[27][L * 4 + h]);
    const float lf = logsig_(softcap_(c.SG[row * 16 + 12 + h] + c.in[28][L * 4 + h]));
    const size_t sidx = ((size_t)L * MS + b) * 4 + h;
    const float m0 = c.in[8][sidx];
    const float mt = fmaxf(lf + m0, li), wts = expf(li - mt), sc = expf(lf + m0 - mt);
    const float n0 = c.in[7][sidx * 64 + lane];
    const float sqk = wave_sum(q * k) * wts, qn = wave_sum(q * n0);
    const float* cin = c.in[6] + sidx * 64 * 128 + half * 64 + lane;
    float* cout = c.out + O_MLC_S + sidx * 64 * 128 + half * 64 + lane;
    float cc[64]; float qC = 0.f;
#pragma unroll
    for (int d = 0; d < 64; ++d) { cc[d] = cin[(size_t)d * 128]; qC += __shfl(q, d) * cc[d]; }
    const float num = sqk * v + sc * qC, den = sqk + sc * qn;
    const float hv = num / fmaxf(fabsf(den), expf(-mt));
#pragma unroll
    for (int d = 0; d < 64; ++d) cout[(size_t)d * 128] = sc * cc[d] + wts * __shfl(k, d) * v;
    if (half == 0) { c.out[O_MLN_S + sidx * 64 + lane] = sc * n0 + wts * k; if (lane == 0) c.out[O_MLM_S + sidx] = mt; }
    c.Y3[(size_t)2 * MPAD * 512 + row * 512 + h * 128 + half * 64 + lane] = f2bf(hv);
}
struct S5P { float lr, li; f32x2 bb[16]; };
DI S5P s5_params(const Ctx& c, int L, int g, int p) {
    S5P P; const size_t gp = ((size_t)L * 32 + g) * 64 + p;
    const float are = c.in[13][gp], aim = c.in[14][gp], dt = expf(c.in[15][L * 32 + g]);
    const float mag = expf(are * dt); P.lr = mag * cosf(aim * dt); P.li = mag * sinf(aim * dt);
    const float inv = 1.f / (are * are + aim * aim), zr = P.lr - 1.f, zi = P.li;
    const float fre = (zr * are + zi * aim) * inv, fim = (zi * are - zr * aim) * inv;
    const float* Bre = c.in[16] + gp * 16; const float* Bim = c.in[17] + gp * 16;
#pragma unroll
    for (int q4 = 0; q4 < 4; ++q4) { const f32x4 br = *(const f32x4*)(Bre + 4 * q4), bi = *(const f32x4*)(Bim + 4 * q4);
#pragma unroll
        for (int e = 0; e < 4; ++e) { P.bb[4 * q4 + e][0] = fre * br[e] - fim * bi[e]; P.bb[4 * q4 + e][1] = fre * bi[e] + fim * br[e]; } }
    return P;
}
DI void task_s5_sample(const Ctx& c, int L, int unit) {
    const int g = unit & 31, b = unit >> 5, lane = c.lane;
    const S5P P = s5_params(c, L, g, lane);
    const size_t row = (size_t)(MP + b);
    const bf16_t* pr = c.R1 + row * NPROJ + PU + g * 16;
    float u[16];
    { const f32x8 u0 = unpack8(*(const bf16x8*)pr), u1 = unpack8(*(const bf16x8*)(pr + 8));
#pragma unroll
      for (int e = 0; e < 8; ++e) { u[e] = u0[e]; u[8 + e] = u1[e]; } }
    f32x2 bu = {0.f, 0.f};
#pragma unroll
    for (int cc = 0; cc < 16; ++cc) bu += P.bb[cc] * u[cc];
    const size_t si = (((size_t)L * MS + b) * 32 + g) * 64 + lane;
    const float h0r = c.in[2][si], h0i = c.in[3][si];
    const float hr = P.lr * h0r - P.li * h0i + bu[0], hi = P.lr * h0i + P.li * h0r + bu[1];
    c.out[O_S5RE_S + si] = hr; c.out[O_S5IM_S + si] = hi;
    const float* Cre = c.in[18] + ((size_t)L * 32 + g) * 16 * 64; const float* Cim = c.in[19] + ((size_t)L * 32 + g) * 16 * 64;
    float ya[16];
#pragma unroll
    for (int cc = 0; cc < 16; ++cc) ya[cc] = hr * Cre[cc * 64 + lane] - hi * Cim[cc * 64 + lane];
    butterfly16(ya, lane);
    if ((lane & 3) == 0) { const int cc = bsel16(lane); const float y = ya[0] + c.in[20][L * 512 + g * 16 + cc] * bf2f(pr[cc]);
        c.YS5[row * 512 + g * 16 + cc] = f2bf(gelu_t(y)); }
}

DI void task_s5_wave(const Ctx& c, int L, int unit, unsigned char* wlds  ) {
    LAS float* Uw = (LAS float*)wlds;
    LAS bf16_t* Hw = (LAS bf16_t*)(wlds + 4096);
    const int lane = c.lane;
    const int g = unit & 31, b = unit >> 5;
    const S5P P = s5_params(c, L, g, lane);
    const size_t rbase = (size_t)(b * SEQ);
    const bf16_t* ub = c.R1 + rbase * NPROJ + PU + g * 16;
    bf16x8 Cb[4];
    { const int cc = lane & 15, kq = (lane >> 4) * 8; const float* Cre = c.in[18] + (((size_t)L * 32 + g) * 16 + cc) * 64; const float* Cim = c.in[19] + (((size_t)L * 32 + g) * 16 + cc) * 64;
#pragma unroll
      for (int ks = 0; ks < 4; ++ks) { f32x8 v;
#pragma unroll
          for (int j = 0; j < 8; ++j) { const int k = ks * 32 + kq + j; v[j] = (k < 64) ? Cre[k] : -Cim[k - 64]; }
          Cb[ks] = pack8v(v); } }
    const float dskip = c.in[20][L * 512 + g * 16 + (lane & 15)];
    float hr = 0.f, hi = 0.f;
    for (int sub = 0; sub < 32; ++sub) {
        WAVE_FENCE();
        { const bf16_t* up = ub + (size_t)(sub * 64 + lane) * NPROJ; const f32x8 u0 = unpack8(*(const bf16x8*)up), u1 = unpack8(*(const bf16x8*)(up + 8));
          LAS f32x4* d = (LAS f32x4*)(Uw + lane * 16);
          d[0] = (f32x4){u0[0], u0[1], u0[2], u0[3]}; d[1] = (f32x4){u0[4], u0[5], u0[6], u0[7]}; d[2] = (f32x4){u1[0], u1[1], u1[2], u1[3]}; d[3] = (f32x4){u1[4], u1[5], u1[6], u1[7]}; }
        WAVE_FENCE();
        for (int blk = 0; blk < 4; ++blk) {
#pragma unroll 4
            for (int st = 0; st < 16; ++st) {
                const LAS f32x4* up4 = (const LAS f32x4*)(Uw + (blk * 16 + st) * 16);
                f32x2 bu = {0.f, 0.f};
#pragma unroll
                for (int q4 = 0; q4 < 4; ++q4) { const f32x4 uv = up4[q4];
#pragma unroll
                    for (int e = 0; e < 4; ++e) bu += P.bb[4 * q4 + e] * uv[e]; }
                const float nr = P.lr * hr - P.li * hi + bu[0], ni = P.lr * hi + P.li * hr + bu[1]; hr = nr; hi = ni;
                Hw[st * 128 + lane] = f2bf(hr); Hw[st * 128 + 64 + lane] = f2bf(hi);
            }
            WAVE_FENCE();
            f32x4 acc = {0.f, 0.f, 0.f, 0.f};
#pragma unroll
            for (int ks = 0; ks < 4; ++ks) { const bf16x8 a = *(const LAS bf16x8*)(Hw + (lane & 15) * 128 + ks * 32 + (lane >> 4) * 8); acc = MFMA16(a, Cb[ks], acc); }
            const int cc = lane & 15;
#pragma unroll
            for (int j = 0; j < 4; ++j) { const int st = (lane >> 4) * 4 + j; const int tl = blk * 16 + st;
                const float y = acc[j] + dskip * Uw[tl * 16 + cc];
                c.YS5[(rbase + sub * 64 + tl) * 512 + g * 16 + cc] = f2bf(gelu_t(y)); }
            WAVE_FENCE();
        }
    }
    { const size_t si = (((size_t)L * NB + b) * 32 + g) * 64 + lane; c.out[O_S5RE_P + si] = hr; c.out[O_S5IM_P + si] = hi; }
}

constexpr int S5Q_BASE = 122880, S5Q_F = S5Q_BASE + 32768, S5Q_FLAG = S5Q_F + 2048;
template <int PASS> DI void s5_steps16(const S5P& P, const LAS float* Ublk, LAS bf16_t* Hw, int lane, float& hr, float& hi) {
#pragma unroll
    for (int s4 = 0; s4 < 4; ++s4) {
        f32x4 uv[4][4];
#pragma unroll
        for (int j = 0; j < 4; ++j)
#pragma unroll
            for (int q4 = 0; q4 < 4; ++q4) uv[j][q4] = *(const LAS f32x4*)(Ublk + (s4 * 4 + j) * 16 + q4 * 4);
        asm volatile("" ::: "memory");
        f32x2 bu[4];
#pragma unroll
        for (int j = 0; j < 4; ++j) { f32x2 acc[4];
#pragma unroll
            for (int q4 = 0; q4 < 4; ++q4) { acc[q4] = P.bb[4 * q4] * uv[j][q4][0];
#pragma unroll
                for (int e = 1; e < 4; ++e) acc[q4] += P.bb[4 * q4 + e] * uv[j][q4][e]; }
            bu[j] = (acc[0] + acc[1]) + (acc[2] + acc[3]); }
#pragma unroll
        for (int j = 0; j < 4; ++j) { const float nr = P.lr * hr - P.li * hi + bu[j][0], ni = P.lr * hi + P.li * hr + bu[j][1]; hr = nr; hi = ni;
            if (PASS == 1) { Hw[(s4 * 4 + j) * 128 + lane] = f2bf(hr); Hw[(s4 * 4 + j) * 128 + 64 + lane] = f2bf(hi); } }
    }
}
DI void task_s5_quad(const Ctx& c, int L, int unit, int wq, int gen) {
    unsigned char* wlds = c.lds + S5Q_BASE + wq * 8192;
    LAS float* Uw = (LAS float*)wlds;
    LAS bf16_t* Hw = (LAS bf16_t*)(wlds + 4096);
    LAS float* F = (LAS float*)(c.lds + S5Q_F);
    volatile LAS int* flag = (volatile LAS int*)(c.lds + S5Q_FLAG);
    const int lane = c.lane;
    const int g = unit & 31, b = unit >> 5;
    const S5P P = s5_params(c, L, g, lane);
    float pr_ = P.lr, pi_ = P.li;
#pragma unroll
    for (int i = 0; i < 9; ++i) { const float nr = pr_ * pr_ - pi_ * pi_, ni = 2.f * pr_ * pi_; pr_ = nr; pi_ = ni; }
    const size_t rbase = (size_t)(b * SEQ + wq * 512);
    const bf16_t* ub = c.R1 + rbase * NPROJ + PU + g * 16;
    bf16x8 Cb[4];
    { const int cc = lane & 15, kq = (lane >> 4) * 8; const float* Cre = c.in[18] + (((size_t)L * 32 + g) * 16 + cc) * 64; const float* Cim = c.in[19] + (((size_t)L * 32 + g) * 16 + cc) * 64;
#pragma unroll
      for (int ks = 0; ks < 4; ++ks) { f32x8 v;
#pragma unroll
          for (int j = 0; j < 8; ++j) { const int k = ks * 32 + kq + j; v[j] = (k < 64) ? Cre[k] : -Cim[k - 64]; }
          Cb[ks] = pack8v(v); } }
    const float dskip = c.in[20][L * 512 + g * 16 + (lane & 15)];
    float hr = 0.f, hi = 0.f;
    for (int pass = 0; pass < 2; ++pass) {
        if (pass == 1) {
            hr = 0.f; hi = 0.f;
            for (int v = 0; v < wq; ++v) { while (flag[v] != gen) __builtin_amdgcn_s_sleep(2);
                asm volatile("" ::: "memory");
                const float fr = F[v * 128 + lane], fi = F[v * 128 + 64 + lane];
                const float nr = pr_ * hr - pi_ * hi + fr, ni = pr_ * hi + pi_ * hr + fi; hr = nr; hi = ni; }
        }
        for (int sub = 0; sub < 8; ++sub) {
            WAVE_FENCE();
            { const bf16_t* up = ub + (size_t)(sub * 64 + lane) * NPROJ; const f32x8 u0 = unpack8(*(const bf16x8*)up), u1 = unpack8(*(const bf16x8*)(up + 8));
              LAS f32x4* d = (LAS f32x4*)(Uw + lane * 16);
              d[0] = (f32x4){u0[0], u0[1], u0[2], u0[3]}; d[1] = (f32x4){u0[4], u0[5], u0[6], u0[7]}; d[2] = (f32x4){u1[0], u1[1], u1[2], u1[3]}; d[3] = (f32x4){u1[4], u1[5], u1[6], u1[7]}; }
            WAVE_FENCE();
            for (int blk = 0; blk < 4; ++blk) {
                if (pass == 1) s5_steps16<1>(P, Uw + blk * 256, Hw, lane, hr, hi); else s5_steps16<0>(P, Uw + blk * 256, Hw, lane, hr, hi);
                if (pass == 1) {
                    WAVE_FENCE();
                    f32x4 acc = {0.f, 0.f, 0.f, 0.f};
#pragma unroll
                    for (int ks = 0; ks < 4; ++ks) { const bf16x8 a = *(const LAS bf16x8*)(Hw + (lane & 15) * 128 + ks * 32 + (lane >> 4) * 8); acc = MFMA16(a, Cb[ks], acc); }
                    const int cc = lane & 15;
#pragma unroll
                    for (int j = 0; j < 4; ++j) { const int st = (lane >> 4) * 4 + j; const int tl = blk * 16 + st;
                        const float y = acc[j] + dskip * Uw[tl * 16 + cc];
                        c.YS5[(rbase + sub * 64 + tl) * 512 + g * 16 + cc] = f2bf(gelu_t(y)); }
                    WAVE_FENCE();
                }
            }
        }
        if (pass == 0) {
            if (wq < 3) { F[wq * 128 + lane] = hr; F[wq * 128 + 64 + lane] = hi; WAVE_FENCE(); if (lane == 0) flag[wq] = gen; }
        }
    }
    if (wq == 3) { const size_t si = (((size_t)L * NB + b) * 32 + g) * 64 + lane; c.out[O_S5RE_P + si] = hr; c.out[O_S5IM_P + si] = hi; }
}

DI void phase_s5_scan(const Ctx& c, int L) {
    float* U = (float*)c.lds;
    bf16_t* H = (bf16_t*)(c.lds + 32768);
    float* F = (float*)(c.lds + 65536);
    const int lane = c.lane, w = c.wave;
    float* Uw = U + w * 1024; bf16_t* Hw = H + w * 2048;
    for (int unit = c.bid; unit < 256; unit += c.G) {
        const int g = unit & 31, b = unit >> 5;
        const S5P P = s5_params(c, L, g, lane);
        float pr_ = P.lr, pi_ = P.li;
#pragma unroll
        for (int i = 0; i < 8; ++i) { const float nr = pr_ * pr_ - pi_ * pi_, ni = 2.f * pr_ * pi_; pr_ = nr; pi_ = ni; }
        const size_t rbase = (size_t)(b * SEQ + w * 256);
        const bf16_t* ub = c.R1 + rbase * NPROJ + PU + g * 16;
        bf16x8 Cb[4];
        { const int cc = lane & 15, kq = (lane >> 4) * 8; const float* Cre = c.in[18] + (((size_t)L * 32 + g) * 16 + cc) * 64; const float* Cim = c.in[19] + (((size_t)L * 32 + g) * 16 + cc) * 64;
#pragma unroll
          for (int ks = 0; ks < 4; ++ks) { f32x8 v;
#pragma unroll
              for (int j = 0; j < 8; ++j) { const int k = ks * 32 + kq + j; v[j] = (k < 64) ? Cre[k] : -Cim[k - 64]; }
              Cb[ks] = pack8v(v); } }
        const float dskip = c.in[20][L * 512 + g * 16 + (lane & 15)];
        float hr = 0.f, hi = 0.f;
        for (int pass = 0; pass < 2; ++pass) {
            if (pass == 1) {
                F[w * 128 + lane] = hr; F[w * 128 + 64 + lane] = hi;
                __syncthreads();
                hr = 0.f; hi = 0.f;
                for (int v = 0; v < w; ++v) { const float fr = F[v * 128 + lane], fi = F[v * 128 + 64 + lane];
                    const float nr = pr_ * hr - pi_ * hi + fr, ni = pr_ * hi + pi_ * hr + fi; hr = nr; hi = ni; }
            }
            for (int sub = 0; sub < 4; ++sub) {
                __syncthreads();
                { const bf16_t* up = ub + (size_t)(sub * 64 + lane) * NPROJ; const f32x8 u0 = unpack8(*(const bf16x8*)up), u1 = unpack8(*(const bf16x8*)(up + 8));
                  f32x4* d = (f32x4*)(Uw + lane * 16);
                  d[0] = (f32x4){u0[0], u0[1], u0[2], u0[3]}; d[1] = (f32x4){u0[4], u0[5], u0[6], u0[7]}; d[2] = (f32x4){u1[0], u1[1], u1[2], u1[3]}; d[3] = (f32x4){u1[4], u1[5], u1[6], u1[7]}; }
                __syncthreads();
                for (int blk = 0; blk < 4; ++blk) {
#pragma unroll 4
                    for (int st = 0; st < 16; ++st) {
                        const f32x4* up4 = (const f32x4*)(Uw + (blk * 16 + st) * 16);
                        f32x2 bu = {0.f, 0.f};
#pragma unroll
                        for (int q4 = 0; q4 < 4; ++q4) { const f32x4 uv = up4[q4];
#pragma unroll
                            for (int e = 0; e < 4; ++e) bu += P.bb[4 * q4 + e] * uv[e]; }
                        const float nr = P.lr * hr - P.li * hi + bu[0], ni = P.lr * hi + P.li * hr + bu[1]; hr = nr; hi = ni;
                        if (pass == 1) { Hw[st * 128 + lane] = f2bf(hr); Hw[st * 128 + 64 + lane] = f2bf(hi); }
                    }
                    if (pass == 1) {
                        __syncthreads();
                        f32x4 acc = {0.f, 0.f, 0.f, 0.f};
#pragma unroll
                        for (int ks = 0; ks < 4; ++ks) { const bf16x8 a = *(const bf16x8*)(Hw + (lane & 15) * 128 + ks * 32 + (lane >> 4) * 8); acc = MFMA16(a, Cb[ks], acc); }
                        const int cc = lane & 15;
#pragma unroll
                        for (int j = 0; j < 4; ++j) { const int st = (lane >> 4) * 4 + j; const int tl = blk * 16 + st;
                            const float y = acc[j] + dskip * Uw[tl * 16 + cc];
                            c.YS5[(rbase + sub * 64 + tl) * 512 + g * 16 + cc] = f2bf(gelu_t(y)); }
                        __syncthreads();
                    }
                }
            }
        }
        if (w == 7) { const size_t si = (((size_t)L * NB + b) * 32 + g) * 64 + lane; c.out[O_S5RE_P + si] = hr; c.out[O_S5IM_P + si] = hi; }
        __syncthreads();
    }
}


#ifdef SELFCHK
DI void blk_reduce2(float& a, float& b, float* red, int tid) {
    a = wave_sum(a); b = wave_sum(b);
    __syncthreads();
    if ((tid & 63) == 0) { red[tid >> 6] = a; red[8 + (tid >> 6)] = b; }
    __syncthreads();
    float x = 0.f, y = 0.f;
    for (int i = 0; i < 8; ++i) { x += red[i]; y += red[8 + i]; }
    a = x; b = y; __syncthreads();
}
DI void chk_gdn(const Ctx& c, int L, int b, int h, float* dg) {
    float* q = (float*)c.lds; float* k = q + 128; float* v = k + 128; float* part = v + 128; float* red = part + 512; float* sc_ = red + 16;
    const int tid = c.tid, dv = tid & 127, qt = tid >> 7;
    const float* convw = c.in[23] + (size_t)L * 4 * 1536;
    float S[32];
#pragma unroll
    for (int i = 0; i < 32; ++i) S[i] = 0.f;
    float e2 = 0.f, r2 = 0.f;
    for (int t = 0; t < SEQ; ++t) {
        const size_t row = (size_t)b * SEQ + t;
        if (tid < 384) { const int which = tid >> 7, d = tid & 127; float a = 0.f;
            for (int j = 0; j < 4; ++j) { const int tt = t + j - 3; if (tt >= 0) a += bf2f(c.R1[((size_t)b * SEQ + tt) * NPROJ + PQ + which * 512 + h * 128 + d]) * convw[j * 1536 + which * 512 + h * 128 + d]; }
            (which == 0 ? q : which == 1 ? k : v)[d] = silu_(a); }
        __syncthreads();
        float sq = 0.f, sk = 0.f;
        for (int d = 0; d < 128; ++d) { sq += q[d] * q[d]; sk += k[d] * k[d]; }
        const float fq = rsqrtf(sq + EPS) * 0.08838834764831845f, fk = rsqrtf(sk + EPS);
        const float beta = sigm(c.SG[row * 16 + h]);
        const float g = -expf(c.in[24][L * 4 + h]) * softplus_(c.SG[row * 16 + 4 + h] + c.in[25][L * 4 + h]);
        const float eg = expf(g);
        float ks = 0.f;
#pragma unroll
        for (int i = 0; i < 32; ++i) { S[i] *= eg; ks += k[qt * 32 + i] * fk * S[i]; }
        part[qt * 128 + dv] = ks;
        __syncthreads();
        const float kS = part[dv] + part[128 + dv] + part[256 + dv] + part[384 + dv];
        const float vnew = beta * (v[dv] - kS);
        float qs = 0.f;
#pragma unroll
        for (int i = 0; i < 32; ++i) { S[i] += k[qt * 32 + i] * fk * vnew; qs += q[qt * 32 + i] * fq * S[i]; }
        __syncthreads();
        part[qt * 128 + dv] = qs;
        __syncthreads();
        if (qt == 0) { const float o = part[dv] + part[128 + dv] + part[256 + dv] + part[384 + dv];
            const float got = bf2f(c.Y3[(size_t)1 * MPAD * 512 + row * 512 + h * 128 + dv]); e2 += (got - o) * (got - o); r2 += o * o; }
        __syncthreads();
    }
    blk_reduce2(e2, r2, red, tid);
    if (tid == 0) dg[0] = sqrtf(e2 / (r2 + 1e-30f));
    float e3 = 0.f, r3 = 0.f;
#pragma unroll
    for (int i = 0; i < 32; ++i) { const float got = c.out[O_GDN_P + (((size_t)L * NB + b) * 4 + h) * 16384 + (size_t)(qt * 32 + i) * 128 + dv]; e3 += (got - S[i]) * (got - S[i]); r3 += S[i] * S[i]; }
    blk_reduce2(e3, r3, red, tid);
    if (tid == 0) dg[1] = sqrtf(e3 / (r3 + 1e-30f));
    (void)sc_;
}
DI void chk_ml(const Ctx& c, int L, int b, int h, float* dg) {
    float* q = (float*)c.lds; float* k = q + 64; float* v = k + 64; float* n = v + 128; float* part = n + 64; float* red = part + 512;
    const int tid = c.tid, e = tid & 127, qt = tid >> 7;
    float C[16];
#pragma unroll
    for (int i = 0; i < 16; ++i) C[i] = 0.f;
    if (tid < 64) n[tid] = 0.f;
    float m = 0.f, e2 = 0.f, r2 = 0.f;
    __syncthreads();
    for (int t = 0; t < SEQ; ++t) {
        const size_t row = (size_t)b * SEQ + t;
        if (tid < 64) { q[tid] = bf2f(c.R1[row * NPROJ + PMQ + h * 64 + tid]); k[tid] = bf2f(c.R1[row * NPROJ + PMK + h * 64 + tid]) * 0.125f; }
        else if (tid < 192) v[tid - 64] = bf2f(c.R1[row * NPROJ + PMV + h * 128 + tid - 64]);
        __syncthreads();
        const float li = softcap_(c.SG[row * 16 + 8 + h] + c.in[27][L * 4 + h]);
        const float lf = logsig_(softcap_(c.SG[row * 16 + 12 + h] + c.in[28][L * 4 + h]));
        const float mn = fmaxf(lf + m, li), wts = expf(li - mn), sc = expf(lf + m - mn);
        float qk = 0.f, qn = 0.f;
        for (int d = 0; d < 64; ++d) { qk += q[d] * k[d]; qn += q[d] * n[d]; }
        float pc = 0.f;
#pragma unroll
        for (int i = 0; i < 16; ++i) pc += q[qt * 16 + i] * C[i];
        part[qt * 128 + e] = pc;
        __syncthreads();
        const float qC = part[e] + part[128 + e] + part[256 + e] + part[384 + e];
        const float sqk = qk * wts, num = sqk * v[e] + sc * qC, den = sqk + sc * qn;
        const float hv = num / fmaxf(fabsf(den), expf(-mn));
        if (qt == 0) { const float got = bf2f(c.Y3[(size_t)2 * MPAD * 512 + row * 512 + h * 128 + e]); e2 += (got - hv) * (got - hv); r2 += hv * hv; }
#pragma unroll
        for (int i = 0; i < 16; ++i) C[i] = sc * C[i] + wts * k[qt * 16 + i] * v[e];
        __syncthreads();
        if (tid < 64) n[tid] = sc * n[tid] + wts * k[tid];
        m = mn;
        __syncthreads();
    }
    blk_reduce2(e2, r2, red, tid);
    if (tid == 0) dg[2] = sqrtf(e2 / (r2 + 1e-30f));
    float e3 = 0.f, r3 = 0.f;
#pragma unroll
    for (int i = 0; i < 16; ++i) { const float got = c.out[O_MLC_P + (((size_t)L * NB + b) * 4 + h) * 8192 + (size_t)(qt * 16 + i) * 128 + e]; e3 += (got - C[i]) * (got - C[i]); r3 += C[i] * C[i]; }
    if (tid < 64) { const float got = c.out[O_MLN_P + (((size_t)L * NB + b) * 4 + h) * 64 + tid]; e3 += (got - n[tid]) * (got - n[tid]) * 64.f; r3 += n[tid] * n[tid] * 64.f; }
    if (tid == 0) { const float got = c.out[O_MLM_P + ((size_t)L * NB + b) * 4 + h]; e3 += (got - m) * (got - m) * 4096.f; r3 += m * m * 4096.f; }
    blk_reduce2(e3, r3, red, tid);
    if (tid == 0) dg[3] = sqrtf(e3 / (r3 + 1e-30f));
}
DI void chk_s5(const Ctx& c, int L, int b, int g, float* dg) {
    float* red = (float*)c.lds;
    float e2 = 0.f, r2 = 0.f, e3 = 0.f, r3 = 0.f;
    if (c.tid < 64) { const int lane = c.tid; const S5P P = s5_params(c, L, g, lane);
        const float* Cre = c.in[18] + ((size_t)L * 32 + g) * 16 * 64; const float* Cim = c.in[19] + ((size_t)L * 32 + g) * 16 * 64;
        float hr = 0.f, hi = 0.f;
        for (int t = 0; t < SEQ; ++t) { const size_t row = (size_t)b * SEQ + t; const bf16_t* pr = c.R1 + row * NPROJ + PU + g * 16;
            f32x2 bu = {0.f, 0.f};
#pragma unroll
            for (int cc = 0; cc < 16; ++cc) bu += P.bb[cc] * bf2f(pr[cc]);
            const float nr = P.lr * hr - P.li * hi + bu[0], ni = P.lr * hi + P.li * hr + bu[1]; hr = nr; hi = ni;
            for (int cc = 0; cc < 16; ++cc) { float y = wave_sum(hr * Cre[cc * 64 + lane] - hi * Cim[cc * 64 + lane]) + c.in[20][L * 512 + g * 16 + cc] * bf2f(pr[cc]);
                y = gelu_t(y); const float got = bf2f(c.YS5[row * 512 + g * 16 + cc]); if (lane == 0) { e2 += (got - y) * (got - y); r2 += y * y; } } }
        const size_t si = (((size_t)L * NB + b) * 32 + g) * 64 + lane;
        e3 = (c.out[O_S5RE_P + si] - hr) * (c.out[O_S5RE_P + si] - hr) + (c.out[O_S5IM_P + si] - hi) * (c.out[O_S5IM_P + si] - hi); r3 = hr * hr + hi * hi; }
    blk_reduce2(e2, r2, red, c.tid);
    blk_reduce2(e3, r3, red, c.tid);
    if (c.tid == 0) { dg[4] = sqrtf(e2 / (r2 + 1e-30f)); dg[5] = sqrtf(e3 / (r3 + 1e-30f)); }
}
#endif


#ifdef SELFCHK
DI float dot_bf(const bf16_t* a, const bf16_t* b, int K) { float s = 0.f; for (int k = 0; k < K; ++k) s += bf2f(a[k]) * bf2f(b[k]); return s; }
DI void chk_gemm(const Ctx& c, int L, int mode, float* dgp) {
    float* red = (float*)c.lds;
    float e2 = 0.f, r2 = 0.f;
    for (int rep = 0; rep < 2; ++rep) {
        const int sidx = c.tid + 512 * rep;
        const int row = (rep == 1 && c.tid < 64) ? MP + (c.tid * 2) : (int)(((unsigned)sidx * 7919u) % (unsigned)MP);
        float want = 0.f, got = 0.f;
        if (mode == 0) { const int col = (int)(((unsigned)sidx * 104729u) % 4096u); want = dot_bf(c.XN + (size_t)row * 1024, c.W + WO_IN + (size_t)col * 1024, 1024); got = bf2f(c.R1[(size_t)row * 4096 + col]); }
        if (mode == 1) { const int col = (int)(((unsigned)sidx * 104729u) % 3072u); want = sigm(dot_bf(c.XN + (size_t)row * 1024, c.W + WO_G + (size_t)col * 1024, 1024)); got = bf2f(c.R1[(size_t)row * 4096 + col]); }
        if (mode == 2) { const int col = (int)(((unsigned)sidx * 104729u) % 512u); const float y = bf2f(c.YS5[(size_t)row * 512 + col]);
            want = y * sigm(dot_bf(c.YS5 + (size_t)row * 512, c.W + WO_GLU + (size_t)col * 512, 512) + c.in[22][L * 512 + col]); got = bf2f(c.Y3[(size_t)row * 512 + col]); }
        if (mode == 3) { const int col = (int)(((unsigned)sidx * 104729u) % 1024u);
            for (int br = 0; br < 3; ++br) want += bf2f(c.R1[(size_t)row * 4096 + br * 1024 + col]) * dot_bf(c.Y3 + (size_t)br * MPAD * 512 + (size_t)row * 512, c.W + WO_BR + (size_t)br * 1024 * 512 + (size_t)col * 512, 512);
            got = bf2f(c.XN[(size_t)row * 1024 + col]); }
        if (mode == 4) { const int col = (int)(((unsigned)sidx * 104729u) % 4096u); const float d = fmaxf(dot_bf(c.XN + (size_t)row * 1024, c.W + WO_UP + (size_t)col * 1024, 1024), 0.f); want = d * d; got = bf2f(c.R1[(size_t)row * 4096 + col]); }
        if (mode == 5) { const int col = (int)(((unsigned)sidx * 104729u) % 1024u); want = dot_bf(c.Y3 + (size_t)row * 256, c.W + WO_PLE + (size_t)col * 256, 256); got = bf2f(c.Y3[(size_t)MPAD * 256 + (size_t)row * 1024 + col]); }
        e2 += (got - want) * (got - want); r2 += want * want;
    }
    blk_reduce2(e2, r2, red, c.tid);
    if (c.tid == 0) *dgp = sqrtf(e2 / (r2 + 1e-30f));
}
#endif

#ifdef SELFCHK
DI void chk_sg(const Ctx& c, float* dgp) {
    float* red = (float*)c.lds; float e2 = 0.f, r2 = 0.f;
    { const int sidx = c.tid >> 4, s = c.tid & 15; const int row = (sidx < 8) ? MP + sidx * 13 : (int)(((unsigned)sidx * 7919u * 37u) % (unsigned)MP);
      const float* x = row < MP ? c.in[0] + (size_t)row * 1024 : c.in[1] + (size_t)(row - MP) * 1024;
      const int sc = s < 4 ? 2560 + s : s < 8 ? 2564 + (s - 4) : s < 12 ? 4104 + (s - 8) : 4108 + (s - 12);
      float ss = 0.f; for (int k = 0; k < 1024; ++k) ss += x[k] * x[k];
      const float rs = rsqrtf(ss * (1.f / 1024.f) + EPS); float a = 0.f;
      for (int k = 0; k < 1024; ++k) a += x[k] * rs * c.in[11][k] * c.in[12][(size_t)k * DIN + sc];
      const float got = c.SG[(size_t)row * 16 + s]; e2 = (got - a) * (got - a); r2 = a * a; }
    blk_reduce2(e2, r2, red, c.tid);
    if (c.tid == 0) *dgp = sqrtf(e2 / (r2 + 1e-30f));
}
DI void chk_post(const Ctx& c, int L, float* dgp) {
    float* red = (float*)c.lds; float e2 = 0.f, r2 = 0.f;
    { const int hd8 = c.tid & 7, sidx = c.tid >> 3; const int row = (sidx < 8) ? MP + sidx * 11 : (int)(((unsigned)sidx * 7919u * 53u) % (unsigned)MP);
      const int br = hd8 >> 2, hd = hd8 & 3; float ms = 0.f;
      for (int e = 0; e < 128; ++e) { const float y = bf2f(c.Y3[(size_t)(1 + br) * MPAD * 512 + (size_t)row * 512 + hd * 128 + e]);
          const float z = bf2f(c.R1[(size_t)row * NPROJ + (br == 0 ? PZ : PMO) + hd * 128 + e]);
          const float gn = br == 0 ? c.in[26][L * 128 + e] : c.in[29][L * 512 + hd * 128 + e];
          const float w = y / (gn * (br == 0 ? silu_(z) : sigm(z))); ms += w * w; }
      ms *= (1.f / 128.f); e2 = (ms - 1.f) * (ms - 1.f); r2 = 1.f; }
    blk_reduce2(e2, r2, red, c.tid);
    if (c.tid == 0) *dgp = sqrtf(e2 / (r2 + 1e-30f));
}
DI void chk_res(const Ctx& c, int L, int mode, const float (&snap)[2], float* dgp) {
    float* red = (float*)c.lds; float e2 = 0.f, r2 = 0.f;
    for (int rep = 0; rep < 2; ++rep) { const int sidx = c.tid + 512 * rep;
        const int row = (rep == 1 && c.tid < 64) ? MP + (c.tid * 2) : (int)(((unsigned)sidx * 7919u) % (unsigned)MP); const int col = (int)(((unsigned)sidx * 104729u) % 1024u);
        const float now = c.out[(size_t)row * 1024 + col]; float before = snap[rep], want = 0.f;
        if (mode == 0) { before = row < MP ? c.in[0][(size_t)row * 1024 + col] : c.in[1][(size_t)(row - MP) * 1024 + col]; want = dot_bf(c.XN + (size_t)row * 1024, c.W + WO_OUT + (size_t)col * 1024, 1024); }
        if (mode == 1) want = dot_bf(c.R1 + (size_t)row * 4096, c.W + WO_DN + (size_t)col * 4096, 4096);
        if (mode == 2) want = bf2f(c.Y3[(size_t)MPAD * 256 + (size_t)row * 1024 + col]) * sigm(dot_bf(c.XN + (size_t)row * 1024, c.W + WO_PG + (size_t)col * 1024, 1024));
        e2 += (now - before - want) * (now - before - want); r2 += want * want; }
    blk_reduce2(e2, r2, red, c.tid);
    if (c.tid == 0) *dgp = sqrtf(e2 / (r2 + 1e-30f));
}
DI void snap_x(const Ctx& c, float (&snap)[2]) {
    for (int rep = 0; rep < 2; ++rep) { const int sidx = c.tid + 512 * rep;
        const int row = (rep == 1 && c.tid < 64) ? MP + (c.tid * 2) : (int)(((unsigned)sidx * 7919u) % (unsigned)MP); const int col = (int)(((unsigned)sidx * 104729u) % 1024u);
        snap[rep] = c.out[(size_t)row * 1024 + col]; }
}
DI void chk_sample(const Ctx& c, int L, int b, int h, float* dgp) {
    float* red = (float*)c.lds; float e2 = 0.f, r2 = 0.f, e3 = 0.f, r3 = 0.f;
    const size_t row = (size_t)(MP + b); const bf16_t* pr = c.R1 + row * NPROJ;
    if (c.tid < 128) { const int dv = c.tid;
        const float* cbuf = c.in[4] + ((size_t)L * MS + b) * 3 * 1536; const float* cw = c.in[23] + (size_t)L * 4 * 1536;
        float sq = 0.f, sk = 0.f;
        for (int d = 0; d < 128; ++d) for (int w = 0; w < 2; ++w) { const int cc = w * 512 + h * 128 + d;
            const float a = silu_(cbuf[cc] * cw[cc] + cbuf[1536 + cc] * cw[1536 + cc] + cbuf[3072 + cc] * cw[3072 + cc] + bf2f(pr[PQ + cc]) * cw[4608 + cc]); if (w == 0) sq += a * a; else sk += a * a; }
        const float fq = rsqrtf(sq + EPS) * 0.08838834764831845f, fk = rsqrtf(sk + EPS);
        const int cv = 1024 + h * 128 + dv;
        const float vv = silu_(cbuf[cv] * cw[cv] + cbuf[1536 + cv] * cw[1536 + cv] + cbuf[3072 + cv] * cw[3072 + cv] + bf2f(pr[PQ + cv]) * cw[4608 + cv]);
        const float beta = sigm(c.SG[row * 16 + h]), eg = expf(-expf(c.in[24][L * 4 + h]) * softplus_(c.SG[row * 16 + 4 + h] + c.in[25][L * 4 + h]));
        const float* S0 = c.in[5] + (((size_t)L * MS + b) * 4 + h) * 16384; const float* S1 = c.out + O_GDN_S + (((size_t)L * MS + b) * 4 + h) * 16384;
        float kS = 0.f, qS = 0.f, qk = 0.f;
        for (int d = 0; d < 128; ++d) { const int cq = h * 128 + d, ck = 512 + h * 128 + d;
            const float qd = silu_(cbuf[cq] * cw[cq] + cbuf[1536 + cq] * cw[1536 + cq] + cbuf[3072 + cq] * cw[3072 + cq] + bf2f(pr[PQ + cq]) * cw[4608 + cq]) * fq;
            const float kd = silu_(cbuf[ck] * cw[ck] + cbuf[1536 + ck] * cw[1536 + ck] + cbuf[3072 + ck] * cw[3072 + ck] + bf2f(pr[PQ + ck]) * cw[4608 + ck]) * fk;
            kS += kd * S0[d * 128 + dv]; qS += qd * S0[d * 128 + dv]; qk += qd * kd; }
        const float vnew = beta * (vv - eg * kS);
        for (int d = 0; d < 128; ++d) { const int ck = 512 + h * 128 + d;
            const float kd = silu_(cbuf[ck] * cw[ck] + cbuf[1536 + ck] * cw[1536 + ck] + cbuf[3072 + ck] * cw[3072 + ck] + bf2f(pr[PQ + ck]) * cw[4608 + ck]) * fk;
            const float want = S0[d * 128 + dv] * eg + kd * vnew, got = S1[d * 128 + dv]; e2 += (got - want) * (got - want); r2 += want * want; }
        (void)qS; (void)qk;
    } else if (c.tid < 256) { const int e = c.tid - 128;
        const size_t sidx = ((size_t)L * MS + b) * 4 + h;
        const float li = softcap_(c.SG[row * 16 + 8 + h] + c.in[27][L * 4 + h]), lf = logsig_(softcap_(c.SG[row * 16 + 12 + h] + c.in[28][L * 4 + h]));
        const float m0 = c.in[8][sidx], mt = fmaxf(lf + m0, li), wts = expf(li - mt), sc = expf(lf + m0 - mt);
        const float v = bf2f(pr[PMV + h * 128 + e]);
        for (int d = 0; d < 64; ++d) { const float k = bf2f(pr[PMK + h * 64 + d]) * 0.125f;
            const float want = sc * c.in[6][sidx * 8192 + d * 128 + e] + wts * k * v, got = c.out[O_MLC_S + sidx * 8192 + d * 128 + e]; e3 += (got - want) * (got - want); r3 += want * want; }
        if (e < 64) { const float k = bf2f(pr[PMK + h * 64 + e]) * 0.125f; const float want = sc * c.in[7][sidx * 64 + e] + wts * k, got = c.out[O_MLN_S + sidx * 64 + e]; e3 += 64.f * (got - want) * (got - want); r3 += 64.f * want * want; }
        if (e == 0) { const float got = c.out[O_MLM_S + sidx]; e3 += 4096.f * (got - mt) * (got - mt); r3 += 4096.f * mt * mt; }
    }
    blk_reduce2(e2, r2, red, c.tid);
    blk_reduce2(e3, r3, red, c.tid);
    if (c.tid == 0) { dgp[0] = sqrtf(e2 / (r2 + 1e-30f)); dgp[1] = sqrtf(e3 / (r3 + 1e-30f)); }
}
#endif
DI void phase_conv_state(const Ctx& c, int L) {
    for (int idx = c.bid * 512 + c.tid; idx < NB * 3 * 1536; idx += c.G * 512) { const int cc = idx % 1536, j = (idx / 1536) % 3, b = idx / (3 * 1536);
        c.out[O_CONV_P + ((size_t)L * NB + b) * 3 * 1536 + j * 1536 + cc] = bf2f(c.R1[(size_t)(b * SEQ + SEQ - 3 + j) * NPROJ + PQ + cc]); }
}
DI void phase_post(const Ctx& c, int L) {
    const int lane = c.lane, hd = lane >> 4, e0 = (lane & 15) * 8;
    bf16_t* yg = c.Y3 + (size_t)1 * MPAD * 512; bf16_t* ym = c.Y3 + (size_t)2 * MPAD * 512;
    const float* gg = c.in[26] + (size_t)L * 128 + e0; const float* gm = c.in[29] + (size_t)L * 512 + hd * 128 + e0;
    for (int row = c.bid * 8 + c.wave; row < MR; row += c.G * 8) {
        const bf16_t* pr = c.R1 + (size_t)row * NPROJ;
#pragma unroll
        for (int br = 0; br < 2; ++br) {
            bf16_t* yp = (br == 0 ? yg : ym) + (size_t)row * 512 + hd * 128 + e0;
            f32x8 o = unpack8(*(const bf16x8*)yp); const f32x8 z = unpack8(*(const bf16x8*)(pr + (br == 0 ? PZ : PMO) + hd * 128 + e0));
            float ss = 0.f;
#pragma unroll
            for (int e = 0; e < 8; ++e) ss += o[e] * o[e];
            ss += __shfl_xor(ss, 1); ss += __shfl_xor(ss, 2); ss += __shfl_xor(ss, 4); ss += __shfl_xor(ss, 8);
            const float rs = rsqrtf(ss * (1.f / 128.f) + EPS);
            const float* gp = br == 0 ? gg : gm;
#pragma unroll
            for (int e = 0; e < 8; ++e) o[e] = o[e] * rs * gp[e] * (br == 0 ? silu_(z[e]) : sigm(z[e]));
            *(bf16x8*)yp = pack8v(o);
        }
    }
}

DI void phase_cvt_ple(const Ctx& c, int L) {
    bf16_t* PB = c.Y3;
    for (size_t i = (size_t)c.bid * 512 + c.tid; i < (size_t)MR * 64; i += (size_t)c.G * 512) {
        const size_t row = i >> 6, c4 = (i & 63) * 4;
        const float* src = row < MP ? c.in[9] + ((size_t)L * MP + row) * 256 + c4 : c.in[10] + ((size_t)L * MS + (row - MP)) * 256 + c4;
        *(s16x4*)(PB + row * 256 + c4) = pack4v(*(const f32x4*)src); }
}
DI void phase_final_norm(const Ctx& c) {
    const float* gain = c.in[39];
    for (int row = c.bid * 8 + c.wave; row < MR; row += c.G * 8) {
        float* xp = c.out + (size_t)row * 1024; f32x4 x[4]; float ss = 0.f;
#pragma unroll
        for (int i = 0; i < 4; ++i) { x[i] = *(const f32x4*)(xp + c.lane * 4 + 256 * i); ss += x[i][0] * x[i][0] + x[i][1] * x[i][1] + x[i][2] * x[i][2] + x[i][3] * x[i][3]; }
        ss = wave_sum(ss); const float rs = rsqrtf(ss * (1.f / 1024.f) + EPS);
#pragma unroll
        for (int i = 0; i < 4; ++i) { const f32x4 g = *(const f32x4*)(gain + c.lane * 4 + 256 * i); *(f32x4*)(xp + c.lane * 4 + 256 * i) = x[i] * rs * g; }
    }
}

#define XB_TMO      128
#define XB_XCNT(j)  (256  + 64 * (j))
#define XB_XSUB(j)  (1280 + 64 * (j))
#define XB_XGEN(j)  (2304 + 64 * (j))
#define XB_TOP      3328
#define XB_TOPGEN   3392
#define XCD_BAR_WORDS 3456
#define XB_SPIN_CAP (1u << 18)

__device__ __forceinline__ unsigned xb_ld(unsigned* p)              { return __hip_atomic_load(p, __ATOMIC_RELAXED, __HIP_MEMORY_SCOPE_AGENT); }
__device__ __forceinline__ unsigned xb_add(unsigned* p, unsigned v) { return __hip_atomic_fetch_add(p, v, __ATOMIC_RELAXED, __HIP_MEMORY_SCOPE_AGENT); }
__device__ __forceinline__ unsigned xb_xcc_id() { return (unsigned)__builtin_amdgcn_s_getreg((3 << 11) | 20) & 0xFu; }
#define XB_SPIN(cond, bar) do { unsigned _sp = 0; while (cond) { __builtin_amdgcn_s_sleep(1); \
    if ((++_sp & 255u) == 0u) { if (xb_ld(&(bar)[XB_TMO])) break; if (_sp > XB_SPIN_CAP) { atomicAdd(&(bar)[XB_TMO], 1u); break; } } } } while (0)

struct XcdBarrier {
    unsigned* bar; unsigned x;
    volatile LAS unsigned* st;
};

__device__ __forceinline__ XcdBarrier xcd_barrier_post(unsigned* bar, volatile LAS unsigned* st) {
    XcdBarrier b; b.bar = bar; b.x = xb_xcc_id(); b.st = st;
    if (threadIdx.x == 0) (void)xb_add(&bar[XB_XCNT(b.x)], 1u);
    return b;
}
__device__ __forceinline__ void xcd_barrier_complete(unsigned* bar, unsigned x, unsigned& nloc, unsigned& nx) {
    const unsigned G = gridDim.x * gridDim.y * gridDim.z;
    unsigned sum, cnt, mine, sp = 0u;
    for (;;) {
        sum = 0u; cnt = 0u; mine = 0u;
#pragma unroll
        for (unsigned j = 0; j < 16; ++j) { const unsigned c = xb_ld(&bar[XB_XCNT(j)]); sum += c; cnt += (c > 0u) ? 1u : 0u; mine = (j == x) ? c : mine; }
        if (sum == G) break;
        __builtin_amdgcn_s_sleep(1);
        if ((++sp & 255u) == 0u) { if (xb_ld(&bar[XB_TMO])) break; if (sp > XB_SPIN_CAP) { atomicAdd(&bar[XB_TMO], 1u); break; } }
    }
    nloc = mine > 0u ? mine : 1u; nx = cnt > 0u ? cnt : 1u;
}

__device__ __forceinline__ void xcd_barrier(const XcdBarrier& b) {
    asm volatile("s_waitcnt vmcnt(0)" ::: "memory");
    __syncthreads();
    if (threadIdx.x == 0) {
        unsigned* bar = b.bar;
        __builtin_amdgcn_s_waitcnt(0);
        unsigned nloc = b.st[0], nx = b.st[1];
        if (nloc == 0u) { xcd_barrier_complete(bar, b.x, nloc, nx); b.st[0] = nloc; b.st[1] = nx; }
        const unsigned old = xb_add(&bar[XB_XSUB(b.x)], 1u);
        const unsigned gen = old / nloc;
        if (old + 1u == (gen + 1u) * nloc) {
            __builtin_amdgcn_fence(__ATOMIC_RELEASE, "agent");
            asm volatile("s_waitcnt vmcnt(0)" ::: "memory");
            const unsigned og = xb_add(&bar[XB_TOP], 1u);
            const unsigned tg = og / nx;
            if (og + 1u == (tg + 1u) * nx) xb_add(&bar[XB_TOPGEN], 1u);
            else XB_SPIN(xb_ld(&bar[XB_TOPGEN]) == tg, bar);
            __builtin_amdgcn_fence(__ATOMIC_ACQUIRE, "agent");
            xb_add(&bar[XB_XGEN(b.x)], 1u);
            asm volatile("s_waitcnt vmcnt(0)" ::: "memory");
        } else {
            XB_SPIN(xb_ld(&bar[XB_XGEN(b.x)]) == gen, bar);
            __builtin_amdgcn_fence(__ATOMIC_ACQUIRE, "agent");
            asm volatile("s_waitcnt vmcnt(0)" ::: "memory");
        }
    }
    __syncthreads();
}

__global__ void __launch_bounds__(512, 2) fwd_megakernel(KP kp) {
    extern __shared__ __attribute__((aligned(16))) unsigned char lds[];
    cg::grid_group grid = cg::this_grid();
    Ctx c; c.lds = lds; c.G = gridDim.x; c.bid = blockIdx.x;
    const ka_t ka0 = (ka_t)__builtin_amdgcn_kernarg_segment_ptr();
    (void)kp;
#define REFRESH() do { ka_t ka_ = ka0; asm volatile("" : "+s"(ka_)); int t_ = threadIdx.x; asm volatile("" : "+v"(t_)); \
        c.in.ka = ka_; c.out = (float*)(gfloat_t*)ka_[40]; unsigned char* w_ = (unsigned char*)(guchar_t*)ka_[41]; c.ws = w_; \
        c.R1 = (bf16_t*)(w_ + WS_R1); c.XN = (bf16_t*)(w_ + WS_XN); c.Y3 = (bf16_t*)(w_ + WS_Y3); c.W = (bf16_t*)(w_ + WS_W); c.YS5 = (bf16_t*)(w_ + WS_YS5); \
        c.GS = w_ + WS_GS; c.SG = (float*)(w_ + WS_SG); c.GL = (float*)(w_ + WS_GL); \
        c.tid = t_; c.lane = t_ & 63; c.wave = __builtin_amdgcn_readfirstlane(t_ >> 6); \
        int b_ = blockIdx.x, g_ = gridDim.x; asm volatile("" : "+s"(b_), "+s"(g_)); c.bid = b_; c.G = g_; } while (0)
    REFRESH();
    volatile LAS unsigned* bst = (volatile LAS unsigned*)(lds + LDS_BYTES - 16);
    if (c.tid < 4) bst[c.tid] = 0u;
    if (c.tid < 16) ((volatile LAS int*)(lds + S5Q_FLAG))[c.tid] = 0;
    __syncthreads();
    XcdBarrier xbar = xcd_barrier_post((unsigned*)(c.ws + WS_BAR), bst);
    int nsync_ = 0;
#ifndef PHMASK
#define PHMASK 0xFFFFFFFFu
#endif
#define PH(n) if (PHMASK & (1 << (n)))
#ifdef DUP_SYNC
#define GSYNC() do { grid.sync(); grid.sync(); } while (0)
#else
#define GSYNC() do { if (nsync_++ == 0) grid.sync(); else xcd_barrier(xbar); } while (0)
#endif
    for (int L = 0; L < 2; ++L) {
        REFRESH(); PH(0) phase_weights(c, L);
        REFRESH(); PH(1) phase_rmsnorm<0>(c, L);
        GSYNC();
        REFRESH(); PH(2) run_gemm(c, c.XN, c.W + WO_IN, NPROJ, 1024, FStore{c.R1, NPROJ});
#ifdef DUP_GEMM
        REFRESH(); PH(2) run_gemm(c, c.XN, c.W + WO_IN, NPROJ, 1024, FStore{c.R1, NPROJ});
#endif
        GSYNC();
#ifdef DUP_MIX
        for (int rep_ = 0; rep_ < 2; ++rep_) {
#else
        {
#endif
        REFRESH(); phase_conv_state(c, L);
        REFRESH(); for (int it = c.bid * 8 + c.wave; it < 1024; it += c.G * 8) task_ml_gates(c, L, it);
        REFRESH(); PH(3) phase_gdn_prep(c, L);
#ifdef DUP_PREP
        REFRESH(); PH(3) phase_gdn_prep(c, L);
#endif
#ifdef DUP_S5
#endif
        GSYNC();
#ifdef DUP_P4
        for (int rep4_ = 0; rep4_ < 2; ++rep4_) {
#else
        {
#endif
        if (c.wave == 0) {
            for (int u = c.bid; u < 256; u += c.G) { REFRESH(); if (u < 128) { PH(5) task_gdn_seq(c, L, u);
#ifdef DUP_GSEQ
                REFRESH(); task_gdn_seq(c, L, u);
#endif
              } else { PH(6) task_ml_seq(c, L, u - 128, (float*)lds);
#ifdef DUP_MSEQ
                REFRESH(); task_ml_seq(c, L, u - 128, (float*)lds);
#endif
              } }
        } else if (c.wave <= 4) {
            int it_ = 0;
            for (int u = c.bid; u < 256; u += c.G, ++it_) { REFRESH(); PH(4) task_s5_quad(c, L, u, c.wave - 1, L * 16 + it_ + 1); }
        } else {
            const int wid = c.bid * 3 + (c.wave - 5), nw = c.G * 3;
            REFRESH(); PH(7) for (int u = wid; u < 2048; u += nw) task_gdn_sample(c, L, u);
            REFRESH(); PH(8) for (int u = wid; u < 1024; u += nw) task_ml_sample(c, L, u);
            REFRESH(); PH(9) for (int u = wid; u < 4096; u += nw) task_s5_sample(c, L, u);
        }
        GSYNC();
        }
        }
#ifdef SELFCHK
        if (L == SELFCHK_L) { REFRESH(); if (c.bid == 0) { float* dg = (float*)(c.ws + WS_GL) + 1024; chk_gdn(c, L, 1, 2, dg); chk_ml(c, L, 1, 2, dg); chk_s5(c, L, 1, 7, dg); chk_gemm(c, L, 0, dg + 6); if (L == 0) chk_sg(c, dg + 12); chk_sample(c, L, 5, 1, dg + 17); } grid.sync(); }
#endif
        REFRESH(); PH(10) phase_post(c, L);
        REFRESH(); PH(11) run_gemm(c, c.XN, c.W + WO_G, NGATE, 1024, FSig{c.R1, NPROJ});
#ifdef DUP_GEMM
        REFRESH(); PH(11) run_gemm(c, c.XN, c.W + WO_G, NGATE, 1024, FSig{c.R1, NPROJ});
#endif
        REFRESH(); PH(12) run_gemm(c, c.YS5, c.W + WO_GLU, 512, 512, FGlu{c.YS5, c.in[22] + (size_t)L * 512, c.Y3});
#ifdef DUP_GEMM
        REFRESH(); PH(12) run_gemm(c, c.YS5, c.W + WO_GLU, 512, 512, FGlu{c.YS5, c.in[22] + (size_t)L * 512, c.Y3});
#endif
        GSYNC();
#ifdef SELFCHK
        if (L == SELFCHK_L) { REFRESH(); if (c.bid == 0) { float* dg = (float*)(c.ws + WS_GL) + 1024; chk_gemm(c, L, 1, dg + 7); chk_gemm(c, L, 2, dg + 8); chk_post(c, L, dg + 13); } grid.sync(); }
#endif
        REFRESH(); PH(13) for (int br = 0; br < 3; ++br)
            run_gemm(c, c.Y3 + (size_t)br * MPAD * 512, c.W + WO_BR + (size_t)br * 1024 * 512, 1024, 512, FBranch{c.R1 + br * 1024, c.XN, br == 0 ? 1 : 0});
#ifdef DUP_GEMM
        REFRESH(); PH(13) for (int br = 0; br < 3; ++br)
            run_gemm(c, c.Y3 + (size_t)br * MPAD * 512, c.W + WO_BR + (size_t)br * 1024 * 512, 1024, 512, FBranch{c.R1 + br * 1024, c.XN, br == 0 ? 1 : 0});
#endif
        GSYNC();
#ifdef SELFCHK
        if (L == SELFCHK_L) { REFRESH(); if (c.bid == 0) { float* dg = (float*)(c.ws + WS_GL) + 1024; chk_gemm(c, L, 3, dg + 9); } grid.sync(); }
#endif
        REFRESH(); PH(14) run_gemm(c, c.XN, c.W + WO_OUT, 1024, 1024, FRes{c.out});
        GSYNC();
#ifdef SELFCHK
        if (L == 0 && SELFCHK_L == 0) { REFRESH(); if (c.bid == 0) { float* dg = (float*)(c.ws + WS_GL) + 1024; float sn[2] = {0.f, 0.f}; chk_res(c, L, 0, sn, dg + 14); } grid.sync(); }
#endif
        REFRESH(); PH(15) phase_rmsnorm<1>(c, L);
        REFRESH(); PH(18) phase_cvt_ple(c, L);
        GSYNC();
        REFRESH(); PH(16) run_gemm(c, c.XN, c.W + WO_UP, DFF, 1024, FRelu2{c.R1});
#ifdef DUP_GEMM
        REFRESH(); PH(16) run_gemm(c, c.XN, c.W + WO_UP, DFF, 1024, FRelu2{c.R1});
#endif
        GSYNC();
#ifdef SELFCHK
        if (L == SELFCHK_L) { REFRESH(); if (c.bid == 0) { float* dg = (float*)(c.ws + WS_GL) + 1024; chk_gemm(c, L, 4, dg + 10); } grid.sync(); }
#endif
#ifdef SELFCHK
        float snp[2] = {0.f, 0.f}; REFRESH(); if (L == SELFCHK_L && c.bid == 0) snap_x(c, snp);
#endif
        REFRESH(); PH(17) run_gemm(c, c.R1, c.W + WO_DN, 1024, 4096, FResB{c.out, c.XN});
        GSYNC();
#ifdef SELFCHK
        if (L == SELFCHK_L) { REFRESH(); if (c.bid == 0) { float* dg = (float*)(c.ws + WS_GL) + 1024; chk_res(c, L, 1, snp, dg + 15); } grid.sync(); }
#endif
#ifdef SELFCHK
        REFRESH(); if (L == SELFCHK_L && c.bid == 0) snap_x(c, snp);
#endif
        REFRESH(); PH(19) run_gemm(c, c.Y3, c.W + WO_PLE, 1024, 256, FStore{c.Y3 + (size_t)MPAD * 256, 1024});
#ifdef DUP_GEMM
        REFRESH(); PH(19) run_gemm(c, c.Y3, c.W + WO_PLE, 1024, 256, FStore{c.Y3 + (size_t)MPAD * 256, 1024});
#endif
        REFRESH(); PH(20) run_gemm(c, c.XN, c.W + WO_PG, 1024, 1024, FPle{c.Y3 + (size_t)MPAD * 256, c.out});
        GSYNC();
#ifdef SELFCHK
        if (L == SELFCHK_L) { REFRESH(); if (c.bid == 0) { float* dg = (float*)(c.ws + WS_GL) + 1024; chk_gemm(c, L, 5, dg + 11); chk_res(c, L, 2, snp, dg + 16); } grid.sync(); }
#endif
    }
    REFRESH(); phase_final_norm(c);
#ifdef SELFCHK
    grid.sync(); REFRESH();
    if (c.bid == 0 && c.tid == 0) { const float* dg = (const float*)(c.ws + WS_GL) + 1024; int kk = -1; float dv = 0.f;
        for (int i = 18; i >= 0; --i) if (dg[i] > SELFCHK_THR) { kk = i; dv = dg[i]; }
        if (kk >= 0) c.out[0] = __powf(10.f, (float)(2 * kk + 4)) * (1.f + fminf(dv, 8.f)); }
#endif
}

extern "C" void kernel_launch(void* const* d_in, const int* in_sizes, int n_in, void* d_out, int out_size, void* d_ws, size_t ws_size, hipStream_t stream) {
    static int grid = 0;
    if (grid == 0) {
        int dev = 0, cus = 0, per_cu = 0;
        if (hipGetDevice(&dev) != hipSuccess || hipDeviceGetAttribute(&cus, hipDeviceAttributeMultiprocessorCount, dev) != hipSuccess) { fprintf(stderr, "kernel_launch: device query failed\n"); grid = -1; return; }
        if (hipFuncSetAttribute((const void*)fwd_megakernel, hipFuncAttributeMaxDynamicSharedMemorySize, LDS_BYTES) != hipSuccess) { fprintf(stderr, "kernel_launch: hipFuncSetAttribute failed\n"); grid = -1; return; }
        if (hipOccupancyMaxActiveBlocksPerMultiprocessor(&per_cu, (const void*)fwd_megakernel, 512, LDS_BYTES) != hipSuccess || per_cu < 1) { fprintf(stderr, "kernel_launch: occupancy query says %d blocks per CU\n", per_cu); grid = -1; return; }
        grid = cus;
        if (grid > 256) grid = 256;
    }
    if (grid < 0) return;
    if (n_in != 40 || (size_t)out_size != O_TOTAL || ws_size < WS_END) { fprintf(stderr, "kernel_launch: unexpected sizes n_in %d out %d ws %zu (need %zu)\n", n_in, out_size, ws_size, (size_t)WS_END); return; }
    if (hipMemsetAsync((char*)d_ws + WS_BAR, 0, SZ_BAR, stream) != hipSuccess) { fprintf(stderr, "kernel_launch: memset failed\n"); return; }
    KP kp{};
    for (int i = 0; i < 40; ++i) kp.in[i] = (const float*)d_in[i];
    kp.out = (float*)d_out; kp.ws = (unsigned char*)d_ws;
    void* args[] = {&kp};
    hipError_t e = hipLaunchCooperativeKernel((const void*)fwd_megakernel, dim3(grid), dim3(512), args, LDS_BYTES, stream);
    if (e != hipSuccess) fprintf(stderr, "kernel_launch: cooperative launch failed: %s (grid %d)\n", hipGetErrorString(e), grid);
}
```

```cpp
#include <hip/hip_runtime.h>
#include <hip/hip_cooperative_groups.h>
#include <cstdio>
namespace cg = cooperative_groups;
namespace pg8 {
#define PG8_LAS __attribute__((address_space(3)))
typedef unsigned short bf16_t;
typedef short bf16x8 __attribute__((ext_vector_type(8)));
typedef float f32x4 __attribute__((ext_vector_type(4)));
typedef unsigned u32x4 __attribute__((ext_vector_type(4)));
constexpr int BM = 256, BK = 64, HALF = 128, HTB = HALF * BK * 2  , STAGE_BYTES = 8 * HTB, NXCD = 8, WGM = 8;

__host__ __device__ __forceinline__ int lds_byte(int r, int c) { const int st = (r >> 4) * 2 + (c >> 5), rr = r & 15, cc = c & 31, ob = rr * 64 + cc * 2; return st * 1024 + (ob ^ (((ob >> 9) & 1) << 5)); }
__host__ __device__ __forceinline__ void stage_rc(int b, int& R, int& C) { const int st = b / 1024, sb = b % 1024, swz = sb ^ (((sb >> 9) & 1) << 5); R = (st >> 1) * 16 + swz / 64; C = (st & 1) * 32 + (swz % 64) / 2; }
__host__ __device__ __forceinline__ int perm32(int rho) { const int n = rho >> 4, i = rho & 15; return 8 * (i >> 2) + 4 * n + (i & 3); }

struct Unit { int pm, pn; };
struct Gemm { const bf16_t* A; const bf16_t* Bt; int M, N, K; };

struct StaticOrder {
    int nM, nN, nwg, G, c;
    __host__ __device__ void init(int M, int N, int G_, int c_) { nM = M / BM; nN = N / BM; nwg = nM * nN; G = G_; c = c_; }
    __host__ __device__ bool next(int i, Unit& u) const {
        const long L = (long)i * G + c; if (L >= nwg) return false;
        int wgid = (int)L; { const int q = nwg / NXCD, r = nwg % NXCD, xcd = wgid % NXCD, off = wgid / NXCD; wgid = (xcd < r ? xcd * (q + 1) : r * (q + 1) + (xcd - r) * q) + off; }
        const int nig = WGM * nN, gid = wgid / nig, fm = gid * WGM, gsz = (nM - fm) < WGM ? (nM - fm) : WGM;
        u.pm = fm + ((wgid % nig) % gsz); u.pn = (wgid % nig) / gsz; return true;
    }
    __device__ __forceinline__ void a_ready(const Unit&) const {}
    __device__ __forceinline__ void done(const Unit&) const {}
};

template <class Epi, class Sched, bool STAMP = false>
__device__ __forceinline__ void gemm_phase(PG8_LAS unsigned char* lds, const Gemm g, const Sched& S, const Epi& E, unsigned long long* stamps) {
    int tid_ = threadIdx.x; asm volatile("" : "+v"(tid_));
    const int tid = tid_, wid = __builtin_amdgcn_readfirstlane(tid >> 6), lane = tid & 63, wr = wid >> 2, wc = wid & 3, fr = lane & 15, fq = lane >> 4;
    const int K = g.K, nt = K / BK;
    unsigned voffA[2], voffB[2];
#pragma unroll
    for (int i = 0; i < 2; ++i) { int R, C; stage_rc(tid * 16 + i * 8192, R, C); const int Rb = Epi::PERM ? ((R & ~31) + perm32(R & 31)) : R;
        voffA[i] = (unsigned)(R * K + C) * 2u; voffB[i] = (unsigned)(Rb * K + C) * 2u; }
    const size_t kstep = (size_t)(BK * 2);
    const size_t hstep = (size_t)HALF * K * 2;
    const size_t tstep = 2 * hstep;
    const unsigned ldsw = (unsigned)wid * 1024u;
    const int aoff = lds_byte(wr * 64 + fr, fq * 8), boff = lds_byte(wc * 32 + fr, fq * 8);
#define PG8_SA(b, h) (((b) * 2 + (h)) * HTB)
#define PG8_SB(b, h) ((4 + (b) * 2 + (h)) * HTB)
#define PG8_STAGE(bufoff, gbase, voff) do { _Pragma("unroll") for (int _i = 0; _i < 2; ++_i) \
        __builtin_amdgcn_global_load_lds((const unsigned*)((const char*)(gbase) + (voff)[_i]), (PG8_LAS unsigned*)(lds + (bufoff) + ldsw + _i * 8192), 16, 0, 0); } while (0)
#define PG8_LDA(dst, b, h) do { _Pragma("unroll") for (int m = 0; m < 4; ++m) _Pragma("unroll") for (int k = 0; k < 2; ++k) dst[m][k] = *(const PG8_LAS bf16x8*)(lds + PG8_SA(b, h) + aoff + m * 2048 + k * 1024); } while (0)
#define PG8_LDB(dst, b, h) do { _Pragma("unroll") for (int n = 0; n < 2; ++n) _Pragma("unroll") for (int k = 0; k < 2; ++k) dst[n][k] = *(const PG8_LAS bf16x8*)(lds + PG8_SB(b, h) + boff + n * 2048 + k * 1024); } while (0)
#define PG8_MMA(ai, bj, At, Bt) do { __builtin_amdgcn_s_setprio(1); _Pragma("unroll") for (int m = 0; m < 4; ++m) _Pragma("unroll") for (int n = 0; n < 2; ++n) _Pragma("unroll") for (int k = 0; k < 2; ++k) \
        acc[ai][bj][m][n] = __builtin_amdgcn_mfma_f32_16x16x32_bf16(Bt[n][k], At[m][k], acc[ai][bj][m][n], 0, 0, 0); __builtin_amdgcn_s_setprio(0); } while (0)
#define PG8_WAIT_V(n) asm volatile("s_waitcnt vmcnt(" #n ")" ::: "memory")
#define PG8_WAIT_L(n) asm volatile("s_waitcnt lgkmcnt(" #n ")" ::: "memory")
#define PG8_BAR __builtin_amdgcn_s_barrier()
#define PG8_SCHED __builtin_amdgcn_sched_barrier(0)
    Unit cur, nxt; int ui = 0;
    if (!S.next(0, cur)) return;
    f32x4 acc[2][2][4][2];
#pragma unroll
    for (int a = 0; a < 2; ++a)
#pragma unroll
        for (int b = 0; b < 2; ++b)
#pragma unroll
            for (int m = 0; m < 4; ++m)
#pragma unroll
                for (int n = 0; n < 2; ++n) acc[a][b][m][n] = (f32x4){0.f, 0.f, 0.f, 0.f};
    bf16x8 At[4][2], B0[2][2], B1[2][2];
    const char* cA = (const char*)g.A + (size_t)cur.pm * tstep; const char* cB = (const char*)g.Bt + (size_t)cur.pn * tstep;
    S.a_ready(cur);
    PG8_STAGE(PG8_SB(0, 0), cB, voffB); PG8_STAGE(PG8_SA(0, 0), cA, voffA); PG8_STAGE(PG8_SB(0, 1), cB + hstep, voffB); PG8_STAGE(PG8_SA(0, 1), cA + hstep, voffA);
    if (wr == 1) PG8_BAR;
    PG8_WAIT_V(4); PG8_BAR;
    PG8_STAGE(PG8_SB(1, 0), cB + kstep, voffB); PG8_STAGE(PG8_SA(1, 0), cA + kstep, voffA); PG8_STAGE(PG8_SB(1, 1), cB + hstep + kstep, voffB);
    PG8_WAIT_V(6); PG8_BAR;
    for (;;) {
        const bool has_next = S.next(ui + 1, nxt);
        const char* nA = has_next ? (const char*)g.A + (size_t)nxt.pm * tstep : cA; const char* nB = has_next ? (const char*)g.Bt + (size_t)nxt.pn * tstep : cB;
        for (int t = 0; t < nt; t += 2) {
            const bool last = (t == nt - 2);
            const char* a1 = cA + (size_t)(t + 1) * kstep;
            const char* a2 = last ? nA : cA + (size_t)(t + 2) * kstep; const char* b2 = last ? nB : cB + (size_t)(t + 2) * kstep;
            const char* a3 = a2 + kstep; const char* b3 = b2 + kstep;
            if (last && has_next) S.a_ready(nxt);
            PG8_LDB(B0, 0, 0); PG8_SCHED; PG8_LDA(At, 0, 0); PG8_STAGE(PG8_SA(1, 1), a1 + hstep, voffA);
            PG8_WAIT_L(8); PG8_BAR; PG8_WAIT_L(0); PG8_MMA(0, 0, At, B0); PG8_BAR; PG8_SCHED;
            PG8_LDB(B1, 0, 1); PG8_STAGE(PG8_SB(0, 0), b2, voffB);
            PG8_BAR; PG8_WAIT_L(0); PG8_MMA(0, 1, At, B1); PG8_BAR;
            PG8_LDA(At, 0, 1); PG8_STAGE(PG8_SA(0, 0), a2, voffA);
            PG8_BAR; PG8_WAIT_L(0); PG8_MMA(1, 0, At, B0); PG8_BAR; PG8_SCHED;
            PG8_STAGE(PG8_SB(0, 1), b2 + hstep, voffB);
            PG8_WAIT_V(6); PG8_BAR; PG8_MMA(1, 1, At, B1); PG8_BAR;
            PG8_LDB(B0, 1, 0); PG8_SCHED; PG8_LDA(At, 1, 0); PG8_STAGE(PG8_SA(0, 1), a2 + hstep, voffA);
            PG8_WAIT_L(8); PG8_BAR; PG8_WAIT_L(0); PG8_MMA(0, 0, At, B0); PG8_BAR; PG8_SCHED;
            PG8_LDB(B1, 1, 1); PG8_STAGE(PG8_SB(1, 0), b3, voffB);
            PG8_BAR; PG8_WAIT_L(0); PG8_MMA(0, 1, At, B1); PG8_BAR;
            PG8_LDA(At, 1, 1); PG8_STAGE(PG8_SA(1, 0), a3, voffA);
            PG8_BAR; PG8_WAIT_L(0); PG8_MMA(1, 0, At, B0); PG8_BAR; PG8_SCHED;
            PG8_STAGE(PG8_SB(1, 1), b3 + hstep, voffB);
            PG8_WAIT_V(6); PG8_BAR; PG8_MMA(1, 1, At, B1); PG8_BAR;
        }
        if constexpr (!Epi::AFTER_DRAIN) { E(acc, cur, wr, wc, fr, fq); S.done(cur); }
        if (!has_next) break;
#pragma unroll
        for (int a = 0; a < 2; ++a)
#pragma unroll
            for (int b = 0; b < 2; ++b)
#pragma unroll
                for (int m = 0; m < 4; ++m)
#pragma unroll
                    for (int n = 0; n < 2; ++n) acc[a][b][m][n] = (f32x4){0.f, 0.f, 0.f, 0.f};
        cur = nxt; cA = nA; cB = nB; ++ui;
    }
    PG8_WAIT_V(0);
    if (wr == 0) PG8_BAR;
    PG8_BAR;
    if constexpr (Epi::AFTER_DRAIN) { E.fused(acc, cur, wr, wc, fr, fq, lds, wid, lane); S.done(cur); }
#undef PG8_SA
#undef PG8_SB
#undef PG8_STAGE
#undef PG8_LDA
#undef PG8_LDB
#undef PG8_MMA
#undef PG8_WAIT_V
#undef PG8_WAIT_L
#undef PG8_BAR
#undef PG8_SCHED
}
}

#include <cstdio>
#include <ctime>
#include <cstdlib>
#include <cstring>
#include <cmath>
#include <vector>
#include <algorithm>
#define CK(x) do { hipError_t e_ = (x); if (e_ != hipSuccess) { fprintf(stderr, "HIP %s:%d %s\n", __FILE__, __LINE__, hipGetErrorString(e_)); exit(2); } } while (0)

#define DI __device__ __forceinline__
#define LAS __attribute__((address_space(3)))
typedef unsigned short bf16_t;
typedef short bf16x8 __attribute__((ext_vector_type(8)));
typedef short s16x4 __attribute__((ext_vector_type(4)));
typedef __bf16 bfv8 __attribute__((ext_vector_type(8)));
typedef __bf16 bfv4 __attribute__((ext_vector_type(4)));
typedef float f32x2 __attribute__((ext_vector_type(2)));
typedef float f32x4 __attribute__((ext_vector_type(4)));
typedef float f32x8 __attribute__((ext_vector_type(8)));
typedef float f32x16 __attribute__((ext_vector_type(16)));
typedef unsigned u32x4 __attribute__((ext_vector_type(4)));
typedef unsigned u32x2 __attribute__((ext_vector_type(2)));

constexpr int MP = 16384, MS = 128, MR = MP + MS, MPAD = 16640, DM = 1024, SEQ = 2048, NB = 8;
constexpr int NPROJ = 4096, NGATE = 3072, DFF = 4096, DIN = 7184;
constexpr int PU = 0, PQ = 512, PK = 1024, PV = 1536, PMQ = 2048, PMK = 2304, PMV = 2560, PZ = 3072, PMO = 3584;
constexpr float EPS = 1e-6f;
constexpr size_t O_S5RE_P = 16908288, O_S5RE_S = 16941056, O_S5IM_P = 17465344, O_S5IM_S = 17498112, O_CONV_P = 18022400, O_CONV_S = 18096128,
                 O_GDN_P = 19275776, O_GDN_S = 20324352, O_MLC_P = 37101568, O_MLC_S = 37625856, O_MLN_P = 46014464, O_MLN_S = 46018560,
                 O_MLM_P = 46084096, O_MLM_S = 46084160, O_TOTAL = 46085184;
constexpr size_t WS_R1 = 0, SZ_R1 = (size_t)MPAD * 4096 * 2;
constexpr size_t WS_XN = WS_R1 + SZ_R1, SZ_XN = (size_t)MPAD * 1024 * 2;
constexpr size_t WS_Y3 = WS_XN + SZ_XN, SZ_Y3 = (size_t)3 * MPAD * 512 * 2;
constexpr size_t WS_YS5 = WS_Y3 + SZ_Y3, SZ_YS5 = (size_t)MPAD * 512 * 2;
constexpr size_t WS_W = WS_YS5 + SZ_YS5;
constexpr size_t WO_IN = 0, WO_G = WO_IN + (size_t)4096 * 1024, WO_GLU = WO_G + (size_t)3072 * 1024, WO_BR = WO_GLU + (size_t)512 * 512,
                 WO_OUT = WO_BR + (size_t)3 * 1024 * 512, WO_UP = WO_OUT + (size_t)1024 * 1024, WO_DN = WO_UP + (size_t)4096 * 1024,
                 WO_PLE = WO_DN + (size_t)1024 * 4096, WO_PG = WO_PLE + (size_t)1024 * 256, WO_END = WO_PG + (size_t)1024 * 1024;
constexpr size_t SZ_W = WO_END * 2;
constexpr size_t WS_GS = WS_W + SZ_W;
constexpr int GI_U = 0, GI_W = 16384, GI_Q = 32768, GI_K = 49152, GI_A = 65536, GI_BYTES = 73728;
constexpr size_t SZ_GS = (size_t)1024 * GI_BYTES;
constexpr size_t WS_SG = WS_GS + SZ_GS, SZ_SG = (size_t)MR * 16 * 4;
constexpr size_t WS_GL = WS_SG + SZ_SG, SZ_GL = 8192;
constexpr size_t WS_MG = WS_GL + SZ_GL, SZ_MG = (size_t)1024 * 4 * 64 * 4;
constexpr size_t WS_PL = WS_MG + SZ_MG, SZ_PL = (size_t)1024 * 8192;
constexpr size_t WS_BAR = WS_PL + SZ_PL, SZ_BAR = 16384;
constexpr size_t WS_END = WS_BAR + SZ_BAR;
constexpr int LDS_BYTES = 122880 + 32768 + 2048 + 64 + 64;

struct KP { const float* in[40]; float* out; unsigned char* ws; };

DI float bf2f(bf16_t b) { return __uint_as_float(((unsigned)b) << 16); }
DI bf16_t f2bf(float f) { __bf16 b = (__bf16)f; return __builtin_bit_cast(bf16_t, b); }
DI bf16x8 pack8v(f32x8 v) { bfv8 b = __builtin_convertvector(v, bfv8); return __builtin_bit_cast(bf16x8, b); }
DI s16x4 pack4v(f32x4 v) { bfv4 b = __builtin_convertvector(v, bfv4); return __builtin_bit_cast(s16x4, b); }
DI bf16x8 pack16(const f32x16& x, int s) { f32x8 v;
#pragma unroll
    for (int j = 0; j < 8; ++j) v[j] = x[8 * s + j];
    return pack8v(v); }
DI float lo16(unsigned u) { return __uint_as_float(u << 16); }
DI float hi16(unsigned u) { return __uint_as_float(u & 0xffff0000u); }
DI f32x8 unpack8(bf16x8 b) { u32x4 u = __builtin_bit_cast(u32x4, b); f32x8 r;
#pragma unroll
    for (int i = 0; i < 4; ++i) { r[2 * i] = lo16(u[i]); r[2 * i + 1] = hi16(u[i]); }
    return r; }
DI float sigm(float x) { return __builtin_amdgcn_rcpf(1.f + __expf(-x)); }
DI float tanh_(float z) { return 1.f - 2.f * __builtin_amdgcn_rcpf(__expf(2.f * z) + 1.f); }
DI float gelu_t(float x) { return 0.5f * x * (1.f + tanh_(0.7978845608028654f * (x + 0.044715f * x * x * x))); }
DI float silu_(float x) { return x * sigm(x); }
DI float softplus_(float x) { return x > 20.f ? x : log1pf(expf(x)); }
DI float logsig_(float x) { return x >= 0.f ? -log1pf(expf(-x)) : x - log1pf(expf(x)); }
DI float softcap_(float x) { return 15.f * tanh_(x * (1.f / 15.f)); }
DI float wave_sum(float v) {
#pragma unroll
    for (int o = 32; o; o >>= 1) v += __shfl_xor(v, o);
    return v; }
DI float wave_incl_sum(float v, int lane) {
#pragma unroll
    for (int o = 1; o < 64; o <<= 1) { float t = __shfl_up(v, o); if (lane >= o) v += t; }
    return v; }
DI float wave_incl_max(float v, int lane) {
#pragma unroll
    for (int o = 1; o < 64; o <<= 1) { float t = __shfl_up(v, o); if (lane >= o) v = fmaxf(v, t); }
    return v; }
DI void butterfly16(float (&a)[16], int lane) {
#pragma unroll
    for (int i = 0; i < 8; ++i) { const bool up = (lane & 32) != 0; const float send = up ? a[i] : a[i + 8], keep = up ? a[i + 8] : a[i]; a[i] = keep + __shfl_xor(send, 32); }
#pragma unroll
    for (int i = 0; i < 4; ++i) { const bool up = (lane & 16) != 0; const float send = up ? a[i] : a[i + 4], keep = up ? a[i + 4] : a[i]; a[i] = keep + __shfl_xor(send, 16); }
#pragma unroll
    for (int i = 0; i < 2; ++i) { const bool up = (lane & 8) != 0; const float send = up ? a[i] : a[i + 2], keep = up ? a[i + 2] : a[i]; a[i] = keep + __shfl_xor(send, 8); }
    { const bool up = (lane & 4) != 0; const float send = up ? a[0] : a[1], keep = up ? a[1] : a[0]; a[0] = keep + __shfl_xor(send, 4); }
    a[0] += __shfl_xor(a[0], 2); a[0] += __shfl_xor(a[0], 1);
}
DI int bsel16(int lane) { return ((lane >> 5) & 1) * 8 + ((lane >> 4) & 1) * 4 + ((lane >> 3) & 1) * 2 + ((lane >> 2) & 1); }
DI int crow(int reg, int h) { return (reg & 3) + 8 * (reg >> 2) + 4 * h; }
DI int perm16(int k) { return (k & ~12) | ((k & 4) << 1) | ((k & 8) >> 1); }
#define MFMA32(a, b, c) __builtin_amdgcn_mfma_f32_32x32x16_bf16((a), (b), (c), 0, 0, 0)
#define MFMA16(a, b, c) __builtin_amdgcn_mfma_f32_16x16x32_bf16((a), (b), (c), 0, 0, 0)
#define WAVE_FENCE() do { asm volatile("s_waitcnt lgkmcnt(0)" ::: "memory"); __builtin_amdgcn_wave_barrier(); asm volatile("" ::: "memory"); } while (0)

typedef __attribute__((address_space(4))) const unsigned long long* ka_t;
typedef __attribute__((address_space(1))) float gfloat_t; typedef __attribute__((address_space(1))) unsigned char guchar_t;
struct InTab { ka_t ka; DI const float* operator[](int i) const { return (const float*)(const gfloat_t*)ka[i]; } };
struct Ctx {
    InTab in; float* out; unsigned char* ws; unsigned char* lds;
    bf16_t *R1, *XN, *Y3, *W, *YS5; unsigned char* GS; float *SG, *GL;
    int tid, lane, wave, G, bid;
};

template <class F> struct Epi8 {
    static constexpr bool PERM = true, AFTER_DRAIN = false;
    F f;
    DI void operator()(const f32x4 (&acc)[2][2][4][2], const pg8::Unit& u, int wr, int wc, int fr, int fq) const {
        const int row0 = u.pm * 256 + wr * 64 + fr, col0 = u.pn * 256 + wc * 32 + 8 * fq;
#pragma unroll
        for (int ai = 0; ai < 2; ++ai)
#pragma unroll
            for (int m = 0; m < 4; ++m)
#pragma unroll
                for (int bj = 0; bj < 2; ++bj) f(row0 + ai * 128 + m * 16, col0 + bj * 128, acc[ai][bj][m][0], acc[ai][bj][m][1]);
    }
};
DI f32x8 cat8(f32x4 a, f32x4 b) { f32x8 r; r[0] = a[0]; r[1] = a[1]; r[2] = a[2]; r[3] = a[3]; r[4] = b[0]; r[5] = b[1]; r[6] = b[2]; r[7] = b[3]; return r; }
struct FStore { bf16_t* dst; int ld;
    DI void s(int row, int col, float v) const { dst[(size_t)row * ld + col] = f2bf(v); }
    DI void operator()(int row, int col, f32x4 a, f32x4 b) const { *(bf16x8*)(dst + (size_t)row * ld + col) = pack8v(cat8(a, b)); } };
struct FSig { bf16_t* dst; int ld;
    DI void s(int row, int col, float v) const { dst[(size_t)row * ld + col] = f2bf(sigm(v)); }
    DI void operator()(int row, int col, f32x4 a, f32x4 b) const { f32x8 v = cat8(a, b);
#pragma unroll
        for (int i = 0; i < 8; ++i) v[i] = sigm(v[i]);
        *(bf16x8*)(dst + (size_t)row * ld + col) = pack8v(v); } };
struct FGlu { const bf16_t* y; const float* bias; bf16_t* dst;
    DI void s(int row, int col, float v) const { dst[(size_t)row * 512 + col] = f2bf(bf2f(y[(size_t)row * 512 + col]) * sigm(v + bias[col])); }
    DI void operator()(int row, int col, f32x4 a, f32x4 b) const { f32x8 v = cat8(a, b); f32x8 yv = unpack8(*(const bf16x8*)(y + (size_t)row * 512 + col));
        f32x4 b0 = *(const f32x4*)(bias + col), b1 = *(const f32x4*)(bias + col + 4);
#pragma unroll
        for (int i = 0; i < 8; ++i) v[i] = yv[i] * sigm(v[i] + (i < 4 ? b0[i] : b1[i - 4]));
        *(bf16x8*)(dst + (size_t)row * 512 + col) = pack8v(v); } };
struct FBranch { const bf16_t* gates; bf16_t* merged; int first;
    DI void s(int row, int col, float v) const { bf16_t* mp = merged + (size_t)row * 1024 + col; const float g = bf2f(gates[(size_t)row * 4096 + col]); *mp = f2bf((first ? 0.f : bf2f(*mp)) + g * v); }
    DI void operator()(int row, int col, f32x4 a, f32x4 b) const { f32x8 v = cat8(a, b); f32x8 gv = unpack8(*(const bf16x8*)(gates + (size_t)row * 4096 + col));
        bf16x8* mp = (bf16x8*)(merged + (size_t)row * 1024 + col);
        f32x8 o;
        if (first) {
#pragma unroll
            for (int i = 0; i < 8; ++i) o[i] = gv[i] * v[i];
        } else { f32x8 mv = unpack8(*mp);
#pragma unroll
            for (int i = 0; i < 8; ++i) o[i] = mv[i] + gv[i] * v[i];
        }
        *mp = pack8v(o); } };
struct FRes { float* xr;
    DI void s(int row, int col, float v) const { xr[(size_t)row * 1024 + col] += v; }
    DI void operator()(int row, int col, f32x4 a, f32x4 b) const { if (row < MR) { f32x4* p = (f32x4*)(xr + (size_t)row * 1024 + col); p[0] = p[0] + a; p[1] = p[1] + b; } } };
struct FResB { float* xr; bf16_t* xb;
    DI void s(int row, int col, float v) const { const float x = xr[(size_t)row * 1024 + col] + v; xr[(size_t)row * 1024 + col] = x; xb[(size_t)row * 1024 + col] = f2bf(x); }
    DI void operator()(int row, int col, f32x4 a, f32x4 b) const { if (row < MR) { f32x4* p = (f32x4*)(xr + (size_t)row * 1024 + col); const f32x4 x0 = p[0] + a, x1 = p[1] + b; p[0] = x0; p[1] = x1;
            *(bf16x8*)(xb + (size_t)row * 1024 + col) = pack8v(cat8(x0, x1)); } } };
struct FRelu2 { bf16_t* dst;
    DI void s(int row, int col, float v) const { const float r = fmaxf(v, 0.f); dst[(size_t)row * 4096 + col] = f2bf(r * r); }
    DI void operator()(int row, int col, f32x4 a, f32x4 b) const { f32x8 v = cat8(a, b);
#pragma unroll
        for (int i = 0; i < 8; ++i) { float r = fmaxf(v[i], 0.f); v[i] = r * r; }
        *(bf16x8*)(dst + (size_t)row * 4096 + col) = pack8v(v); } };
struct FPle { const bf16_t* T; float* xr;
    DI void s(int row, int col, float v) const { xr[(size_t)row * 1024 + col] += bf2f(T[(size_t)row * 1024 + col]) * sigm(v); }
    DI void operator()(int row, int col, f32x4 a, f32x4 b) const { if (row < MR) { f32x8 v = cat8(a, b); f32x8 tv = unpack8(*(const bf16x8*)(T + (size_t)row * 1024 + col));
            f32x4* p = (f32x4*)(xr + (size_t)row * 1024 + col); f32x4 x0 = p[0], x1 = p[1];
#pragma unroll
            for (int i = 0; i < 4; ++i) { x0[i] += tv[i] * sigm(v[i]); x1[i] += tv[4 + i] * sigm(v[4 + i]); }
            p[0] = x0; p[1] = x1; } } };

DI f32x16 small_part(const Ctx& c, const bf16_t* A, const bf16_t* Bt, int K, int tile, int kq) {
    int r = c.lane & 31, hh = c.lane >> 5; asm volatile("" : "+v"(r), "+v"(hh));
    const int mt = tile & 3, nt = tile >> 2, K4 = K >> 2;
    const bf16_t* ap = A + (size_t)(MP + mt * 32 + r) * K + kq * K4 + hh * 8;
    const bf16_t* bp = Bt + (size_t)(nt * 32 + r) * K + kq * K4 + hh * 8;
    f32x16 acc;
#pragma unroll
    for (int j = 0; j < 16; ++j) acc[j] = 0.f;
    if (K4 >= 128) {
        bf16x8 a[8], b[8];
#pragma unroll
        for (int j = 0; j < 8; ++j) { a[j] = *(const bf16x8*)(ap + j * 16); b[j] = *(const bf16x8*)(bp + j * 16); }
        for (int k = 128; k < K4; k += 128) {
            bf16x8 an[8], bn[8];
#pragma unroll
            for (int j = 0; j < 8; ++j) { an[j] = *(const bf16x8*)(ap + k + j * 16); bn[j] = *(const bf16x8*)(bp + k + j * 16); }
#pragma unroll
            for (int j = 0; j < 8; ++j) acc = MFMA32(a[j], b[j], acc);
#pragma unroll
            for (int j = 0; j < 8; ++j) { a[j] = an[j]; b[j] = bn[j]; }
        }
#pragma unroll
        for (int j = 0; j < 8; ++j) acc = MFMA32(a[j], b[j], acc);
    } else {
#pragma unroll
        for (int j = 0; j < 4; ++j) { const bf16x8 a = *(const bf16x8*)(ap + j * 16), b = *(const bf16x8*)(bp + j * 16); acc = MFMA32(a, b, acc); }
    }
    return acc;
}
template <class F> DI void run_gemm(const Ctx& c, const bf16_t* A, const bf16_t* Bt, int N, int K, const F& f) {
    { const int ntile = 4 * (N >> 5), grp = c.wave >> 2, kq = c.wave & 3;
      LAS float* red = (LAS float*)c.lds;
      for (int t0 = 0; t0 < ntile; t0 += 2 * c.G) {
          const int t = t0 + grp * c.G + c.bid; const bool live = t < ntile;
          if (live) { const f32x16 acc = small_part(c, A, Bt, K, t, kq);
#pragma unroll
              for (int i = 0; i < 16; ++i) red[(c.wave * 16 + i) * 64 + c.lane] = acc[i]; }
          __syncthreads();
          if (live && kq == 0) { const int mt = t & 3, nt = t >> 2, r = c.lane & 31, hh = c.lane >> 5;
#pragma unroll
              for (int i = 0; i < 16; ++i) { const int o = (c.wave * 16 + i) * 64 + c.lane; const float v = (red[o] + red[o + 1024]) + (red[o + 2048] + red[o + 3072]);
                  f.s(MP + mt * 32 + crow(i, hh), nt * 32 + r, v); } }
          __syncthreads();
      } }
    pg8::Gemm g{A, Bt, MP, N, K}; pg8::StaticOrder S; S.init(MP, N, c.G, c.bid);
    Epi8<F> E{f};
    pg8::gemm_phase<Epi8<F>, pg8::StaticOrder>((PG8_LAS unsigned char*)c.lds, g, S, E, nullptr);
    __syncthreads();
}

DI void tr_task(const Ctx& c, const float* src, int ld, int K, int n, bf16_t* dst, int rot) {
    float* tile = (float*)c.lds;
    const int nkt = K >> 6, ntiles = nkt * (n >> 6);
    const int start = (c.bid + c.G - (rot % c.G)) % c.G;
    for (int t = start; t < ntiles; t += c.G) {
        const int kt = t % nkt, nt = t / nkt;
        const int r = c.tid >> 4, c4 = (c.tid & 15) * 4;
#pragma unroll
        for (int p = 0; p < 2; ++p) { const int row = r + 32 * p; const f32x4 v = *(const f32x4*)(src + (size_t)(kt * 64 + row) * ld + nt * 64 + c4);
            tile[row * 65 + c4] = v[0]; tile[row * 65 + c4 + 1] = v[1]; tile[row * 65 + c4 + 2] = v[2]; tile[row * 65 + c4 + 3] = v[3]; }
        __syncthreads();
        { const int nn = c.tid >> 3, kc = (c.tid & 7) * 8; f32x8 v;
#pragma unroll
          for (int e = 0; e < 8; ++e) v[e] = tile[(kc + e) * 65 + nn];
          *(bf16x8*)(dst + (size_t)(nt * 64 + nn) * K + kt * 64 + kc) = pack8v(v); }
        __syncthreads();
    }
}
DI void phase_weights(const Ctx& c, int L) {
    const float* win = c.in[12] + (size_t)L * 1024 * DIN;
    bf16_t* W = c.W;
    tr_task(c, win + 0, DIN, 1024, 2048, W + WO_IN, 0);
    tr_task(c, win + 2568, DIN, 1024, 1024, W + WO_IN + (size_t)2048 * 1024, 0);
    tr_task(c, win + 2048, DIN, 1024, 512, W + WO_IN + (size_t)3072 * 1024, 0);
    tr_task(c, win + 3592, DIN, 1024, 512, W + WO_IN + (size_t)3584 * 1024, 128);
    tr_task(c, win + 4112, DIN, 1024, 3072, W + WO_G, 0);
    tr_task(c, c.in[21] + (size_t)L * 512 * 512, 512, 512, 512, W + WO_GLU, 0);
    tr_task(c, c.in[30] + (size_t)L * 512 * 1024, 1024, 512, 1024, W + WO_BR, 64);
    tr_task(c, c.in[31] + (size_t)L * 512 * 1024, 1024, 512, 1024, W + WO_BR + (size_t)1024 * 512, 192);
    tr_task(c, c.in[32] + (size_t)L * 512 * 1024, 1024, 512, 1024, W + WO_BR + (size_t)2 * 1024 * 512, 64);
    tr_task(c, c.in[33] + (size_t)L * 1024 * 1024, 1024, 1024, 1024, W + WO_OUT, 0);
    tr_task(c, c.in[35] + (size_t)L * 1024 * 4096, 4096, 1024, 4096, W + WO_UP, 0);
    tr_task(c, c.in[36] + (size_t)L * 4096 * 1024, 1024, 4096, 1024, W + WO_DN, 0);
    tr_task(c, c.in[37] + (size_t)L * 256 * 1024, 1024, 256, 1024, W + WO_PLE, 0);
    tr_task(c, c.in[38] + (size_t)L * 1024 * 1024, 1024, 1024, 1024, W + WO_PG, 64);
}

template <int MODE> DI void phase_rmsnorm(const Ctx& c, int L) {
    float* wsm = (float*)c.lds;
    const float* gain = (MODE == 0 ? c.in[11] : c.in[34]) + (size_t)L * 1024;
    if (MODE == 0) {
        const float* win = c.in[12] + (size_t)L * 1024 * DIN;
        for (int idx = c.tid; idx < 4096; idx += 512) { const int k = idx >> 2, part = idx & 3, seg = part >> 1, half = part & 1;
            const f32x4 v = *(const f32x4*)(win + (size_t)k * DIN + (seg ? 4104 : 2560) + half * 4);
            const int sb = seg * 8 + half * 4;
            wsm[(sb + 0) * 1024 + k] = v[0]; wsm[(sb + 1) * 1024 + k] = v[1]; wsm[(sb + 2) * 1024 + k] = v[2]; wsm[(sb + 3) * 1024 + k] = v[3]; }
        __syncthreads();
    }
    float* XR = c.out;
    for (int row = c.bid * 8 + c.wave; row < MR; row += c.G * 8) {
        const float* src = (MODE == 0 && L == 0) ? (row < MP ? c.in[0] + (size_t)row * 1024 : c.in[1] + (size_t)(row - MP) * 1024) : XR + (size_t)row * 1024;
        f32x4 x[4]; float ss = 0.f;
#pragma unroll
        for (int i = 0; i < 4; ++i) { x[i] = *(const f32x4*)(src + c.lane * 4 + 256 * i); ss += x[i][0] * x[i][0] + x[i][1] * x[i][1] + x[i][2] * x[i][2] + x[i][3] * x[i][3]; }
        ss = wave_sum(ss);
        const float rs = rsqrtf(ss * (1.f / 1024.f) + EPS);
        if (MODE == 0 && L == 0) {
#pragma unroll
            for (int i = 0; i < 4; ++i) *(f32x4*)(XR + (size_t)row * 1024 + c.lane * 4 + 256 * i) = x[i];
        }
#pragma unroll
        for (int i = 0; i < 4; ++i) { const f32x4 g = *(const f32x4*)(gain + c.lane * 4 + 256 * i); x[i] = x[i] * rs * g;
            *(s16x4*)(c.XN + (size_t)row * 1024 + c.lane * 4 + 256 * i) = pack4v(x[i]); }
        if (MODE == 0) {
            float a[16];
#pragma unroll
            for (int s = 0; s < 16; ++s) { float t = 0.f;
#pragma unroll
                for (int i = 0; i < 4; ++i) { const f32x4 w = *(const f32x4*)(wsm + s * 1024 + c.lane * 4 + 256 * i); t += x[i][0] * w[0] + x[i][1] * w[1] + x[i][2] * w[2] + x[i][3] * w[3]; }
                a[s] = t; asm volatile("" ::: "memory"); }
#pragma unroll
            for (int i = 0; i < 8; ++i) { const bool up = (c.lane & 32) != 0; const float send = up ? a[i] : a[i + 8], keep = up ? a[i + 8] : a[i]; a[i] = keep + __shfl_xor(send, 32); }
#pragma unroll
            for (int i = 0; i < 4; ++i) { const bool up = (c.lane & 16) != 0; const float send = up ? a[i] : a[i + 4], keep = up ? a[i + 4] : a[i]; a[i] = keep + __shfl_xor(send, 16); }
#pragma unroll
            for (int i = 0; i < 2; ++i) { const bool up = (c.lane & 8) != 0; const float send = up ? a[i] : a[i + 2], keep = up ? a[i + 2] : a[i]; a[i] = keep + __shfl_xor(send, 8); }
            { const bool up = (c.lane & 4) != 0; const float send = up ? a[0] : a[1], keep = up ? a[1] : a[0]; a[0] = keep + __shfl_xor(send, 4); }
            a[0] += __shfl_xor(a[0], 2); a[0] += __shfl_xor(a[0], 1);
            if ((c.lane & 3) == 0) { const int sidx = ((c.lane >> 5) & 1) * 8 + ((c.lane >> 4) & 1) * 4 + ((c.lane >> 3) & 1) * 2 + ((c.lane >> 2) & 1); c.SG[(size_t)row * 16 + sidx] = a[0]; }
        }
    }
    __syncthreads();
}

DI void phase_gdn_prep(const Ctx& c, int L) {
    constexpr int RS = 132, AS = 68, BP = 136;
    LAS float* AmT0 = (LAS float*)c.lds;
    const float* convw = c.in[23] + (size_t)L * 4 * 1536;
    const bf16_t* PR = c.R1;
    for (int item = c.bid; item < 1024; item += c.G) {
        const int ch = item & 31, h = (item >> 5) & 3, b = item >> 7;
        const int t0 = b * SEQ + ch * 64;
        unsigned char* gi = c.GS + (size_t)item * GI_BYTES;
        LAS float* AmT = AmT0; asm volatile("" : "+v"(AmT));
        LAS float* beta = AmT + 64 * AS; LAS float* gcum = beta + 64; LAS float* part = gcum + 64;
        LAS float* vs = part + 128; asm volatile("" : "+v"(vs));
        LAS bf16_t* qb = (LAS bf16_t*)(vs + 64 * RS); asm volatile("" : "+v"(qb));
        LAS bf16_t* khi = qb + 64 * BP; asm volatile("" : "+v"(khi));
        LAS bf16_t* klo = khi + 64 * BP; asm volatile("" : "+v"(klo));
        if (c.wave == 7) { const size_t row = (size_t)(t0 + c.lane);
            const float bt = sigm(c.SG[row * 16 + h]);
            const float g = -expf(c.in[24][L * 4 + h]) * softplus_(c.SG[row * 16 + 4 + h] + c.in[25][L * 4 + h]);
            const float gc = wave_incl_sum(g, c.lane);
            beta[c.lane] = bt; gcum[c.lane] = gc;
            if (c.lane == 63) c.GL[item] = expf(gc); }
        { const int d = c.tid & 127, tq = c.tid >> 7;
          float qk[2][16];
#pragma unroll
          for (int which = 0; which < 3; ++which) {
              const int pcol = PQ + which * 512 + h * 128 + d, wcol = which * 512 + h * 128 + d;
              const float w0 = convw[wcol], w1 = convw[1536 + wcol], w2 = convw[3072 + wcol], w3 = convw[4608 + wcol];
              float xin[19];
#pragma unroll
              for (int i = 0; i < 19; ++i) { const int tt = ch * 64 + tq * 16 + i - 3; const int tc = tt < 0 ? 0 : tt;
                  const float v = bf2f(PR[(size_t)(b * SEQ + tc) * NPROJ + pcol]); xin[i] = tt < 0 ? 0.f : v; }
#pragma unroll
              for (int t = 0; t < 16; ++t) { const float a = silu_(xin[t] * w0 + xin[t + 1] * w1 + xin[t + 2] * w2 + xin[t + 3] * w3);
                  if (which == 2) vs[(tq * 16 + t) * RS + d] = a; else qk[which][t] = a; }
          }
#pragma unroll
          for (int which = 0; which < 2; ++which) {
              float ssq[16];
#pragma unroll
              for (int t = 0; t < 16; ++t) ssq[t] = qk[which][t] * qk[which][t];
              butterfly16(ssq, c.lane);
              __syncthreads();
              if ((c.lane & 3) == 0) part[c.wave * 16 + bsel16(c.lane)] = ssq[0];
              __syncthreads();
#pragma unroll
              for (int t = 0; t < 16; ++t) { const float tot = part[c.wave * 16 + t] + part[(c.wave ^ 1) * 16 + t];
                  const float v = qk[which][t] * rsqrtf(tot + EPS) * (which == 0 ? 0.08838834764831845f : 1.f);
                  const bf16_t hi = f2bf(v);
                  if (which == 0) qb[(tq * 16 + t) * BP + d] = hi;
                  else { khi[(tq * 16 + t) * BP + d] = hi; klo[(tq * 16 + t) * BP + d] = f2bf(v - bf2f(hi)); } }
          } }
        __syncthreads();
        { const int r = c.lane & 31, hh = c.lane >> 5, wq = c.wave & 3, tm = wq >> 1, tn = wq & 1;
          if (!(c.wave < 4 && tm == 0 && tn == 1)) {
              f32x16 acc;
#pragma unroll
              for (int j = 0; j < 16; ++j) acc[j] = 0.f;
              const LAS bf16_t* arow = (c.wave < 4 ? khi : qb) + (tm * 32 + r) * BP + hh * 8;
              const LAS bf16_t* brow = khi + (tn * 32 + r) * BP + hh * 8;
#pragma unroll
              for (int ks = 0; ks < 8; ++ks) { const bf16x8 av = *(const LAS bf16x8*)(arow + ks * 16), bv = *(const LAS bf16x8*)(brow + ks * 16);
                  acc = MFMA32(av, bv, acc);
                  if (c.wave < 4) { const bf16x8 al = *(const LAS bf16x8*)(arow + 64 * BP + ks * 16), bl = *(const LAS bf16x8*)(brow + 64 * BP + ks * 16);
                      acc = MFMA32(av, bl, acc); acc = MFMA32(al, bv, acc); } }
              const int s = tn * 32 + r; const float gs = gcum[s];
              bf16_t* at = (bf16_t*)(gi + GI_A);
#pragma unroll
              for (int i = 0; i < 16; ++i) { const int t = tm * 32 + crow(i, hh); const float dec = (t >= s) ? __expf(gcum[t] - gs) : 0.f;
                  if (c.wave < 4) { if (t > s) AmT[s * AS + t] = beta[t] * acc[i] * dec; }
                  else at[t * 64 + (s & ~15) + perm16(s & 15)] = f2bf(acc[i] * dec); }
          } }
        __syncthreads();
        if (c.tid < 256) {
            const int col = c.tid; float x[64];
#pragma unroll
            for (int t = 0; t < 64; ++t) x[t] = (col < 128) ? vs[t * RS + col] * beta[t] : (bf2f(khi[t * BP + (col - 128)]) + bf2f(klo[t * BP + (col - 128)])) * beta[t] * __expf(gcum[t]);
#pragma unroll
            for (int j = 0; j < 63; ++j) { const float xj = x[j];
#pragma unroll
                for (int g4 = (j + 1) / 4; g4 < 16; ++g4) { const f32x4 a = *(const LAS f32x4*)(AmT + j * AS + g4 * 4);
#pragma unroll
                    for (int e = 0; e < 4; ++e) if (g4 * 4 + e > j) x[g4 * 4 + e] -= a[e] * xj; } }
            if (col < 128) { bf16_t* up = (bf16_t*)(gi + GI_U); const int sl = col >> 5, r = col & 31;
#pragma unroll
                for (int t = 0; t < 64; ++t) { const int mt = t >> 5, tt = t & 31, hh = (tt >> 2) & 1, i = (tt & 3) + 4 * (tt >> 3);
                    up[((sl * 2 + mt) * 16 + i) * 64 + r + 32 * hh] = f2bf(x[t]); }
            } else { bf16_t* wp = (bf16_t*)(gi + GI_W); const int dk = col - 128, pd = (dk & ~15) + perm16(dk & 15);
#pragma unroll
                for (int t = 0; t < 64; ++t) wp[t * 128 + pd] = f2bf(-x[t]); }
        } else {
            bf16_t* qp = (bf16_t*)(gi + GI_Q); bf16_t* kp = (bf16_t*)(gi + GI_K);
            const float g63 = gcum[63];
            for (int idx = c.tid - 256; idx < 64 * 128; idx += 256) { const int t = idx >> 7, d = idx & 127;
                qp[t * 128 + (d & ~15) + perm16(d & 15)] = f2bf(bf2f(qb[t * BP + d]) * __expf(gcum[t])); }
            for (int idx = c.tid - 256; idx < 64 * 128; idx += 256) { const int d = idx >> 6, t = idx & 63;
                kp[d * 64 + (t & ~15) + perm16(t & 15)] = f2bf((bf2f(khi[t * BP + d]) + bf2f(klo[t * BP + d])) * __expf(g63 - gcum[t])); }
        }
        __syncthreads();
    }
}

constexpr int GB_W = 0, GB_Q = 16384, GB_A = 32768, GB_K = 40960, GB_U = 57344, GB_BYTES = 61440;
DI void dma16(const void* g, unsigned lds_addr) { asm volatile("s_mov_b32 m0, %1\n\tglobal_load_lds_dwordx4 %0, off" :: "v"(g), "s"(lds_addr) : "memory", "m0"); }
DI void gdn_issue(const Ctx& c, int item, int sl, int r, int hh, int ln, PG8_LAS unsigned char* buf) {
    const unsigned char* gi = c.GS + (size_t)item * GI_BYTES;
    const bf16_t* up = (const bf16_t*)(gi + GI_U); const bf16_t* wp = (const bf16_t*)(gi + GI_W); const bf16_t* qp = (const bf16_t*)(gi + GI_Q);
    const bf16_t* kp = (const bf16_t*)(gi + GI_K); const bf16_t* ap = (const bf16_t*)(gi + GI_A);
#pragma unroll
    for (int mt = 0; mt < 2; ++mt)
#pragma unroll
        for (int ks = 0; ks < 8; ++ks) {
            dma16((wp + (mt * 32 + r) * 128 + ks * 16 + hh * 8), (unsigned)(size_t)(buf + GB_W + (mt * 8 + ks) * 1024));
            dma16((qp + (mt * 32 + r) * 128 + ks * 16 + hh * 8), (unsigned)(size_t)(buf + GB_Q + (mt * 8 + ks) * 1024)); }
#pragma unroll
    for (int mt = 0; mt < 2; ++mt)
#pragma unroll
        for (int ks = 0; ks < 4; ++ks)
            dma16((ap + (mt * 32 + r) * 64 + ks * 16 + hh * 8), (unsigned)(size_t)(buf + GB_A + (mt * 4 + ks) * 1024));
#pragma unroll
    for (int i = 0; i < 4; ++i)
#pragma unroll
        for (int ks = 0; ks < 4; ++ks)
            dma16((kp + (i * 32 + r) * 64 + ks * 16 + hh * 8), (unsigned)(size_t)(buf + GB_K + (i * 4 + ks) * 1024));
#pragma unroll
    for (int j = 0; j < 4; ++j)
        dma16((up + (size_t)sl * 2048 + j * 512 + ln * 8), (unsigned)(size_t)(buf + GB_U + j * 1024));
}
DI void task_gdn_seq(const Ctx& c, int L, int unit) {
    const int sl = (unit >> 3) & 3, stream = (unit & 7) + 8 * (unit >> 5);
    const int b = stream >> 2, h = stream & 3;
    const int r0_ = c.lane & 31, hh0_ = c.lane >> 5; int r = r0_, hh = hh0_, ln = c.lane;
    PG8_LAS unsigned char* lbase = (PG8_LAS unsigned char*)c.lds;
    f32x16 S[4];
#pragma unroll
    for (int i = 0; i < 4; ++i)
#pragma unroll
        for (int j = 0; j < 16; ++j) S[i][j] = 0.f;
    bf16_t* yo = c.Y3 + (size_t)1 * MPAD * 512;
    gdn_issue(c, stream * 32, sl, r, hh, ln, lbase);
    for (int ch = 0; ch < 32; ++ch) {
        r = r0_; hh = hh0_; ln = c.lane; asm volatile("" : "+v"(r), "+v"(hh), "+v"(ln));
        const int item = stream * 32 + ch;
        const float gl = c.GL[item];
        asm volatile("s_waitcnt vmcnt(0)" ::: "memory");
        PG8_LAS unsigned char* buf = lbase + (ch & 1) * GB_BYTES;
        if (ch + 1 < 32) gdn_issue(c, item + 1, sl, r, hh, ln, lbase + ((ch + 1) & 1) * GB_BYTES);
        PG8_LAS unsigned char* lb = buf + ln * 16; asm volatile("" : "+v"(lb));
        PG8_LAS unsigned char* ub = buf + GB_U + ln * 2; asm volatile("" : "+v"(ub));
        f32x16 vn[2], o[2];
#pragma unroll
        for (int mt = 0; mt < 2; ++mt)
#pragma unroll
            for (int i = 0; i < 16; ++i) { vn[mt][i] = bf2f(*(const PG8_LAS bf16_t*)(ub + (mt * 16 + i) * 128)); o[mt][i] = 0.f; }
        bf16x8 Sb[8];
#pragma unroll
        for (int ks = 0; ks < 8; ++ks) Sb[ks] = pack16(S[ks >> 1], ks & 1);
#pragma unroll
        for (int mt = 0; mt < 2; ++mt)
#pragma unroll
            for (int ks = 0; ks < 8; ++ks) { const bf16x8 a = *(const PG8_LAS bf16x8*)(lb + GB_W + (mt * 8 + ks) * 1024); vn[mt] = MFMA32(a, Sb[ks], vn[mt]); }
#pragma unroll
        for (int mt = 0; mt < 2; ++mt)
#pragma unroll
            for (int ks = 0; ks < 8; ++ks) { const bf16x8 a = *(const PG8_LAS bf16x8*)(lb + GB_Q + (mt * 8 + ks) * 1024); o[mt] = MFMA32(a, Sb[ks], o[mt]); }
        bf16x8 Vb[4];
#pragma unroll
        for (int ks = 0; ks < 4; ++ks) Vb[ks] = pack16(vn[ks >> 1], ks & 1);
#pragma unroll
        for (int mt = 0; mt < 2; ++mt)
#pragma unroll
            for (int ks = 0; ks < 4; ++ks) { const bf16x8 a = *(const PG8_LAS bf16x8*)(lb + GB_A + (mt * 4 + ks) * 1024); o[mt] = MFMA32(a, Vb[ks], o[mt]); }
#pragma unroll
        for (int i = 0; i < 4; ++i) {
#pragma unroll
            for (int j = 0; j < 16; ++j) S[i][j] *= gl;
#pragma unroll
            for (int ks = 0; ks < 4; ++ks) { const bf16x8 a = *(const PG8_LAS bf16x8*)(lb + GB_K + (i * 4 + ks) * 1024); S[i] = MFMA32(a, Vb[ks], S[i]); }
        }
        const size_t rowb = (size_t)(b * SEQ + ch * 64);
#pragma unroll
        for (int mt = 0; mt < 2; ++mt)
#pragma unroll
            for (int i = 0; i < 16; ++i) yo[(rowb + mt * 32 + crow(i, hh)) * 512 + h * 128 + sl * 32 + r] = f2bf(o[mt][i]);
        asm volatile("s_waitcnt lgkmcnt(0)" ::: "memory");
    }
    float* so = c.out + O_GDN_P + ((size_t)(L * NB + b) * 4 + h) * 128 * 128;
#pragma unroll
    for (int i = 0; i < 4; ++i)
#pragma unroll
        for (int j = 0; j < 16; ++j) so[(size_t)(i * 32 + crow(j, hh)) * 128 + sl * 32 + r] = S[i][j];
}

DI void task_ml_gates(const Ctx& c, int L, int item) {
    const int ch = item & 31, h = (item >> 5) & 3, b = item >> 7, lane = c.lane;
    int r = lane & 31, hh = lane >> 5; asm volatile("" : "+v"(r), "+v"(hh));
    const size_t t0 = (size_t)(b * SEQ + ch * 64);
    const size_t row = t0 + lane;
    const float li = softcap_(c.SG[row * 16 + 8 + h] + c.in[27][L * 4 + h]);
    const float lf = logsig_(softcap_(c.SG[row * 16 + 12 + h] + c.in[28][L * 4 + h]));
    const float bc = wave_incl_sum(lf, lane);
    const float av = li - bc;
    const float cm = wave_incl_max(av, lane);
    float* mg = (float*)(c.ws + WS_MG) + (size_t)item * 256;
    mg[lane] = av; mg[64 + lane] = cm; mg[128 + lane] = bc;
    LAS float* a_s = (LAS float*)(c.lds + 122880 + c.wave * 1024);
    WAVE_FENCE();
    a_s[lane] = av;
    WAVE_FENCE();
    const bf16_t* qb = c.R1 + t0 * NPROJ + PMQ + h * 64; const bf16_t* kb = c.R1 + t0 * NPROJ + PMK + h * 64;
    f32x16 PT[2][2];
#pragma unroll
    for (int ms = 0; ms < 2; ++ms)
#pragma unroll
        for (int nt = 0; nt < 2; ++nt)
#pragma unroll
            for (int j = 0; j < 16; ++j) PT[ms][nt][j] = 0.f;
#pragma unroll
    for (int ks = 0; ks < 4; ++ks) { bf16x8 ak[2], bq[2];
#pragma unroll
        for (int m = 0; m < 2; ++m) { ak[m] = *(const bf16x8*)(kb + (size_t)(m * 32 + r) * NPROJ + ks * 16 + hh * 8); bq[m] = *(const bf16x8*)(qb + (size_t)(m * 32 + r) * NPROJ + ks * 16 + hh * 8); }
#pragma unroll
        for (int ms = 0; ms < 2; ++ms)
#pragma unroll
            for (int nt = 0; nt < 2; ++nt) PT[ms][nt] = MFMA32(ak[ms], bq[nt], PT[ms][nt]); }
    float dpv[2];
    unsigned char* pl = c.ws + WS_PL + (size_t)item * 8192 + lane * 16;
#pragma unroll
    for (int nt = 0; nt < 2; ++nt) { const float cmn = __shfl(cm, nt * 32 + r); float dp = 0.f;
#pragma unroll
        for (int ms = 0; ms < 2; ++ms)
#pragma unroll
            for (int g = 0; g < 4; ++g) { const f32x4 a4 = *(const LAS f32x4*)(a_s + ms * 32 + 8 * g + 4 * hh);
#pragma unroll
                for (int jj = 0; jj < 4; ++jj) { const int i = 4 * g + jj; const int s = ms * 32 + 8 * g + 4 * hh + jj;
                    const float wv = (s <= nt * 32 + r) ? __expf(a4[jj] - cmn) * 0.125f : 0.f;
                    PT[ms][nt][i] *= wv; dp += PT[ms][nt][i]; } }
        dp += __shfl_xor(dp, 32); dpv[nt] = dp;
#pragma unroll
        for (int ks = 0; ks < 4; ++ks) *(bf16x8*)(pl + (nt * 4 + ks) * 1024) = pack16(PT[ks >> 1][nt], ks & 1); }
    mg[192 + lane] = lane < 32 ? dpv[0] : dpv[1];
}
DI void ml_issue(const bf16_t* PR, const unsigned char* PLs  , int b, int h, int sl, int ch, int lane, unsigned bufaddr) {
    const size_t row = (size_t)(b * SEQ + ch * 64 + lane);
    const bf16_t* kp = PR + row * NPROJ + PMK + h * 64; const bf16_t* qp = PR + row * NPROJ + PMQ + h * 64; const bf16_t* vp = PR + row * NPROJ + PMV + h * 128 + sl * 32;
#pragma unroll
    for (int d8 = 0; d8 < 8; ++d8) { dma16(kp + d8 * 8, bufaddr + d8 * 1024); dma16(qp + d8 * 8, bufaddr + 8192 + d8 * 1024); }
#pragma unroll
    for (int d8 = 0; d8 < 4; ++d8) dma16(vp + d8 * 8, bufaddr + 16384 + d8 * 1024);
    const unsigned char* pl = PLs + (size_t)ch * 8192 + lane * 16;
#pragma unroll
    for (int fr = 0; fr < 8; ++fr) dma16(pl + fr * 1024, bufaddr + 20480 + fr * 1024);
}
DI void task_ml_seq(const Ctx& c, int L, int unit, float* wl  ) {
    const int sl = (unit >> 3) & 3, stream = (unit & 7) + 8 * (unit >> 5);
    const int b = stream >> 2, h = stream & 3;
    const int lane = c.lane, r0_ = lane & 31, hh0_ = lane >> 5;
    int r = r0_, hh = hh0_, lane_v = lane;
    LAS float* a_l = (LAS float*)wl; LAS float* w_l = a_l + 64; LAS float* sc_l = a_l + 128; LAS float* inv_l = a_l + 192;
    LAS float* n_l = a_l + 256;
    LAS unsigned char* bufs = (LAS unsigned char*)(a_l + 320);
    const unsigned bufaddr0 = (unsigned)(size_t)bufs;
    const bf16_t* PR = c.R1;
    f32x16 C[2];
#pragma unroll
    for (int i = 0; i < 2; ++i)
#pragma unroll
        for (int j = 0; j < 16; ++j) C[i][j] = 0.f;
    float nst = 0.f, mprev = 0.f;
    n_l[lane] = 0.f;
    bf16_t* yo = c.Y3 + (size_t)2 * MPAD * 512;
    float mgv[4];
    const unsigned char* PLs = c.ws + WS_PL + (size_t)(stream * 32) * 8192;
    { const float* mg = (const float*)(c.ws + WS_MG) + (size_t)(stream * 32) * 256; mgv[0] = mg[lane]; mgv[1] = mg[64 + lane]; mgv[2] = mg[128 + lane]; mgv[3] = mg[192 + lane]; }
    ml_issue(PR, PLs, b, h, sl, 0, lane, bufaddr0);
    for (int ch = 0; ch < 32; ++ch) {
        r = r0_; hh = hh0_; lane_v = lane; asm volatile("" : "+v"(r), "+v"(hh), "+v"(lane_v));
        const float av = mgv[0], cmx = mgv[1], bc = mgv[2], dploc = mgv[3];
        asm volatile("s_waitcnt vmcnt(0)" ::: "memory");
        if (ch + 1 < 32) ml_issue(PR, PLs, b, h, sl, ch + 1, lane_v, bufaddr0 + ((ch + 1) & 1) * 28672);
        { const int chn = ch + 1 < 32 ? ch + 1 : 31; const float* mg = (const float*)(c.ws + WS_MG) + (size_t)(stream * 32 + chn) * 256;
          mgv[0] = mg[lane_v]; mgv[1] = mg[64 + lane_v]; mgv[2] = mg[128 + lane_v]; mgv[3] = mg[192 + lane_v]; }
        LAS unsigned char* Kc = bufs + (ch & 1) * 28672; asm volatile("" : "+v"(Kc));
        LAS unsigned char* Pf = Kc + 20480 + lane_v * 16; asm volatile("" : "+v"(Pf));
        LAS unsigned char* Qc = Kc + 8192; LAS unsigned char* Vc = Kc + 16384;
        LAS unsigned char* vbase = Vc + (r >> 3) * 1024 + (r & 7) * 2 + hh * 64; asm volatile("" : "+v"(vbase));
        LAS unsigned char* kbase = Kc + (r >> 3) * 1024 + (r & 7) * 2 + hh * 64; asm volatile("" : "+v"(kbase));
        LAS unsigned char* krow = Kc + hh * 1024 + r * 16; asm volatile("" : "+v"(krow));
        LAS unsigned char* qrow = Qc + hh * 1024 + r * 16; asm volatile("" : "+v"(qrow));
        LAS unsigned char* qr4 = Qc + r * 16 + hh * 8; asm volatile("" : "+v"(qr4));
        LAS unsigned char* kn = Kc + (lane_v >> 3) * 1024 + (lane_v & 7) * 2; asm volatile("" : "+v"(kn));
        LAS unsigned char* qln = Qc + lane_v * 16; asm volatile("" : "+v"(qln));
        LAS float* a4b = a_l + 4 * hh; asm volatile("" : "+v"(a4b));
        const size_t t0 = (size_t)(b * SEQ + ch * 64);
        const float Mt = fmaxf(mprev, cmx);
        const float sct = __expf(mprev - Mt);
        const float fsc = __expf(cmx - Mt);
        const float M63 = __shfl(Mt, 63), bc63 = __shfl(bc, 63);
        const float wlast = __expf(av - M63) * 0.125f;
        const float sclast = __expf(mprev - M63);
        WAVE_FENCE();
        float qn = 0.f;
#pragma unroll
        for (int d8 = 0; d8 < 8; ++d8) { const f32x8 qv = unpack8(*(const LAS bf16x8*)(qln + d8 * 1024));
            const f32x4 n0 = *(const LAS f32x4*)(n_l + d8 * 8), n1 = *(const LAS f32x4*)(n_l + d8 * 8 + 4);
            qn += qv[0] * n0[0] + qv[1] * n0[1] + qv[2] * n0[2] + qv[3] * n0[3] + qv[4] * n1[0] + qv[5] * n1[1] + qv[6] * n1[2] + qv[7] * n1[3]; }
        a_l[lane] = fsc; w_l[lane] = wlast;
        WAVE_FENCE();
        bf16x8 Vb[4];
#pragma unroll
        for (int ks = 0; ks < 4; ++ks)
#pragma unroll
            for (int j = 0; j < 8; ++j) Vb[ks][j] = (short)*(const LAS bf16_t*)(vbase + (16 * ks + 8 * (j >> 2) + (j & 3)) * 16);
        f32x16 num[2];
#pragma unroll
        for (int nt = 0; nt < 2; ++nt) {
#pragma unroll
            for (int j = 0; j < 16; ++j) num[nt][j] = 0.f;
#pragma unroll
            for (int ks = 0; ks < 4; ++ks) num[nt] = MFMA32(*(const LAS bf16x8*)(Pf + (nt * 4 + ks) * 1024), Vb[ks], num[nt]);
        }
        const float den = fsc * dploc + sct * qn;
        const float inv = 1.f / fmaxf(fabsf(den), __expf(-(bc + Mt)));
        sc_l[lane] = sct; inv_l[lane] = inv;
        WAVE_FENCE();
        { bf16x8 Cb[4];
#pragma unroll
          for (int kd = 0; kd < 4; ++kd) Cb[kd] = pack16(C[kd >> 1], kd & 1);
#pragma unroll
          for (int mt = 0; mt < 2; ++mt) { f32x16 qc;
#pragma unroll
              for (int j = 0; j < 16; ++j) qc[j] = 0.f;
#pragma unroll
              for (int kd = 0; kd < 4; ++kd) { const LAS unsigned char* qr = qr4 + kd * 2048 + mt * 512;
                  const s16x4 lo = *(const LAS s16x4*)qr, hi = *(const LAS s16x4*)(qr + 1024);
                  const bf16x8 a = __builtin_shufflevector(lo, hi, 0, 1, 2, 3, 4, 5, 6, 7);
                  qc = MFMA32(a, Cb[kd], qc); }
#pragma unroll
              for (int g = 0; g < 4; ++g) { const f32x4 f4 = *(const LAS f32x4*)(a4b + mt * 32 + 8 * g), s4 = *(const LAS f32x4*)(a4b + 128 + mt * 32 + 8 * g), i4 = *(const LAS f32x4*)(a4b + 192 + mt * 32 + 8 * g);
#pragma unroll
                  for (int jj = 0; jj < 4; ++jj) { const int i = 4 * g + jj; const float hv = (f4[jj] * num[mt][i] + s4[jj] * qc[i]) * i4[jj];
                      yo[(t0 + mt * 32 + 8 * g + 4 * hh + jj) * 512 + h * 128 + sl * 32 + r] = f2bf(hv); } }
                } }
#pragma unroll
        for (int i = 0; i < 2; ++i) {
#pragma unroll
            for (int j = 0; j < 16; ++j) C[i][j] *= sclast;
#pragma unroll
            for (int ks = 0; ks < 4; ++ks) { const f32x4 wA = *(const LAS f32x4*)(a4b + 64 + 16 * ks), wB = *(const LAS f32x4*)(a4b + 64 + 16 * ks + 8);
                f32x8 kv;
#pragma unroll
                for (int j = 0; j < 8; ++j) kv[j] = bf2f(*(const LAS bf16_t*)(kbase + i * 4096 + (16 * ks + 8 * (j >> 2) + (j & 3)) * 16)) * (j < 4 ? wA[j & 3] : wB[j & 3]);
                C[i] = MFMA32(pack8v(kv), Vb[ks], C[i]); }
            }
        { float na = 0.f;
#pragma unroll
          for (int s4 = 0; s4 < 16; ++s4) { const f32x4 w4 = *(const LAS f32x4*)(w_l + s4 * 4);
#pragma unroll
              for (int e = 0; e < 4; ++e) na += w4[e] * bf2f(*(const LAS bf16_t*)(kn + (s4 * 4 + e) * 16)); }
          nst = sclast * nst + na; n_l[lane] = nst; }
        mprev = bc63 + M63;
        asm volatile("s_waitcnt lgkmcnt(0)" ::: "memory");
    }
    float* co = c.out + O_MLC_P + ((size_t)(L * NB + b) * 4 + h) * 64 * 128;
#pragma unroll
    for (int i = 0; i < 2; ++i)
#pragma unroll
        for (int j = 0; j < 16; ++j) co[(size_t)(i * 32 + crow(j, hh)) * 128 + sl * 32 + r] = C[i][j];
    if (sl == 0) { c.out[O_MLN_P + ((size_t)(L * NB + b) * 4 + h) * 64 + lane] = nst; if (lane == 0) c.out[O_MLM_P + (size_t)(L * NB + b) * 4 + h] = mprev; }
}

DI void task_gdn_sample(const Ctx& c, int L, int unit) {
    const int q4 = unit & 3, h = (unit >> 2) & 3, b = unit >> 4, lane = c.lane, c32 = lane & 31, hh2 = lane >> 5;
    const int dv = q4 * 32 + c32;
    const size_t row = (size_t)(MP + b);
    const bf16_t* pr = c.R1 + row * NPROJ;
    const float* cbuf = c.in[4] + ((size_t)L * MS + b) * 3 * 1536;
    const float* cw = c.in[23] + (size_t)L * 4 * 1536;
    float* cout = c.out + O_CONV_S + ((size_t)L * MS + b) * 3 * 1536;
    float qv[2], kv[2], vv;
#pragma unroll
    for (int w = 0; w < 5; ++w) {
        const int which = w < 2 ? 0 : w < 4 ? 1 : 2; const int d = (w == 4) ? dv : lane + 64 * (w & 1);
        const int cc = which * 512 + h * 128 + d;
        const float xin = bf2f(pr[PQ + cc]);
        const float b0 = cbuf[cc], b1 = cbuf[1536 + cc], b2 = cbuf[3072 + cc];
        float a = b0 * cw[cc] + b1 * cw[1536 + cc] + b2 * cw[3072 + cc] + xin * cw[4608 + cc];
        a = silu_(a);
        cout[cc] = b1; cout[1536 + cc] = b2; cout[3072 + cc] = xin;
        if (w < 2) qv[w] = a; else if (w < 4) kv[w - 2] = a; else vv = a;
    }
    { const float sq = wave_sum(qv[0] * qv[0] + qv[1] * qv[1]), sk = wave_sum(kv[0] * kv[0] + kv[1] * kv[1]);
      const float fq = rsqrtf(sq + EPS) * 0.08838834764831845f, fk = rsqrtf(sk + EPS);
      qv[0] *= fq; qv[1] *= fq; kv[0] *= fk; kv[1] *= fk; }
    const float qk = wave_sum(qv[0] * kv[0] + qv[1] * kv[1]);
    const float beta = sigm(c.SG[row * 16 + h]);
    const float g = -expf(c.in[24][L * 4 + h]) * softplus_(c.SG[row * 16 + 4 + h] + c.in[25][L * 4 + h]);
    const float eg = expf(g);
    const size_t soff = (((size_t)L * MS + b) * 4 + h) * 128 * 128 + (size_t)(hh2 * 64) * 128 + dv;
    const float* sin_ = c.in[5] + soff; float* sout = c.out + O_GDN_S + soff;
    float sreg[64];
#pragma unroll
    for (int d = 0; d < 64; ++d) sreg[d] = sin_[(size_t)d * 128];
    float kS = 0.f, qS = 0.f;
#pragma unroll
    for (int d = 0; d < 64; ++d) { const float ka = __shfl(kv[0], d), kb = __shfl(kv[1], d), qa = __shfl(qv[0], d), qb2 = __shfl(qv[1], d);
        kS += (hh2 ? kb : ka) * sreg[d]; qS += (hh2 ? qb2 : qa) * sreg[d]; }
    kS += __shfl_xor(kS, 32); qS += __shfl_xor(qS, 32);
    const float vnew = beta * (vv - eg * kS);
    const float o = eg * qS + qk * vnew;
#pragma unroll
    for (int d = 0; d < 64; ++d) { const float ka = __shfl(kv[0], d), kb = __shfl(kv[1], d); sout[(size_t)d * 128] = sreg[d] * eg + (hh2 ? kb : ka) * vnew; }
    if (hh2 == 0) c.Y3[(size_t)1 * MPAD * 512 + row * 512 + h * 128 + dv] = f2bf(o);
}
DI void task_ml_sample(const Ctx& c, int L, int unit) {
    const int half = unit & 1, h = (unit >> 1) & 3, b = unit >> 3, lane = c.lane;
    const size_t row = (size_t)(MP + b);
    const bf16_t* pr = c.R1 + row * NPROJ;
    const float q = bf2f(pr[PMQ + h * 64 + lane]), k = bf2f(pr[PMK + h * 64 + lane]) * 0.125f, v = bf2f(pr[PMV + h * 128 + half * 64 + lane]);
    const float li = softcap_(c.SG[row * 16 + 8 + h] + c.in[27][L * 4 + h]);
    const float lf = logsig_(softcap_(c.SG[row * 16 + 12 + h] + c.in[28][L * 4 + h]));
    const size_t sidx = ((size_t)L * MS + b) * 4 + h;
    const float m0 = c.in[8][sidx];
    const float mt = fmaxf(lf + m0, li), wts = expf(li - mt), sc = expf(lf + m0 - mt);
    const float n0 = c.in[7][sidx * 64 + lane];
    const float sqk = wave_sum(q * k) * wts, qn = wave_sum(q * n0);
    const float* cin = c.in[6] + sidx * 64 * 128 + half * 64 + lane;
    float* cout = c.out + O_MLC_S + sidx * 64 * 128 + half * 64 + lane;
    float cc[64]; float qC = 0.f;
#pragma unroll
    for (int d = 0; d < 64; ++d) { cc[d] = cin[(size_t)d * 128]; qC += __shfl(q, d) * cc[d]; }
    const float num = sqk * v + sc * qC, den = sqk + sc * qn;
    const float hv = num / fmaxf(fabsf(den), expf(-mt));
#pragma unroll
    for (int d = 0; d < 64; ++d) cout[(size_t)d * 128] = sc * cc[d] + wts * __shfl(k, d) * v;
    if (half == 0) { c.out[O_MLN_S + sidx * 64 + lane] = sc * n0 + wts * k; if (lane == 0) c.out[O_MLM_S + sidx] = mt; }
    c.Y3[(size_t)2 * MPAD * 512 + row * 512 + h * 128 + half * 64 + lane] = f2bf(hv);
}
struct S5P { float lr, li; f32x2 bb[16]; };
DI S5P s5_params(const Ctx& c, int L, int g, int p) {
    S5P P; const size_t gp = ((size_t)L * 32 + g) * 64 + p;
    const float are = c.in[13][gp], aim = c.in[14][gp], dt = expf(c.in[15][L * 32 + g]);
    const float mag = expf(are * dt); P.lr = mag * cosf(aim * dt); P.li = mag * sinf(aim * dt);
    const float inv = 1.f / (are * are + aim * aim), zr = P.lr - 1.f, zi = P.li;
    const float fre = (zr * are + zi * aim) * inv, fim = (zi * are - zr * aim) * inv;
    const float* Bre = c.in[16] + gp * 16; const float* Bim = c.in[17] + gp * 16;
#pragma unroll
    for (int q4 = 0; q4 < 4; ++q4) { const f32x4 br = *(const f32x4*)(Bre + 4 * q4), bi = *(const f32x4*)(Bim + 4 * q4);
#pragma unroll
        for (int e = 0; e < 4; ++e) { P.bb[4 * q4 + e][0] = fre * br[e] - fim * bi[e]; P.bb[4 * q4 + e][1] = fre * bi[e] + fim * br[e]; } }
    return P;
}
DI void task_s5_sample(const Ctx& c, int L, int unit) {
    const int g = unit & 31, b = unit >> 5, lane = c.lane;
    const S5P P = s5_params(c, L, g, lane);
    const size_t row = (size_t)(MP + b);
    const bf16_t* pr = c.R1 + row * NPROJ + PU + g * 16;
    float u[16];
    { const f32x8 u0 = unpack8(*(const bf16x8*)pr), u1 = unpack8(*(const bf16x8*)(pr + 8));
#pragma unroll
      for (int e = 0; e < 8; ++e) { u[e] = u0[e]; u[8 + e] = u1[e]; } }
    f32x2 bu = {0.f, 0.f};
#pragma unroll
    for (int cc = 0; cc < 16; ++cc) bu += P.bb[cc] * u[cc];
    const size_t si = (((size_t)L * MS + b) * 32 + g) * 64 + lane;
    const float h0r = c.in[2][si], h0i = c.in[3][si];
    const float hr = P.lr * h0r - P.li * h0i + bu[0], hi = P.lr * h0i + P.li * h0r + bu[1];
    c.out[O_S5RE_S + si] = hr; c.out[O_S5IM_S + si] = hi;
    const float* Cre = c.in[18] + ((size_t)L * 32 + g) * 16 * 64; const float* Cim = c.in[19] + ((size_t)L * 32 + g) * 16 * 64;
    float ya[16];
#pragma unroll
    for (int cc = 0; cc < 16; ++cc) ya[cc] = hr * Cre[cc * 64 + lane] - hi * Cim[cc * 64 + lane];
    butterfly16(ya, lane);
    if ((lane & 3) == 0) { const int cc = bsel16(lane); const float y = ya[0] + c.in[20][L * 512 + g * 16 + cc] * bf2f(pr[cc]);
        c.YS5[row * 512 + g * 16 + cc] = f2bf(gelu_t(y)); }
}

DI void task_s5_wave(const Ctx& c, int L, int unit, unsigned char* wlds  ) {
    LAS float* Uw = (LAS float*)wlds;
    LAS bf16_t* Hw = (LAS bf16_t*)(wlds + 4096);
    const int lane = c.lane;
    const int g = unit & 31, b = unit >> 5;
    const S5P P = s5_params(c, L, g, lane);
    const size_t rbase = (size_t)(b * SEQ);
    const bf16_t* ub = c.R1 + rbase * NPROJ + PU + g * 16;
    bf16x8 Cb[4];
    { const int cc = lane & 15, kq = (lane >> 4) * 8; const float* Cre = c.in[18] + (((size_t)L * 32 + g) * 16 + cc) * 64; const float* Cim = c.in[19] + (((size_t)L * 32 + g) * 16 + cc) * 64;
#pragma unroll
      for (int ks = 0; ks < 4; ++ks) { f32x8 v;
#pragma unroll
          for (int j = 0; j < 8; ++j) { const int k = ks * 32 + kq + j; v[j] = (k < 64) ? Cre[k] : -Cim[k - 64]; }
          Cb[ks] = pack8v(v); } }
    const float dskip = c.in[20][L * 512 + g * 16 + (lane & 15)];
    float hr = 0.f, hi = 0.f;
    for (int sub = 0; sub < 32; ++sub) {
        WAVE_FENCE();
        { const bf16_t* up = ub + (size_t)(sub * 64 + lane) * NPROJ; const f32x8 u0 = unpack8(*(const bf16x8*)up), u1 = unpack8(*(const bf16x8*)(up + 8));
          LAS f32x4* d = (LAS f32x4*)(Uw + lane * 16);
          d[0] = (f32x4){u0[0], u0[1], u0[2], u0[3]}; d[1] = (f32x4){u0[4], u0[5], u0[6], u0[7]}; d[2] = (f32x4){u1[0], u1[1], u1[2], u1[3]}; d[3] = (f32x4){u1[4], u1[5], u1[6], u1[7]}; }
        WAVE_FENCE();
        for (int blk = 0; blk < 4; ++blk) {
#pragma unroll 4
            for (int st = 0; st < 16; ++st) {
                const LAS f32x4* up4 = (const LAS f32x4*)(Uw + (blk * 16 + st) * 16);
                f32x2 bu = {0.f, 0.f};
#pragma unroll
                for (int q4 = 0; q4 < 4; ++q4) { const f32x4 uv = up4[q4];
#pragma unroll
                    for (int e = 0; e < 4; ++e) bu += P.bb[4 * q4 + e] * uv[e]; }
                const float nr = P.lr * hr - P.li * hi + bu[0], ni = P.lr * hi + P.li * hr + bu[1]; hr = nr; hi = ni;
                Hw[st * 128 + lane] = f2bf(hr); Hw[st * 128 + 64 + lane] = f2bf(hi);
            }
            WAVE_FENCE();
            f32x4 acc = {0.f, 0.f, 0.f, 0.f};
#pragma unroll
            for (int ks = 0; ks < 4; ++ks) { const bf16x8 a = *(const LAS bf16x8*)(Hw + (lane & 15) * 128 + ks * 32 + (lane >> 4) * 8); acc = MFMA16(a, Cb[ks], acc); }
            const int cc = lane & 15;
#pragma unroll
            for (int j = 0; j < 4; ++j) { const int st = (lane >> 4) * 4 + j; const int tl = blk * 16 + st;
                const float y = acc[j] + dskip * Uw[tl * 16 + cc];
                c.YS5[(rbase + sub * 64 + tl) * 512 + g * 16 + cc] = f2bf(gelu_t(y)); }
            WAVE_FENCE();
        }
    }
    { const size_t si = (((size_t)L * NB + b) * 32 + g) * 64 + lane; c.out[O_S5RE_P + si] = hr; c.out[O_S5IM_P + si] = hi; }
}

constexpr int S5Q_BASE = 122880, S5Q_F = S5Q_BASE + 32768, S5Q_FLAG = S5Q_F + 2048;
template <int PASS> DI void s5_steps16(const S5P& P, const LAS float* Ublk, LAS bf16_t* Hw, int lane, float& hr, float& hi) {
#pragma unroll
    for (int s4 = 0; s4 < 4; ++s4) {
        f32x4 uv[4][4];
#pragma unroll
        for (int j = 0; j < 4; ++j)
#pragma unroll
            for (int q4 = 0; q4 < 4; ++q4) uv[j][q4] = *(const LAS f32x4*)(Ublk + (s4 * 4 + j) * 16 + q4 * 4);
        asm volatile("" ::: "memory");
        f32x2 bu[4];
#pragma unroll
        for (int j = 0; j < 4; ++j) { f32x2 acc[4];
#pragma unroll
            for (int q4 = 0; q4 < 4; ++q4) { acc[q4] = P.bb[4 * q4] * uv[j][q4][0];
#pragma unroll
                for (int e = 1; e < 4; ++e) acc[q4] += P.bb[4 * q4 + e] * uv[j][q4][e]; }
            bu[j] = (acc[0] + acc[1]) + (acc[2] + acc[3]); }
#pragma unroll
        for (int j = 0; j < 4; ++j) { const float nr = P.lr * hr - P.li * hi + bu[j][0], ni = P.lr * hi + P.li * hr + bu[j][1]; hr = nr; hi = ni;
            if (PASS == 1) { Hw[(s4 * 4 + j) * 128 + lane] = f2bf(hr); Hw[(s4 * 4 + j) * 128 + 64 + lane] = f2bf(hi); } }
    }
}
DI void task_s5_quad(const Ctx& c, int L, int unit, int wq, int gen) {
    unsigned char* wlds = c.lds + S5Q_BASE + wq * 8192;
    LAS float* Uw = (LAS float*)wlds;
    LAS bf16_t* Hw = (LAS bf16_t*)(wlds + 4096);
    LAS float* F = (LAS float*)(c.lds + S5Q_F);
    volatile LAS int* flag = (volatile LAS int*)(c.lds + S5Q_FLAG);
    const int lane = c.lane;
    const int g = unit & 31, b = unit >> 5;
    const S5P P = s5_params(c, L, g, lane);
    float pr_ = P.lr, pi_ = P.li;
#pragma unroll
    for (int i = 0; i < 9; ++i) { const float nr = pr_ * pr_ - pi_ * pi_, ni = 2.f * pr_ * pi_; pr_ = nr; pi_ = ni; }
    const size_t rbase = (size_t)(b * SEQ + wq * 512);
    const bf16_t* ub = c.R1 + rbase * NPROJ + PU + g * 16;
    bf16x8 Cb[4];
    { const int cc = lane & 15, kq = (lane >> 4) * 8; const float* Cre = c.in[18] + (((size_t)L * 32 + g) * 16 + cc) * 64; const float* Cim = c.in[19] + (((size_t)L * 32 + g) * 16 + cc) * 64;
#pragma unroll
      for (int ks = 0; ks < 4; ++ks) { f32x8 v;
#pragma unroll
          for (int j = 0; j < 8; ++j) { const int k = ks * 32 + kq + j; v[j] = (k < 64) ? Cre[k] : -Cim[k - 64]; }
          Cb[ks] = pack8v(v); } }
    const float dskip = c.in[20][L * 512 + g * 16 + (lane & 15)];
    float hr = 0.f, hi = 0.f;
    for (int pass = 0; pass < 2; ++pass) {
        if (pass == 1) {
            hr = 0.f; hi = 0.f;
            for (int v = 0; v < wq; ++v) { while (flag[v] != gen) __builtin_amdgcn_s_sleep(2);
                asm volatile("" ::: "memory");
                const float fr = F[v * 128 + lane], fi = F[v * 128 + 64 + lane];
                const float nr = pr_ * hr - pi_ * hi + fr, ni = pr_ * hi + pi_ * hr + fi; hr = nr; hi = ni; }
        }
        for (int sub = 0; sub < 8; ++sub) {
            WAVE_FENCE();
            { const bf16_t* up = ub + (size_t)(sub * 64 + lane) * NPROJ; const f32x8 u0 = unpack8(*(const bf16x8*)up), u1 = unpack8(*(const bf16x8*)(up + 8));
              LAS f32x4* d = (LAS f32x4*)(Uw + lane * 16);
              d[0] = (f32x4){u0[0], u0[1], u0[2], u0[3]}; d[1] = (f32x4){u0[4], u0[5], u0[6], u0[7]}; d[2] = (f32x4){u1[0], u1[1], u1[2], u1[3]}; d[3] = (f32x4){u1[4], u1[5], u1[6], u1[7]}; }
            WAVE_FENCE();
            for (int blk = 0; blk < 4; ++blk) {
                if (pass == 1) s5_steps16<1>(P, Uw + blk * 256, Hw, lane, hr, hi); else s5_steps16<0>(P, Uw + blk * 256, Hw, lane, hr, hi);
                if (pass == 1) {
                    WAVE_FENCE();
                    f32x4 acc = {0.f, 0.f, 0.f, 0.f};
#pragma unroll
                    for (int ks = 0; ks < 4; ++ks) { const bf16x8 a = *(const LAS bf16x8*)(Hw + (lane & 15) * 128 + ks * 32 + (lane >> 4) * 8); acc = MFMA16(a, Cb[ks], acc); }
                    const int cc = lane & 15;
#pragma unroll
                    for (int j = 0; j < 4; ++j) { const int st = (lane >> 4) * 4 + j; const int tl = blk * 16 + st;
                        const float y = acc[j] + dskip * Uw[tl * 16 + cc];
                        c.YS5[(rbase + sub * 64 + tl) * 512 + g * 16 + cc] = f2bf(gelu_t(y)); }
                    WAVE_FENCE();
                }
            }
        }
        if (pass == 0) {
            if (wq < 3) { F[wq * 128 + lane] = hr; F[wq * 128 + 64 + lane] = hi; WAVE_FENCE(); if (lane == 0) flag[wq] = gen; }
        }
    }
    if (wq == 3) { const size_t si = (((size_t)L * NB + b) * 32 + g) * 64 + lane; c.out[O_S5RE_P + si] = hr; c.out[O_S5IM_P + si] = hi; }
}

DI void phase_s5_scan(const Ctx& c, int L) {
    float* U = (float*)c.lds;
    bf16_t* H = (bf16_t*)(c.lds + 32768);
    float* F = (float*)(c.lds + 65536);
    const int lane = c.lane, w = c.wave;
    float* Uw = U + w * 1024; bf16_t* Hw = H + w * 2048;
    for (int unit = c.bid; unit < 256; unit += c.G) {
        const int g = unit & 31, b = unit >> 5;
        const S5P P = s5_params(c, L, g, lane);
        float pr_ = P.lr, pi_ = P.li;
#pragma unroll
        for (int i = 0; i < 8; ++i) { const float nr = pr_ * pr_ - pi_ * pi_, ni = 2.f * pr_ * pi_; pr_ = nr; pi_ = ni; }
        const size_t rbase = (size_t)(b * SEQ + w * 256);
        const bf16_t* ub = c.R1 + rbase * NPROJ + PU + g * 16;
        bf16x8 Cb[4];
        { const int cc = lane & 15, kq = (lane >> 4) * 8; const float* Cre = c.in[18] + (((size_t)L * 32 + g) * 16 + cc) * 64; const float* Cim = c.in[19] + (((size_t)L * 32 + g) * 16 + cc) * 64;
#pragma unroll
          for (int ks = 0; ks < 4; ++ks) { f32x8 v;
#pragma unroll
              for (int j = 0; j < 8; ++j) { const int k = ks * 32 + kq + j; v[j] = (k < 64) ? Cre[k] : -Cim[k - 64]; }
              Cb[ks] = pack8v(v); } }
        const float dskip = c.in[20][L * 512 + g * 16 + (lane & 15)];
        float hr = 0.f, hi = 0.f;
        for (int pass = 0; pass < 2; ++pass) {
            if (pass == 1) {
                F[w * 128 + lane] = hr; F[w * 128 + 64 + lane] = hi;
                __syncthreads();
                hr = 0.f; hi = 0.f;
                for (int v = 0; v < w; ++v) { const float fr = F[v * 128 + lane], fi = F[v * 128 + 64 + lane];
                    const float nr = pr_ * hr - pi_ * hi + fr, ni = pr_ * hi + pi_ * hr + fi; hr = nr; hi = ni; }
            }
            for (int sub = 0; sub < 4; ++sub) {
                __syncthreads();
                { const bf16_t* up = ub + (size_t)(sub * 64 + lane) * NPROJ; const f32x8 u0 = unpack8(*(const bf16x8*)up), u1 = unpack8(*(const bf16x8*)(up + 8));
                  f32x4* d = (f32x4*)(Uw + lane * 16);
                  d[0] = (f32x4){u0[0], u0[1], u0[2], u0[3]}; d[1] = (f32x4){u0[4], u0[5], u0[6], u0[7]}; d[2] = (f32x4){u1[0], u1[1], u1[2], u1[3]}; d[3] = (f32x4){u1[4], u1[5], u1[6], u1[7]}; }
                __syncthreads();
                for (int blk = 0; blk < 4; ++blk) {
#pragma unroll 4
                    for (int st = 0; st < 16; ++st) {
                        const f32x4* up4 = (const f32x4*)(Uw + (blk * 16 + st) * 16);
                        f32x2 bu = {0.f, 0.f};
#pragma unroll
                        for (int q4 = 0; q4 < 4; ++q4) { const f32x4 uv = up4[q4];
#pragma unroll
                            for (int e = 0; e < 4; ++e) bu += P.bb[4 * q4 + e] * uv[e]; }
                        const float nr = P.lr * hr - P.li * hi + bu[0], ni = P.lr * hi + P.li * hr + bu[1]; hr = nr; hi = ni;
                        if (pass == 1) { Hw[st * 128 + lane] = f2bf(hr); Hw[st * 128 + 64 + lane] = f2bf(hi); }
                    }
                    if (pass == 1) {
                        __syncthreads();
                        f32x4 acc = {0.f, 0.f, 0.f, 0.f};
#pragma unroll
                        for (int ks = 0; ks < 4; ++ks) { const bf16x8 a = *(const bf16x8*)(Hw + (lane & 15) * 128 + ks * 32 + (lane >> 4) * 8); acc = MFMA16(a, Cb[ks], acc); }
                        const int cc = lane & 15;
#pragma unroll
                        for (int j = 0; j < 4; ++j) { const int st = (lane >> 4) * 4 + j; const int tl = blk * 16 + st;
                            const float y = acc[j] + dskip * Uw[tl * 16 + cc];
                            c.YS5[(rbase + sub * 64 + tl) * 512 + g * 16 + cc] = f2bf(gelu_t(y)); }
                        __syncthreads();
                    }
                }
            }
        }
        if (w == 7) { const size_t si = (((size_t)L * NB + b) * 32 + g) * 64 + lane; c.out[O_S5RE_P + si] = hr; c.out[O_S5IM_P + si] = hi; }
        __syncthreads();
    }
}


#ifdef SELFCHK
DI void blk_reduce2(float& a, float& b, float* red, int tid) {
    a = wave_sum(a); b = wave_sum(b);
    __syncthreads();
    if ((tid & 63) == 0) { red[tid >> 6] = a; red[8 + (tid >> 6)] = b; }
    __syncthreads();
    float x = 0.f, y = 0.f;
    for (int i = 0; i < 8; ++i) { x += red[i]; y += red[8 + i]; }
    a = x; b = y; __syncthreads();
}
DI void chk_gdn(const Ctx& c, int L, int b, int h, float* dg) {
    float* q = (float*)c.lds; float* k = q + 128; float* v = k + 128; float* part = v + 128; float* red = part + 512; float* sc_ = red + 16;
    const int tid = c.tid, dv = tid & 127, qt = tid >> 7;
    const float* convw = c.in[23] + (size_t)L * 4 * 1536;
    float S[32];
#pragma unroll
    for (int i = 0; i < 32; ++i) S[i] = 0.f;
    float e2 = 0.f, r2 = 0.f;
    for (int t = 0; t < SEQ; ++t) {
        const size_t row = (size_t)b * SEQ + t;
        if (tid < 384) { const int which = tid >> 7, d = tid & 127; float a = 0.f;
            for (int j = 0; j < 4; ++j) { const int tt = t + j - 3; if (tt >= 0) a += bf2f(c.R1[((size_t)b * SEQ + tt) * NPROJ + PQ + which * 512 + h * 128 + d]) * convw[j * 1536 + which * 512 + h * 128 + d]; }
            (which == 0 ? q : which == 1 ? k : v)[d] = silu_(a); }
        __syncthreads();
        float sq = 0.f, sk = 0.f;
        for (int d = 0; d < 128; ++d) { sq += q[d] * q[d]; sk += k[d] * k[d]; }
        const float fq = rsqrtf(sq + EPS) * 0.08838834764831845f, fk = rsqrtf(sk + EPS);
        const float beta = sigm(c.SG[row * 16 + h]);
        const float g = -expf(c.in[24][L * 4 + h]) * softplus_(c.SG[row * 16 + 4 + h] + c.in[25][L * 4 + h]);
        const float eg = expf(g);
        float ks = 0.f;
#pragma unroll
        for (int i = 0; i < 32; ++i) { S[i] *= eg; ks += k[qt * 32 + i] * fk * S[i]; }
        part[qt * 128 + dv] = ks;
        __syncthreads();
        const float kS = part[dv] + part[128 + dv] + part[256 + dv] + part[384 + dv];
        const float vnew = beta * (v[dv] - kS);
        float qs = 0.f;
#pragma unroll
        for (int i = 0; i < 32; ++i) { S[i] += k[qt * 32 + i] * fk * vnew; qs += q[qt * 32 + i] * fq * S[i]; }
        __syncthreads();
        part[qt * 128 + dv] = qs;
        __syncthreads();
        if (qt == 0) { const float o = part[dv] + part[128 + dv] + part[256 + dv] + part[384 + dv];
            const float got = bf2f(c.Y3[(size_t)1 * MPAD * 512 + row * 512 + h * 128 + dv]); e2 += (got - o) * (got - o); r2 += o * o; }
        __syncthreads();
    }
    blk_reduce2(e2, r2, red, tid);
    if (tid == 0) dg[0] = sqrtf(e2 / (r2 + 1e-30f));
    float e3 = 0.f, r3 = 0.f;
#pragma unroll
    for (int i = 0; i < 32; ++i) { const float got = c.out[O_GDN_P + (((size_t)L * NB + b) * 4 + h) * 16384 + (size_t)(qt * 32 + i) * 128 + dv]; e3 += (got - S[i]) * (got - S[i]); r3 += S[i] * S[i]; }
    blk_reduce2(e3, r3, red, tid);
    if (tid == 0) dg[1] = sqrtf(e3 / (r3 + 1e-30f));
    (void)sc_;
}
DI void chk_ml(const Ctx& c, int L, int b, int h, float* dg) {
    float* q = (float*)c.lds; float* k = q + 64; float* v = k + 64; float* n = v + 128; float* part = n + 64; float* red = part + 512;
    const int tid = c.tid, e = tid & 127, qt = tid >> 7;
    float C[16];
#pragma unroll
    for (int i = 0; i < 16; ++i) C[i] = 0.f;
    if (tid < 64) n[tid] = 0.f;
    float m = 0.f, e2 = 0.f, r2 = 0.f;
    __syncthreads();
    for (int t = 0; t < SEQ; ++t) {
        const size_t row = (size_t)b * SEQ + t;
        if (tid < 64) { q[tid] = bf2f(c.R1[row * NPROJ + PMQ + h * 64 + tid]); k[tid] = bf2f(c.R1[row * NPROJ + PMK + h * 64 + tid]) * 0.125f; }
        else if (tid < 192) v[tid - 64] = bf2f(c.R1[row * NPROJ + PMV + h * 128 + tid - 64]);
        __syncthreads();
        const float li = softcap_(c.SG[row * 16 + 8 + h] + c.in[27][L * 4 + h]);
        const float lf = logsig_(softcap_(c.SG[row * 16 + 12 + h] + c.in[28][L * 4 + h]));
        const float mn = fmaxf(lf + m, li), wts = expf(li - mn), sc = expf(lf + m - mn);
        float qk = 0.f, qn = 0.f;
        for (int d = 0; d < 64; ++d) { qk += q[d] * k[d]; qn += q[d] * n[d]; }
        float pc = 0.f;
#pragma unroll
        for (int i = 0; i < 16; ++i) pc += q[qt * 16 + i] * C[i];
        part[qt * 128 + e] = pc;
        __syncthreads();
        const float qC = part[e] + part[128 + e] + part[256 + e] + part[384 + e];
        const float sqk = qk * wts, num = sqk * v[e] + sc * qC, den = sqk + sc * qn;
        const float hv = num / fmaxf(fabsf(den), expf(-mn));
        if (qt == 0) { const float got = bf2f(c.Y3[(size_t)2 * MPAD * 512 + row * 512 + h * 128 + e]); e2 += (got - hv) * (got - hv); r2 += hv * hv; }
#pragma unroll
        for (int i = 0; i < 16; ++i) C[i] = sc * C[i] + wts * k[qt * 16 + i] * v[e];
        __syncthreads();
        if (tid < 64) n[tid] = sc * n[tid] + wts * k[tid];
        m = mn;
        __syncthreads();
    }
    blk_reduce2(e2, r2, red, tid);
    if (tid == 0) dg[2] = sqrtf(e2 / (r2 + 1e-30f));
    float e3 = 0.f, r3 = 0.f;
#pragma unroll
    for (int i = 0; i < 16; ++i) { const float got = c.out[O_MLC_P + (((size_t)L * NB + b) * 4 + h) * 8192 + (size_t)(qt * 16 + i) * 128 + e]; e3 += (got - C[i]) * (got - C[i]); r3 += C[i] * C[i]; }
    if (tid < 64) { const float got = c.out[O_MLN_P + (((size_t)L * NB + b) * 4 + h) * 64 + tid]; e3 += (got - n[tid]) * (got - n[tid]) * 64.f; r3 += n[tid] * n[tid] * 64.f; }
    if (tid == 0) { const float got = c.out[O_MLM_P + ((size_t)L * NB + b) * 4 + h]; e3 += (got - m) * (got - m) * 4096.f; r3 += m * m * 4096.f; }
    blk_reduce2(e3, r3, red, tid);
    if (tid == 0) dg[3] = sqrtf(e3 / (r3 + 1e-30f));
}
DI void chk_s5(const Ctx& c, int L, int b, int g, float* dg) {
    float* red = (float*)c.lds;
    float e2 = 0.f, r2 = 0.f, e3 = 0.f, r3 = 0.f;
    if (c.tid < 64) { const int lane = c.tid; const S5P P = s5_params(c, L, g, lane);
        const float* Cre = c.in[18] + ((size_t)L * 32 + g) * 16 * 64; const float* Cim = c.in[19] + ((size_t)L * 32 + g) * 16 * 64;
        float hr = 0.f, hi = 0.f;
        for (int t = 0; t < SEQ; ++t) { const size_t row = (size_t)b * SEQ + t; const bf16_t* pr = c.R1 + row * NPROJ + PU + g * 16;
            f32x2 bu = {0.f, 0.f};
#pragma unroll
            for (int cc = 0; cc < 16; ++cc) bu += P.bb[cc] * bf2f(pr[cc]);
            const float nr = P.lr * hr - P.li * hi + bu[0], ni = P.lr * hi + P.li * hr + bu[1]; hr = nr; hi = ni;
            for (int cc = 0; cc < 16; ++cc) { float y = wave_sum(hr * Cre[cc * 64 + lane] - hi * Cim[cc * 64 + lane]) + c.in[20][L * 512 + g * 16 + cc] * bf2f(pr[cc]);
                y = gelu_t(y); const float got = bf2f(c.YS5[row * 512 + g * 16 + cc]); if (lane == 0) { e2 += (got - y) * (got - y); r2 += y * y; } } }
        const size_t si = (((size_t)L * NB + b) * 32 + g) * 64 + lane;
        e3 = (c.out[O_S5RE_P + si] - hr) * (c.out[O_S5RE_P + si] - hr) + (c.out[O_S5IM_P + si] - hi) * (c.out[O_S5IM_P + si] - hi); r3 = hr * hr + hi * hi; }
    blk_reduce2(e2, r2, red, c.tid);
    blk_reduce2(e3, r3, red, c.tid);
    if (c.tid == 0) { dg[4] = sqrtf(e2 / (r2 + 1e-30f)); dg[5] = sqrtf(e3 / (r3 + 1e-30f)); }
}
#endif


#ifdef SELFCHK
DI float dot_bf(const bf16_t* a, const bf16_t* b, int K) { float s = 0.f; for (int k = 0; k < K; ++k) s += bf2f(a[k]) * bf2f(b[k]); return s; }
DI void chk_gemm(const Ctx& c, int L, int mode, float* dgp) {
    float* red = (float*)c.lds;
    float e2 = 0.f, r2 = 0.f;
    for (int rep = 0; rep < 2; ++rep) {
        const int sidx = c.tid + 512 * rep;
        const int row = (rep == 1 && c.tid < 64) ? MP + (c.tid * 2) : (int)(((unsigned)sidx * 7919u) % (unsigned)MP);
        float want = 0.f, got = 0.f;
        if (mode == 0) { const int col = (int)(((unsigned)sidx * 104729u) % 4096u); want = dot_bf(c.XN + (size_t)row * 1024, c.W + WO_IN + (size_t)col * 1024, 1024); got = bf2f(c.R1[(size_t)row * 4096 + col]); }
        if (mode == 1) { const int col = (int)(((unsigned)sidx * 104729u) % 3072u); want = sigm(dot_bf(c.XN + (size_t)row * 1024, c.W + WO_G + (size_t)col * 1024, 1024)); got = bf2f(c.R1[(size_t)row * 4096 + col]); }
        if (mode == 2) { const int col = (int)(((unsigned)sidx * 104729u) % 512u); const float y = bf2f(c.YS5[(size_t)row * 512 + col]);
            want = y * sigm(dot_bf(c.YS5 + (size_t)row * 512, c.W + WO_GLU + (size_t)col * 512, 512) + c.in[22][L * 512 + col]); got = bf2f(c.Y3[(size_t)row * 512 + col]); }
        if (mode == 3) { const int col = (int)(((unsigned)sidx * 104729u) % 1024u);
            for (int br = 0; br < 3; ++br) want += bf2f(c.R1[(size_t)row * 4096 + br * 1024 + col]) * dot_bf(c.Y3 + (size_t)br * MPAD * 512 + (size_t)row * 512, c.W + WO_BR + (size_t)br * 1024 * 512 + (size_t)col * 512, 512);
            got = bf2f(c.XN[(size_t)row * 1024 + col]); }
        if (mode == 4) { const int col = (int)(((unsigned)sidx * 104729u) % 4096u); const float d = fmaxf(dot_bf(c.XN + (size_t)row * 1024, c.W + WO_UP + (size_t)col * 1024, 1024), 0.f); want = d * d; got = bf2f(c.R1[(size_t)row * 4096 + col]); }
        if (mode == 5) { const int col = (int)(((unsigned)sidx * 104729u) % 1024u); want = dot_bf(c.Y3 + (size_t)row * 256, c.W + WO_PLE + (size_t)col * 256, 256); got = bf2f(c.Y3[(size_t)MPAD * 256 + (size_t)row * 1024 + col]); }
        e2 += (got - want) * (got - want); r2 += want * want;
    }
    blk_reduce2(e2, r2, red, c.tid);
    if (c.tid == 0) *dgp = sqrtf(e2 / (r2 + 1e-30f));
}
#endif

#ifdef SELFCHK
DI void chk_sg(const Ctx& c, float* dgp) {
    float* red = (float*)c.lds; float e2 = 0.f, r2 = 0.f;
    { const int sidx = c.tid >> 4, s = c.tid & 15; const int row = (sidx < 8) ? MP + sidx * 13 : (int)(((unsigned)sidx * 7919u * 37u) % (unsigned)MP);
      const float* x = row < MP ? c.in[0] + (size_t)row * 1024 : c.in[1] + (size_t)(row - MP) * 1024;
      const int sc = s < 4 ? 2560 + s : s < 8 ? 2564 + (s - 4) : s < 12 ? 4104 + (s - 8) : 4108 + (s - 12);
      float ss = 0.f; for (int k = 0; k < 1024; ++k) ss += x[k] * x[k];
      const float rs = rsqrtf(ss * (1.f / 1024.f) + EPS); float a = 0.f;
      for (int k = 0; k < 1024; ++k) a += x[k] * rs * c.in[11][k] * c.in[12][(size_t)k * DIN + sc];
      const float got = c.SG[(size_t)row * 16 + s]; e2 = (got - a) * (got - a); r2 = a * a; }
    blk_reduce2(e2, r2, red, c.tid);
    if (c.tid == 0) *dgp = sqrtf(e2 / (r2 + 1e-30f));
}
DI void chk_post(const Ctx& c, int L, float* dgp) {
    float* red = (float*)c.lds; float e2 = 0.f, r2 = 0.f;
    { const int hd8 = c.tid & 7, sidx = c.tid >> 3; const int row = (sidx < 8) ? MP + sidx * 11 : (int)(((unsigned)sidx * 7919u * 53u) % (unsigned)MP);
      const int br = hd8 >> 2, hd = hd8 & 3; float ms = 0.f;
      for (int e = 0; e < 128; ++e) { const float y = bf2f(c.Y3[(size_t)(1 + br) * MPAD * 512 + (size_t)row * 512 + hd * 128 + e]);
          const float z = bf2f(c.R1[(size_t)row * NPROJ + (br == 0 ? PZ : PMO) + hd * 128 + e]);
          const float gn = br == 0 ? c.in[26][L * 128 + e] : c.in[29][L * 512 + hd * 128 + e];
          const float w = y / (gn * (br == 0 ? silu_(z) : sigm(z))); ms += w * w; }
      ms *= (1.f / 128.f); e2 = (ms - 1.f) * (ms - 1.f); r2 = 1.f; }
    blk_reduce2(e2, r2, red, c.tid);
    if (c.tid == 0) *dgp = sqrtf(e2 / (r2 + 1e-30f));
}
DI void chk_res(const Ctx& c, int L, int mode, const float (&snap)[2], float* dgp) {
    float* red = (float*)c.lds; float e2 = 0.f, r2 = 0.f;
    for (int rep = 0; rep < 2; ++rep) { const int sidx = c.tid + 512 * rep;
        const int row = (rep == 1 && c.tid < 64) ? MP + (c.tid * 2) : (int)(((unsigned)sidx * 7919u) % (unsigned)MP); const int col = (int)(((unsigned)sidx * 104729u) % 1024u);
        const float now = c.out[(size_t)row * 1024 + col]; float before = snap[rep], want = 0.f;
        if (mode == 0) { before = row < MP ? c.in[0][(size_t)row * 1024 + col] : c.in[1][(size_t)(row - MP) * 1024 + col]; want = dot_bf(c.XN + (size_t)row * 1024, c.W + WO_OUT + (size_t)col * 1024, 1024); }
        if (mode == 1) want = dot_bf(c.R1 + (size_t)row * 4096, c.W + WO_DN + (size_t)col * 4096, 4096);
        if (mode == 2) want = bf2f(c.Y3[(size_t)MPAD * 256 + (size_t)row * 1024 + col]) * sigm(dot_bf(c.XN + (size_t)row * 1024, c.W + WO_PG + (size_t)col * 1024, 1024));
        e2 += (now - before - want) * (now - before - want); r2 += want * want; }
    blk_reduce2(e2, r2, red, c.tid);
    if (c.tid == 0) *dgp = sqrtf(e2 / (r2 + 1e-30f));
}
DI void snap_x(const Ctx& c, float (&snap)[2]) {
    for (int rep = 0; rep < 2; ++rep) { const int sidx = c.tid + 512 * rep;
        const int row = (rep == 1 && c.tid < 64) ? MP + (c.tid * 2) : (int)(((unsigned)sidx * 7919u) % (unsigned)MP); const int col = (int)(((unsigned)sidx * 104729u) % 1024u);
        snap[rep] = c.out[(size_t)row * 1024 + col]; }
}
DI void chk_sample(const Ctx& c, int L, int b, int h, float* dgp) {
    float* red = (float*)c.lds; float e2 = 0.f, r2 = 0.f, e3 = 0.f, r3 = 0.f;
    const size_t row = (size_t)(MP + b); const bf16_t* pr = c.R1 + row * NPROJ;
    if (c.tid < 128) { const int dv = c.tid;
        const float* cbuf = c.in[4] + ((size_t)L * MS + b) * 3 * 1536; const float* cw = c.in[23] + (size_t)L * 4 * 1536;
        float sq = 0.f, sk = 0.f;
        for (int d = 0; d < 128; ++d) for (int w = 0; w < 2; ++w) { const int cc = w * 512 + h * 128 + d;
            const float a = silu_(cbuf[cc] * cw[cc] + cbuf[1536 + cc] * cw[1536 + cc] + cbuf[3072 + cc] * cw[3072 + cc] + bf2f(pr[PQ + cc]) * cw[4608 + cc]); if (w == 0) sq += a * a; else sk += a * a; }
        const float fq = rsqrtf(sq + EPS) * 0.08838834764831845f, fk = rsqrtf(sk + EPS);
        const int cv = 1024 + h * 128 + dv;
        const float vv = silu_(cbuf[cv] * cw[cv] + cbuf[1536 + cv] * cw[1536 + cv] + cbuf[3072 + cv] * cw[3072 + cv] + bf2f(pr[PQ + cv]) * cw[4608 + cv]);
        const float beta = sigm(c.SG[row * 16 + h]), eg = expf(-expf(c.in[24][L * 4 + h]) * softplus_(c.SG[row * 16 + 4 + h] + c.in[25][L * 4 + h]));
        const float* S0 = c.in[5] + (((size_t)L * MS + b) * 4 + h) * 16384; const float* S1 = c.out + O_GDN_S + (((size_t)L * MS + b) * 4 + h) * 16384;
        float kS = 0.f, qS = 0.f, qk = 0.f;
        for (int d = 0; d < 128; ++d) { const int cq = h * 128 + d, ck = 512 + h * 128 + d;
            const float qd = silu_(cbuf[cq] * cw[cq] + cbuf[1536 + cq] * cw[1536 + cq] + cbuf[3072 + cq] * cw[3072 + cq] + bf2f(pr[PQ + cq]) * cw[4608 + cq]) * fq;
            const float kd = silu_(cbuf[ck] * cw[ck] + cbuf[1536 + ck] * cw[1536 + ck] + cbuf[3072 + ck] * cw[3072 + ck] + bf2f(pr[PQ + ck]) * cw[4608 + ck]) * fk;
            kS += kd * S0[d * 128 + dv]; qS += qd * S0[d * 128 + dv]; qk += qd * kd; }
        const float vnew = beta * (vv - eg * kS);
        for (int d = 0; d < 128; ++d) { const int ck = 512 + h * 128 + d;
            const float kd = silu_(cbuf[ck] * cw[ck] + cbuf[1536 + ck] * cw[1536 + ck] + cbuf[3072 + ck] * cw[3072 + ck] + bf2f(pr[PQ + ck]) * cw[4608 + ck]) * fk;
            const float want = S0[d * 128 + dv] * eg + kd * vnew, got = S1[d * 128 + dv]; e2 += (got - want) * (got - want); r2 += want * want; }
        (void)qS; (void)qk;
    } else if (c.tid < 256) { const int e = c.tid - 128;
        const size_t sidx = ((size_t)L * MS + b) * 4 + h;
        const float li = softcap_(c.SG[row * 16 + 8 + h] + c.in[27][L * 4 + h]), lf = logsig_(softcap_(c.SG[row * 16 + 12 + h] + c.in[28][L * 4 + h]));
        const float m0 = c.in[8][sidx], mt = fmaxf(lf + m0, li), wts = expf(li - mt), sc = expf(lf + m0 - mt);
        const float v = bf2f(pr[PMV + h * 128 + e]);
        for (int d = 0; d < 64; ++d) { const float k = bf2f(pr[PMK + h * 64 + d]) * 0.125f;
            const float want = sc * c.in[6][sidx * 8192 + d * 128 + e] + wts * k * v, got = c.out[O_MLC_S + sidx * 8192 + d * 128 + e]; e3 += (got - want) * (got - want); r3 += want * want; }
        if (e < 64) { const float k = bf2f(pr[PMK + h * 64 + e]) * 0.125f; const float want = sc * c.in[7][sidx * 64 + e] + wts * k, got = c.out[O_MLN_S + sidx * 64 + e]; e3 += 64.f * (got - want) * (got - want); r3 += 64.f * want * want; }
        if (e == 0) { const float got = c.out[O_MLM_S + sidx]; e3 += 4096.f * (got - mt) * (got - mt); r3 += 4096.f * mt * mt; }
    }
    blk_reduce2(e2, r2, red, c.tid);
    blk_reduce2(e3, r3, red, c.tid);
    if (c.tid == 0) { dgp[0] = sqrtf(e2 / (r2 + 1e-30f)); dgp[1] = sqrtf(e3 / (r3 + 1e-30f)); }
}
#endif
DI void phase_conv_state(const Ctx& c, int L) {
    for (int idx = c.bid * 512 + c.tid; idx < NB * 3 * 1536; idx += c.G * 512) { const int cc = idx % 1536, j = (idx / 1536) % 3, b = idx / (3 * 1536);
        c.out[O_CONV_P + ((size_t)L * NB + b) * 3 * 1536 + j * 1536 + cc] = bf2f(c.R1[(size_t)(b * SEQ + SEQ - 3 + j) * NPROJ + PQ + cc]); }
}
DI void phase_post(const Ctx& c, int L) {
    const int lane = c.lane, hd = lane >> 4, e0 = (lane & 15) * 8;
    bf16_t* yg = c.Y3 + (size_t)1 * MPAD * 512; bf16_t* ym = c.Y3 + (size_t)2 * MPAD * 512;
    const float* gg = c.in[26] + (size_t)L * 128 + e0; const float* gm = c.in[29] + (size_t)L * 512 + hd * 128 + e0;
    for (int row = c.bid * 8 + c.wave; row < MR; row += c.G * 8) {
        const bf16_t* pr = c.R1 + (size_t)row * NPROJ;
#pragma unroll
        for (int br = 0; br < 2; ++br) {
            bf16_t* yp = (br == 0 ? yg : ym) + (size_t)row * 512 + hd * 128 + e0;
            f32x8 o = unpack8(*(const bf16x8*)yp); const f32x8 z = unpack8(*(const bf16x8*)(pr + (br == 0 ? PZ : PMO) + hd * 128 + e0));
            float ss = 0.f;
#pragma unroll
            for (int e = 0; e < 8; ++e) ss += o[e] * o[e];
            ss += __shfl_xor(ss, 1); ss += __shfl_xor(ss, 2); ss += __shfl_xor(ss, 4); ss += __shfl_xor(ss, 8);
            const float rs = rsqrtf(ss * (1.f / 128.f) + EPS);
            const float* gp = br == 0 ? gg : gm;
#pragma unroll
            for (int e = 0; e < 8; ++e) o[e] = o[e] * rs * gp[e] * (br == 0 ? silu_(z[e]) : sigm(z[e]));
            *(bf16x8*)yp = pack8v(o);
        }
    }
}

DI void phase_cvt_ple(const Ctx& c, int L) {
    bf16_t* PB = c.Y3;
    for (size_t i = (size_t)c.bid * 512 + c.tid; i < (size_t)MR * 64; i += (size_t)c.G * 512) {
        const size_t row = i >> 6, c4 = (i & 63) * 4;
        const float* src = row < MP ? c.in[9] + ((size_t)L * MP + row) * 256 + c4 : c.in[10] + ((size_t)L * MS + (row - MP)) * 256 + c4;
        *(s16x4*)(PB + row * 256 + c4) = pack4v(*(const f32x4*)src); }
}
DI void phase_final_norm(const Ctx& c) {
    const float* gain = c.in[39];
    for (int row = c.bid * 8 + c.wave; row < MR; row += c.G * 8) {
        float* xp = c.out + (size_t)row * 1024; f32x4 x[4]; float ss = 0.f;
#pragma unroll
        for (int i = 0; i < 4; ++i) { x[i] = *(const f32x4*)(xp + c.lane * 4 + 256 * i); ss += x[i][0] * x[i][0] + x[i][1] * x[i][1] + x[i][2] * x[i][2] + x[i][3] * x[i][3]; }
        ss = wave_sum(ss); const float rs = rsqrtf(ss * (1.f / 1024.f) + EPS);
#pragma unroll
        for (int i = 0; i < 4; ++i) { const f32x4 g = *(const f32x4*)(gain + c.lane * 4 + 256 * i); *(f32x4*)(xp + c.lane * 4 + 256 * i) = x[i] * rs * g; }
    }
}

#define XB_TMO      128
#define XB_XCNT(j)  (256  + 64 * (j))
#define XB_XSUB(j)  (1280 + 64 * (j))
#define XB_XGEN(j)  (2304 + 64 * (j))
#define XB_TOP      3328
#define XB_TOPGEN   3392
#define XCD_BAR_WORDS 3456
#define XB_SPIN_CAP (1u << 18)

__device__ __forceinline__ unsigned xb_ld(unsigned* p)              { return __hip_atomic_load(p, __ATOMIC_RELAXED, __HIP_MEMORY_SCOPE_AGENT); }
__device__ __forceinline__ unsigned xb_add(unsigned* p, unsigned v) { return __hip_atomic_fetch_add(p, v, __ATOMIC_RELAXED, __HIP_MEMORY_SCOPE_AGENT); }
__device__ __forceinline__ unsigned xb_xcc_id() { return (unsigned)__builtin_amdgcn_s_getreg((3 << 11) | 20) & 0xFu; }
#define XB_SPIN(cond, bar) do { unsigned _sp = 0; while (cond) { __builtin_amdgcn_s_sleep(1); \
    if ((++_sp & 255u) == 0u) { if (xb_ld(&(bar)[XB_TMO])) break; if (_sp > XB_SPIN_CAP) { atomicAdd(&(bar)[XB_TMO], 1u); break; } } } } while (0)

struct XcdBarrier {
    unsigned* bar; unsigned x;
    volatile LAS unsigned* st;
};

__device__ __forceinline__ XcdBarrier xcd_barrier_post(unsigned* bar, volatile LAS unsigned* st) {
    XcdBarrier b; b.bar = bar; b.x = xb_xcc_id(); b.st = st;
    if (threadIdx.x == 0) (void)xb_add(&bar[XB_XCNT(b.x)], 1u);
    return b;
}
__device__ __forceinline__ void xcd_barrier_complete(unsigned* bar, unsigned x, unsigned& nloc, unsigned& nx) {
    const unsigned G = gridDim.x * gridDim.y * gridDim.z;
    unsigned sum, cnt, mine, sp = 0u;
    for (;;) {
        sum = 0u; cnt = 0u; mine = 0u;
#pragma unroll
        for (unsigned j = 0; j < 16; ++j) { const unsigned c = xb_ld(&bar[XB_XCNT(j)]); sum += c; cnt += (c > 0u) ? 1u : 0u; mine = (j == x) ? c : mine; }
        if (sum == G) break;
        __builtin_amdgcn_s_sleep(1);
        if ((++sp & 255u) == 0u) { if (xb_ld(&bar[XB_TMO])) break; if (sp > XB_SPIN_CAP) { atomicAdd(&bar[XB_TMO], 1u); break; } }
    }
    nloc = mine > 0u ? mine : 1u; nx = cnt > 0u ? cnt : 1u;
}

__device__ __forceinline__ void xcd_barrier(const XcdBarrier& b) {
    asm volatile("s_waitcnt vmcnt(0)" ::: "memory");
    __syncthreads();
    if (threadIdx.x == 0) {
        unsigned* bar = b.bar;
        __builtin_amdgcn_s_waitcnt(0);
        unsigned nloc = b.st[0], nx = b.st[1];
        if (nloc == 0u) { xcd_barrier_complete(bar, b.x, nloc, nx); b.st[0] = nloc; b.st[1] = nx; }
        const unsigned old = xb_add(&bar[XB_XSUB(b.x)], 1u);
        const unsigned gen = old / nloc;
        if (old + 1u == (gen + 1u) * nloc) {
            __builtin_amdgcn_fence(__ATOMIC_RELEASE, "agent");
            asm volatile("s_waitcnt vmcnt(0)" ::: "memory");
            const unsigned og = xb_add(&bar[XB_TOP], 1u);
            const unsigned tg = og / nx;
            if (og + 1u == (tg + 1u) * nx) xb_add(&bar[XB_TOPGEN], 1u);
            else XB_SPIN(xb_ld(&bar[XB_TOPGEN]) == tg, bar);
            __builtin_amdgcn_fence(__ATOMIC_ACQUIRE, "agent");
            xb_add(&bar[XB_XGEN(b.x)], 1u);
            asm volatile("s_waitcnt vmcnt(0)" ::: "memory");
        } else {
            XB_SPIN(xb_ld(&bar[XB_XGEN(b.x)]) == gen, bar);
            __builtin_amdgcn_fence(__ATOMIC_ACQUIRE, "agent");
            asm volatile("s_waitcnt vmcnt(0)" ::: "memory");
        }
    }
    __syncthreads();
}

__global__ void __launch_bounds__(512, 2) fwd_megakernel(KP kp) {
    extern __shared__ __attribute__((aligned(16))) unsigned char lds[];
    cg::grid_group grid = cg::this_grid();
    Ctx c; c.lds = lds; c.G = gridDim.x; c.bid = blockIdx.x;
    const ka_t ka0 = (ka_t)__builtin_amdgcn_kernarg_segment_ptr();
    (void)kp;
#define REFRESH() do { ka_t ka_ = ka0; asm volatile("" : "+s"(ka_)); int t_ = threadIdx.x; asm volatile("" : "+v"(t_)); \
        c.in.ka = ka_; c.out = (float*)(gfloat_t*)ka_[40]; unsigned char* w_ = (unsigned char*)(guchar_t*)ka_[41]; c.ws = w_; \
        c.R1 = (bf16_t*)(w_ + WS_R1); c.XN = (bf16_t*)(w_ + WS_XN); c.Y3 = (bf16_t*)(w_ + WS_Y3); c.W = (bf16_t*)(w_ + WS_W); c.YS5 = (bf16_t*)(w_ + WS_YS5); \
        c.GS = w_ + WS_GS; c.SG = (float*)(w_ + WS_SG); c.GL = (float*)(w_ + WS_GL); \
        c.tid = t_; c.lane = t_ & 63; c.wave = __builtin_amdgcn_readfirstlane(t_ >> 6); \
        int b_ = blockIdx.x, g_ = gridDim.x; asm volatile("" : "+s"(b_), "+s"(g_)); c.bid = b_; c.G = g_; } while (0)
    REFRESH();
    volatile LAS unsigned* bst = (volatile LAS unsigned*)(lds + LDS_BYTES - 16);
    if (c.tid < 4) bst[c.tid] = 0u;
    if (c.tid < 16) ((volatile LAS int*)(lds + S5Q_FLAG))[c.tid] = 0;
    __syncthreads();
    XcdBarrier xbar = xcd_barrier_post((unsigned*)(c.ws + WS_BAR), bst);
    int nsync_ = 0;
#ifndef PHMASK
#define PHMASK 0xFFFFFFFFu
#endif
#define PH(n) if (PHMASK & (1 << (n)))
#ifdef DUP_SYNC
#define GSYNC() do { grid.sync(); grid.sync(); } while (0)
#else
#define GSYNC() do { if (nsync_++ == 0) grid.sync(); else xcd_barrier(xbar); } while (0)
#endif
    for (int L = 0; L < 2; ++L) {
        REFRESH(); PH(0) phase_weights(c, L);
        REFRESH(); PH(1) phase_rmsnorm<0>(c, L);
        GSYNC();
        REFRESH(); PH(2) run_gemm(c, c.XN, c.W + WO_IN, NPROJ, 1024, FStore{c.R1, NPROJ});
#ifdef DUP_GEMM
        REFRESH(); PH(2) run_gemm(c, c.XN, c.W + WO_IN, NPROJ, 1024, FStore{c.R1, NPROJ});
#endif
        GSYNC();
#ifdef DUP_MIX
        for (int rep_ = 0; rep_ < 2; ++rep_) {
#else
        {
#endif
        REFRESH(); phase_conv_state(c, L);
        REFRESH(); for (int it = c.bid * 8 + c.wave; it < 1024; it += c.G * 8) task_ml_gates(c, L, it);
        REFRESH(); PH(3) phase_gdn_prep(c, L);
#ifdef DUP_PREP
        REFRESH(); PH(3) phase_gdn_prep(c, L);
#endif
#ifdef DUP_S5
#endif
        GSYNC();
#ifdef DUP_P4
        for (int rep4_ = 0; rep4_ < 2; ++rep4_) {
#else
        {
#endif
        if (c.wave == 0) {
            for (int u = c.bid; u < 256; u += c.G) { REFRESH(); if (u < 128) { PH(5) task_gdn_seq(c, L, u);
#ifdef DUP_GSEQ
                REFRESH(); task_gdn_seq(c, L, u);
#endif
              } else { PH(6) task_ml_seq(c, L, u - 128, (float*)lds);
#ifdef DUP_MSEQ
                REFRESH(); task_ml_seq(c, L, u - 128, (float*)lds);
#endif
              } }
        } else if (c.wave <= 4) {
            int it_ = 0;
            for (int u = c.bid; u < 256; u += c.G, ++it_) { REFRESH(); PH(4) task_s5_quad(c, L, u, c.wave - 1, L * 16 + it_ + 1); }
        } else {
            const int wid = c.bid * 3 + (c.wave - 5), nw = c.G * 3;
            REFRESH(); PH(7) for (int u = wid; u < 2048; u += nw) task_gdn_sample(c, L, u);
            REFRESH(); PH(8) for (int u = wid; u < 1024; u += nw) task_ml_sample(c, L, u);
            REFRESH(); PH(9) for (int u = wid; u < 4096; u += nw) task_s5_sample(c, L, u);
        }
        GSYNC();
        }
        }
#ifdef SELFCHK
        if (L == SELFCHK_L) { REFRESH(); if (c.bid == 0) { float* dg = (float*)(c.ws + WS_GL) + 1024; chk_gdn(c, L, 1, 2, dg); chk_ml(c, L, 1, 2, dg); chk_s5(c, L, 1, 7, dg); chk_gemm(c, L, 0, dg + 6); if (L == 0) chk_sg(c, dg + 12); chk_sample(c, L, 5, 1, dg + 17); } grid.sync(); }
#endif
        REFRESH(); PH(10) phase_post(c, L);
        REFRESH(); PH(11) run_gemm(c, c.XN, c.W + WO_G, NGATE, 1024, FSig{c.R1, NPROJ});
#ifdef DUP_GEMM
        REFRESH(); PH(11) run_gemm(c, c.XN, c.W + WO_G, NGATE, 1024, FSig{c.R1, NPROJ});
#endif
        REFRESH(); PH(12) run_gemm(c, c.YS5, c.W + WO_GLU, 512, 512, FGlu{c.YS5, c.in[22] + (size_t)L * 512, c.Y3});
#ifdef DUP_GEMM
        REFRESH(); PH(12) run_gemm(c, c.YS5, c.W + WO_GLU, 512, 512, FGlu{c.YS5, c.in[22] + (size_t)L * 512, c.Y3});
#endif
        GSYNC();
#ifdef SELFCHK
        if (L == SELFCHK_L) { REFRESH(); if (c.bid == 0) { float* dg = (float*)(c.ws + WS_GL) + 1024; chk_gemm(c, L, 1, dg + 7); chk_gemm(c, L, 2, dg + 8); chk_post(c, L, dg + 13); } grid.sync(); }
#endif
        REFRESH(); PH(13) for (int br = 0; br < 3; ++br)
            run_gemm(c, c.Y3 + (size_t)br * MPAD * 512, c.W + WO_BR + (size_t)br * 1024 * 512, 1024, 512, FBranch{c.R1 + br * 1024, c.XN, br == 0 ? 1 : 0});
#ifdef DUP_GEMM
        REFRESH(); PH(13) for (int br = 0; br < 3; ++br)
            run_gemm(c, c.Y3 + (size_t)br * MPAD * 512, c.W + WO_BR + (size_t)br * 1024 * 512, 1024, 512, FBranch{c.R1 + br * 1024, c.XN, br == 0 ? 1 : 0});
#endif
        GSYNC();
#ifdef SELFCHK
        if (L == SELFCHK_L) { REFRESH(); if (c.bid == 0) { float* dg = (float*)(c.ws + WS_GL) + 1024; chk_gemm(c, L, 3, dg + 9); } grid.sync(); }
#endif
        REFRESH(); PH(14) run_gemm(c, c.XN, c.W + WO_OUT, 1024, 1024, FRes{c.out});
        GSYNC();
#ifdef SELFCHK
        if (L == 0 && SELFCHK_L == 0) { REFRESH(); if (c.bid == 0) { float* dg = (float*)(c.ws + WS_GL) + 1024; float sn[2] = {0.f, 0.f}; chk_res(c, L, 0, sn, dg + 14); } grid.sync(); }
#endif
        REFRESH(); PH(15) phase_rmsnorm<1>(c, L);
        REFRESH(); PH(18) phase_cvt_ple(c, L);
        GSYNC();
        REFRESH(); PH(16) run_gemm(c, c.XN, c.W + WO_UP, DFF, 1024, FRelu2{c.R1});
#ifdef DUP_GEMM
        REFRESH(); PH(16) run_gemm(c, c.XN, c.W + WO_UP, DFF, 1024, FRelu2{c.R1});
#endif
        GSYNC();
#ifdef SELFCHK
        if (L == SELFCHK_L) { REFRESH(); if (c.bid == 0) { float* dg = (float*)(c.ws + WS_GL) + 1024; chk_gemm(c, L, 4, dg + 10); } grid.sync(); }
#endif
#ifdef SELFCHK
        float snp[2] = {0.f, 0.f}; REFRESH(); if (L == SELFCHK_L && c.bid == 0) snap_x(c, snp);
#endif
        REFRESH(); PH(17) run_gemm(c, c.R1, c.W + WO_DN, 1024, 4096, FResB{c.out, c.XN});
        GSYNC();
#ifdef SELFCHK
        if (L == SELFCHK_L) { REFRESH(); if (c.bid == 0) { float* dg = (float*)(c.ws + WS_GL) + 1024; chk_res(c, L, 1, snp, dg + 15); } grid.sync(); }
#endif
#ifdef SELFCHK
        REFRESH(); if (L == SELFCHK_L && c.bid == 0) snap_x(c, snp);
#endif
        REFRESH(); PH(19) run_gemm(c, c.Y3, c.W + WO_PLE, 1024, 256, FStore{c.Y3 + (size_t)MPAD * 256, 1024});
#ifdef DUP_GEMM
        REFRESH(); PH(19) run_gemm(c, c.Y3, c.W + WO_PLE, 1024, 256, FStore{c.Y3 + (size_t)MPAD * 256, 1024});
#endif
        REFRESH(); PH(20) run_gemm(c, c.XN, c.W + WO_PG, 1024, 1024, FPle{c.Y3 + (size_t)MPAD * 256, c.out});
        GSYNC();
#ifdef SELFCHK
        if (L == SELFCHK_L) { REFRESH(); if (c.bid == 0) { float* dg = (float*)(c.ws + WS_GL) + 1024; chk_gemm(c, L, 5, dg + 11); chk_res(c, L, 2, snp, dg + 16); } grid.sync(); }
#endif
    }
    REFRESH(); phase_final_norm(c);
#ifdef SELFCHK
    grid.sync(); REFRESH();
    if (c.bid == 0 && c.tid == 0) { const float* dg = (const float*)(c.ws + WS_GL) + 1024; int kk = -1; float dv = 0.f;
        for (int i = 18; i >= 0; --i) if (dg[i] > SELFCHK_THR) { kk = i; dv = dg[i]; }
        if (kk >= 0) c.out[0] = __powf(10.f, (float)(2 * kk + 4)) * (1.f + fminf(dv, 8.f)); }
#endif
}

extern "C" void kernel_launch(void* const* d_in, const int* in_sizes, int n_in, void* d_out, int out_size, void* d_ws, size_t ws_size, hipStream_t stream) {
    static int grid = 0;
    if (grid == 0) {
        int dev = 0, cus = 0, per_cu = 0;
        if (hipGetDevice(&dev) != hipSuccess || hipDeviceGetAttribute(&cus, hipDeviceAttributeMultiprocessorCount, dev) != hipSuccess) { fprintf(stderr, "kernel_launch: device query failed\n"); grid = -1; return; }
        if (hipFuncSetAttribute((const void*)fwd_megakernel, hipFuncAttributeMaxDynamicSharedMemorySize, LDS_BYTES) != hipSuccess) { fprintf(stderr, "kernel_launch: hipFuncSetAttribute failed\n"); grid = -1; return; }
        if (hipOccupancyMaxActiveBlocksPerMultiprocessor(&per_cu, (const void*)fwd_megakernel, 512, LDS_BYTES) != hipSuccess || per_cu < 1) { fprintf(stderr, "kernel_launch: occupancy query says %d blocks per CU\n", per_cu); grid = -1; return; }
        grid = cus;
        if (grid > 256) grid = 256;
    }
    if (grid < 0) return;
    if (n_in != 40 || (size_t)out_size != O_TOTAL || ws_size < WS_END) { fprintf(stderr, "kernel_launch: unexpected sizes n_in %d out %d ws %zu (need %zu)\n", n_in, out_size, ws_size, (size_t)WS_END); return; }
    if (hipMemsetAsync((char*)d_ws + WS_BAR, 0, SZ_BAR, stream) != hipSuccess) { fprintf(stderr, "kernel_launch: memset failed\n"); return; }
    KP kp{};
    for (int i = 0; i < 40; ++i) kp.in[i] = (const float*)d_in[i];
    kp.out = (float*)d_out; kp.ws = (unsigned char*)d_ws;
    void* args[] = {&kp};
    hipError_t e = hipLaunchCooperativeKernel((const void*)fwd_megakernel, dim3(grid), dim3(512), args, LDS_BYTES, stream);
    if (e != hipSuccess) fprintf(stderr, "kernel_launch: cooperative launch failed: %s (grid %d)\n", hipGetErrorString(e), grid);
}
```

```cpp
#include <hip/hip_runtime.h>
#include <hip/hip_cooperative_groups.h>
#include <cstdio>
namespace cg = cooperative_groups;
namespace pg8 {
#define PG8_LAS __attribute__((address_space(3)))
typedef unsigned short bf16_t;
typedef short bf16x8 __attribute__((ext_vector_type(8)));
typedef float f32x4 __attribute__((ext_vector_type(4)));
typedef unsigned u32x4 __attribute__((ext_vector_type(4)));
constexpr int BM = 256, BK = 64, HALF = 128, HTB = HALF * BK * 2  , STAGE_BYTES = 8 * HTB, NXCD = 8, WGM = 8;

__host__ __device__ __forceinline__ int lds_byte(int r, int c) { const int st = (r >> 4) * 2 + (c >> 5), rr = r & 15, cc = c & 31, ob = rr * 64 + cc * 2; return st * 1024 + (ob ^ (((ob >> 9) & 1) << 5)); }
__host__ __device__ __forceinline__ void stage_rc(int b, int& R, int& C) { const int st = b / 1024, sb = b % 1024, swz = sb ^ (((sb >> 9) & 1) << 5); R = (st >> 1) * 16 + swz / 64; C = (st & 1) * 32 + (swz % 64) / 2; }
__host__ __device__ __forceinline__ int perm32(int rho) { const int n = rho >> 4, i = rho & 15; return 8 * (i >> 2) + 4 * n + (i & 3); }

struct Unit { int pm, pn; };
struct Gemm { const bf16_t* A; const bf16_t* Bt; int M, N, K; };

struct StaticOrder {
    int nM, nN, nwg, G, c;
    __host__ __device__ void init(int M, int N, int G_, int c_) { nM = M / BM; nN = N / BM; nwg = nM * nN; G = G_; c = c_; }
    __host__ __device__ bool next(int i, Unit& u) const {
        const long L = (long)i * G + c; if (L >= nwg) return false;
        int wgid = (int)L; { const int q = nwg / NXCD, r = nwg % NXCD, xcd = wgid % NXCD, off = wgid / NXCD; wgid = (xcd < r ? xcd * (q + 1) : r * (q + 1) + (xcd - r) * q) + off; }
        const int nig = WGM * nN, gid = wgid / nig, fm = gid * WGM, gsz = (nM - fm) < WGM ? (nM - fm) : WGM;
        u.pm = fm + ((wgid % nig) % gsz); u.pn = (wgid % nig) / gsz; return true;
    }
    __device__ __forceinline__ void a_ready(const Unit&) const {}
    __device__ __forceinline__ void done(const Unit&) const {}
};

template <class Epi, class Sched, bool STAMP = false>
__device__ __forceinline__ void gemm_phase(PG8_LAS unsigned char* lds, const Gemm g, const Sched& S, const Epi& E, unsigned long long* stamps) {
    int tid_ = threadIdx.x; asm volatile("" : "+v"(tid_));
    const int tid = tid_, wid = __builtin_amdgcn_readfirstlane(tid >> 6), lane = tid & 63, wr = wid >> 2, wc = wid & 3, fr = lane & 15, fq = lane >> 4;
    const int K = g.K, nt = K / BK;
    unsigned voffA[2], voffB[2];
#pragma unroll
    for (int i = 0; i < 2; ++i) { int R, C; stage_rc(tid * 16 + i * 8192, R, C); const int Rb = Epi::PERM ? ((R & ~31) + perm32(R & 31)) : R;
        voffA[i] = (unsigned)(R * K + C) * 2u; voffB[i] = (unsigned)(Rb * K + C) * 2u; }
    const size_t kstep = (size_t)(BK * 2);
    const size_t hstep = (size_t)HALF * K * 2;
    const size_t tstep = 2 * hstep;
    const unsigned ldsw = (unsigned)wid * 1024u;
    const int aoff = lds_byte(wr * 64 + fr, fq * 8), boff = lds_byte(wc * 32 + fr, fq * 8);
#define PG8_SA(b, h) (((b) * 2 + (h)) * HTB)
#define PG8_SB(b, h) ((4 + (b) * 2 + (h)) * HTB)
#define PG8_STAGE(bufoff, gbase, voff) do { _Pragma("unroll") for (int _i = 0; _i < 2; ++_i) \
        __builtin_amdgcn_global_load_lds((const unsigned*)((const char*)(gbase) + (voff)[_i]), (PG8_LAS unsigned*)(lds + (bufoff) + ldsw + _i * 8192), 16, 0, 0); } while (0)
#define PG8_LDA(dst, b, h) do { _Pragma("unroll") for (int m = 0; m < 4; ++m) _Pragma("unroll") for (int k = 0; k < 2; ++k) dst[m][k] = *(const PG8_LAS bf16x8*)(lds + PG8_SA(b, h) + aoff + m * 2048 + k * 1024); } while (0)
#define PG8_LDB(dst, b, h) do { _Pragma("unroll") for (int n = 0; n < 2; ++n) _Pragma("unroll") for (int k = 0; k < 2; ++k) dst[n][k] = *(const PG8_LAS bf16x8*)(lds + PG8_SB(b, h) + boff + n * 2048 + k * 1024); } while (0)
#define PG8_MMA(ai, bj, At, Bt) do { __builtin_amdgcn_s_setprio(1); _Pragma("unroll") for (int m = 0; m < 4; ++m) _Pragma("unroll") for (int n = 0; n < 2; ++n) _Pragma("unroll") for (int k = 0; k < 2; ++k) \
        acc[ai][bj][m][n] = __builtin_amdgcn_mfma_f32_16x16x32_bf16(Bt[n][k], At[m][k], acc[ai][bj][m][n], 0, 0, 0); __builtin_amdgcn_s_setprio(0); } while (0)
#define PG8_WAIT_V(n) asm volatile("s_waitcnt vmcnt(" #n ")" ::: "memory")
#define PG8_WAIT_L(n) asm volatile("s_waitcnt lgkmcnt(" #n ")" ::: "memory")
#define PG8_BAR __builtin_amdgcn_s_barrier()
#define PG8_SCHED __builtin_amdgcn_sched_barrier(0)
    Unit cur, nxt; int ui = 0;
    if (!S.next(0, cur)) return;
    f32x4 acc[2][2][4][2];
#pragma unroll
    for (int a = 0; a < 2; ++a)
#pragma unroll
        for (int b = 0; b < 2; ++b)
#pragma unroll
            for (int m = 0; m < 4; ++m)
#pragma unroll
                for (int n = 0; n < 2; ++n) acc[a][b][m][n] = (f32x4){0.f, 0.f, 0.f, 0.f};
    bf16x8 At[4][2], B0[2][2], B1[2][2];
    const char* cA = (const char*)g.A + (size_t)cur.pm * tstep; const char* cB = (const char*)g.Bt + (size_t)cur.pn * tstep;
    S.a_ready(cur);
    PG8_STAGE(PG8_SB(0, 0), cB, voffB); PG8_STAGE(PG8_SA(0, 0), cA, voffA); PG8_STAGE(PG8_SB(0, 1), cB + hstep, voffB); PG8_STAGE(PG8_SA(0, 1), cA + hstep, voffA);
    if (wr == 1) PG8_BAR;
    PG8_WAIT_V(4); PG8_BAR;
    PG8_STAGE(PG8_SB(1, 0), cB + kstep, voffB); PG8_STAGE(PG8_SA(1, 0), cA + kstep, voffA); PG8_STAGE(PG8_SB(1, 1), cB + hstep + kstep, voffB);
    PG8_WAIT_V(6); PG8_BAR;
    for (;;) {
        const bool has_next = S.next(ui + 1, nxt);
        const char* nA = has_next ? (const char*)g.A + (size_t)nxt.pm * tstep : cA; const char* nB = has_next ? (const char*)g.Bt + (size_t)nxt.pn * tstep : cB;
        for (int t = 0; t < nt; t += 2) {
            const bool last = (t == nt - 2);
            const char* a1 = cA + (size_t)(t + 1) * kstep;
            const char* a2 = last ? nA : cA + (size_t)(t + 2) * kstep; const char* b2 = last ? nB : cB + (size_t)(t + 2) * kstep;
            const char* a3 = a2 + kstep; const char* b3 = b2 + kstep;
            if (last && has_next) S.a_ready(nxt);
            PG8_LDB(B0, 0, 0); PG8_SCHED; PG8_LDA(At, 0, 0); PG8_STAGE(PG8_SA(1, 1), a1 + hstep, voffA);
            PG8_WAIT_L(8); PG8_BAR; PG8_WAIT_L(0); PG8_MMA(0, 0, At, B0); PG8_BAR; PG8_SCHED;
            PG8_LDB(B1, 0, 1); PG8_STAGE(PG8_SB(0, 0), b2, voffB);
            PG8_BAR; PG8_WAIT_L(0); PG8_MMA(0, 1, At, B1); PG8_BAR;
            PG8_LDA(At, 0, 1); PG8_STAGE(PG8_SA(0, 0), a2, voffA);
            PG8_BAR; PG8_WAIT_L(0); PG8_MMA(1, 0, At, B0); PG8_BAR; PG8_SCHED;
            PG8_STAGE(PG8_SB(0, 1), b2 + hstep, voffB);
            PG8_WAIT_V(6); PG8_BAR; PG8_MMA(1, 1, At, B1); PG8_BAR;
            PG8_LDB(B0, 1, 0); PG8_SCHED; PG8_LDA(At, 1, 0); PG8_STAGE(PG8_SA(0, 1), a2 + hstep, voffA);
            PG8_WAIT_L(8); PG8_BAR; PG8_WAIT_L(0); PG8_MMA(0, 0, At, B0); PG8_BAR; PG8_SCHED;
            PG8_LDB(B1, 1, 1); PG8_STAGE(PG8_SB(1, 0), b3, voffB);
            PG8_BAR; PG8_WAIT_L(0); PG8_MMA(0, 1, At, B1); PG8_BAR;
            PG8_LDA(At, 1, 1); PG8_STAGE(PG8_SA(1, 0), a3, voffA);
            PG8_BAR; PG8_WAIT_L(0); PG8_MMA(1, 0, At, B0); PG8_BAR; PG8_SCHED;
            PG8_STAGE(PG8_SB(1, 1), b3 + hstep, voffB);
            PG8_WAIT_V(6); PG8_BAR; PG8_MMA(1, 1, At, B1); PG8_BAR;
        }
        if constexpr (!Epi::AFTER_DRAIN) { E(acc, cur, wr, wc, fr, fq); S.done(cur); }
        if (!has_next) break;
#pragma unroll
        for (int a = 0; a < 2; ++a)
#pragma unroll
            for (int b = 0; b < 2; ++b)
#pragma unroll
                for (int m = 0; m < 4; ++m)
#pragma unroll
                    for (int n = 0; n < 2; ++n) acc[a][b][m][n] = (f32x4){0.f, 0.f, 0.f, 0.f};
        cur = nxt; cA = nA; cB = nB; ++ui;
    }
    PG8_WAIT_V(0);
    if (wr == 0) PG8_BAR;
    PG8_BAR;
    if constexpr (Epi::AFTER_DRAIN) { E.fused(acc, cur, wr, wc, fr, fq, lds, wid, lane); S.done(cur); }
#undef PG8_SA
#undef PG8_SB
#undef PG8_STAGE
#undef PG8_LDA
#undef PG8_LDB
#undef PG8_MMA
#undef PG8_WAIT_V
#undef PG8_WAIT_L
#undef PG8_BAR
#undef PG8_SCHED
}
}

#include <cstdio>
#include <ctime>
#include <cstdlib>
#include <cstring>
#include <cmath>
#include <vector>
#include <algorithm>
#define CK(x) do { hipError_t e_ = (x); if (e_ != hipSuccess) { fprintf(stderr, "HIP %s:%d %s\n", __FILE__, __LINE__, hipGetErrorString(e_)); exit(2); } } while (0)

#define DI __device__ __forceinline__
#define LAS __attribute__((address_space(3)))
typedef unsigned short bf16_t;
typedef short bf16x8 __attribute__((ext_vector_type(8)));
typedef short s16x4 __attribute__((ext_vector_type(4)));
typedef __bf16 bfv8 __attribute__((ext_vector_type(8)));
typedef __bf16 bfv4 __attribute__((ext_vector_type(4)));
typedef float f32x2 __attribute__((ext_vector_type(2)));
typedef float f32x4 __attribute__((ext_vector_type(4)));
typedef float f32x8 __attribute__((ext_vector_type(8)));
typedef float f32x16 __attribute__((ext_vector_type(16)));
typedef unsigned u32x4 __attribute__((ext_vector_type(4)));
typedef unsigned u32x2 __attribute__((ext_vector_type(2)));

constexpr int MP = 16384, MS = 128, MR = MP + MS, MPAD = 16640, DM = 1024, SEQ = 2048, NB = 8;
constexpr int NPROJ = 4096, NGATE = 3072, DFF = 4096, DIN = 7184;
constexpr int PU = 0, PQ = 512, PK = 1024, PV = 1536, PMQ = 2048, PMK = 2304, PMV = 2560, PZ = 3072, PMO = 3584;
constexpr float EPS = 1e-6f;
constexpr size_t O_S5RE_P = 16908288, O_S5RE_S = 16941056, O_S5IM_P = 17465344, O_S5IM_S = 17498112, O_CONV_P = 18022400, O_CONV_S = 18096128,
                 O_GDN_P = 19275776, O_GDN_S = 20324352, O_MLC_P = 37101568, O_MLC_S = 37625856, O_MLN_P = 46014464, O_MLN_S = 46018560,
                 O_MLM_P = 46084096, O_MLM_S = 46084160, O_TOTAL = 46085184;
constexpr size_t WS_R1 = 0, SZ_R1 = (size_t)MPAD * 4096 * 2;
constexpr size_t WS_XN = WS_R1 + SZ_R1, SZ_XN = (size_t)MPAD * 1024 * 2;
constexpr size_t WS_Y3 = WS_XN + SZ_XN, SZ_Y3 = (size_t)3 * MPAD * 512 * 2;
constexpr size_t WS_YS5 = WS_Y3 + SZ_Y3, SZ_YS5 = (size_t)MPAD * 512 * 2;
constexpr size_t WS_W = WS_YS5 + SZ_YS5;
constexpr size_t WO_IN = 0, WO_G = WO_IN + (size_t)4096 * 1024, WO_GLU = WO_G + (size_t)3072 * 1024, WO_BR = WO_GLU + (size_t)512 * 512,
                 WO_OUT = WO_BR + (size_t)3 * 1024 * 512, WO_UP = WO_OUT + (size_t)1024 * 1024, WO_DN = WO_UP + (size_t)4096 * 1024,
                 WO_PLE = WO_DN + (size_t)1024 * 4096, WO_PG = WO_PLE + (size_t)1024 * 256, WO_END = WO_PG + (size_t)1024 * 1024;
constexpr size_t SZ_W = WO_END * 2;
constexpr size_t WS_GS = WS_W + SZ_W;
constexpr int GI_U = 0, GI_W = 16384, GI_Q = 32768, GI_K = 49152, GI_A = 65536, GI_BYTES = 73728;
constexpr size_t SZ_GS = (size_t)1024 * GI_BYTES;
constexpr size_t WS_SG = WS_GS + SZ_GS, SZ_SG = (size_t)MR * 16 * 4;
constexpr size_t WS_GL = WS_SG + SZ_SG, SZ_GL = 8192;
constexpr size_t WS_MG = WS_GL + SZ_GL, SZ_MG = (size_t)1024 * 5 * 64 * 4;
constexpr size_t WS_PL = WS_MG + SZ_MG, SZ_PL = (size_t)1024 * 8192;
constexpr size_t WS_BAR = WS_PL + SZ_PL, SZ_BAR = 16384;
constexpr size_t WS_END = WS_BAR + SZ_BAR;
constexpr int LDS_BYTES = 122880 + 32768 + 2048 + 64 + 64;

struct KP { const float* in[40]; float* out; unsigned char* ws; };

DI float bf2f(bf16_t b) { return __uint_as_float(((unsigned)b) << 16); }
DI bf16_t f2bf(float f) { __bf16 b = (__bf16)f; return __builtin_bit_cast(bf16_t, b); }
DI bf16x8 pack8v(f32x8 v) { bfv8 b = __builtin_convertvector(v, bfv8); return __builtin_bit_cast(bf16x8, b); }
DI s16x4 pack4v(f32x4 v) { bfv4 b = __builtin_convertvector(v, bfv4); return __builtin_bit_cast(s16x4, b); }
DI bf16x8 pack16(const f32x16& x, int s) { f32x8 v;
#pragma unroll
    for (int j = 0; j < 8; ++j) v[j] = x[8 * s + j];
    return pack8v(v); }
DI float lo16(unsigned u) { return __uint_as_float(u << 16); }
DI float hi16(unsigned u) { return __uint_as_float(u & 0xffff0000u); }
DI f32x8 unpack8(bf16x8 b) { u32x4 u = __builtin_bit_cast(u32x4, b); f32x8 r;
#pragma unroll
    for (int i = 0; i < 4; ++i) { r[2 * i] = lo16(u[i]); r[2 * i + 1] = hi16(u[i]); }
    return r; }
DI float sigm(float x) { return __builtin_amdgcn_rcpf(1.f + __expf(-x)); }
DI float tanh_(float z) { return 1.f - 2.f * __builtin_amdgcn_rcpf(__expf(2.f * z) + 1.f); }
DI float gelu_t(float x) { return 0.5f * x * (1.f + tanh_(0.7978845608028654f * (x + 0.044715f * x * x * x))); }
DI float silu_(float x) { return x * sigm(x); }
DI float softplus_(float x) { return x > 20.f ? x : log1pf(expf(x)); }
DI float logsig_(float x) { return x >= 0.f ? -log1pf(expf(-x)) : x - log1pf(expf(x)); }
DI float softcap_(float x) { return 15.f * tanh_(x * (1.f / 15.f)); }
DI float wave_sum(float v) {
#pragma unroll
    for (int o = 32; o; o >>= 1) v += __shfl_xor(v, o);
    return v; }
DI float wave_incl_sum(float v, int lane) {
#pragma unroll
    for (int o = 1; o < 64; o <<= 1) { float t = __shfl_up(v, o); if (lane >= o) v += t; }
    return v; }
DI float wave_incl_max(float v, int lane) {
#pragma unroll
    for (int o = 1; o < 64; o <<= 1) { float t = __shfl_up(v, o); if (lane >= o) v = fmaxf(v, t); }
    return v; }
DI void butterfly16(float (&a)[16], int lane) {
#pragma unroll
    for (int i = 0; i < 8; ++i) { const bool up = (lane & 32) != 0; const float send = up ? a[i] : a[i + 8], keep = up ? a[i + 8] : a[i]; a[i] = keep + __shfl_xor(send, 32); }
#pragma unroll
    for (int i = 0; i < 4; ++i) { const bool up = (lane & 16) != 0; const float send = up ? a[i] : a[i + 4], keep = up ? a[i + 4] : a[i]; a[i] = keep + __shfl_xor(send, 16); }
#pragma unroll
    for (int i = 0; i < 2; ++i) { const bool up = (lane & 8) != 0; const float send = up ? a[i] : a[i + 2], keep = up ? a[i + 2] : a[i]; a[i] = keep + __shfl_xor(send, 8); }
    { const bool up = (lane & 4) != 0; const float send = up ? a[0] : a[1], keep = up ? a[1] : a[0]; a[0] = keep + __shfl_xor(send, 4); }
    a[0] += __shfl_xor(a[0], 2); a[0] += __shfl_xor(a[0], 1);
}
DI int bsel16(int lane) { return ((lane >> 5) & 1) * 8 + ((lane >> 4) & 1) * 4 + ((lane >> 3) & 1) * 2 + ((lane >> 2) & 1); }
DI int crow(int reg, int h) { return (reg & 3) + 8 * (reg >> 2) + 4 * h; }
DI int perm16(int k) { return (k & ~12) | ((k & 4) << 1) | ((k & 8) >> 1); }
#define MFMA32(a, b, c) __builtin_amdgcn_mfma_f32_32x32x16_bf16((a), (b), (c), 0, 0, 0)
#define MFMA16(a, b, c) __builtin_amdgcn_mfma_f32_16x16x32_bf16((a), (b), (c), 0, 0, 0)
#define WAVE_FENCE() do { asm volatile("s_waitcnt lgkmcnt(0)" ::: "memory"); __builtin_amdgcn_wave_barrier(); asm volatile("" ::: "memory"); } while (0)

typedef __attribute__((address_space(4))) const unsigned long long* ka_t;
typedef __attribute__((address_space(1))) float gfloat_t; typedef __attribute__((address_space(1))) unsigned char guchar_t;
struct InTab { ka_t ka; DI const float* operator[](int i) const { return (const float*)(const gfloat_t*)ka[i]; } };
struct Ctx {
    InTab in; float* out; unsigned char* ws; unsigned char* lds;
    bf16_t *R1, *XN, *Y3, *W, *YS5; unsigned char* GS; float *SG, *GL;
    int tid, lane, wave, G, bid;
};

template <class F> struct Epi8 {
    static constexpr bool PERM = true, AFTER_DRAIN = false;
    F f;
    DI void operator()(const f32x4 (&acc)[2][2][4][2], const pg8::Unit& u, int wr, int wc, int fr, int fq) const {
        const int row0 = u.pm * 256 + wr * 64 + fr, col0 = u.pn * 256 + wc * 32 + 8 * fq;
#pragma unroll
        for (int ai = 0; ai < 2; ++ai)
#pragma unroll
            for (int m = 0; m < 4; ++m)
#pragma unroll
                for (int bj = 0; bj < 2; ++bj) f(row0 + ai * 128 + m * 16, col0 + bj * 128, acc[ai][bj][m][0], acc[ai][bj][m][1]);
    }
};
DI f32x8 cat8(f32x4 a, f32x4 b) { f32x8 r; r[0] = a[0]; r[1] = a[1]; r[2] = a[2]; r[3] = a[3]; r[4] = b[0]; r[5] = b[1]; r[6] = b[2]; r[7] = b[3]; return r; }
struct FStore { bf16_t* dst; int ld;
    DI void s(int row, int col, float v) const { dst[(size_t)row * ld + col] = f2bf(v); }
    DI void operator()(int row, int col, f32x4 a, f32x4 b) const { *(bf16x8*)(dst + (size_t)row * ld + col) = pack8v(cat8(a, b)); } };
struct FSig { bf16_t* dst; int ld;
    DI void s(int row, int col, float v) const { dst[(size_t)row * ld + col] = f2bf(sigm(v)); }
    DI void operator()(int row, int col, f32x4 a, f32x4 b) const { f32x8 v = cat8(a, b);
#pragma unroll
        for (int i = 0; i < 8; ++i) v[i] = sigm(v[i]);
        *(bf16x8*)(dst + (size_t)row * ld + col) = pack8v(v); } };
struct FGlu { const bf16_t* y; const float* bias; bf16_t* dst;
    DI void s(int row, int col, float v) const { dst[(size_t)row * 512 + col] = f2bf(bf2f(y[(size_t)row * 512 + col]) * sigm(v + bias[col])); }
    DI void operator()(int row, int col, f32x4 a, f32x4 b) const { f32x8 v = cat8(a, b); f32x8 yv = unpack8(*(const bf16x8*)(y + (size_t)row * 512 + col));
        f32x4 b0 = *(const f32x4*)(bias + col), b1 = *(const f32x4*)(bias + col + 4);
#pragma unroll
        for (int i = 0; i < 8; ++i) v[i] = yv[i] * sigm(v[i] + (i < 4 ? b0[i] : b1[i - 4]));
        *(bf16x8*)(dst + (size_t)row * 512 + col) = pack8v(v); } };
struct FBranch { const bf16_t* gates; bf16_t* merged; int first;
    DI void s(int row, int col, float v) const { bf16_t* mp = merged + (size_t)row * 1024 + col; const float g = bf2f(gates[(size_t)row * 4096 + col]); *mp = f2bf((first ? 0.f : bf2f(*mp)) + g * v); }
    DI void operator()(int row, int col, f32x4 a, f32x4 b) const { f32x8 v = cat8(a, b); f32x8 gv = unpack8(*(const bf16x8*)(gates + (size_t)row * 4096 + col));
        bf16x8* mp = (bf16x8*)(merged + (size_t)row * 1024 + col);
        f32x8 o;
        if (first) {
#pragma unroll
            for (int i = 0; i < 8; ++i) o[i] = gv[i] * v[i];
        } else { f32x8 mv = unpack8(*mp);
#pragma unroll
            for (int i = 0; i < 8; ++i) o[i] = mv[i] + gv[i] * v[i];
        }
        *mp = pack8v(o); } };
struct FRes { float* xr;
    DI void s(int row, int col, float v) const { xr[(size_t)row * 1024 + col] += v; }
    DI void operator()(int row, int col, f32x4 a, f32x4 b) const { if (row < MR) { f32x4* p = (f32x4*)(xr + (size_t)row * 1024 + col); p[0] = p[0] + a; p[1] = p[1] + b; } } };
struct FResB { float* xr; bf16_t* xb;
    DI void s(int row, int col, float v) const { const float x = xr[(size_t)row * 1024 + col] + v; xr[(size_t)row * 1024 + col] = x; xb[(size_t)row * 1024 + col] = f2bf(x); }
    DI void operator()(int row, int col, f32x4 a, f32x4 b) const { if (row < MR) { f32x4* p = (f32x4*)(xr + (size_t)row * 1024 + col); const f32x4 x0 = p[0] + a, x1 = p[1] + b; p[0] = x0; p[1] = x1;
            *(bf16x8*)(xb + (size_t)row * 1024 + col) = pack8v(cat8(x0, x1)); } } };
struct FRelu2 { bf16_t* dst;
    DI void s(int row, int col, float v) const { const float r = fmaxf(v, 0.f); dst[(size_t)row * 4096 + col] = f2bf(r * r); }
    DI void operator()(int row, int col, f32x4 a, f32x4 b) const { f32x8 v = cat8(a, b);
#pragma unroll
        for (int i = 0; i < 8; ++i) { float r = fmaxf(v[i], 0.f); v[i] = r * r; }
        *(bf16x8*)(dst + (size_t)row * 4096 + col) = pack8v(v); } };
struct FPle { const bf16_t* T; float* xr;
    DI void s(int row, int col, float v) const { xr[(size_t)row * 1024 + col] += bf2f(T[(size_t)row * 1024 + col]) * sigm(v); }
    DI void operator()(int row, int col, f32x4 a, f32x4 b) const { if (row < MR) { f32x8 v = cat8(a, b); f32x8 tv = unpack8(*(const bf16x8*)(T + (size_t)row * 1024 + col));
            f32x4* p = (f32x4*)(xr + (size_t)row * 1024 + col); f32x4 x0 = p[0], x1 = p[1];
#pragma unroll
            for (int i = 0; i < 4; ++i) { x0[i] += tv[i] * sigm(v[i]); x1[i] += tv[4 + i] * sigm(v[4 + i]); }
            p[0] = x0; p[1] = x1; } } };

DI f32x16 small_part(const Ctx& c, const bf16_t* A, const bf16_t* Bt, int K, int tile, int kq) {
    int r = c.lane & 31, hh = c.lane >> 5; asm volatile("" : "+v"(r), "+v"(hh));
    const int mt = tile & 3, nt = tile >> 2, K4 = K >> 2;
    const bf16_t* ap = A + (size_t)(MP + mt * 32 + r) * K + kq * K4 + hh * 8;
    const bf16_t* bp = Bt + (size_t)(nt * 32 + r) * K + kq * K4 + hh * 8;
    f32x16 acc;
#pragma unroll
    for (int j = 0; j < 16; ++j) acc[j] = 0.f;
    if (K4 >= 128) {
        bf16x8 a[8], b[8];
#pragma unroll
        for (int j = 0; j < 8; ++j) { a[j] = *(const bf16x8*)(ap + j * 16); b[j] = *(const bf16x8*)(bp + j * 16); }
        for (int k = 128; k < K4; k += 128) {
            bf16x8 an[8], bn[8];
#pragma unroll
            for (int j = 0; j < 8; ++j) { an[j] = *(const bf16x8*)(ap + k + j * 16); bn[j] = *(const bf16x8*)(bp + k + j * 16); }
#pragma unroll
            for (int j = 0; j < 8; ++j) acc = MFMA32(a[j], b[j], acc);
#pragma unroll
            for (int j = 0; j < 8; ++j) { a[j] = an[j]; b[j] = bn[j]; }
        }
#pragma unroll
        for (int j = 0; j < 8; ++j) acc = MFMA32(a[j], b[j], acc);
    } else {
#pragma unroll
        for (int j = 0; j < 4; ++j) { const bf16x8 a = *(const bf16x8*)(ap + j * 16), b = *(const bf16x8*)(bp + j * 16); acc = MFMA32(a, b, acc); }
    }
    return acc;
}
template <class F> DI void run_gemm(const Ctx& c, const bf16_t* A, const bf16_t* Bt, int N, int K, const F& f) {
    { const int ntile = 4 * (N >> 5), grp = c.wave >> 2, kq = c.wave & 3;
      LAS float* red = (LAS float*)c.lds;
      for (int t0 = 0; t0 < ntile; t0 += 2 * c.G) {
          const int t = t0 + grp * c.G + c.bid; const bool live = t < ntile;
          if (live) { const f32x16 acc = small_part(c, A, Bt, K, t, kq);
#pragma unroll
              for (int i = 0; i < 16; ++i) red[(c.wave * 16 + i) * 64 + c.lane] = acc[i]; }
          __syncthreads();
          if (live && kq == 0) { const int mt = t & 3, nt = t >> 2, r = c.lane & 31, hh = c.lane >> 5;
#pragma unroll
              for (int i = 0; i < 16; ++i) { const int o = (c.wave * 16 + i) * 64 + c.lane; const float v = (red[o] + red[o + 1024]) + (red[o + 2048] + red[o + 3072]);
                  f.s(MP + mt * 32 + crow(i, hh), nt * 32 + r, v); } }
          __syncthreads();
      } }
    pg8::Gemm g{A, Bt, MP, N, K}; pg8::StaticOrder S; S.init(MP, N, c.G, c.bid);
    Epi8<F> E{f};
    pg8::gemm_phase<Epi8<F>, pg8::StaticOrder>((PG8_LAS unsigned char*)c.lds, g, S, E, nullptr);
    __syncthreads();
}

DI void tr_task(const Ctx& c, const float* src, int ld, int K, int n, bf16_t* dst, int rot) {
    float* tile = (float*)c.lds;
    const int nkt = K >> 6, ntiles = nkt * (n >> 6);
    const int start = (c.bid + c.G - (rot % c.G)) % c.G;
    for (int t = start; t < ntiles; t += c.G) {
        const int kt = t % nkt, nt = t / nkt;
        const int r = c.tid >> 4, c4 = (c.tid & 15) * 4;
#pragma unroll
        for (int p = 0; p < 2; ++p) { const int row = r + 32 * p; const f32x4 v = *(const f32x4*)(src + (size_t)(kt * 64 + row) * ld + nt * 64 + c4);
            tile[row * 65 + c4] = v[0]; tile[row * 65 + c4 + 1] = v[1]; tile[row * 65 + c4 + 2] = v[2]; tile[row * 65 + c4 + 3] = v[3]; }
        __syncthreads();
        { const int nn = c.tid >> 3, kc = (c.tid & 7) * 8; f32x8 v;
#pragma unroll
          for (int e = 0; e < 8; ++e) v[e] = tile[(kc + e) * 65 + nn];
          *(bf16x8*)(dst + (size_t)(nt * 64 + nn) * K + kt * 64 + kc) = pack8v(v); }
        __syncthreads();
    }
}
DI void phase_weights(const Ctx& c, int L) {
    const float* win = c.in[12] + (size_t)L * 1024 * DIN;
    bf16_t* W = c.W;
    tr_task(c, win + 0, DIN, 1024, 2048, W + WO_IN, 0);
    tr_task(c, win + 2568, DIN, 1024, 1024, W + WO_IN + (size_t)2048 * 1024, 0);
    tr_task(c, win + 2048, DIN, 1024, 512, W + WO_IN + (size_t)3072 * 1024, 0);
    tr_task(c, win + 3592, DIN, 1024, 512, W + WO_IN + (size_t)3584 * 1024, 128);
    tr_task(c, win + 4112, DIN, 1024, 3072, W + WO_G, 0);
    tr_task(c, c.in[21] + (size_t)L * 512 * 512, 512, 512, 512, W + WO_GLU, 0);
    tr_task(c, c.in[30] + (size_t)L * 512 * 1024, 1024, 512, 1024, W + WO_BR, 64);
    tr_task(c, c.in[31] + (size_t)L * 512 * 1024, 1024, 512, 1024, W + WO_BR + (size_t)1024 * 512, 192);
    tr_task(c, c.in[32] + (size_t)L * 512 * 1024, 1024, 512, 1024, W + WO_BR + (size_t)2 * 1024 * 512, 64);
    tr_task(c, c.in[33] + (size_t)L * 1024 * 1024, 1024, 1024, 1024, W + WO_OUT, 0);
    tr_task(c, c.in[35] + (size_t)L * 1024 * 4096, 4096, 1024, 4096, W + WO_UP, 0);
    tr_task(c, c.in[36] + (size_t)L * 4096 * 1024, 1024, 4096, 1024, W + WO_DN, 0);
    tr_task(c, c.in[37] + (size_t)L * 256 * 1024, 1024, 256, 1024, W + WO_PLE, 0);
    tr_task(c, c.in[38] + (size_t)L * 1024 * 1024, 1024, 1024, 1024, W + WO_PG, 64);
}

template <int MODE> DI void phase_rmsnorm(const Ctx& c, int L) {
    float* wsm = (float*)c.lds;
    const float* gain = (MODE == 0 ? c.in[11] : c.in[34]) + (size_t)L * 1024;
    if (MODE == 0) {
        const float* win = c.in[12] + (size_t)L * 1024 * DIN;
        for (int idx = c.tid; idx < 4096; idx += 512) { const int k = idx >> 2, part = idx & 3, seg = part >> 1, half = part & 1;
            const f32x4 v = *(const f32x4*)(win + (size_t)k * DIN + (seg ? 4104 : 2560) + half * 4);
            const int sb = seg * 8 + half * 4;
            wsm[(sb + 0) * 1024 + k] = v[0]; wsm[(sb + 1) * 1024 + k] = v[1]; wsm[(sb + 2) * 1024 + k] = v[2]; wsm[(sb + 3) * 1024 + k] = v[3]; }
        __syncthreads();
    }
    float* XR = c.out;
    for (int row = c.bid * 8 + c.wave; row < MR; row += c.G * 8) {
        const float* src = (MODE == 0 && L == 0) ? (row < MP ? c.in[0] + (size_t)row * 1024 : c.in[1] + (size_t)(row - MP) * 1024) : XR + (size_t)row * 1024;
        f32x4 x[4]; float ss = 0.f;
#pragma unroll
        for (int i = 0; i < 4; ++i) { x[i] = *(const f32x4*)(src + c.lane * 4 + 256 * i); ss += x[i][0] * x[i][0] + x[i][1] * x[i][1] + x[i][2] * x[i][2] + x[i][3] * x[i][3]; }
        ss = wave_sum(ss);
        const float rs = rsqrtf(ss * (1.f / 1024.f) + EPS);
        if (MODE == 0 && L == 0) {
#pragma unroll
            for (int i = 0; i < 4; ++i) *(f32x4*)(XR + (size_t)row * 1024 + c.lane * 4 + 256 * i) = x[i];
        }
#pragma unroll
        for (int i = 0; i < 4; ++i) { const f32x4 g = *(const f32x4*)(gain + c.lane * 4 + 256 * i); x[i] = x[i] * rs * g;
            *(s16x4*)(c.XN + (size_t)row * 1024 + c.lane * 4 + 256 * i) = pack4v(x[i]); }
        if (MODE == 0) {
            float a[16];
#pragma unroll
            for (int s = 0; s < 16; ++s) { float t = 0.f;
#pragma unroll
                for (int i = 0; i < 4; ++i) { const f32x4 w = *(const f32x4*)(wsm + s * 1024 + c.lane * 4 + 256 * i); t += x[i][0] * w[0] + x[i][1] * w[1] + x[i][2] * w[2] + x[i][3] * w[3]; }
                a[s] = t; asm volatile("" ::: "memory"); }
#pragma unroll
            for (int i = 0; i < 8; ++i) { const bool up = (c.lane & 32) != 0; const float send = up ? a[i] : a[i + 8], keep = up ? a[i + 8] : a[i]; a[i] = keep + __shfl_xor(send, 32); }
#pragma unroll
            for (int i = 0; i < 4; ++i) { const bool up = (c.lane & 16) != 0; const float send = up ? a[i] : a[i + 4], keep = up ? a[i + 4] : a[i]; a[i] = keep + __shfl_xor(send, 16); }
#pragma unroll
            for (int i = 0; i < 2; ++i) { const bool up = (c.lane & 8) != 0; const float send = up ? a[i] : a[i + 2], keep = up ? a[i + 2] : a[i]; a[i] = keep + __shfl_xor(send, 8); }
            { const bool up = (c.lane & 4) != 0; const float send = up ? a[0] : a[1], keep = up ? a[1] : a[0]; a[0] = keep + __shfl_xor(send, 4); }
            a[0] += __shfl_xor(a[0], 2); a[0] += __shfl_xor(a[0], 1);
            if ((c.lane & 3) == 0) { const int sidx = ((c.lane >> 5) & 1) * 8 + ((c.lane >> 4) & 1) * 4 + ((c.lane >> 3) & 1) * 2 + ((c.lane >> 2) & 1); c.SG[(size_t)row * 16 + sidx] = a[0]; }
        }
    }
    __syncthreads();
}

DI void phase_gdn_prep(const Ctx& c, int L) {
    constexpr int RS = 132, AS = 68, BP = 136;
    LAS float* AmT0 = (LAS float*)c.lds;
    const float* convw = c.in[23] + (size_t)L * 4 * 1536;
    const bf16_t* PR = c.R1;
    for (int item = c.bid; item < 1024; item += c.G) {
        const int ch = item & 31, h = (item >> 5) & 3, b = item >> 7;
        const int t0 = b * SEQ + ch * 64;
        unsigned char* gi = c.GS + (size_t)item * GI_BYTES;
        LAS float* AmT = AmT0; asm volatile("" : "+v"(AmT));
        LAS float* beta = AmT + 64 * AS; LAS float* gcum = beta + 64; LAS float* part = gcum + 64;
        LAS float* vs = part + 128; asm volatile("" : "+v"(vs));
        LAS bf16_t* qb = (LAS bf16_t*)(vs + 64 * RS); asm volatile("" : "+v"(qb));
        LAS bf16_t* khi = qb + 64 * BP; asm volatile("" : "+v"(khi));
        LAS bf16_t* klo = khi + 64 * BP; asm volatile("" : "+v"(klo));
        if (c.wave == 7) { const size_t row = (size_t)(t0 + c.lane);
            const float bt = sigm(c.SG[row * 16 + h]);
            const float g = -expf(c.in[24][L * 4 + h]) * softplus_(c.SG[row * 16 + 4 + h] + c.in[25][L * 4 + h]);
            const float gc = wave_incl_sum(g, c.lane);
            beta[c.lane] = bt; gcum[c.lane] = gc;
            if (c.lane == 63) c.GL[item] = expf(gc); }
        { const int d = c.tid & 127, tq = c.tid >> 7;
          float qk[2][16];
#pragma unroll
          for (int which = 0; which < 3; ++which) {
              const int pcol = PQ + which * 512 + h * 128 + d, wcol = which * 512 + h * 128 + d;
              const float w0 = convw[wcol], w1 = convw[1536 + wcol], w2 = convw[3072 + wcol], w3 = convw[4608 + wcol];
              float xin[19];
#pragma unroll
              for (int i = 0; i < 19; ++i) { const int tt = ch * 64 + tq * 16 + i - 3; const int tc = tt < 0 ? 0 : tt;
                  const float v = bf2f(PR[(size_t)(b * SEQ + tc) * NPROJ + pcol]); xin[i] = tt < 0 ? 0.f : v; }
#pragma unroll
              for (int t = 0; t < 16; ++t) { const float a = silu_(xin[t] * w0 + xin[t + 1] * w1 + xin[t + 2] * w2 + xin[t + 3] * w3);
                  if (which == 2) vs[(tq * 16 + t) * RS + d] = a; else qk[which][t] = a; }
          }
#pragma unroll
          for (int which = 0; which < 2; ++which) {
              float ssq[16];
#pragma unroll
              for (int t = 0; t < 16; ++t) ssq[t] = qk[which][t] * qk[which][t];
              butterfly16(ssq, c.lane);
              __syncthreads();
              if ((c.lane & 3) == 0) part[c.wave * 16 + bsel16(c.lane)] = ssq[0];
              __syncthreads();
#pragma unroll
              for (int t = 0; t < 16; ++t) { const float tot = part[c.wave * 16 + t] + part[(c.wave ^ 1) * 16 + t];
                  const float v = qk[which][t] * rsqrtf(tot + EPS) * (which == 0 ? 0.08838834764831845f : 1.f);
                  const bf16_t hi = f2bf(v);
                  if (which == 0) qb[(tq * 16 + t) * BP + d] = hi;
                  else { khi[(tq * 16 + t) * BP + d] = hi; klo[(tq * 16 + t) * BP + d] = f2bf(v - bf2f(hi)); } }
          } }
        __syncthreads();
        { const int r = c.lane & 31, hh = c.lane >> 5, wq = c.wave & 3, tm = wq >> 1, tn = wq & 1;
          if (!(c.wave < 4 && tm == 0 && tn == 1)) {
              f32x16 acc;
#pragma unroll
              for (int j = 0; j < 16; ++j) acc[j] = 0.f;
              const LAS bf16_t* arow = (c.wave < 4 ? khi : qb) + (tm * 32 + r) * BP + hh * 8;
              const LAS bf16_t* brow = khi + (tn * 32 + r) * BP + hh * 8;
#pragma unroll
              for (int ks = 0; ks < 8; ++ks) { const bf16x8 av = *(const LAS bf16x8*)(arow + ks * 16), bv = *(const LAS bf16x8*)(brow + ks * 16);
                  acc = MFMA32(av, bv, acc);
                  if (c.wave < 4) { const bf16x8 al = *(const LAS bf16x8*)(arow + 64 * BP + ks * 16), bl = *(const LAS bf16x8*)(brow + 64 * BP + ks * 16);
                      acc = MFMA32(av, bl, acc); acc = MFMA32(al, bv, acc); } }
              const int s = tn * 32 + r; const float gs = gcum[s];
              bf16_t* at = (bf16_t*)(gi + GI_A);
#pragma unroll
              for (int i = 0; i < 16; ++i) { const int t = tm * 32 + crow(i, hh); const float dec = (t >= s) ? __expf(gcum[t] - gs) : 0.f;
                  if (c.wave < 4) { if (t > s) AmT[s * AS + t] = beta[t] * acc[i] * dec; }
                  else at[t * 64 + (s & ~15) + perm16(s & 15)] = f2bf(acc[i] * dec); }
          } }
        __syncthreads();
        if (c.tid < 256) {
            const int col = c.tid; float x[64];
#pragma unroll
            for (int t = 0; t < 64; ++t) x[t] = (col < 128) ? vs[t * RS + col] * beta[t] : (bf2f(khi[t * BP + (col - 128)]) + bf2f(klo[t * BP + (col - 128)])) * beta[t] * __expf(gcum[t]);
#pragma unroll
            for (int j = 0; j < 63; ++j) { const float xj = x[j];
#pragma unroll
                for (int g4 = (j + 1) / 4; g4 < 16; ++g4) { const f32x4 a = *(const LAS f32x4*)(AmT + j * AS + g4 * 4);
#pragma unroll
                    for (int e = 0; e < 4; ++e) if (g4 * 4 + e > j) x[g4 * 4 + e] -= a[e] * xj; } }
            if (col < 128) { bf16_t* up = (bf16_t*)(gi + GI_U); const int sl = col >> 5, r = col & 31;
#pragma unroll
                for (int t = 0; t < 64; ++t) { const int mt = t >> 5, tt = t & 31, hh = (tt >> 2) & 1, i = (tt & 3) + 4 * (tt >> 3);
                    up[((sl * 2 + mt) * 16 + i) * 64 + r + 32 * hh] = f2bf(x[t]); }
            } else { bf16_t* wp = (bf16_t*)(gi + GI_W); const int dk = col - 128, pd = (dk & ~15) + perm16(dk & 15);
#pragma unroll
                for (int t = 0; t < 64; ++t) wp[t * 128 + pd] = f2bf(-x[t]); }
        } else {
            bf16_t* qp = (bf16_t*)(gi + GI_Q); bf16_t* kp = (bf16_t*)(gi + GI_K);
            const float g63 = gcum[63];
            for (int idx = c.tid - 256; idx < 64 * 128; idx += 256) { const int t = idx >> 7, d = idx & 127;
                qp[t * 128 + (d & ~15) + perm16(d & 15)] = f2bf(bf2f(qb[t * BP + d]) * __expf(gcum[t])); }
            for (int idx = c.tid - 256; idx < 64 * 128; idx += 256) { const int d = idx >> 6, t = idx & 63;
                kp[d * 64 + (t & ~15) + perm16(t & 15)] = f2bf((bf2f(khi[t * BP + d]) + bf2f(klo[t * BP + d])) * __expf(g63 - gcum[t])); }
        }
        __syncthreads();
    }
}

constexpr int GB_W = 0, GB_Q = 16384, GB_A = 32768, GB_K = 40960, GB_U = 57344, GB_BYTES = 61440;
DI void dma16(const void* g, unsigned lds_addr) { asm volatile("s_mov_b32 m0, %1\n\tglobal_load_lds_dwordx4 %0, off" :: "v"(g), "s"(lds_addr) : "memory", "m0"); }
DI void gdn_issue(const Ctx& c, int item, int sl, int r, int hh, int ln, PG8_LAS unsigned char* buf) {
    const unsigned char* gi = c.GS + (size_t)item * GI_BYTES;
    const bf16_t* up = (const bf16_t*)(gi + GI_U); const bf16_t* wp = (const bf16_t*)(gi + GI_W); const bf16_t* qp = (const bf16_t*)(gi + GI_Q);
    const bf16_t* kp = (const bf16_t*)(gi + GI_K); const bf16_t* ap = (const bf16_t*)(gi + GI_A);
#pragma unroll
    for (int mt = 0; mt < 2; ++mt)
#pragma unroll
        for (int ks = 0; ks < 8; ++ks) {
            dma16((wp + (mt * 32 + r) * 128 + ks * 16 + hh * 8), (unsigned)(size_t)(buf + GB_W + (mt * 8 + ks) * 1024));
            dma16((qp + (mt * 32 + r) * 128 + ks * 16 + hh * 8), (unsigned)(size_t)(buf + GB_Q + (mt * 8 + ks) * 1024)); }
#pragma unroll
    for (int mt = 0; mt < 2; ++mt)
#pragma unroll
        for (int ks = 0; ks < 4; ++ks)
            dma16((ap + (mt * 32 + r) * 64 + ks * 16 + hh * 8), (unsigned)(size_t)(buf + GB_A + (mt * 4 + ks) * 1024));
#pragma unroll
    for (int i = 0; i < 4; ++i)
#pragma unroll
        for (int ks = 0; ks < 4; ++ks)
            dma16((kp + (i * 32 + r) * 64 + ks * 16 + hh * 8), (unsigned)(size_t)(buf + GB_K + (i * 4 + ks) * 1024));
#pragma unroll
    for (int j = 0; j < 4; ++j)
        dma16((up + (size_t)sl * 2048 + j * 512 + ln * 8), (unsigned)(size_t)(buf + GB_U + j * 1024));
}
DI void task_gdn_seq(const Ctx& c, int L, int unit) {
    const int sl = (unit >> 3) & 3, stream = (unit & 7) + 8 * (unit >> 5);
    const int b = stream >> 2, h = stream & 3;
    const int r0_ = c.lane & 31, hh0_ = c.lane >> 5; int r = r0_, hh = hh0_, ln = c.lane;
    PG8_LAS unsigned char* lbase = (PG8_LAS unsigned char*)c.lds;
    f32x16 S[4];
#pragma unroll
    for (int i = 0; i < 4; ++i)
#pragma unroll
        for (int j = 0; j < 16; ++j) S[i][j] = 0.f;
    bf16_t* yo = c.Y3 + (size_t)1 * MPAD * 512;
    gdn_issue(c, stream * 32, sl, r, hh, ln, lbase);
    for (int ch = 0; ch < 32; ++ch) {
        r = r0_; hh = hh0_; ln = c.lane; asm volatile("" : "+v"(r), "+v"(hh), "+v"(ln));
        const int item = stream * 32 + ch;
        const float gl = c.GL[item];
        asm volatile("s_waitcnt vmcnt(0)" ::: "memory");
        PG8_LAS unsigned char* buf = lbase + (ch & 1) * GB_BYTES;
        if (ch + 1 < 32) gdn_issue(c, item + 1, sl, r, hh, ln, lbase + ((ch + 1) & 1) * GB_BYTES);
        PG8_LAS unsigned char* lb = buf + ln * 16; asm volatile("" : "+v"(lb));
        PG8_LAS unsigned char* ub = buf + GB_U + ln * 2; asm volatile("" : "+v"(ub));
        f32x16 vn[2], o[2];
#pragma unroll
        for (int mt = 0; mt < 2; ++mt)
#pragma unroll
            for (int i = 0; i < 16; ++i) { vn[mt][i] = bf2f(*(const PG8_LAS bf16_t*)(ub + (mt * 16 + i) * 128)); o[mt][i] = 0.f; }
        bf16x8 Sb[8];
#pragma unroll
        for (int ks = 0; ks < 8; ++ks) Sb[ks] = pack16(S[ks >> 1], ks & 1);
#pragma unroll
        for (int mt = 0; mt < 2; ++mt)
#pragma unroll
            for (int ks = 0; ks < 8; ++ks) { const bf16x8 a = *(const PG8_LAS bf16x8*)(lb + GB_W + (mt * 8 + ks) * 1024); vn[mt] = MFMA32(a, Sb[ks], vn[mt]); }
#pragma unroll
        for (int mt = 0; mt < 2; ++mt)
#pragma unroll
            for (int ks = 0; ks < 8; ++ks) { const bf16x8 a = *(const PG8_LAS bf16x8*)(lb + GB_Q + (mt * 8 + ks) * 1024); o[mt] = MFMA32(a, Sb[ks], o[mt]); }
        bf16x8 Vb[4];
#pragma unroll
        for (int ks = 0; ks < 4; ++ks) Vb[ks] = pack16(vn[ks >> 1], ks & 1);
#pragma unroll
        for (int mt = 0; mt < 2; ++mt)
#pragma unroll
            for (int ks = 0; ks < 4; ++ks) { const bf16x8 a = *(const PG8_LAS bf16x8*)(lb + GB_A + (mt * 4 + ks) * 1024); o[mt] = MFMA32(a, Vb[ks], o[mt]); }
#pragma unroll
        for (int i = 0; i < 4; ++i) {
#pragma unroll
            for (int j = 0; j < 16; ++j) S[i][j] *= gl;
#pragma unroll
            for (int ks = 0; ks < 4; ++ks) { const bf16x8 a = *(const PG8_LAS bf16x8*)(lb + GB_K + (i * 4 + ks) * 1024); S[i] = MFMA32(a, Vb[ks], S[i]); }
        }
        const size_t rowb = (size_t)(b * SEQ + ch * 64);
#pragma unroll
        for (int mt = 0; mt < 2; ++mt)
#pragma unroll
            for (int i = 0; i < 16; ++i) yo[(rowb + mt * 32 + crow(i, hh)) * 512 + h * 128 + sl * 32 + r] = f2bf(o[mt][i]);
        asm volatile("s_waitcnt lgkmcnt(0)" ::: "memory");
    }
    float* so = c.out + O_GDN_P + ((size_t)(L * NB + b) * 4 + h) * 128 * 128;
#pragma unroll
    for (int i = 0; i < 4; ++i)
#pragma unroll
        for (int j = 0; j < 16; ++j) so[(size_t)(i * 32 + crow(j, hh)) * 128 + sl * 32 + r] = S[i][j];
}

DI void task_ml_gates(const Ctx& c, int L, int item) {
    const int ch = item & 31, h = (item >> 5) & 3, b = item >> 7, lane = c.lane;
    int r = lane & 31, hh = lane >> 5; asm volatile("" : "+v"(r), "+v"(hh));
    const size_t t0 = (size_t)(b * SEQ + ch * 64);
    const size_t row = t0 + lane;
    const float li = softcap_(c.SG[row * 16 + 8 + h] + c.in[27][L * 4 + h]);
    const float lf = logsig_(softcap_(c.SG[row * 16 + 12 + h] + c.in[28][L * 4 + h]));
    const float bc = wave_incl_sum(lf, lane);
    const float av = li - bc;
    const float cm = wave_incl_max(av, lane);
    float* mg = (float*)(c.ws + WS_MG) + (size_t)item * 320;
    mg[lane] = av; mg[64 + lane] = cm; mg[128 + lane] = bc;
    LAS float* a_s = (LAS float*)(c.lds + 122880 + c.wave * 1024);
    WAVE_FENCE();
    a_s[lane] = av;
    WAVE_FENCE();
    const bf16_t* qb = c.R1 + t0 * NPROJ + PMQ + h * 64; const bf16_t* kb = c.R1 + t0 * NPROJ + PMK + h * 64;
    f32x16 PT[2][2];
#pragma unroll
    for (int ms = 0; ms < 2; ++ms)
#pragma unroll
        for (int nt = 0; nt < 2; ++nt)
#pragma unroll
            for (int j = 0; j < 16; ++j) PT[ms][nt][j] = 0.f;
#pragma unroll
    for (int ks = 0; ks < 4; ++ks) { bf16x8 ak[2], bq[2];
#pragma unroll
        for (int m = 0; m < 2; ++m) { ak[m] = *(const bf16x8*)(kb + (size_t)(m * 32 + r) * NPROJ + ks * 16 + hh * 8); bq[m] = *(const bf16x8*)(qb + (size_t)(m * 32 + r) * NPROJ + ks * 16 + hh * 8); }
#pragma unroll
        for (int ms = 0; ms < 2; ++ms)
#pragma unroll
            for (int nt = 0; nt < 2; ++nt) PT[ms][nt] = MFMA32(ak[ms], bq[nt], PT[ms][nt]); }
    float dpv[2];
    unsigned char* pl = c.ws + WS_PL + (size_t)item * 8192 + lane * 16;
#pragma unroll
    for (int nt = 0; nt < 2; ++nt) { const float cmn = __shfl(cm, nt * 32 + r); float dp = 0.f;
#pragma unroll
        for (int ms = 0; ms < 2; ++ms)
#pragma unroll
            for (int g = 0; g < 4; ++g) { const f32x4 a4 = *(const LAS f32x4*)(a_s + ms * 32 + 8 * g + 4 * hh);
#pragma unroll
                for (int jj = 0; jj < 4; ++jj) { const int i = 4 * g + jj; const int s = ms * 32 + 8 * g + 4 * hh + jj;
                    const float wv = (s <= nt * 32 + r) ? __expf(a4[jj] - cmn) * 0.125f : 0.f;
                    PT[ms][nt][i] *= wv; dp += PT[ms][nt][i]; } }
        dp += __shfl_xor(dp, 32); dpv[nt] = dp;
#pragma unroll
        for (int ks = 0; ks < 4; ++ks) *(bf16x8*)(pl + (nt * 4 + ks) * 1024) = pack16(PT[ks >> 1][nt], ks & 1); }
    mg[192 + lane] = lane < 32 ? dpv[0] : dpv[1];
    { const float cm63 = __shfl(cm, 63);
      WAVE_FENCE();
      a_s[64 + lane] = __expf(av - cm63) * 0.125f;
      WAVE_FENCE();
      float dn = 0.f;
#pragma unroll 16
      for (int sq = 0; sq < 64; ++sq) dn += a_s[64 + sq] * bf2f(kb[(size_t)sq * NPROJ + lane]);
      mg[256 + lane] = dn; }
}
DI void ml_issue(const bf16_t* PR, const unsigned char* PLs  , int b, int h, int sl, int ch, int lane, unsigned bufaddr) {
    const size_t row = (size_t)(b * SEQ + ch * 64 + lane);
    const bf16_t* kp = PR + row * NPROJ + PMK + h * 64; const bf16_t* qp = PR + row * NPROJ + PMQ + h * 64; const bf16_t* vp = PR + row * NPROJ + PMV + h * 128 + sl * 32;
#pragma unroll
    for (int d8 = 0; d8 < 8; ++d8) { dma16(kp + d8 * 8, bufaddr + d8 * 1024); dma16(qp + d8 * 8, bufaddr + 8192 + d8 * 1024); }
#pragma unroll
    for (int d8 = 0; d8 < 4; ++d8) dma16(vp + d8 * 8, bufaddr + 16384 + d8 * 1024);
    const unsigned char* pl = PLs + (size_t)ch * 8192 + lane * 16;
#pragma unroll
    for (int fr = 0; fr < 8; ++fr) dma16(pl + fr * 1024, bufaddr + 20480 + fr * 1024);
}
DI void task_ml_seq(const Ctx& c, int L, int unit, float* wl  ) {
    const int sl = (unit >> 3) & 3, stream = (unit & 7) + 8 * (unit >> 5);
    const int b = stream >> 2, h = stream & 3;
    const int lane = c.lane, r0_ = lane & 31, hh0_ = lane >> 5;
    int r = r0_, hh = hh0_, lane_v = lane;
    LAS float* a_l = (LAS float*)wl; LAS float* w_l = a_l + 64; LAS float* sc_l = a_l + 128; LAS float* inv_l = a_l + 192;
    LAS float* n_l = a_l + 256;
    LAS unsigned char* bufs = (LAS unsigned char*)(a_l + 320);
    const unsigned bufaddr0 = (unsigned)(size_t)bufs;
    const bf16_t* PR = c.R1;
    f32x16 C[2];
#pragma unroll
    for (int i = 0; i < 2; ++i)
#pragma unroll
        for (int j = 0; j < 16; ++j) C[i][j] = 0.f;
    float nst = 0.f, mprev = 0.f;
    n_l[lane] = 0.f;
    bf16_t* yo = c.Y3 + (size_t)2 * MPAD * 512;
    float mgv[5];
    const unsigned char* PLs = c.ws + WS_PL + (size_t)(stream * 32) * 8192;
    { const float* mg = (const float*)(c.ws + WS_MG) + (size_t)(stream * 32) * 320; mgv[0] = mg[lane]; mgv[1] = mg[64 + lane]; mgv[2] = mg[128 + lane]; mgv[3] = mg[192 + lane]; mgv[4] = mg[256 + lane]; }
    ml_issue(PR, PLs, b, h, sl, 0, lane, bufaddr0);
    for (int ch = 0; ch < 32; ++ch) {
        r = r0_; hh = hh0_; lane_v = lane; asm volatile("" : "+v"(r), "+v"(hh), "+v"(lane_v));
        const float av = mgv[0], cmx = mgv[1], bc = mgv[2], dploc = mgv[3], dnloc = mgv[4];
        asm volatile("s_waitcnt vmcnt(0)" ::: "memory");
        if (ch + 1 < 32) ml_issue(PR, PLs, b, h, sl, ch + 1, lane_v, bufaddr0 + ((ch + 1) & 1) * 28672);
        { const int chn = ch + 1 < 32 ? ch + 1 : 31; const float* mg = (const float*)(c.ws + WS_MG) + (size_t)(stream * 32 + chn) * 320;
          mgv[0] = mg[lane_v]; mgv[1] = mg[64 + lane_v]; mgv[2] = mg[128 + lane_v]; mgv[3] = mg[192 + lane_v]; mgv[4] = mg[256 + lane_v]; }
        LAS unsigned char* Kc = bufs + (ch & 1) * 28672; asm volatile("" : "+v"(Kc));
        LAS unsigned char* Pf = Kc + 20480 + lane_v * 16; asm volatile("" : "+v"(Pf));
        LAS unsigned char* Qc = Kc + 8192; LAS unsigned char* Vc = Kc + 16384;
        LAS unsigned char* vbase = Vc + (r >> 3) * 1024 + (r & 7) * 2 + hh * 64; asm volatile("" : "+v"(vbase));
        LAS unsigned char* kbase = Kc + (r >> 3) * 1024 + (r & 7) * 2 + hh * 64; asm volatile("" : "+v"(kbase));
        LAS unsigned char* krow = Kc + hh * 1024 + r * 16; asm volatile("" : "+v"(krow));
        LAS unsigned char* qrow = Qc + hh * 1024 + r * 16; asm volatile("" : "+v"(qrow));
        LAS unsigned char* qr4 = Qc + r * 16 + hh * 8; asm volatile("" : "+v"(qr4));
        LAS unsigned char* kn = Kc + (lane_v >> 3) * 1024 + (lane_v & 7) * 2; asm volatile("" : "+v"(kn));
        LAS unsigned char* qln = Qc + lane_v * 16; asm volatile("" : "+v"(qln));
        LAS float* a4b = a_l + 4 * hh; asm volatile("" : "+v"(a4b));
        const size_t t0 = (size_t)(b * SEQ + ch * 64);
        const float Mt = fmaxf(mprev, cmx);
        const float sct = __expf(mprev - Mt);
        const float fsc = __expf(cmx - Mt);
        const float M63 = __shfl(Mt, 63), bc63 = __shfl(bc, 63);
        const float wlast = __expf(av - M63) * 0.125f;
        const float sclast = __expf(mprev - M63);
        WAVE_FENCE();
        float qn = 0.f;
#pragma unroll
        for (int d8 = 0; d8 < 8; ++d8) { const f32x8 qv = unpack8(*(const LAS bf16x8*)(qln + d8 * 1024));
            const f32x4 n0 = *(const LAS f32x4*)(n_l + d8 * 8), n1 = *(const LAS f32x4*)(n_l + d8 * 8 + 4);
            qn += qv[0] * n0[0] + qv[1] * n0[1] + qv[2] * n0[2] + qv[3] * n0[3] + qv[4] * n1[0] + qv[5] * n1[1] + qv[6] * n1[2] + qv[7] * n1[3]; }
        a_l[lane] = fsc; w_l[lane] = wlast;
        WAVE_FENCE();
        bf16x8 Vb[4];
#pragma unroll
        for (int ks = 0; ks < 4; ++ks)
#pragma unroll
            for (int j = 0; j < 8; ++j) Vb[ks][j] = (short)*(const LAS bf16_t*)(vbase + (16 * ks + 8 * (j >> 2) + (j & 3)) * 16);
        f32x16 num[2];
#pragma unroll
        for (int nt = 0; nt < 2; ++nt) {
#pragma unroll
            for (int j = 0; j < 16; ++j) num[nt][j] = 0.f;
#pragma unroll
            for (int ks = 0; ks < 4; ++ks) num[nt] = MFMA32(*(const LAS bf16x8*)(Pf + (nt * 4 + ks) * 1024), Vb[ks], num[nt]);
        }
        const float den = fsc * dploc + sct * qn;
        const float inv = 1.f / fmaxf(fabsf(den), __expf(-(bc + Mt)));
        sc_l[lane] = sct; inv_l[lane] = inv;
        WAVE_FENCE();
        { bf16x8 Cb[4];
#pragma unroll
          for (int kd = 0; kd < 4; ++kd) Cb[kd] = pack16(C[kd >> 1], kd & 1);
#pragma unroll
          for (int mt = 0; mt < 2; ++mt) { f32x16 qc;
#pragma unroll
              for (int j = 0; j < 16; ++j) qc[j] = 0.f;
#pragma unroll
              for (int kd = 0; kd < 4; ++kd) { const LAS unsigned char* qr = qr4 + kd * 2048 + mt * 512;
                  const s16x4 lo = *(const LAS s16x4*)qr, hi = *(const LAS s16x4*)(qr + 1024);
                  const bf16x8 a = __builtin_shufflevector(lo, hi, 0, 1, 2, 3, 4, 5, 6, 7);
                  qc = MFMA32(a, Cb[kd], qc); }
#pragma unroll
              for (int g = 0; g < 4; ++g) { const f32x4 f4 = *(const LAS f32x4*)(a4b + mt * 32 + 8 * g), s4 = *(const LAS f32x4*)(a4b + 128 + mt * 32 + 8 * g), i4 = *(const LAS f32x4*)(a4b + 192 + mt * 32 + 8 * g);
#pragma unroll
                  for (int jj = 0; jj < 4; ++jj) { const int i = 4 * g + jj; const float hv = (f4[jj] * num[mt][i] + s4[jj] * qc[i]) * i4[jj];
                      yo[(t0 + mt * 32 + 8 * g + 4 * hh + jj) * 512 + h * 128 + sl * 32 + r] = f2bf(hv); } }
                } }
#pragma unroll
        for (int i = 0; i < 2; ++i) {
#pragma unroll
            for (int j = 0; j < 16; ++j) C[i][j] *= sclast;
#pragma unroll
            for (int ks = 0; ks < 4; ++ks) { const f32x4 wA = *(const LAS f32x4*)(a4b + 64 + 16 * ks), wB = *(const LAS f32x4*)(a4b + 64 + 16 * ks + 8);
                f32x8 kv;
#pragma unroll
                for (int j = 0; j < 8; ++j) kv[j] = bf2f(*(const LAS bf16_t*)(kbase + i * 4096 + (16 * ks + 8 * (j >> 2) + (j & 3)) * 16)) * (j < 4 ? wA[j & 3] : wB[j & 3]);
                C[i] = MFMA32(pack8v(kv), Vb[ks], C[i]); }
            }
        nst = sclast * nst + __expf(__shfl(cmx, 63) - M63) * dnloc; n_l[lane] = nst;
        mprev = bc63 + M63;
        asm volatile("s_waitcnt lgkmcnt(0)" ::: "memory");
    }
    float* co = c.out + O_MLC_P + ((size_t)(L * NB + b) * 4 + h) * 64 * 128;
#pragma unroll
    for (int i = 0; i < 2; ++i)
#pragma unroll
        for (int j = 0; j < 16; ++j) co[(size_t)(i * 32 + crow(j, hh)) * 128 + sl * 32 + r] = C[i][j];
    if (sl == 0) { c.out[O_MLN_P + ((size_t)(L * NB + b) * 4 + h) * 64 + lane] = nst; if (lane == 0) c.out[O_MLM_P + (size_t)(L * NB + b) * 4 + h] = mprev; }
}

DI void task_gdn_sample(const Ctx& c, int L, int unit) {
    const int q4 = unit & 3, h = (unit >> 2) & 3, b = unit >> 4, lane = c.lane, c32 = lane & 31, hh2 = lane >> 5;
    const int dv = q4 * 32 + c32;
    const size_t row = (size_t)(MP + b);
    const bf16_t* pr = c.R1 + row * NPROJ;
    const float* cbuf = c.in[4] + ((size_t)L * MS + b) * 3 * 1536;
    const float* cw = c.in[23] + (size_t)L * 4 * 1536;
    float* cout = c.out + O_CONV_S + ((size_t)L * MS + b) * 3 * 1536;
    float qv[2], kv[2], vv;
#pragma unroll
    for (int w = 0; w < 5; ++w) {
        const int which = w < 2 ? 0 : w < 4 ? 1 : 2; const int d = (w == 4) ? dv : lane + 64 * (w & 1);
        const int cc = which * 512 + h * 128 + d;
        const float xin = bf2f(pr[PQ + cc]);
        const float b0 = cbuf[cc], b1 = cbuf[1536 + cc], b2 = cbuf[3072 + cc];
        float a = b0 * cw[cc] + b1 * cw[1536 + cc] + b2 * cw[3072 + cc] + xin * cw[4608 + cc];
        a = silu_(a);
        cout[cc] = b1; cout[1536 + cc] = b2; cout[3072 + cc] = xin;
        if (w < 2) qv[w] = a; else if (w < 4) kv[w - 2] = a; else vv = a;
    }
    { const float sq = wave_sum(qv[0] * qv[0] + qv[1] * qv[1]), sk = wave_sum(kv[0] * kv[0] + kv[1] * kv[1]);
      const float fq = rsqrtf(sq + EPS) * 0.08838834764831845f, fk = rsqrtf(sk + EPS);
      qv[0] *= fq; qv[1] *= fq; kv[0] *= fk; kv[1] *= fk; }
    const float qk = wave_sum(qv[0] * kv[0] + qv[1] * kv[1]);
    const float beta = sigm(c.SG[row * 16 + h]);
    const float g = -expf(c.in[24][L * 4 + h]) * softplus_(c.SG[row * 16 + 4 + h] + c.in[25][L * 4 + h]);
    const float eg = expf(g);
    const size_t soff = (((size_t)L * MS + b) * 4 + h) * 128 * 128 + (size_t)(hh2 * 64) * 128 + dv;
    const float* sin_ = c.in[5] + soff; float* sout = c.out + O_GDN_S + soff;
    float sreg[64];
#pragma unroll
    for (int d = 0; d < 64; ++d) sreg[d] = sin_[(size_t)d * 128];
    float kS = 0.f, qS = 0.f;
#pragma unroll
    for (int d = 0; d < 64; ++d) { const float ka = __shfl(kv[0], d), kb = __shfl(kv[1], d), qa = __shfl(qv[0], d), qb2 = __shfl(qv[1], d);
        kS += (hh2 ? kb : ka) * sreg[d]; qS += (hh2 ? qb2 : qa) * sreg[d]; }
    kS += __shfl_xor(kS, 32); qS += __shfl_xor(qS, 32);
    const float vnew = beta * (vv - eg * kS);
    const float o = eg * qS + qk * vnew;
#pragma unroll
    for (int d = 0; d < 64; ++d) { const float ka = __shfl(kv[0], d), kb = __shfl(kv[1], d); sout[(size_t)d * 128] = sreg[d] * eg + (hh2 ? kb : ka) * vnew; }
    if (hh2 == 0) c.Y3[(size_t)1 * MPAD * 512 + row * 512 + h * 128 + dv] = f2bf(o);
}
DI void task_ml_sample(const Ctx& c, int L, int unit) {
    const int half = unit & 1, h = (unit >> 1) & 3, b = unit >> 3, lane = c.lane;
    const size_t row = (size_t)(MP + b);
    const bf16_t* pr = c.R1 + row * NPROJ;
    const float q = bf2f(pr[PMQ + h * 64 + lane]), k = bf2f(pr[PMK + h * 64 + lane]) * 0.125f, v = bf2f(pr[PMV + h * 128 + half * 64 + lane]);
    const float li = softcap_(c.SG[row * 16 + 8 + h] + c.in[27][L * 4 + h]);
    const float lf = logsig_(softcap_(c.SG[row * 16 + 12 + h] + c.in[28][L * 4 + h]));
    const size_t sidx = ((size_t)L * MS + b) * 4 + h;
    const float m0 = c.in[8][sidx];
    const float mt = fmaxf(lf + m0, li), wts = expf(li - mt), sc = expf(lf + m0 - mt);
    const float n0 = c.in[7][sidx * 64 + lane];
    const float sqk = wave_sum(q * k) * wts, qn = wave_sum(q * n0);
    const float* cin = c.in[6] + sidx * 64 * 128 + half * 64 + lane;
    float* cout = c.out + O_MLC_S + sidx * 64 * 128 + half * 64 + lane;
    float cc[64]; float qC = 0.f;
#pragma unroll
    for (int d = 0; d < 64; ++d) { cc[d] = cin[(size_t)d * 128]; qC += __shfl(q, d) * cc[d]; }
    const float num = sqk * v + sc * qC, den = sqk + sc * qn;
    const float hv = num / fmaxf(fabsf(den), expf(-mt));
#pragma unroll
    for (int d = 0; d < 64; ++d) cout[(size_t)d * 128] = sc * cc[d] + wts * __shfl(k, d) * v;
    if (half == 0) { c.out[O_MLN_S + sidx * 64 + lane] = sc * n0 + wts * k; if (lane == 0) c.out[O_MLM_S + sidx] = mt; }
    c.Y3[(size_t)2 * MPAD * 512 + row * 512 + h * 128 + half * 64 + lane] = f2bf(hv);
}
struct S5P { float lr, li; f32x2 bb[16]; };
DI S5P s5_params(const Ctx& c, int L, int g, int p) {
    S5P P; const size_t gp = ((size_t)L * 32 + g) * 64 + p;
    const float are = c.in[13][gp], aim = c.in[14][gp], dt = expf(c.in[15][L * 32 + g]);
    const float mag = expf(are * dt); P.lr = mag * cosf(aim * dt); P.li = mag * sinf(aim * dt);
    const float inv = 1.f / (are * are + aim * aim), zr = P.lr - 1.f, zi = P.li;
    const float fre = (zr * are + zi * aim) * inv, fim = (zi * are - zr * aim) * inv;
    const float* Bre = c.in[16] + gp * 16; const float* Bim = c.in[17] + gp * 16;
#pragma unroll
    for (int q4 = 0; q4 < 4; ++q4) { const f32x4 br = *(const f32x4*)(Bre + 4 * q4), bi = *(const f32x4*)(Bim + 4 * q4);
#pragma unroll
        for (int e = 0; e < 4; ++e) { P.bb[4 * q4 + e][0] = fre * br[e] - fim * bi[e]; P.bb[4 * q4 + e][1] = fre * bi[e] + fim * br[e]; } }
    return P;
}
DI void task_s5_sample(const Ctx& c, int L, int unit) {
    const int g = unit & 31, b = unit >> 5, lane = c.lane;
    const S5P P = s5_params(c, L, g, lane);
    const size_t row = (size_t)(MP + b);
    const bf16_t* pr = c.R1 + row * NPROJ + PU + g * 16;
    float u[16];
    { const f32x8 u0 = unpack8(*(const bf16x8*)pr), u1 = unpack8(*(const bf16x8*)(pr + 8));
#pragma unroll
      for (int e = 0; e < 8; ++e) { u[e] = u0[e]; u[8 + e] = u1[e]; } }
    f32x2 bu = {0.f, 0.f};
#pragma unroll
    for (int cc = 0; cc < 16; ++cc) bu += P.bb[cc] * u[cc];
    const size_t si = (((size_t)L * MS + b) * 32 + g) * 64 + lane;
    const float h0r = c.in[2][si], h0i = c.in[3][si];
    const float hr = P.lr * h0r - P.li * h0i + bu[0], hi = P.lr * h0i + P.li * h0r + bu[1];
    c.out[O_S5RE_S + si] = hr; c.out[O_S5IM_S + si] = hi;
    const float* Cre = c.in[18] + ((size_t)L * 32 + g) * 16 * 64; const float* Cim = c.in[19] + ((size_t)L * 32 + g) * 16 * 64;
    float ya[16];
#pragma unroll
    for (int cc = 0; cc < 16; ++cc) ya[cc] = hr * Cre[cc * 64 + lane] - hi * Cim[cc * 64 + lane];
    butterfly16(ya, lane);
    if ((lane & 3) == 0) { const int cc = bsel16(lane); const float y = ya[0] + c.in[20][L * 512 + g * 16 + cc] * bf2f(pr[cc]);
        c.YS5[row * 512 + g * 16 + cc] = f2bf(gelu_t(y)); }
}

DI void task_s5_wave(const Ctx& c, int L, int unit, unsigned char* wlds  ) {
    LAS float* Uw = (LAS float*)wlds;
    LAS bf16_t* Hw = (LAS bf16_t*)(wlds + 4096);
    const int lane = c.lane;
    const int g = unit & 31, b = unit >> 5;
    const S5P P = s5_params(c, L, g, lane);
    const size_t rbase = (size_t)(b * SEQ);
    const bf16_t* ub = c.R1 + rbase * NPROJ + PU + g * 16;
    bf16x8 Cb[4];
    { const int cc = lane & 15, kq = (lane >> 4) * 8; const float* Cre = c.in[18] + (((size_t)L * 32 + g) * 16 + cc) * 64; const float* Cim = c.in[19] + (((size_t)L * 32 + g) * 16 + cc) * 64;
#pragma unroll
      for (int ks = 0; ks < 4; ++ks) { f32x8 v;
#pragma unroll
          for (int j = 0; j < 8; ++j) { const int k = ks * 32 + kq + j; v[j] = (k < 64) ? Cre[k] : -Cim[k - 64]; }
          Cb[ks] = pack8v(v); } }
    const float dskip = c.in[20][L * 512 + g * 16 + (lane & 15)];
    float hr = 0.f, hi = 0.f;
    for (int sub = 0; sub < 32; ++sub) {
        WAVE_FENCE();
        { const bf16_t* up = ub + (size_t)(sub * 64 + lane) * NPROJ; const f32x8 u0 = unpack8(*(const bf16x8*)up), u1 = unpack8(*(const bf16x8*)(up + 8));
          LAS f32x4* d = (LAS f32x4*)(Uw + lane * 16);
          d[0] = (f32x4){u0[0], u0[1], u0[2], u0[3]}; d[1] = (f32x4){u0[4], u0[5], u0[6], u0[7]}; d[2] = (f32x4){u1[0], u1[1], u1[2], u1[3]}; d[3] = (f32x4){u1[4], u1[5], u1[6], u1[7]}; }
        WAVE_FENCE();
        for (int blk = 0; blk < 4; ++blk) {
#pragma unroll 4
            for (int st = 0; st < 16; ++st) {
                const LAS f32x4* up4 = (const LAS f32x4*)(Uw + (blk * 16 + st) * 16);
                f32x2 bu = {0.f, 0.f};
#pragma unroll
                for (int q4 = 0; q4 < 4; ++q4) { const f32x4 uv = up4[q4];
#pragma unroll
                    for (int e = 0; e < 4; ++e) bu += P.bb[4 * q4 + e] * uv[e]; }
                const float nr = P.lr * hr - P.li * hi + bu[0], ni = P.lr * hi + P.li * hr + bu[1]; hr = nr; hi = ni;
                Hw[st * 128 + lane] = f2bf(hr); Hw[st * 128 + 64 + lane] = f2bf(hi);
            }
            WAVE_FENCE();
            f32x4 acc = {0.f, 0.f, 0.f, 0.f};
#pragma unroll
            for (int ks = 0; ks < 4; ++ks) { const bf16x8 a = *(const LAS bf16x8*)(Hw + (lane & 15) * 128 + ks * 32 + (lane >> 4) * 8); acc = MFMA16(a, Cb[ks], acc); }
            const int cc = lane & 15;
#pragma unroll
            for (int j = 0; j < 4; ++j) { const int st = (lane >> 4) * 4 + j; const int tl = blk * 16 + st;
                const float y = acc[j] + dskip * Uw[tl * 16 + cc];
                c.YS5[(rbase + sub * 64 + tl) * 512 + g * 16 + cc] = f2bf(gelu_t(y)); }
            WAVE_FENCE();
        }
    }
    { const size_t si = (((size_t)L * NB + b) * 32 + g) * 64 + lane; c.out[O_S5RE_P + si] = hr; c.out[O_S5IM_P + si] = hi; }
}

constexpr int S5Q_BASE = 122880, S5Q_F = S5Q_BASE + 32768, S5Q_FLAG = S5Q_F + 2048;
template <int PASS> DI void s5_steps16(const S5P& P, const LAS float* Ublk, LAS bf16_t* Hw, int lane, float& hr, float& hi) {
#pragma unroll
    for (int s4 = 0; s4 < 4; ++s4) {
        f32x4 uv[4][4];
#pragma unroll
        for (int j = 0; j < 4; ++j)
#pragma unroll
            for (int q4 = 0; q4 < 4; ++q4) uv[j][q4] = *(const LAS f32x4*)(Ublk + (s4 * 4 + j) * 16 + q4 * 4);
        asm volatile("" ::: "memory");
        f32x2 bu[4];
#pragma unroll
        for (int j = 0; j < 4; ++j) { f32x2 acc[4];
#pragma unroll
            for (int q4 = 0; q4 < 4; ++q4) { acc[q4] = P.bb[4 * q4] * uv[j][q4][0];
#pragma unroll
                for (int e = 1; e < 4; ++e) acc[q4] += P.bb[4 * q4 + e] * uv[j][q4][e]; }
            bu[j] = (acc[0] + acc[1]) + (acc[2] + acc[3]); }
#pragma unroll
        for (int j = 0; j < 4; ++j) { const float nr = P.lr * hr - P.li * hi + bu[j][0], ni = P.lr * hi + P.li * hr + bu[j][1]; hr = nr; hi = ni;
            if (PASS == 1) { Hw[(s4 * 4 + j) * 128 + lane] = f2bf(hr); Hw[(s4 * 4 + j) * 128 + 64 + lane] = f2bf(hi); } }
    }
}
DI void task_s5_quad(const Ctx& c, int L, int unit, int wq, int gen) {
    unsigned char* wlds = c.lds + S5Q_BASE + wq * 8192;
    LAS float* Uw = (LAS float*)wlds;
    LAS bf16_t* Hw = (LAS bf16_t*)(wlds + 4096);
    LAS float* F = (LAS float*)(c.lds + S5Q_F);
    volatile LAS int* flag = (volatile LAS int*)(c.lds + S5Q_FLAG);
    const int lane = c.lane;
    const int g = unit & 31, b = unit >> 5;
    const S5P P = s5_params(c, L, g, lane);
    float pr_ = P.lr, pi_ = P.li;
#pragma unroll
    for (int i = 0; i < 9; ++i) { const float nr = pr_ * pr_ - pi_ * pi_, ni = 2.f * pr_ * pi_; pr_ = nr; pi_ = ni; }
    const size_t rbase = (size_t)(b * SEQ + wq * 512);
    const bf16_t* ub = c.R1 + rbase * NPROJ + PU + g * 16;
    bf16x8 Cb[4];
    { const int cc = lane & 15, kq = (lane >> 4) * 8; const float* Cre = c.in[18] + (((size_t)L * 32 + g) * 16 + cc) * 64; const float* Cim = c.in[19] + (((size_t)L * 32 + g) * 16 + cc) * 64;
#pragma unroll
      for (int ks = 0; ks < 4; ++ks) { f32x8 v;
#pragma unroll
          for (int j = 0; j < 8; ++j) { const int k = ks * 32 + kq + j; v[j] = (k < 64) ? Cre[k] : -Cim[k - 64]; }
          Cb[ks] = pack8v(v); } }
    const float dskip = c.in[20][L * 512 + g * 16 + (lane & 15)];
    float hr = 0.f, hi = 0.f;
    for (int pass = 0; pass < 2; ++pass) {
        if (pass == 1) {
            hr = 0.f; hi = 0.f;
            for (int v = 0; v < wq; ++v) { while (flag[v] != gen) __builtin_amdgcn_s_sleep(2);
                asm volatile("" ::: "memory");
                const float fr = F[v * 128 + lane], fi = F[v * 128 + 64 + lane];
                const float nr = pr_ * hr - pi_ * hi + fr, ni = pr_ * hi + pi_ * hr + fi; hr = nr; hi = ni; }
        }
        for (int sub = 0; sub < 8; ++sub) {
            WAVE_FENCE();
            { const bf16_t* up = ub + (size_t)(sub * 64 + lane) * NPROJ; const f32x8 u0 = unpack8(*(const bf16x8*)up), u1 = unpack8(*(const bf16x8*)(up + 8));
              LAS f32x4* d = (LAS f32x4*)(Uw + lane * 16);
              d[0] = (f32x4){u0[0], u0[1], u0[2], u0[3]}; d[1] = (f32x4){u0[4], u0[5], u0[6], u0[7]}; d[2] = (f32x4){u1[0], u1[1], u1[2], u1[3]}; d[3] = (f32x4){u1[4], u1[5], u1[6], u1[7]}; }
            WAVE_FENCE();
            for (int blk = 0; blk < 4; ++blk) {
                if (pass == 1) s5_steps16<1>(P, Uw + blk * 256, Hw, lane, hr, hi); else s5_steps16<0>(P, Uw + blk * 256, Hw, lane, hr, hi);
                if (pass == 1) {
                    WAVE_FENCE();
                    f32x4 acc = {0.f, 0.f, 0.f, 0.f};
#pragma unroll
                    for (int ks = 0; ks < 4; ++ks) { const bf16x8 a = *(const LAS bf16x8*)(Hw + (lane & 15) * 128 + ks * 32 + (lane >> 4) * 8); acc = MFMA16(a, Cb[ks], acc); }
                    const int cc = lane & 15;
#pragma unroll
                    for (int j = 0; j < 4; ++j) { const int st = (lane >> 4) * 4 + j; const int tl = blk * 16 + st;
                        const float y = acc[j] + dskip * Uw[tl * 16 + cc];
                        c.YS5[(rbase + sub * 64 + tl) * 512 + g * 16 + cc] = f2bf(gelu_t(y)); }
                    WAVE_FENCE();
                }
            }
        }
        if (pass == 0) {
            if (wq < 3) { F[wq * 128 + lane] = hr; F[wq * 128 + 64 + lane] = hi; WAVE_FENCE(); if (lane == 0) flag[wq] = gen; }
        }
    }
    if (wq == 3) { const size_t si = (((size_t)L * NB + b) * 32 + g) * 64 + lane; c.out[O_S5RE_P + si] = hr; c.out[O_S5IM_P + si] = hi; }
}

DI void phase_s5_scan(const Ctx& c, int L) {
    float* U = (float*)c.lds;
    bf16_t* H = (bf16_t*)(c.lds + 32768);
    float* F = (float*)(c.lds + 65536);
    const int lane = c.lane, w = c.wave;
    float* Uw = U + w * 1024; bf16_t* Hw = H + w * 2048;
    for (int unit = c.bid; unit < 256; unit += c.G) {
        const int g = unit & 31, b = unit >> 5;
        const S5P P = s5_params(c, L, g, lane);
        float pr_ = P.lr, pi_ = P.li;
#pragma unroll
        for (int i = 0; i < 8; ++i) { const float nr = pr_ * pr_ - pi_ * pi_, ni = 2.f * pr_ * pi_; pr_ = nr; pi_ = ni; }
        const size_t rbase = (size_t)(b * SEQ + w * 256);
        const bf16_t* ub = c.R1 + rbase * NPROJ + PU + g * 16;
        bf16x8 Cb[4];
        { const int cc = lane & 15, kq = (lane >> 4) * 8; const float* Cre = c.in[18] + (((size_t)L * 32 + g) * 16 + cc) * 64; const float* Cim = c.in[19] + (((size_t)L * 32 + g) * 16 + cc) * 64;
#pragma unroll
          for (int ks = 0; ks < 4; ++ks) { f32x8 v;
#pragma unroll
              for (int j = 0; j < 8; ++j) { const int k = ks * 32 + kq + j; v[j] = (k < 64) ? Cre[k] : -Cim[k - 64]; }
              Cb[ks] = pack8v(v); } }
        const float dskip = c.in[20][L * 512 + g * 16 + (lane & 15)];
        float hr = 0.f, hi = 0.f;
        for (int pass = 0; pass < 2; ++pass) {
            if (pass == 1) {
                F[w * 128 + lane] = hr; F[w * 128 + 64 + lane] = hi;
                __syncthreads();
                hr = 0.f; hi = 0.f;
                for (int v = 0; v < w; ++v) { const float fr = F[v * 128 + lane], fi = F[v * 128 + 64 + lane];
                    const float nr = pr_ * hr - pi_ * hi + fr, ni = pr_ * hi + pi_ * hr + fi; hr = nr; hi = ni; }
            }
            for (int sub = 0; sub < 4; ++sub) {
                __syncthreads();
                { const bf16_t* up = ub + (size_t)(sub * 64 + lane) * NPROJ; const f32x8 u0 = unpack8(*(const bf16x8*)up), u1 = unpack8(*(const bf16x8*)(up + 8));
                  f32x4* d = (f32x4*)(Uw + lane * 16);
                  d[0] = (f32x4){u0[0], u0[1], u0[2], u0[3]}; d[1] = (f32x4){u0[4], u0[5], u0[6], u0[7]}; d[2] = (f32x4){u1[0], u1[1], u1[2], u1[3]}; d[3] = (f32x4){u1[4], u1[5], u1[6], u1[7]}; }
                __syncthreads();
                for (int blk = 0; blk < 4; ++blk) {
#pragma unroll 4
                    for (int st = 0; st < 16; ++st) {
                        const f32x4* up4 = (const f32x4*)(Uw + (blk * 16 + st) * 16);
                        f32x2 bu = {0.f, 0.f};
#pragma unroll
                        for (int q4 = 0; q4 < 4; ++q4) { const f32x4 uv = up4[q4];
#pragma unroll
                            for (int e = 0; e < 4; ++e) bu += P.bb[4 * q4 + e] * uv[e]; }
                        const float nr = P.lr * hr - P.li * hi + bu[0], ni = P.lr * hi + P.li * hr + bu[1]; hr = nr; hi = ni;
                        if (pass == 1) { Hw[st * 128 + lane] = f2bf(hr); Hw[st * 128 + 64 + lane] = f2bf(hi); }
                    }
                    if (pass == 1) {
                        __syncthreads();
                        f32x4 acc = {0.f, 0.f, 0.f, 0.f};
#pragma unroll
                        for (int ks = 0; ks < 4; ++ks) { const bf16x8 a = *(const bf16x8*)(Hw + (lane & 15) * 128 + ks * 32 + (lane >> 4) * 8); acc = MFMA16(a, Cb[ks], acc); }
                        const int cc = lane & 15;
#pragma unroll
                        for (int j = 0; j < 4; ++j) { const int st = (lane >> 4) * 4 + j; const int tl = blk * 16 + st;
                            const float y = acc[j] + dskip * Uw[tl * 16 + cc];
                            c.YS5[(rbase + sub * 64 + tl) * 512 + g * 16 + cc] = f2bf(gelu_t(y)); }
                        __syncthreads();
                    }
                }
            }
        }
        if (w == 7) { const size_t si = (((size_t)L * NB + b) * 32 + g) * 64 + lane; c.out[O_S5RE_P + si] = hr; c.out[O_S5IM_P + si] = hi; }
        __syncthreads();
    }
}


#ifdef SELFCHK
DI void blk_reduce2(float& a, float& b, float* red, int tid) {
    a = wave_sum(a); b = wave_sum(b);
    __syncthreads();
    if ((tid & 63) == 0) { red[tid >> 6] = a; red[8 + (tid >> 6)] = b; }
    __syncthreads();
    float x = 0.f, y = 0.f;
    for (int i = 0; i < 8; ++i) { x += red[i]; y += red[8 + i]; }
    a = x; b = y; __syncthreads();
}
DI void chk_gdn(const Ctx& c, int L, int b, int h, float* dg) {
    float* q = (float*)c.lds; float* k = q + 128; float* v = k + 128; float* part = v + 128; float* red = part + 512; float* sc_ = red + 16;
    const int tid = c.tid, dv = tid & 127, qt = tid >> 7;
    const float* convw = c.in[23] + (size_t)L * 4 * 1536;
    float S[32];
#pragma unroll
    for (int i = 0; i < 32; ++i) S[i] = 0.f;
    float e2 = 0.f, r2 = 0.f;
    for (int t = 0; t < SEQ; ++t) {
        const size_t row = (size_t)b * SEQ + t;
        if (tid < 384) { const int which = tid >> 7, d = tid & 127; float a = 0.f;
            for (int j = 0; j < 4; ++j) { const int tt = t + j - 3; if (tt >= 0) a += bf2f(c.R1[((size_t)b * SEQ + tt) * NPROJ + PQ + which * 512 + h * 128 + d]) * convw[j * 1536 + which * 512 + h * 128 + d]; }
            (which == 0 ? q : which == 1 ? k : v)[d] = silu_(a); }
        __syncthreads();
        float sq = 0.f, sk = 0.f;
        for (int d = 0; d < 128; ++d) { sq += q[d] * q[d]; sk += k[d] * k[d]; }
        const float fq = rsqrtf(sq + EPS) * 0.08838834764831845f, fk = rsqrtf(sk + EPS);
        const float beta = sigm(c.SG[row * 16 + h]);
        const float g = -expf(c.in[24][L * 4 + h]) * softplus_(c.SG[row * 16 + 4 + h] + c.in[25][L * 4 + h]);
        const float eg = expf(g);
        float ks = 0.f;
#pragma unroll
        for (int i = 0; i < 32; ++i) { S[i] *= eg; ks += k[qt * 32 + i] * fk * S[i]; }
        part[qt * 128 + dv] = ks;
        __syncthreads();
        const float kS = part[dv] + part[128 + dv] + part[256 + dv] + part[384 + dv];
        const float vnew = beta * (v[dv] - kS);
        float qs = 0.f;
#pragma unroll
        for (int i = 0; i < 32; ++i) { S[i] += k[qt * 32 + i] * fk * vnew; qs += q[qt * 32 + i] * fq * S[i]; }
        __syncthreads();
        part[qt * 128 + dv] = qs;
        __syncthreads();
        if (qt == 0) { const float o = part[dv] + part[128 + dv] + part[256 + dv] + part[384 + dv];
            const float got = bf2f(c.Y3[(size_t)1 * MPAD * 512 + row * 512 + h * 128 + dv]); e2 += (got - o) * (got - o); r2 += o * o; }
        __syncthreads();
    }
    blk_reduce2(e2, r2, red, tid);
    if (tid == 0) dg[0] = sqrtf(e2 / (r2 + 1e-30f));
    float e3 = 0.f, r3 = 0.f;
#pragma unroll
    for (int i = 0; i < 32; ++i) { const float got = c.out[O_GDN_P + (((size_t)L * NB + b) * 4 + h) * 16384 + (size_t)(qt * 32 + i) * 128 + dv]; e3 += (got - S[i]) * (got - S[i]); r3 += S[i] * S[i]; }
    blk_reduce2(e3, r3, red, tid);
    if (tid == 0) dg[1] = sqrtf(e3 / (r3 + 1e-30f));
    (void)sc_;
}
DI void chk_ml(const Ctx& c, int L, int b, int h, float* dg) {
    float* q = (float*)c.lds; float* k = q + 64; float* v = k + 64; float* n = v + 128; float* part = n + 64; float* red = part + 512;
    const int tid = c.tid, e = tid & 127, qt = tid >> 7;
    float C[16];
#pragma unroll
    for (int i = 0; i < 16; ++i) C[i] = 0.f;
    if (tid < 64) n[tid] = 0.f;
    float m = 0.f, e2 = 0.f, r2 = 0.f;
    __syncthreads();
    for (int t = 0; t < SEQ; ++t) {
        const size_t row = (size_t)b * SEQ + t;
        if (tid < 64) { q[tid] = bf2f(c.R1[row * NPROJ + PMQ + h * 64 + tid]); k[tid] = bf2f(c.R1[row * NPROJ + PMK + h * 64 + tid]) * 0.125f; }
        else if (tid < 192) v[tid - 64] = bf2f(c.R1[row * NPROJ + PMV + h * 128 + tid - 64]);
        __syncthreads();
        const float li = softcap_(c.SG[row * 16 + 8 + h] + c.in[27][L * 4 + h]);
        const float lf = logsig_(softcap_(c.SG[row * 16 + 12 + h] + c.in[28][L * 4 + h]));
        const float mn = fmaxf(lf + m, li), wts = expf(li - mn), sc = expf(lf + m - mn);
        float qk = 0.f, qn = 0.f;
        for (int d = 0; d < 64; ++d) { qk += q[d] * k[d]; qn += q[d] * n[d]; }
        float pc = 0.f;
#pragma unroll
        for (int i = 0; i < 16; ++i) pc += q[qt * 16 + i] * C[i];
        part[qt * 128 + e] = pc;
        __syncthreads();
        const float qC = part[e] + part[128 + e] + part[256 + e] + part[384 + e];
        const float sqk = qk * wts, num = sqk * v[e] + sc * qC, den = sqk + sc * qn;
        const float hv = num / fmaxf(fabsf(den), expf(-mn));
        if (qt == 0) { const float got = bf2f(c.Y3[(size_t)2 * MPAD * 512 + row * 512 + h * 128 + e]); e2 += (got - hv) * (got - hv); r2 += hv * hv; }
#pragma unroll
        for (int i = 0; i < 16; ++i) C[i] = sc * C[i] + wts * k[qt * 16 + i] * v[e];
        __syncthreads();
        if (tid < 64) n[tid] = sc * n[tid] + wts * k[tid];
        m = mn;
        __syncthreads();
    }
    blk_reduce2(e2, r2, red, tid);
    if (tid == 0) dg[2] = sqrtf(e2 / (r2 + 1e-30f));
    float e3 = 0.f, r3 = 0.f;
#pragma unroll
    for (int i = 0; i < 16; ++i) { const float got = c.out[O_MLC_P + (((size_t)L * NB + b) * 4 + h) * 8192 + (size_t)(qt * 16 + i) * 128 + e]; e3 += (got - C[i]) * (got - C[i]); r3 += C[i] * C[i]; }
    if (tid < 64) { const float got = c.out[O_MLN_P + (((size_t)L * NB + b) * 4 + h) * 64 + tid]; e3 += (got - n[tid]) * (got - n[tid]) * 64.f; r3 += n[tid] * n[tid] * 64.f; }
    if (tid == 0) { const float got = c.out[O_MLM_P + ((size_t)L * NB + b) * 4 + h]; e3 += (got - m) * (got - m) * 4096.f; r3 += m * m * 4096.f; }
    blk_reduce2(e3, r3, red, tid);
    if (tid == 0) dg[3] = sqrtf(e3 / (r3 + 1e-30f));
}
DI void chk_s5(const Ctx& c, int L, int b, int g, float* dg) {
    float* red = (float*)c.lds;
    float e2 = 0.f, r2 = 0.f, e3 = 0.f, r3 = 0.f;
    if (c.tid < 64) { const int lane = c.tid; const S5P P = s5_params(c, L, g, lane);
        const float* Cre = c.in[18] + ((size_t)L * 32 + g) * 16 * 64; const float* Cim = c.in[19] + ((size_t)L * 32 + g) * 16 * 64;
        float hr = 0.f, hi = 0.f;
        for (int t = 0; t < SEQ; ++t) { const size_t row = (size_t)b * SEQ + t; const bf16_t* pr = c.R1 + row * NPROJ + PU + g * 16;
            f32x2 bu = {0.f, 0.f};
#pragma unroll
            for (int cc = 0; cc < 16; ++cc) bu += P.bb[cc] * bf2f(pr[cc]);
            const float nr = P.lr * hr - P.li * hi + bu[0], ni = P.lr * hi + P.li * hr + bu[1]; hr = nr; hi = ni;
            for (int cc = 0; cc < 16; ++cc) { float y = wave_sum(hr * Cre[cc * 64 + lane] - hi * Cim[cc * 64 + lane]) + c.in[20][L * 512 + g * 16 + cc] * bf2f(pr[cc]);
                y = gelu_t(y); const float got = bf2f(c.YS5[row * 512 + g * 16 + cc]); if (lane == 0) { e2 += (got - y) * (got - y); r2 += y * y; } } }
        const size_t si = (((size_t)L * NB + b) * 32 + g) * 64 + lane;
        e3 = (c.out[O_S5RE_P + si] - hr) * (c.out[O_S5RE_P + si] - hr) + (c.out[O_S5IM_P + si] - hi) * (c.out[O_S5IM_P + si] - hi); r3 = hr * hr + hi * hi; }
    blk_reduce2(e2, r2, red, c.tid);
    blk_reduce2(e3, r3, red, c.tid);
    if (c.tid == 0) { dg[4] = sqrtf(e2 / (r2 + 1e-30f)); dg[5] = sqrtf(e3 / (r3 + 1e-30f)); }
}
#endif


#ifdef SELFCHK
DI float dot_bf(const bf16_t* a, const bf16_t* b, int K) { float s = 0.f; for (int k = 0; k < K; ++k) s += bf2f(a[k]) * bf2f(b[k]); return s; }
DI void chk_gemm(const Ctx& c, int L, int mode, float* dgp) {
    float* red = (float*)c.lds;
    float e2 = 0.f, r2 = 0.f;
    for (int rep = 0; rep < 2; ++rep) {
        const int sidx = c.tid + 512 * rep;
        const int row = (rep == 1 && c.tid < 64) ? MP + (c.tid * 2) : (int)(((unsigned)sidx * 7919u) % (unsigned)MP);
        float want = 0.f, got = 0.f;
        if (mode == 0) { const int col = (int)(((unsigned)sidx * 104729u) % 4096u); want = dot_bf(c.XN + (size_t)row * 1024, c.W + WO_IN + (size_t)col * 1024, 1024); got = bf2f(c.R1[(size_t)row * 4096 + col]); }
        if (mode == 1) { const int col = (int)(((unsigned)sidx * 104729u) % 3072u); want = sigm(dot_bf(c.XN + (size_t)row * 1024, c.W + WO_G + (size_t)col * 1024, 1024)); got = bf2f(c.R1[(size_t)row * 4096 + col]); }
        if (mode == 2) { const int col = (int)(((unsigned)sidx * 104729u) % 512u); const float y = bf2f(c.YS5[(size_t)row * 512 + col]);
            want = y * sigm(dot_bf(c.YS5 + (size_t)row * 512, c.W + WO_GLU + (size_t)col * 512, 512) + c.in[22][L * 512 + col]); got = bf2f(c.Y3[(size_t)row * 512 + col]); }
        if (mode == 3) { const int col = (int)(((unsigned)sidx * 104729u) % 1024u);
            for (int br = 0; br < 3; ++br) want += bf2f(c.R1[(size_t)row * 4096 + br * 1024 + col]) * dot_bf(c.Y3 + (size_t)br * MPAD * 512 + (size_t)row * 512, c.W + WO_BR + (size_t)br * 1024 * 512 + (size_t)col * 512, 512);
            got = bf2f(c.XN[(size_t)row * 1024 + col]); }
        if (mode == 4) { const int col = (int)(((unsigned)sidx * 104729u) % 4096u); const float d = fmaxf(dot_bf(c.XN + (size_t)row * 1024, c.W + WO_UP + (size_t)col * 1024, 1024), 0.f); want = d * d; got = bf2f(c.R1[(size_t)row * 4096 + col]); }
        if (mode == 5) { const int col = (int)(((unsigned)sidx * 104729u) % 1024u); want = dot_bf(c.Y3 + (size_t)row * 256, c.W + WO_PLE + (size_t)col * 256, 256); got = bf2f(c.Y3[(size_t)MPAD * 256 + (size_t)row * 1024 + col]); }
        e2 += (got - want) * (got - want); r2 += want * want;
    }
    blk_reduce2(e2, r2, red, c.tid);
    if (c.tid == 0) *dgp = sqrtf(e2 / (r2 + 1e-30f));
}
#endif

#ifdef SELFCHK
DI void chk_sg(const Ctx& c, float* dgp) {
    float* red = (float*)c.lds; float e2 = 0.f, r2 = 0.f;
    { const int sidx = c.tid >> 4, s = c.tid & 15; const int row = (sidx < 8) ? MP + sidx * 13 : (int)(((unsigned)sidx * 7919u * 37u) % (unsigned)MP);
      const float* x = row < MP ? c.in[0] + (size_t)row * 1024 : c.in[1] + (size_t)(row - MP) * 1024;
      const int sc = s < 4 ? 2560 + s : s < 8 ? 2564 + (s - 4) : s < 12 ? 4104 + (s - 8) : 4108 + (s - 12);
      float ss = 0.f; for (int k = 0; k < 1024; ++k) ss += x[k] * x[k];
      const float rs = rsqrtf(ss * (1.f / 1024.f) + EPS); float a = 0.f;
      for (int k = 0; k < 1024; ++k) a += x[k] * rs * c.in[11][k] * c.in[12][(size_t)k * DIN + sc];
      const float got = c.SG[(size_t)row * 16 + s]; e2 = (got - a) * (got - a); r2 = a * a; }
    blk_reduce2(e2, r2, red, c.tid);
    if (c.tid == 0) *dgp = sqrtf(e2 / (r2 + 1e-30f));
}
DI void chk_post(const Ctx& c, int L, float* dgp) {
    float* red = (float*)c.lds; float e2 = 0.f, r2 = 0.f;
    { const int hd8 = c.tid & 7, sidx = c.tid >> 3; const int row = (sidx < 8) ? MP + sidx * 11 : (int)(((unsigned)sidx * 7919u * 53u) % (unsigned)MP);
      const int br = hd8 >> 2, hd = hd8 & 3; float ms = 0.f;
      for (int e = 0; e < 128; ++e) { const float y = bf2f(c.Y3[(size_t)(1 + br) * MPAD * 512 + (size_t)row * 512 + hd * 128 + e]);
          const float z = bf2f(c.R1[(size_t)row * NPROJ + (br == 0 ? PZ : PMO) + hd * 128 + e]);
          const float gn = br == 0 ? c.in[26][L * 128 + e] : c.in[29][L * 512 + hd * 128 + e];
          const float w = y / (gn * (br == 0 ? silu_(z) : sigm(z))); ms += w * w; }
      ms *= (1.f / 128.f); e2 = (ms - 1.f) * (ms - 1.f); r2 = 1.f; }
    blk_reduce2(e2, r2, red, c.tid);
    if (c.tid == 0) *dgp = sqrtf(e2 / (r2 + 1e-30f));
}
DI void chk_res(const Ctx& c, int L, int mode, const float (&snap)[2], float* dgp) {
    float* red = (float*)c.lds; float e2 = 0.f, r2 = 0.f;
    for (int rep = 0; rep < 2; ++rep) { const int sidx = c.tid + 512 * rep;
        const int row = (rep == 1 && c.tid < 64) ? MP + (c.tid * 2) : (int)(((unsigned)sidx * 7919u) % (unsigned)MP); const int col = (int)(((unsigned)sidx * 104729u) % 1024u);
        const float now = c.out[(size_t)row * 1024 + col]; float before = snap[rep], want = 0.f;
        if (mode == 0) { before = row < MP ? c.in[0][(size_t)row * 1024 + col] : c.in[1][(size_t)(row - MP) * 1024 + col]; want = dot_bf(c.XN + (size_t)row * 1024, c.W + WO_OUT + (size_t)col * 1024, 1024); }
        if (mode == 1) want = dot_bf(c.R1 + (size_t)row * 4096, c.W + WO_DN + (size_t)col * 4096, 4096);
        if (mode == 2) want = bf2f(c.Y3[(size_t)MPAD * 256 + (size_t)row * 1024 + col]) * sigm(dot_bf(c.XN + (size_t)row * 1024, c.W + WO_PG + (size_t)col * 1024, 1024));
        e2 += (now - before - want) * (now - before - want); r2 += want * want; }
    blk_reduce2(e2, r2, red, c.tid);
    if (c.tid == 0) *dgp = sqrtf(e2 / (r2 + 1e-30f));
}
DI void snap_x(const Ctx& c, float (&snap)[2]) {
    for (int rep = 0; rep < 2; ++rep) { const int sidx = c.tid + 512 * rep;
        const int row = (rep == 1 && c.tid < 64) ? MP + (c.tid * 2) : (int)(((unsigned)sidx * 7919u) % (unsigned)MP); const int col = (int)(((unsigned)sidx * 104729u) % 1024u);
        snap[rep] = c.out[(size_t)row * 1024 + col]; }
}
DI void chk_sample(const Ctx& c, int L, int b, int h, float* dgp) {
    float* red = (float*)c.lds; float e2 = 0.f, r2 = 0.f, e3 = 0.f, r3 = 0.f;
    const size_t row = (size_t)(MP + b); const bf16_t* pr = c.R1 + row * NPROJ;
    if (c.tid < 128) { const int dv = c.tid;
        const float* cbuf = c.in[4] + ((size_t)L * MS + b) * 3 * 1536; const float* cw = c.in[23] + (size_t)L * 4 * 1536;
        float sq = 0.f, sk = 0.f;
        for (int d = 0; d < 128; ++d) for (int w = 0; w < 2; ++w) { const int cc = w * 512 + h * 128 + d;
            const float a = silu_(cbuf[cc] * cw[cc] + cbuf[1536 + cc] * cw[1536 + cc] + cbuf[3072 + cc] * cw[3072 + cc] + bf2f(pr[PQ + cc]) * cw[4608 + cc]); if (w == 0) sq += a * a; else sk += a * a; }
        const float fq = rsqrtf(sq + EPS) * 0.08838834764831845f, fk = rsqrtf(sk + EPS);
        const int cv = 1024 + h * 128 + dv;
        const float vv = silu_(cbuf[cv] * cw[cv] + cbuf[1536 + cv] * cw[1536 + cv] + cbuf[3072 + cv] * cw[3072 + cv] + bf2f(pr[PQ + cv]) * cw[4608 + cv]);
        const float beta = sigm(c.SG[row * 16 + h]), eg = expf(-expf(c.in[24][L * 4 + h]) * softplus_(c.SG[row * 16 + 4 + h] + c.in[25][L * 4 + h]));
        const float* S0 = c.in[5] + (((size_t)L * MS + b) * 4 + h) * 16384; const float* S1 = c.out + O_GDN_S + (((size_t)L * MS + b) * 4 + h) * 16384;
        float kS = 0.f, qS = 0.f, qk = 0.f;
        for (int d = 0; d < 128; ++d) { const int cq = h * 128 + d, ck = 512 + h * 128 + d;
            const float qd = silu_(cbuf[cq] * cw[cq] + cbuf[1536 + cq] * cw[1536 + cq] + cbuf[3072 + cq] * cw[3072 + cq] + bf2f(pr[PQ + cq]) * cw[4608 + cq]) * fq;
            const float kd = silu_(cbuf[ck] * cw[ck] + cbuf[1536 + ck] * cw[1536 + ck] + cbuf[3072 + ck] * cw[3072 + ck] + bf2f(pr[PQ + ck]) * cw[4608 + ck]) * fk;
            kS += kd * S0[d * 128 + dv]; qS += qd * S0[d * 128 + dv]; qk += qd * kd; }
        const float vnew = beta * (vv - eg * kS);
        for (int d = 0; d < 128; ++d) { const int ck = 512 + h * 128 + d;
            const float kd = silu_(cbuf[ck] * cw[ck] + cbuf[1536 + ck] * cw[1536 + ck] + cbuf[3072 + ck] * cw[3072 + ck] + bf2f(pr[PQ + ck]) * cw[4608 + ck]) * fk;
            const float want = S0[d * 128 + dv] * eg + kd * vnew, got = S1[d * 128 + dv]; e2 += (got - want) * (got - want); r2 += want * want; }
        (void)qS; (void)qk;
    } else if (c.tid < 256) { const int e = c.tid - 128;
        const size_t sidx = ((size_t)L * MS + b) * 4 + h;
        const float li = softcap_(c.SG[row * 16 + 8 + h] + c.in[27][L * 4 + h]), lf = logsig_(softcap_(c.SG[row * 16 + 12 + h] + c.in[28][L * 4 + h]));
        const float m0 = c.in[8][sidx], mt = fmaxf(lf + m0, li), wts = expf(li - mt), sc = expf(lf + m0 - mt);
        const float v = bf2f(pr[PMV + h * 128 + e]);
        for (int d = 0; d < 64; ++d) { const float k = bf2f(pr[PMK + h * 64 + d]) * 0.125f;
            const float want = sc * c.in[6][sidx * 8192 + d * 128 + e] + wts * k * v, got = c.out[O_MLC_S + sidx * 8192 + d * 128 + e]; e3 += (got - want) * (got - want); r3 += want * want; }
        if (e < 64) { const float k = bf2f(pr[PMK + h * 64 + e]) * 0.125f; const float want = sc * c.in[7][sidx * 64 + e] + wts * k, got = c.out[O_MLN_S + sidx * 64 + e]; e3 += 64.f * (got - want) * (got - want); r3 += 64.f * want * want; }
        if (e == 0) { const float got = c.out[O_MLM_S + sidx]; e3 += 4096.f * (got - mt) * (got - mt); r3 += 4096.f * mt * mt; }
    }
    blk_reduce2(e2, r2, red, c.tid);
    blk_reduce2(e3, r3, red, c.tid);
    if (c.tid == 0) { dgp[0] = sqrtf(e2 / (r2 + 1e-30f)); dgp[1] = sqrtf(e3 / (r3 + 1e-30f)); }
}
#endif
DI void phase_conv_state(const Ctx& c, int L) {
    for (int idx = c.bid * 512 + c.tid; idx < NB * 3 * 1536; idx += c.G * 512) { const int cc = idx % 1536, j = (idx / 1536) % 3, b = idx / (3 * 1536);
        c.out[O_CONV_P + ((size_t)L * NB + b) * 3 * 1536 + j * 1536 + cc] = bf2f(c.R1[(size_t)(b * SEQ + SEQ - 3 + j) * NPROJ + PQ + cc]); }
}
DI void phase_post(const Ctx& c, int L) {
    const int lane = c.lane, hd = lane >> 4, e0 = (lane & 15) * 8;
    bf16_t* yg = c.Y3 + (size_t)1 * MPAD * 512; bf16_t* ym = c.Y3 + (size_t)2 * MPAD * 512;
    const float* gg = c.in[26] + (size_t)L * 128 + e0; const float* gm = c.in[29] + (size_t)L * 512 + hd * 128 + e0;
    for (int row = c.bid * 8 + c.wave; row < MR; row += c.G * 8) {
        const bf16_t* pr = c.R1 + (size_t)row * NPROJ;
#pragma unroll
        for (int br = 0; br < 2; ++br) {
            bf16_t* yp = (br == 0 ? yg : ym) + (size_t)row * 512 + hd * 128 + e0;
            f32x8 o = unpack8(*(const bf16x8*)yp); const f32x8 z = unpack8(*(const bf16x8*)(pr + (br == 0 ? PZ : PMO) + hd * 128 + e0));
            float ss = 0.f;
#pragma unroll
            for (int e = 0; e < 8; ++e) ss += o[e] * o[e];
            ss += __shfl_xor(ss, 1); ss += __shfl_xor(ss, 2); ss += __shfl_xor(ss, 4); ss += __shfl_xor(ss, 8);
            const float rs = rsqrtf(ss * (1.f / 128.f) + EPS);
            const float* gp = br == 0 ? gg : gm;
#pragma unroll
            for (int e = 0; e < 8; ++e) o[e] = o[e] * rs * gp[e] * (br == 0 ? silu_(z[e]) : sigm(z[e]));
            *(bf16x8*)yp = pack8v(o);
        }
    }
}

DI void phase_cvt_ple(const Ctx& c, int L) {
    bf16_t* PB = c.Y3;
    for (size_t i = (size_t)c.bid * 512 + c.tid; i < (size_t)MR * 64; i += (size_t)c.G * 512) {
        const size_t row = i >> 6, c4 = (i & 63) * 4;
        const float* src = row < MP ? c.in[9] + ((size_t)L * MP + row) * 256 + c4 : c.in[10] + ((size_t)L * MS + (row - MP)) * 256 + c4;
        *(s16x4*)(PB + row * 256 + c4) = pack4v(*(const f32x4*)src); }
}
DI void phase_final_norm(const Ctx& c) {
    const float* gain = c.in[39];
    for (int row = c.bid * 8 + c.wave; row < MR; row += c.G * 8) {
        float* xp = c.out + (size_t)row * 1024; f32x4 x[4]; float ss = 0.f;
#pragma unroll
        for (int i = 0; i < 4; ++i) { x[i] = *(const f32x4*)(xp + c.lane * 4 + 256 * i); ss += x[i][0] * x[i][0] + x[i][1] * x[i][1] + x[i][2] * x[i][2] + x[i][3] * x[i][3]; }
        ss = wave_sum(ss); const float rs = rsqrtf(ss * (1.f / 1024.f) + EPS);
#pragma unroll
        for (int i = 0; i < 4; ++i) { const f32x4 g = *(const f32x4*)(gain + c.lane * 4 + 256 * i); *(f32x4*)(xp + c.lane * 4 + 256 * i) = x[i] * rs * g; }
    }
}

#define XB_TMO      128
#define XB_XCNT(j)  (256  + 64 * (j))
#define XB_XSUB(j)  (1280 + 64 * (j))
#define XB_XGEN(j)  (2304 + 64 * (j))
#define XB_TOP      3328
#define XB_TOPGEN   3392
#define XCD_BAR_WORDS 3456
#define XB_SPIN_CAP (1u << 18)

__device__ __forceinline__ unsigned xb_ld(unsigned* p)              { return __hip_atomic_load(p, __ATOMIC_RELAXED, __HIP_MEMORY_SCOPE_AGENT); }
__device__ __forceinline__ unsigned xb_add(unsigned* p, unsigned v) { return __hip_atomic_fetch_add(p, v, __ATOMIC_RELAXED, __HIP_MEMORY_SCOPE_AGENT); }
__device__ __forceinline__ unsigned xb_xcc_id() { return (unsigned)__builtin_amdgcn_s_getreg((3 << 11) | 20) & 0xFu; }
#define XB_SPIN(cond, bar) do { unsigned _sp = 0; while (cond) { __builtin_amdgcn_s_sleep(1); \
    if ((++_sp & 255u) == 0u) { if (xb_ld(&(bar)[XB_TMO])) break; if (_sp > XB_SPIN_CAP) { atomicAdd(&(bar)[XB_TMO], 1u); break; } } } } while (0)

struct XcdBarrier {
    unsigned* bar; unsigned x;
    volatile LAS unsigned* st;
};

__device__ __forceinline__ XcdBarrier xcd_barrier_post(unsigned* bar, volatile LAS unsigned* st) {
    XcdBarrier b; b.bar = bar; b.x = xb_xcc_id(); b.st = st;
    if (threadIdx.x == 0) (void)xb_add(&bar[XB_XCNT(b.x)], 1u);
    return b;
}
__device__ __forceinline__ void xcd_barrier_complete(unsigned* bar, unsigned x, unsigned& nloc, unsigned& nx) {
    const unsigned G = gridDim.x * gridDim.y * gridDim.z;
    unsigned sum, cnt, mine, sp = 0u;
    for (;;) {
        sum = 0u; cnt = 0u; mine = 0u;
#pragma unroll
        for (unsigned j = 0; j < 16; ++j) { const unsigned c = xb_ld(&bar[XB_XCNT(j)]); sum += c; cnt += (c > 0u) ? 1u : 0u; mine = (j == x) ? c : mine; }
        if (sum == G) break;
        __builtin_amdgcn_s_sleep(1);
        if ((++sp & 255u) == 0u) { if (xb_ld(&bar[XB_TMO])) break; if (sp > XB_SPIN_CAP) { atomicAdd(&bar[XB_TMO], 1u); break; } }
    }
    nloc = mine > 0u ? mine : 1u; nx = cnt > 0u ? cnt : 1u;
}

__device__ __forceinline__ void xcd_barrier(const XcdBarrier& b) {
    asm volatile("s_waitcnt vmcnt(0)" ::: "memory");
    __syncthreads();
    if (threadIdx.x == 0) {
        unsigned* bar = b.bar;
        __builtin_amdgcn_s_waitcnt(0);
        unsigned nloc = b.st[0], nx = b.st[1];
        if (nloc == 0u) { xcd_barrier_complete(bar, b.x, nloc, nx); b.st[0] = nloc; b.st[1] = nx; }
        const unsigned old = xb_add(&bar[XB_XSUB(b.x)], 1u);
        const unsigned gen = old / nloc;
        if (old + 1u == (gen + 1u) * nloc) {
            __builtin_amdgcn_fence(__ATOMIC_RELEASE, "agent");
            asm volatile("s_waitcnt vmcnt(0)" ::: "memory");
            const unsigned og = xb_add(&bar[XB_TOP], 1u);
            const unsigned tg = og / nx;
            if (og + 1u == (tg + 1u) * nx) xb_add(&bar[XB_TOPGEN], 1u);
            else XB_SPIN(xb_ld(&bar[XB_TOPGEN]) == tg, bar);
            __builtin_amdgcn_fence(__ATOMIC_ACQUIRE, "agent");
            xb_add(&bar[XB_XGEN(b.x)], 1u);
            asm volatile("s_waitcnt vmcnt(0)" ::: "memory");
        } else {
            XB_SPIN(xb_ld(&bar[XB_XGEN(b.x)]) == gen, bar);
            __builtin_amdgcn_fence(__ATOMIC_ACQUIRE, "agent");
            asm volatile("s_waitcnt vmcnt(0)" ::: "memory");
        }
    }
    __syncthreads();
}

__global__ void __launch_bounds__(512, 2) fwd_megakernel(KP kp) {
    extern __shared__ __attribute__((aligned(16))) unsigned char lds[];
    cg::grid_group grid = cg::this_grid();
    Ctx c; c.lds = lds; c.G = gridDim.x; c.bid = blockIdx.x;
    const ka_t ka0 = (ka_t)__builtin_amdgcn_kernarg_segment_ptr();
    (void)kp;
#define REFRESH() do { ka_t ka_ = ka0; asm volatile("" : "+s"(ka_)); int t_ = threadIdx.x; asm volatile("" : "+v"(t_)); \
        c.in.ka = ka_; c.out = (float*)(gfloat_t*)ka_[40]; unsigned char* w_ = (unsigned char*)(guchar_t*)ka_[41]; c.ws = w_; \
        c.R1 = (bf16_t*)(w_ + WS_R1); c.XN = (bf16_t*)(w_ + WS_XN); c.Y3 = (bf16_t*)(w_ + WS_Y3); c.W = (bf16_t*)(w_ + WS_W); c.YS5 = (bf16_t*)(w_ + WS_YS5); \
        c.GS = w_ + WS_GS; c.SG = (float*)(w_ + WS_SG); c.GL = (float*)(w_ + WS_GL); \
        c.tid = t_; c.lane = t_ & 63; c.wave = __builtin_amdgcn_readfirstlane(t_ >> 6); \
        int b_ = blockIdx.x, g_ = gridDim.x; asm volatile("" : "+s"(b_), "+s"(g_)); c.bid = b_; c.G = g_; } while (0)
    REFRESH();
    volatile LAS unsigned* bst = (volatile LAS unsigned*)(lds + LDS_BYTES - 16);
    if (c.tid < 4) bst[c.tid] = 0u;
    if (c.tid < 16) ((volatile LAS int*)(lds + S5Q_FLAG))[c.tid] = 0;
    __syncthreads();
    XcdBarrier xbar = xcd_barrier_post((unsigned*)(c.ws + WS_BAR), bst);
    int nsync_ = 0;
#ifndef PHMASK
#define PHMASK 0xFFFFFFFFu
#endif
#define PH(n) if (PHMASK & (1 << (n)))
#ifdef DUP_SYNC
#define GSYNC() do { grid.sync(); grid.sync(); } while (0)
#else
#define GSYNC() do { if (nsync_++ == 0) grid.sync(); else xcd_barrier(xbar); } while (0)
#endif
    for (int L = 0; L < 2; ++L) {
        REFRESH(); PH(0) phase_weights(c, L);
        REFRESH(); PH(1) phase_rmsnorm<0>(c, L);
        GSYNC();
        REFRESH(); PH(2) run_gemm(c, c.XN, c.W + WO_IN, NPROJ, 1024, FStore{c.R1, NPROJ});
#ifdef DUP_GEMM
        REFRESH(); PH(2) run_gemm(c, c.XN, c.W + WO_IN, NPROJ, 1024, FStore{c.R1, NPROJ});
#endif
        GSYNC();
#ifdef DUP_MIX
        for (int rep_ = 0; rep_ < 2; ++rep_) {
#else
        {
#endif
        REFRESH(); phase_conv_state(c, L);
        REFRESH(); for (int it = c.bid * 8 + c.wave; it < 1024; it += c.G * 8) task_ml_gates(c, L, it);
        REFRESH(); PH(3) phase_gdn_prep(c, L);
#ifdef DUP_PREP
        REFRESH(); PH(3) phase_gdn_prep(c, L);
#endif
#ifdef DUP_S5
#endif
        GSYNC();
#ifdef DUP_P4
        for (int rep4_ = 0; rep4_ < 2; ++rep4_) {
#else
        {
#endif
        if (c.wave == 0) {
            for (int u = c.bid; u < 256; u += c.G) { REFRESH(); if (u < 128) { PH(5) task_gdn_seq(c, L, u);
#ifdef DUP_GSEQ
                REFRESH(); task_gdn_seq(c, L, u);
#endif
              } else { PH(6) task_ml_seq(c, L, u - 128, (float*)lds);
#ifdef DUP_MSEQ
                REFRESH(); task_ml_seq(c, L, u - 128, (float*)lds);
#endif
              } }
        } else if (c.wave <= 4) {
            int it_ = 0;
            for (int u = c.bid; u < 256; u += c.G, ++it_) { REFRESH(); PH(4) task_s5_quad(c, L, u, c.wave - 1, L * 16 + it_ + 1); }
        } else {
            const int wid = c.bid * 3 + (c.wave - 5), nw = c.G * 3;
            REFRESH(); PH(7) for (int u = wid; u < 2048; u += nw) task_gdn_sample(c, L, u);
            REFRESH(); PH(8) for (int u = wid; u < 1024; u += nw) task_ml_sample(c, L, u);
            REFRESH(); PH(9) for (int u = wid; u < 4096; u += nw) task_s5_sample(c, L, u);
        }
        GSYNC();
        }
        }
#ifdef SELFCHK
        if (L == SELFCHK_L) { REFRESH(); if (c.bid == 0) { float* dg = (float*)(c.ws + WS_GL) + 1024; chk_gdn(c, L, 1, 2, dg); chk_ml(c, L, 1, 2, dg); chk_s5(c, L, 1, 7, dg); chk_gemm(c, L, 0, dg + 6); if (L == 0) chk_sg(c, dg + 12); chk_sample(c, L, 5, 1, dg + 17); } grid.sync(); }
#endif
        REFRESH(); PH(10) phase_post(c, L);
        REFRESH(); PH(11) run_gemm(c, c.XN, c.W + WO_G, NGATE, 1024, FSig{c.R1, NPROJ});
#ifdef DUP_GEMM
        REFRESH(); PH(11) run_gemm(c, c.XN, c.W + WO_G, NGATE, 1024, FSig{c.R1, NPROJ});
#endif
        REFRESH(); PH(12) run_gemm(c, c.YS5, c.W + WO_GLU, 512, 512, FGlu{c.YS5, c.in[22] + (size_t)L * 512, c.Y3});
#ifdef DUP_GEMM
        REFRESH(); PH(12) run_gemm(c, c.YS5, c.W + WO_GLU, 512, 512, FGlu{c.YS5, c.in[22] + (size_t)L * 512, c.Y3});
#endif
        GSYNC();
#ifdef SELFCHK
        if (L == SELFCHK_L) { REFRESH(); if (c.bid == 0) { float* dg = (float*)(c.ws + WS_GL) + 1024; chk_gemm(c, L, 1, dg + 7); chk_gemm(c, L, 2, dg + 8); chk_post(c, L, dg + 13); } grid.sync(); }
#endif
        REFRESH(); PH(13) for (int br = 0; br < 3; ++br)
            run_gemm(c, c.Y3 + (size_t)br * MPAD * 512, c.W + WO_BR + (size_t)br * 1024 * 512, 1024, 512, FBranch{c.R1 + br * 1024, c.XN, br == 0 ? 1 : 0});
#ifdef DUP_GEMM
        REFRESH(); PH(13) for (int br = 0; br < 3; ++br)
            run_gemm(c, c.Y3 + (size_t)br * MPAD * 512, c.W + WO_BR + (size_t)br * 1024 * 512, 1024, 512, FBranch{c.R1 + br * 1024, c.XN, br == 0 ? 1 : 0});
#endif
        GSYNC();
#ifdef SELFCHK
        if (L == SELFCHK_L) { REFRESH(); if (c.bid == 0) { float* dg = (float*)(c.ws + WS_GL) + 1024; chk_gemm(c, L, 3, dg + 9); } grid.sync(); }
#endif
        REFRESH(); PH(14) run_gemm(c, c.XN, c.W + WO_OUT, 1024, 1024, FRes{c.out});
        GSYNC();
#ifdef SELFCHK
        if (L == 0 && SELFCHK_L == 0) { REFRESH(); if (c.bid == 0) { float* dg = (float*)(c.ws + WS_GL) + 1024; float sn[2] = {0.f, 0.f}; chk_res(c, L, 0, sn, dg + 14); } grid.sync(); }
#endif
        REFRESH(); PH(15) phase_rmsnorm<1>(c, L);
        REFRESH(); PH(18) phase_cvt_ple(c, L);
        GSYNC();
        REFRESH(); PH(16) run_gemm(c, c.XN, c.W + WO_UP, DFF, 1024, FRelu2{c.R1});
#ifdef DUP_GEMM
        REFRESH(); PH(16) run_gemm(c, c.XN, c.W + WO_UP, DFF, 1024, FRelu2{c.R1});
#endif
        GSYNC();
#ifdef SELFCHK
        if (L == SELFCHK_L) { REFRESH(); if (c.bid == 0) { float* dg = (float*)(c.ws + WS_GL) + 1024; chk_gemm(c, L, 4, dg + 10); } grid.sync(); }
#endif
#ifdef SELFCHK
        float snp[2] = {0.f, 0.f}; REFRESH(); if (L == SELFCHK_L && c.bid == 0) snap_x(c, snp);
#endif
        REFRESH(); PH(17) run_gemm(c, c.R1, c.W + WO_DN, 1024, 4096, FResB{c.out, c.XN});
        GSYNC();
#ifdef SELFCHK
        if (L == SELFCHK_L) { REFRESH(); if (c.bid == 0) { float* dg = (float*)(c.ws + WS_GL) + 1024; chk_res(c, L, 1, snp, dg + 15); } grid.sync(); }
#endif
#ifdef SELFCHK
        REFRESH(); if (L == SELFCHK_L && c.bid == 0) snap_x(c, snp);
#endif
        REFRESH(); PH(19) run_gemm(c, c.Y3, c.W + WO_PLE, 1024, 256, FStore{c.Y3 + (size_t)MPAD * 256, 1024});
#ifdef DUP_GEMM
        REFRESH(); PH(19) run_gemm(c, c.Y3, c.W + WO_PLE, 1024, 256, FStore{c.Y3 + (size_t)MPAD * 256, 1024});
#endif
        REFRESH(); PH(20) run_gemm(c, c.XN, c.W + WO_PG, 1024, 1024, FPle{c.Y3 + (size_t)MPAD * 256, c.out});
        GSYNC();
#ifdef SELFCHK
        if (L == SELFCHK_L) { REFRESH(); if (c.bid == 0) { float* dg = (float*)(c.ws + WS_GL) + 1024; chk_gemm(c, L, 5, dg + 11); chk_res(c, L, 2, snp, dg + 16); } grid.sync(); }
#endif
    }
    REFRESH(); phase_final_norm(c);
#ifdef SELFCHK
    grid.sync(); REFRESH();
    if (c.bid == 0 && c.tid == 0) { const float* dg = (const float*)(c.ws + WS_GL) + 1024; int kk = -1; float dv = 0.f;
        for (int i = 18; i >= 0; --i) if (dg[i] > SELFCHK_THR) { kk = i; dv = dg[i]; }
        if (kk >= 0) c.out[0] = __powf(10.f, (float)(2 * kk + 4)) * (1.f + fminf(dv, 8.f)); }
#endif
}

extern "C" void kernel_launch(void* const* d_in, const int* in_sizes, int n_in, void* d_out, int out_size, void* d_ws, size_t ws_size, hipStream_t stream) {
    static int grid = 0;
    if (grid == 0) {
        int dev = 0, cus = 0, per_cu = 0;
        if (hipGetDevice(&dev) != hipSuccess || hipDeviceGetAttribute(&cus, hipDeviceAttributeMultiprocessorCount, dev) != hipSuccess) { fprintf(stderr, "kernel_launch: device query failed\n"); grid = -1; return; }
        if (hipFuncSetAttribute((const void*)fwd_megakernel, hipFuncAttributeMaxDynamicSharedMemorySize, LDS_BYTES) != hipSuccess) { fprintf(stderr, "kernel_launch: hipFuncSetAttribute failed\n"); grid = -1; return; }
        if (hipOccupancyMaxActiveBlocksPerMultiprocessor(&per_cu, (const void*)fwd_megakernel, 512, LDS_BYTES) != hipSuccess || per_cu < 1) { fprintf(stderr, "kernel_launch: occupancy query says %d blocks per CU\n", per_cu); grid = -1; return; }
        grid = cus;
        if (grid > 256) grid = 256;
    }
    if (grid < 0) return;
    if (n_in != 40 || (size_t)out_size != O_TOTAL || ws_size < WS_END) { fprintf(stderr, "kernel_launch: unexpected sizes n_in %d out %d ws %zu (need %zu)\n", n_in, out_size, ws_size, (size_t)WS_END); return; }
    if (hipMemsetAsync((char*)d_ws + WS_BAR, 0, SZ_BAR, stream) != hipSuccess) { fprintf(stderr, "kernel_launch: memset failed\n"); return; }
    KP kp{};
    for (int i = 0; i < 40; ++i) kp.in[i] = (const float*)d_in[i];
    kp.out = (float*)d_out; kp.ws = (unsigned char*)d_ws;
    void* args[] = {&kp};
    hipError_t e = hipLaunchCooperativeKernel((const void*)fwd_megakernel, dim3(grid), dim3(512), args, LDS_BYTES, stream);
    if (e != hipSuccess) fprintf(stderr, "kernel_launch: cooperative launch failed: %s (grid %d)\n", hipGetErrorString(e), grid);
}
```

```cpp
#include <hip/hip_runtime.h>
#include <hip/hip_cooperative_groups.h>
#include <cstdio>
namespace cg = cooperative_groups;
namespace pg8 {
#define PG8_LAS __attribute__((address_space(3)))
typedef unsigned short bf16_t;
typedef short bf16x8 __attribute__((ext_vector_type(8)));
typedef float f32x4 __attribute__((ext_vector_type(4)));
typedef unsigned u32x4 __attribute__((ext_vector_type(4)));
constexpr int BM = 256, BK = 64, HALF = 128, HTB = HALF * BK * 2  , STAGE_BYTES = 8 * HTB, NXCD = 8, WGM = 8;

__host__ __device__ __forceinline__ int lds_byte(int r, int c) { const int st = (r >> 4) * 2 + (c >> 5), rr = r & 15, cc = c & 31, ob = rr * 64 + cc * 2; return st * 1024 + (ob ^ (((ob >> 9) & 1) << 5)); }
__host__ __device__ __forceinline__ void stage_rc(int b, int& R, int& C) { const int st = b / 1024, sb = b % 1024, swz = sb ^ (((sb >> 9) & 1) << 5); R = (st >> 1) * 16 + swz / 64; C = (st & 1) * 32 + (swz % 64) / 2; }
__host__ __device__ __forceinline__ int perm32(int rho) { const int n = rho >> 4, i = rho & 15; return 8 * (i >> 2) + 4 * n + (i & 3); }

struct Unit { int pm, pn; };
struct Gemm { const bf16_t* A; const bf16_t* Bt; int M, N, K; };

struct StaticOrder {
    int nM, nN, nwg, G, c;
    __host__ __device__ void init(int M, int N, int G_, int c_) { nM = M / BM; nN = N / BM; nwg = nM * nN; G = G_; c = c_; }
    __host__ __device__ bool next(int i, Unit& u) const {
        const long L = (long)i * G + c; if (L >= nwg) return false;
        int wgid = (int)L; { const int q = nwg / NXCD, r = nwg % NXCD, xcd = wgid % NXCD, off = wgid / NXCD; wgid = (xcd < r ? xcd * (q + 1) : r * (q + 1) + (xcd - r) * q) + off; }
        const int nig = WGM * nN, gid = wgid / nig, fm = gid * WGM, gsz = (nM - fm) < WGM ? (nM - fm) : WGM;
        u.pm = fm + ((wgid % nig) % gsz); u.pn = (wgid % nig) / gsz; return true;
    }
    __device__ __forceinline__ void a_ready(const Unit&) const {}
    __device__ __forceinline__ void done(const Unit&) const {}
};

template <class Epi, class Sched, bool STAMP = false>
__device__ __forceinline__ void gemm_phase(PG8_LAS unsigned char* lds, const Gemm g, const Sched& S, const Epi& E, unsigned long long* stamps) {
    int tid_ = threadIdx.x; asm volatile("" : "+v"(tid_));
    const int tid = tid_, wid = __builtin_amdgcn_readfirstlane(tid >> 6), lane = tid & 63, wr = wid >> 2, wc = wid & 3, fr = lane & 15, fq = lane >> 4;
    const int K = g.K, nt = K / BK;
    unsigned voffA[2], voffB[2];
#pragma unroll
    for (int i = 0; i < 2; ++i) { int R, C; stage_rc(tid * 16 + i * 8192, R, C); const int Rb = Epi::PERM ? ((R & ~31) + perm32(R & 31)) : R;
        voffA[i] = (unsigned)(R * K + C) * 2u; voffB[i] = (unsigned)(Rb * K + C) * 2u; }
    const size_t kstep = (size_t)(BK * 2);
    const size_t hstep = (size_t)HALF * K * 2;
    const size_t tstep = 2 * hstep;
    const unsigned ldsw = (unsigned)wid * 1024u;
    const int aoff = lds_byte(wr * 64 + fr, fq * 8), boff = lds_byte(wc * 32 + fr, fq * 8);
#define PG8_SA(b, h) (((b) * 2 + (h)) * HTB)
#define PG8_SB(b, h) ((4 + (b) * 2 + (h)) * HTB)
#define PG8_STAGE(bufoff, gbase, voff) do { _Pragma("unroll") for (int _i = 0; _i < 2; ++_i) \
        __builtin_amdgcn_global_load_lds((const unsigned*)((const char*)(gbase) + (voff)[_i]), (PG8_LAS unsigned*)(lds + (bufoff) + ldsw + _i * 8192), 16, 0, 0); } while (0)
#define PG8_LDA(dst, b, h) do { _Pragma("unroll") for (int m = 0; m < 4; ++m) _Pragma("unroll") for (int k = 0; k < 2; ++k) dst[m][k] = *(const PG8_LAS bf16x8*)(lds + PG8_SA(b, h) + aoff + m * 2048 + k * 1024); } while (0)
#define PG8_LDB(dst, b, h) do { _Pragma("unroll") for (int n = 0; n < 2; ++n) _Pragma("unroll") for (int k = 0; k < 2; ++k) dst[n][k] = *(const PG8_LAS bf16x8*)(lds + PG8_SB(b, h) + boff + n * 2048 + k * 1024); } while (0)
#define PG8_MMA(ai, bj, At, Bt) do { __builtin_amdgcn_s_setprio(1); _Pragma("unroll") for (int m = 0; m < 4; ++m) _Pragma("unroll") for (int n = 0; n < 2; ++n) _Pragma("unroll") for (int k = 0; k < 2; ++k) \
        acc[ai][bj][m][n] = __builtin_amdgcn_mfma_f32_16x16x32_bf16(Bt[n][k], At[m][k], acc[ai][bj][m][n], 0, 0, 0); __builtin_amdgcn_s_setprio(0); } while (0)
#define PG8_WAIT_V(n) asm volatile("s_waitcnt vmcnt(" #n ")" ::: "memory")
#define PG8_WAIT_L(n) asm volatile("s_waitcnt lgkmcnt(" #n ")" ::: "memory")
#define PG8_BAR __builtin_amdgcn_s_barrier()
#define PG8_SCHED __builtin_amdgcn_sched_barrier(0)
    Unit cur, nxt; int ui = 0;
    if (!S.next(0, cur)) return;
    f32x4 acc[2][2][4][2];
#pragma unroll
    for (int a = 0; a < 2; ++a)
#pragma unroll
        for (int b = 0; b < 2; ++b)
#pragma unroll
            for (int m = 0; m < 4; ++m)
#pragma unroll
                for (int n = 0; n < 2; ++n) acc[a][b][m][n] = (f32x4){0.f, 0.f, 0.f, 0.f};
    bf16x8 At[4][2], B0[2][2], B1[2][2];
    const char* cA = (const char*)g.A + (size_t)cur.pm * tstep; const char* cB = (const char*)g.Bt + (size_t)cur.pn * tstep;
    S.a_ready(cur);
    PG8_STAGE(PG8_SB(0, 0), cB, voffB); PG8_STAGE(PG8_SA(0, 0), cA, voffA); PG8_STAGE(PG8_SB(0, 1), cB + hstep, voffB); PG8_STAGE(PG8_SA(0, 1), cA + hstep, voffA);
    if (wr == 1) PG8_BAR;
    PG8_WAIT_V(4); PG8_BAR;
    PG8_STAGE(PG8_SB(1, 0), cB + kstep, voffB); PG8_STAGE(PG8_SA(1, 0), cA + kstep, voffA); PG8_STAGE(PG8_SB(1, 1), cB + hstep + kstep, voffB);
    PG8_WAIT_V(6); PG8_BAR;
    for (;;) {
        const bool has_next = S.next(ui + 1, nxt);
        const char* nA = has_next ? (const char*)g.A + (size_t)nxt.pm * tstep : cA; const char* nB = has_next ? (const char*)g.Bt + (size_t)nxt.pn * tstep : cB;
        for (int t = 0; t < nt; t += 2) {
            const bool last = (t == nt - 2);
            const char* a1 = cA + (size_t)(t + 1) * kstep;
            const char* a2 = last ? nA : cA + (size_t)(t + 2) * kstep; const char* b2 = last ? nB : cB + (size_t)(t + 2) * kstep;
            const char* a3 = a2 + kstep; const char* b3 = b2 + kstep;
            if (last && has_next) S.a_ready(nxt);
            PG8_LDB(B0, 0, 0); PG8_SCHED; PG8_LDA(At, 0, 0); PG8_STAGE(PG8_SA(1, 1), a1 + hstep, voffA);
            PG8_WAIT_L(8); PG8_BAR; PG8_WAIT_L(0); PG8_MMA(0, 0, At, B0); PG8_BAR; PG8_SCHED;
            PG8_LDB(B1, 0, 1); PG8_STAGE(PG8_SB(0, 0), b2, voffB);
            PG8_BAR; PG8_WAIT_L(0); PG8_MMA(0, 1, At, B1); PG8_BAR;
            PG8_LDA(At, 0, 1); PG8_STAGE(PG8_SA(0, 0), a2, voffA);
            PG8_BAR; PG8_WAIT_L(0); PG8_MMA(1, 0, At, B0); PG8_BAR; PG8_SCHED;
            PG8_STAGE(PG8_SB(0, 1), b2 + hstep, voffB);
            PG8_WAIT_V(6); PG8_BAR; PG8_MMA(1, 1, At, B1); PG8_BAR;
            PG8_LDB(B0, 1, 0); PG8_SCHED; PG8_LDA(At, 1, 0); PG8_STAGE(PG8_SA(0, 1), a2 + hstep, voffA);
            PG8_WAIT_L(8); PG8_BAR; PG8_WAIT_L(0); PG8_MMA(0, 0, At, B0); PG8_BAR; PG8_SCHED;
            PG8_LDB(B1, 1, 1); PG8_STAGE(PG8_SB(1, 0), b3, voffB);
            PG8_BAR; PG8_WAIT_L(0); PG8_MMA(0, 1, At, B1); PG8_BAR;
            PG8_LDA(At, 1, 1); PG8_STAGE(PG8_SA(1, 0), a3, voffA);
            PG8_BAR; PG8_WAIT_L(0); PG8_MMA(1, 0, At, B0); PG8_BAR; PG8_SCHED;
            PG8_STAGE(PG8_SB(1, 1), b3 + hstep, voffB);
            PG8_WAIT_V(6); PG8_BAR; PG8_MMA(1, 1, At, B1); PG8_BAR;
        }
        if constexpr (!Epi::AFTER_DRAIN) { E(acc, cur, wr, wc, fr, fq); S.done(cur); }
        if (!has_next) break;
#pragma unroll
        for (int a = 0; a < 2; ++a)
#pragma unroll
            for (int b = 0; b < 2; ++b)
#pragma unroll
                for (int m = 0; m < 4; ++m)
#pragma unroll
                    for (int n = 0; n < 2; ++n) acc[a][b][m][n] = (f32x4){0.f, 0.f, 0.f, 0.f};
        cur = nxt; cA = nA; cB = nB; ++ui;
    }
    PG8_WAIT_V(0);
    if (wr == 0) PG8_BAR;
    PG8_BAR;
    if constexpr (Epi::AFTER_DRAIN) { E.fused(acc, cur, wr, wc, fr, fq, lds, wid, lane); S.done(cur); }
#undef PG8_SA
#undef PG8_SB
#undef PG8_STAGE
#undef PG8_LDA
#undef PG8_LDB
#undef PG8_MMA
#undef PG8_WAIT_V
#undef PG8_WAIT_L
#undef PG8_BAR
#undef PG8_SCHED
}
}

#include <cstdio>
#include <ctime>
#include <cstdlib>
#include <cstring>
#include <cmath>
#include <vector>
#include <algorithm>
#define CK(x) do { hipError_t e_ = (x); if (e_ != hipSuccess) { fprintf(stderr, "HIP %s:%d %s\n", __FILE__, __LINE__, hipGetErrorString(e_)); exit(2); } } while (0)

#define DI __device__ __forceinline__
#define LAS __attribute__((address_space(3)))
typedef unsigned short bf16_t;
typedef short bf16x8 __attribute__((ext_vector_type(8)));
typedef short s16x4 __attribute__((ext_vector_type(4)));
typedef __bf16 bfv8 __attribute__((ext_vector_type(8)));
typedef __bf16 bfv4 __attribute__((ext_vector_type(4)));
typedef float f32x2 __attribute__((ext_vector_type(2)));
typedef float f32x4 __attribute__((ext_vector_type(4)));
typedef float f32x8 __attribute__((ext_vector_type(8)));
typedef float f32x16 __attribute__((ext_vector_type(16)));
typedef unsigned u32x4 __attribute__((ext_vector_type(4)));
typedef unsigned u32x2 __attribute__((ext_vector_type(2)));

constexpr int MP = 16384, MS = 128, MR = MP + MS, MPAD = 16640, DM = 1024, SEQ = 2048, NB = 8;
constexpr int NPROJ = 4096, NGATE = 3072, DFF = 4096, DIN = 7184;
constexpr int PU = 0, PQ = 512, PK = 1024, PV = 1536, PMQ = 2048, PMK = 2304, PMV = 2560, PZ = 3072, PMO = 3584;
constexpr float EPS = 1e-6f;
constexpr size_t O_S5RE_P = 16908288, O_S5RE_S = 16941056, O_S5IM_P = 17465344, O_S5IM_S = 17498112, O_CONV_P = 18022400, O_CONV_S = 18096128,
                 O_GDN_P = 19275776, O_GDN_S = 20324352, O_MLC_P = 37101568, O_MLC_S = 37625856, O_MLN_P = 46014464, O_MLN_S = 46018560,
                 O_MLM_P = 46084096, O_MLM_S = 46084160, O_TOTAL = 46085184;
constexpr size_t WS_R1 = 0, SZ_R1 = (size_t)MPAD * 4096 * 2;
constexpr size_t WS_XN = WS_R1 + SZ_R1, SZ_XN = (size_t)MPAD * 1024 * 2;
constexpr size_t WS_Y3 = WS_XN + SZ_XN, SZ_Y3 = (size_t)3 * MPAD * 512 * 2;
constexpr size_t WS_YS5 = WS_Y3 + SZ_Y3, SZ_YS5 = (size_t)MPAD * 512 * 2;
constexpr size_t WS_W = WS_YS5 + SZ_YS5;
constexpr size_t WO_IN = 0, WO_G = WO_IN + (size_t)4096 * 1024, WO_GLU = WO_G + (size_t)3072 * 1024, WO_BR = WO_GLU + (size_t)512 * 512,
                 WO_OUT = WO_BR + (size_t)3 * 1024 * 512, WO_UP = WO_OUT + (size_t)1024 * 1024, WO_DN = WO_UP + (size_t)4096 * 1024,
                 WO_PLE = WO_DN + (size_t)1024 * 4096, WO_PG = WO_PLE + (size_t)1024 * 256, WO_END = WO_PG + (size_t)1024 * 1024;
constexpr size_t SZ_W = WO_END * 2;
constexpr size_t WS_GS = WS_W + SZ_W;
constexpr int GI_U = 0, GI_W = 16384, GI_Q = 32768, GI_K = 49152, GI_A = 65536, GI_BYTES = 73728;
constexpr size_t SZ_GS = (size_t)1024 * GI_BYTES;
constexpr size_t WS_SG = WS_GS + SZ_GS, SZ_SG = (size_t)MR * 16 * 4;
constexpr size_t WS_GL = WS_SG + SZ_SG, SZ_GL = 8192;
constexpr size_t WS_MG = WS_GL + SZ_GL, SZ_MG = (size_t)1024 * 5 * 64 * 4;
constexpr size_t WS_PL = WS_MG + SZ_MG, SZ_PL = (size_t)1024 * 8192;
constexpr size_t WS_BAR = WS_PL + SZ_PL, SZ_BAR = 16384;
constexpr size_t WS_END = WS_BAR + SZ_BAR;
constexpr int LDS_BYTES = 122880 + 32768 + 2048 + 64 + 64;

struct KP { const float* in[40]; float* out; unsigned char* ws; };

DI float bf2f(bf16_t b) { return __uint_as_float(((unsigned)b) << 16); }
DI bf16_t f2bf(float f) { __bf16 b = (__bf16)f; return __builtin_bit_cast(bf16_t, b); }
DI bf16x8 pack8v(f32x8 v) { bfv8 b = __builtin_convertvector(v, bfv8); return __builtin_bit_cast(bf16x8, b); }
DI s16x4 pack4v(f32x4 v) { bfv4 b = __builtin_convertvector(v, bfv4); return __builtin_bit_cast(s16x4, b); }
DI bf16x8 pack16(const f32x16& x, int s) { f32x8 v;
#pragma unroll
    for (int j = 0; j < 8; ++j) v[j] = x[8 * s + j];
    return pack8v(v); }
DI float lo16(unsigned u) { return __uint_as_float(u << 16); }
DI float hi16(unsigned u) { return __uint_as_float(u & 0xffff0000u); }
DI f32x8 unpack8(bf16x8 b) { u32x4 u = __builtin_bit_cast(u32x4, b); f32x8 r;
#pragma unroll
    for (int i = 0; i < 4; ++i) { r[2 * i] = lo16(u[i]); r[2 * i + 1] = hi16(u[i]); }
    return r; }
DI float sigm(float x) { return __builtin_amdgcn_rcpf(1.f + __expf(-x)); }
DI float tanh_(float z) { return 1.f - 2.f * __builtin_amdgcn_rcpf(__expf(2.f * z) + 1.f); }
DI float gelu_t(float x) { return 0.5f * x * (1.f + tanh_(0.7978845608028654f * (x + 0.044715f * x * x * x))); }
DI float silu_(float x) { return x * sigm(x); }
DI float softplus_(float x) { return x > 20.f ? x : log1pf(expf(x)); }
DI float logsig_(float x) { return x >= 0.f ? -log1pf(expf(-x)) : x - log1pf(expf(x)); }
DI float softcap_(float x) { return 15.f * tanh_(x * (1.f / 15.f)); }
DI float wave_sum(float v) {
#pragma unroll
    for (int o = 32; o; o >>= 1) v += __shfl_xor(v, o);
    return v; }
DI float wave_incl_sum(float v, int lane) {
#pragma unroll
    for (int o = 1; o < 64; o <<= 1) { float t = __shfl_up(v, o); if (lane >= o) v += t; }
    return v; }
DI float wave_incl_max(float v, int lane) {
#pragma unroll
    for (int o = 1; o < 64; o <<= 1) { float t = __shfl_up(v, o); if (lane >= o) v = fmaxf(v, t); }
    return v; }
DI void butterfly16(float (&a)[16], int lane) {
#pragma unroll
    for (int i = 0; i < 8; ++i) { const bool up = (lane & 32) != 0; const float send = up ? a[i] : a[i + 8], keep = up ? a[i + 8] : a[i]; a[i] = keep + __shfl_xor(send, 32); }
#pragma unroll
    for (int i = 0; i < 4; ++i) { const bool up = (lane & 16) != 0; const float send = up ? a[i] : a[i + 4], keep = up ? a[i + 4] : a[i]; a[i] = keep + __shfl_xor(send, 16); }
#pragma unroll
    for (int i = 0; i < 2; ++i) { const bool up = (lane & 8) != 0; const float send = up ? a[i] : a[i + 2], keep = up ? a[i + 2] : a[i]; a[i] = keep + __shfl_xor(send, 8); }
    { const bool up = (lane & 4) != 0; const float send = up ? a[0] : a[1], keep = up ? a[1] : a[0]; a[0] = keep + __shfl_xor(send, 4); }
    a[0] += __shfl_xor(a[0], 2); a[0] += __shfl_xor(a[0], 1);
}
DI int bsel16(int lane) { return ((lane >> 5) & 1) * 8 + ((lane >> 4) & 1) * 4 + ((lane >> 3) & 1) * 2 + ((lane >> 2) & 1); }
DI int crow(int reg, int h) { return (reg & 3) + 8 * (reg >> 2) + 4 * h; }
DI int perm16(int k) { return (k & ~12) | ((k & 4) << 1) | ((k & 8) >> 1); }
#define MFMA32(a, b, c) __builtin_amdgcn_mfma_f32_32x32x16_bf16((a), (b), (c), 0, 0, 0)
#define MFMA16(a, b, c) __builtin_amdgcn_mfma_f32_16x16x32_bf16((a), (b), (c), 0, 0, 0)
#define WAVE_FENCE() do { asm volatile("s_waitcnt lgkmcnt(0)" ::: "memory"); __builtin_amdgcn_wave_barrier(); asm volatile("" ::: "memory"); } while (0)

typedef __attribute__((address_space(4))) const unsigned long long* ka_t;
typedef __attribute__((address_space(1))) float gfloat_t; typedef __attribute__((address_space(1))) unsigned char guchar_t;
struct InTab { ka_t ka; DI const float* operator[](int i) const { return (const float*)(const gfloat_t*)ka[i]; } };
struct Ctx {
    InTab in; float* out; unsigned char* ws; unsigned char* lds;
    bf16_t *R1, *XN, *Y3, *W, *YS5; unsigned char* GS; float *SG, *GL;
    int tid, lane, wave, G, bid;
};

template <class F> struct Epi8 {
    static constexpr bool PERM = true, AFTER_DRAIN = false;
    F f;
    DI void operator()(const f32x4 (&acc)[2][2][4][2], const pg8::Unit& u, int wr, int wc, int fr, int fq) const {
        const int row0 = u.pm * 256 + wr * 64 + fr, col0 = u.pn * 256 + wc * 32 + 8 * fq;
#pragma unroll
        for (int ai = 0; ai < 2; ++ai)
#pragma unroll
            for (int m = 0; m < 4; ++m)
#pragma unroll
                for (int bj = 0; bj < 2; ++bj) f(row0 + ai * 128 + m * 16, col0 + bj * 128, acc[ai][bj][m][0], acc[ai][bj][m][1]);
    }
};
DI f32x8 cat8(f32x4 a, f32x4 b) { f32x8 r; r[0] = a[0]; r[1] = a[1]; r[2] = a[2]; r[3] = a[3]; r[4] = b[0]; r[5] = b[1]; r[6] = b[2]; r[7] = b[3]; return r; }
struct FStore { bf16_t* dst; int ld;
    DI void s(int row, int col, float v) const { dst[(size_t)row * ld + col] = f2bf(v); }
    DI void operator()(int row, int col, f32x4 a, f32x4 b) const { *(bf16x8*)(dst + (size_t)row * ld + col) = pack8v(cat8(a, b)); } };
struct FSig { bf16_t* dst; int ld;
    DI void s(int row, int col, float v) const { dst[(size_t)row * ld + col] = f2bf(sigm(v)); }
    DI void operator()(int row, int col, f32x4 a, f32x4 b) const { f32x8 v = cat8(a, b);
#pragma unroll
        for (int i = 0; i < 8; ++i) v[i] = sigm(v[i]);
        *(bf16x8*)(dst + (size_t)row * ld + col) = pack8v(v); } };
struct FGlu { const bf16_t* y; const float* bias; bf16_t* dst;
    DI void s(int row, int col, float v) const { dst[(size_t)row * 512 + col] = f2bf(bf2f(y[(size_t)row * 512 + col]) * sigm(v + bias[col])); }
    DI void operator()(int row, int col, f32x4 a, f32x4 b) const { f32x8 v = cat8(a, b); f32x8 yv = unpack8(*(const bf16x8*)(y + (size_t)row * 512 + col));
        f32x4 b0 = *(const f32x4*)(bias + col), b1 = *(const f32x4*)(bias + col + 4);
#pragma unroll
        for (int i = 0; i < 8; ++i) v[i] = yv[i] * sigm(v[i] + (i < 4 ? b0[i] : b1[i - 4]));
        *(bf16x8*)(dst + (size_t)row * 512 + col) = pack8v(v); } };
struct FBranch { const bf16_t* gates; bf16_t* merged; int first;
    DI void s(int row, int col, float v) const { bf16_t* mp = merged + (size_t)row * 1024 + col; const float g = bf2f(gates[(size_t)row * 4096 + col]); *mp = f2bf((first ? 0.f : bf2f(*mp)) + g * v); }
    DI void operator()(int row, int col, f32x4 a, f32x4 b) const { f32x8 v = cat8(a, b); f32x8 gv = unpack8(*(const bf16x8*)(gates + (size_t)row * 4096 + col));
        bf16x8* mp = (bf16x8*)(merged + (size_t)row * 1024 + col);
        f32x8 o;
        if (first) {
#pragma unroll
            for (int i = 0; i < 8; ++i) o[i] = gv[i] * v[i];
        } else { f32x8 mv = unpack8(*mp);
#pragma unroll
            for (int i = 0; i < 8; ++i) o[i] = mv[i] + gv[i] * v[i];
        }
        *mp = pack8v(o); } };
struct FRes { float* xr;
    DI void s(int row, int col, float v) const { xr[(size_t)row * 1024 + col] += v; }
    DI void operator()(int row, int col, f32x4 a, f32x4 b) const { if (row < MR) { f32x4* p = (f32x4*)(xr + (size_t)row * 1024 + col); p[0] = p[0] + a; p[1] = p[1] + b; } } };
struct FResB { float* xr; bf16_t* xb;
    DI void s(int row, int col, float v) const { const float x = xr[(size_t)row * 1024 + col] + v; xr[(size_t)row * 1024 + col] = x; xb[(size_t)row * 1024 + col] = f2bf(x); }
    DI void operator()(int row, int col, f32x4 a, f32x4 b) const { if (row < MR) { f32x4* p = (f32x4*)(xr + (size_t)row * 1024 + col); const f32x4 x0 = p[0] + a, x1 = p[1] + b; p[0] = x0; p[1] = x1;
            *(bf16x8*)(xb + (size_t)row * 1024 + col) = pack8v(cat8(x0, x1)); } } };
struct FRelu2 { bf16_t* dst;
    DI void s(int row, int col, float v) const { const float r = fmaxf(v, 0.f); dst[(size_t)row * 4096 + col] = f2bf(r * r); }
    DI void operator()(int row, int col, f32x4 a, f32x4 b) const { f32x8 v = cat8(a, b);
#pragma unroll
        for (int i = 0; i < 8; ++i) { float r = fmaxf(v[i], 0.f); v[i] = r * r; }
        *(bf16x8*)(dst + (size_t)row * 4096 + col) = pack8v(v); } };
struct FPle { const bf16_t* T; float* xr;
    DI void s(int row, int col, float v) const { xr[(size_t)row * 1024 + col] += bf2f(T[(size_t)row * 1024 + col]) * sigm(v); }
    DI void operator()(int row, int col, f32x4 a, f32x4 b) const { if (row < MR) { f32x8 v = cat8(a, b); f32x8 tv = unpack8(*(const bf16x8*)(T + (size_t)row * 1024 + col));
            f32x4* p = (f32x4*)(xr + (size_t)row * 1024 + col); f32x4 x0 = p[0], x1 = p[1];
#pragma unroll
            for (int i = 0; i < 4; ++i) { x0[i] += tv[i] * sigm(v[i]); x1[i] += tv[4 + i] * sigm(v[4 + i]); }
            p[0] = x0; p[1] = x1; } } };

DI f32x16 small_part(const Ctx& c, const bf16_t* A, const bf16_t* Bt, int K, int tile, int kq) {
    int r = c.lane & 31, hh = c.lane >> 5; asm volatile("" : "+v"(r), "+v"(hh));
    const int mt = tile & 3, nt = tile >> 2, K4 = K >> 2;
    const bf16_t* ap = A + (size_t)(MP + mt * 32 + r) * K + kq * K4 + hh * 8;
    const bf16_t* bp = Bt + (size_t)(nt * 32 + r) * K + kq * K4 + hh * 8;
    f32x16 acc;
#pragma unroll
    for (int j = 0; j < 16; ++j) acc[j] = 0.f;
    if (K4 >= 128) {
        bf16x8 a[8], b[8];
#pragma unroll
        for (int j = 0; j < 8; ++j) { a[j] = *(const bf16x8*)(ap + j * 16); b[j] = *(const bf16x8*)(bp + j * 16); }
        for (int k = 128; k < K4; k += 128) {
            bf16x8 an[8], bn[8];
#pragma unroll
            for (int j = 0; j < 8; ++j) { an[j] = *(const bf16x8*)(ap + k + j * 16); bn[j] = *(const bf16x8*)(bp + k + j * 16); }
#pragma unroll
            for (int j = 0; j < 8; ++j) acc = MFMA32(a[j], b[j], acc);
#pragma unroll
            for (int j = 0; j < 8; ++j) { a[j] = an[j]; b[j] = bn[j]; }
        }
#pragma unroll
        for (int j = 0; j < 8; ++j) acc = MFMA32(a[j], b[j], acc);
    } else {
#pragma unroll
        for (int j = 0; j < 4; ++j) { const bf16x8 a = *(const bf16x8*)(ap + j * 16), b = *(const bf16x8*)(bp + j * 16); acc = MFMA32(a, b, acc); }
    }
    return acc;
}
template <class F> DI void run_gemm(const Ctx& c, const bf16_t* A, const bf16_t* Bt, int N, int K, const F& f) {
    { const int ntile = 4 * (N >> 5), grp = c.wave >> 2, kq = c.wave & 3;
      LAS float* red = (LAS float*)c.lds;
      for (int t0 = 0; t0 < ntile; t0 += 2 * c.G) {
          const int t = t0 + grp * c.G + c.bid; const bool live = t < ntile;
          if (live) { const f32x16 acc = small_part(c, A, Bt, K, t, kq);
#pragma unroll
              for (int i = 0; i < 16; ++i) red[(c.wave * 16 + i) * 64 + c.lane] = acc[i]; }
          __syncthreads();
          if (live && kq == 0) { const int mt = t & 3, nt = t >> 2, r = c.lane & 31, hh = c.lane >> 5;
#pragma unroll
              for (int i = 0; i < 16; ++i) { const int o = (c.wave * 16 + i) * 64 + c.lane; const float v = (red[o] + red[o + 1024]) + (red[o + 2048] + red[o + 3072]);
                  f.s(MP + mt * 32 + crow(i, hh), nt * 32 + r, v); } }
          __syncthreads();
      } }
    pg8::Gemm g{A, Bt, MP, N, K}; pg8::StaticOrder S; S.init(MP, N, c.G, c.bid);
    Epi8<F> E{f};
    pg8::gemm_phase<Epi8<F>, pg8::StaticOrder>((PG8_LAS unsigned char*)c.lds, g, S, E, nullptr);
    __syncthreads();
}

DI void tr_task(const Ctx& c, const float* src, int ld, int K, int n, bf16_t* dst, int rot) {
    float* tile = (float*)c.lds;
    const int nkt = K >> 6, ntiles = nkt * (n >> 6);
    const int start = (c.bid + c.G - (rot % c.G)) % c.G;
    for (int t = start; t < ntiles; t += c.G) {
        const int kt = t % nkt, nt = t / nkt;
        const int r = c.tid >> 4, c4 = (c.tid & 15) * 4;
#pragma unroll
        for (int p = 0; p < 2; ++p) { const int row = r + 32 * p; const f32x4 v = *(const f32x4*)(src + (size_t)(kt * 64 + row) * ld + nt * 64 + c4);
            tile[row * 65 + c4] = v[0]; tile[row * 65 + c4 + 1] = v[1]; tile[row * 65 + c4 + 2] = v[2]; tile[row * 65 + c4 + 3] = v[3]; }
        __syncthreads();
        { const int nn = c.tid >> 3, kc = (c.tid & 7) * 8; f32x8 v;
#pragma unroll
          for (int e = 0; e < 8; ++e) v[e] = tile[(kc + e) * 65 + nn];
          *(bf16x8*)(dst + (size_t)(nt * 64 + nn) * K + kt * 64 + kc) = pack8v(v); }
        __syncthreads();
    }
}
DI void phase_weights(const Ctx& c, int L) {
    const float* win = c.in[12] + (size_t)L * 1024 * DIN;
    bf16_t* W = c.W;
    tr_task(c, win + 0, DIN, 1024, 2048, W + WO_IN, 0);
    tr_task(c, win + 2568, DIN, 1024, 1024, W + WO_IN + (size_t)2048 * 1024, 0);
    tr_task(c, win + 2048, DIN, 1024, 512, W + WO_IN + (size_t)3072 * 1024, 0);
    tr_task(c, win + 3592, DIN, 1024, 512, W + WO_IN + (size_t)3584 * 1024, 128);
    tr_task(c, win + 4112, DIN, 1024, 3072, W + WO_G, 0);
    tr_task(c, c.in[21] + (size_t)L * 512 * 512, 512, 512, 512, W + WO_GLU, 0);
    tr_task(c, c.in[30] + (size_t)L * 512 * 1024, 1024, 512, 1024, W + WO_BR, 64);
    tr_task(c, c.in[31] + (size_t)L * 512 * 1024, 1024, 512, 1024, W + WO_BR + (size_t)1024 * 512, 192);
    tr_task(c, c.in[32] + (size_t)L * 512 * 1024, 1024, 512, 1024, W + WO_BR + (size_t)2 * 1024 * 512, 64);
    tr_task(c, c.in[33] + (size_t)L * 1024 * 1024, 1024, 1024, 1024, W + WO_OUT, 0);
    tr_task(c, c.in[35] + (size_t)L * 1024 * 4096, 4096, 1024, 4096, W + WO_UP, 0);
    tr_task(c, c.in[36] + (size_t)L * 4096 * 1024, 1024, 4096, 1024, W + WO_DN, 0);
    tr_task(c, c.in[37] + (size_t)L * 256 * 1024, 1024, 256, 1024, W + WO_PLE, 0);
    tr_task(c, c.in[38] + (size_t)L * 1024 * 1024, 1024, 1024, 1024, W + WO_PG, 64);
}

template <int MODE> DI void phase_rmsnorm(const Ctx& c, int L) {
    float* wsm = (float*)c.lds;
    const float* gain = (MODE == 0 ? c.in[11] : c.in[34]) + (size_t)L * 1024;
    if (MODE == 0) {
        const float* win = c.in[12] + (size_t)L * 1024 * DIN;
        for (int idx = c.tid; idx < 4096; idx += 512) { const int k = idx >> 2, part = idx & 3, seg = part >> 1, half = part & 1;
            const f32x4 v = *(const f32x4*)(win + (size_t)k * DIN + (seg ? 4104 : 2560) + half * 4);
            const int sb = seg * 8 + half * 4;
            wsm[(sb + 0) * 1024 + k] = v[0]; wsm[(sb + 1) * 1024 + k] = v[1]; wsm[(sb + 2) * 1024 + k] = v[2]; wsm[(sb + 3) * 1024 + k] = v[3]; }
        __syncthreads();
    }
    float* XR = c.out;
    for (int row = c.bid * 8 + c.wave; row < MR; row += c.G * 8) {
        const float* src = (MODE == 0 && L == 0) ? (row < MP ? c.in[0] + (size_t)row * 1024 : c.in[1] + (size_t)(row - MP) * 1024) : XR + (size_t)row * 1024;
        f32x4 x[4]; float ss = 0.f;
#pragma unroll
        for (int i = 0; i < 4; ++i) { x[i] = *(const f32x4*)(src + c.lane * 4 + 256 * i); ss += x[i][0] * x[i][0] + x[i][1] * x[i][1] + x[i][2] * x[i][2] + x[i][3] * x[i][3]; }
        ss = wave_sum(ss);
        const float rs = rsqrtf(ss * (1.f / 1024.f) + EPS);
        if (MODE == 0 && L == 0) {
#pragma unroll
            for (int i = 0; i < 4; ++i) *(f32x4*)(XR + (size_t)row * 1024 + c.lane * 4 + 256 * i) = x[i];
        }
#pragma unroll
        for (int i = 0; i < 4; ++i) { const f32x4 g = *(const f32x4*)(gain + c.lane * 4 + 256 * i); x[i] = x[i] * rs * g;
            *(s16x4*)(c.XN + (size_t)row * 1024 + c.lane * 4 + 256 * i) = pack4v(x[i]); }
        if (MODE == 0) {
            float a[16];
#pragma unroll
            for (int s = 0; s < 16; ++s) { float t = 0.f;
#pragma unroll
                for (int i = 0; i < 4; ++i) { const f32x4 w = *(const f32x4*)(wsm + s * 1024 + c.lane * 4 + 256 * i); t += x[i][0] * w[0] + x[i][1] * w[1] + x[i][2] * w[2] + x[i][3] * w[3]; }
                a[s] = t; asm volatile("" ::: "memory"); }
#pragma unroll
            for (int i = 0; i < 8; ++i) { const bool up = (c.lane & 32) != 0; const float send = up ? a[i] : a[i + 8], keep = up ? a[i + 8] : a[i]; a[i] = keep + __shfl_xor(send, 32); }
#pragma unroll
            for (int i = 0; i < 4; ++i) { const bool up = (c.lane & 16) != 0; const float send = up ? a[i] : a[i + 4], keep = up ? a[i + 4] : a[i]; a[i] = keep + __shfl_xor(send, 16); }
#pragma unroll
            for (int i = 0; i < 2; ++i) { const bool up = (c.lane & 8) != 0; const float send = up ? a[i] : a[i + 2], keep = up ? a[i + 2] : a[i]; a[i] = keep + __shfl_xor(send, 8); }
            { const bool up = (c.lane & 4) != 0; const float send = up ? a[0] : a[1], keep = up ? a[1] : a[0]; a[0] = keep + __shfl_xor(send, 4); }
            a[0] += __shfl_xor(a[0], 2); a[0] += __shfl_xor(a[0], 1);
            if ((c.lane & 3) == 0) { const int sidx = ((c.lane >> 5) & 1) * 8 + ((c.lane >> 4) & 1) * 4 + ((c.lane >> 3) & 1) * 2 + ((c.lane >> 2) & 1); c.SG[(size_t)row * 16 + sidx] = a[0]; }
        }
    }
    __syncthreads();
}

DI void phase_gdn_prep(const Ctx& c, int L) {
    constexpr int RS = 132, AS = 68, BP = 136;
    LAS float* AmT0 = (LAS float*)c.lds;
    const float* convw = c.in[23] + (size_t)L * 4 * 1536;
    const bf16_t* PR = c.R1;
    for (int item = c.bid; item < 1024; item += c.G) {
        const int ch = item & 31, h = (item >> 5) & 3, b = item >> 7;
        const int t0 = b * SEQ + ch * 64;
        unsigned char* gi = c.GS + (size_t)item * GI_BYTES;
        LAS float* AmT = AmT0; asm volatile("" : "+v"(AmT));
        LAS float* beta = AmT + 64 * AS; LAS float* gcum = beta + 64; LAS float* part = gcum + 64;
        LAS float* vs = part + 128; asm volatile("" : "+v"(vs));
        LAS bf16_t* qb = (LAS bf16_t*)(vs + 64 * RS); asm volatile("" : "+v"(qb));
        LAS bf16_t* khi = qb + 64 * BP; asm volatile("" : "+v"(khi));
        LAS bf16_t* klo = khi + 64 * BP; asm volatile("" : "+v"(klo));
        if (c.wave == 7) { const size_t row = (size_t)(t0 + c.lane);
            const float bt = sigm(c.SG[row * 16 + h]);
            const float g = -expf(c.in[24][L * 4 + h]) * softplus_(c.SG[row * 16 + 4 + h] + c.in[25][L * 4 + h]);
            const float gc = wave_incl_sum(g, c.lane);
            beta[c.lane] = bt; gcum[c.lane] = gc;
            if (c.lane == 63) c.GL[item] = expf(gc); }
        { const int d = c.tid & 127, tq = c.tid >> 7;
          float qk[2][16];
#pragma unroll
          for (int which = 0; which < 3; ++which) {
              const int pcol = PQ + which * 512 + h * 128 + d, wcol = which * 512 + h * 128 + d;
              const float w0 = convw[wcol], w1 = convw[1536 + wcol], w2 = convw[3072 + wcol], w3 = convw[4608 + wcol];
              float xin[19];
#pragma unroll
              for (int i = 0; i < 19; ++i) { const int tt = ch * 64 + tq * 16 + i - 3; const int tc = tt < 0 ? 0 : tt;
                  const float v = bf2f(PR[(size_t)(b * SEQ + tc) * NPROJ + pcol]); xin[i] = tt < 0 ? 0.f : v; }
#pragma unroll
              for (int t = 0; t < 16; ++t) { const float a = silu_(xin[t] * w0 + xin[t + 1] * w1 + xin[t + 2] * w2 + xin[t + 3] * w3);
                  if (which == 2) vs[(tq * 16 + t) * RS + d] = a; else qk[which][t] = a; }
          }
#pragma unroll
          for (int which = 0; which < 2; ++which) {
              float ssq[16];
#pragma unroll
              for (int t = 0; t < 16; ++t) ssq[t] = qk[which][t] * qk[which][t];
              butterfly16(ssq, c.lane);
              __syncthreads();
              if ((c.lane & 3) == 0) part[c.wave * 16 + bsel16(c.lane)] = ssq[0];
              __syncthreads();
#pragma unroll
              for (int t = 0; t < 16; ++t) { const float tot = part[c.wave * 16 + t] + part[(c.wave ^ 1) * 16 + t];
                  const float v = qk[which][t] * rsqrtf(tot + EPS) * (which == 0 ? 0.08838834764831845f : 1.f);
                  const bf16_t hi = f2bf(v);
                  if (which == 0) qb[(tq * 16 + t) * BP + d] = hi;
                  else { khi[(tq * 16 + t) * BP + d] = hi; klo[(tq * 16 + t) * BP + d] = f2bf(v - bf2f(hi)); } }
          } }
        __syncthreads();
        { const int r = c.lane & 31, hh = c.lane >> 5, wq = c.wave & 3, tm = wq >> 1, tn = wq & 1;
          if (!(c.wave < 4 && tm == 0 && tn == 1)) {
              f32x16 acc;
#pragma unroll
              for (int j = 0; j < 16; ++j) acc[j] = 0.f;
              const LAS bf16_t* arow = (c.wave < 4 ? khi : qb) + (tm * 32 + r) * BP + hh * 8;
              const LAS bf16_t* brow = khi + (tn * 32 + r) * BP + hh * 8;
#pragma unroll
              for (int ks = 0; ks < 8; ++ks) { const bf16x8 av = *(const LAS bf16x8*)(arow + ks * 16), bv = *(const LAS bf16x8*)(brow + ks * 16);
                  acc = MFMA32(av, bv, acc);
                  if (c.wave < 4) { const bf16x8 al = *(const LAS bf16x8*)(arow + 64 * BP + ks * 16), bl = *(const LAS bf16x8*)(brow + 64 * BP + ks * 16);
                      acc = MFMA32(av, bl, acc); acc = MFMA32(al, bv, acc); } }
              const int s = tn * 32 + r; const float gs = gcum[s];
              bf16_t* at = (bf16_t*)(gi + GI_A);
#pragma unroll
              for (int i = 0; i < 16; ++i) { const int t = tm * 32 + crow(i, hh); const float dec = (t >= s) ? __expf(gcum[t] - gs) : 0.f;
                  if (c.wave < 4) { if (t > s) AmT[s * AS + t] = beta[t] * acc[i] * dec; }
                  else at[t * 64 + (s & ~15) + perm16(s & 15)] = f2bf(acc[i] * dec); }
          } }
        __syncthreads();
        if (c.tid < 256) {
            const int col = c.tid; float x[64];
#pragma unroll
            for (int t = 0; t < 64; ++t) x[t] = (col < 128) ? vs[t * RS + col] * beta[t] : (bf2f(khi[t * BP + (col - 128)]) + bf2f(klo[t * BP + (col - 128)])) * beta[t] * __expf(gcum[t]);
#pragma unroll
            for (int j = 0; j < 63; ++j) { const float xj = x[j];
#pragma unroll
                for (int g4 = (j + 1) / 4; g4 < 16; ++g4) { const f32x4 a = *(const LAS f32x4*)(AmT + j * AS + g4 * 4);
#pragma unroll
                    for (int e = 0; e < 4; ++e) if (g4 * 4 + e > j) x[g4 * 4 + e] -= a[e] * xj; } }
            if (col < 128) { bf16_t* up = (bf16_t*)(gi + GI_U); const int sl = col >> 5, r = col & 31;
#pragma unroll
                for (int t = 0; t < 64; ++t) { const int mt = t >> 5, tt = t & 31, hh = (tt >> 2) & 1, i = (tt & 3) + 4 * (tt >> 3);
                    up[((sl * 2 + mt) * 16 + i) * 64 + r + 32 * hh] = f2bf(x[t]); }
            } else { bf16_t* wp = (bf16_t*)(gi + GI_W); const int dk = col - 128, pd = (dk & ~15) + perm16(dk & 15);
#pragma unroll
                for (int t = 0; t < 64; ++t) wp[t * 128 + pd] = f2bf(-x[t]); }
        } else {
            bf16_t* qp = (bf16_t*)(gi + GI_Q); bf16_t* kp = (bf16_t*)(gi + GI_K);
            const float g63 = gcum[63];
            for (int idx = c.tid - 256; idx < 64 * 128; idx += 256) { const int t = idx >> 7, d = idx & 127;
                qp[t * 128 + (d & ~15) + perm16(d & 15)] = f2bf(bf2f(qb[t * BP + d]) * __expf(gcum[t])); }
            for (int idx = c.tid - 256; idx < 64 * 128; idx += 256) { const int d = idx >> 6, t = idx & 63;
                kp[d * 64 + (t & ~15) + perm16(t & 15)] = f2bf((bf2f(khi[t * BP + d]) + bf2f(klo[t * BP + d])) * __expf(g63 - gcum[t])); }
        }
        __syncthreads();
    }
}

constexpr int GB_W = 0, GB_Q = 16384, GB_A = 32768, GB_K = 40960, GB_U = 57344, GB_BYTES = 61440;
DI void dma16(const void* g, unsigned lds_addr) { asm volatile("s_mov_b32 m0, %1\n\tglobal_load_lds_dwordx4 %0, off" :: "v"(g), "s"(lds_addr) : "memory", "m0"); }
DI void gdn_issue(const Ctx& c, int item, int sl, int r, int hh, int ln, PG8_LAS unsigned char* buf) {
    const unsigned char* gi = c.GS + (size_t)item * GI_BYTES;
    const bf16_t* up = (const bf16_t*)(gi + GI_U); const bf16_t* wp = (const bf16_t*)(gi + GI_W); const bf16_t* qp = (const bf16_t*)(gi + GI_Q);
    const bf16_t* kp = (const bf16_t*)(gi + GI_K); const bf16_t* ap = (const bf16_t*)(gi + GI_A);
#pragma unroll
    for (int mt = 0; mt < 2; ++mt)
#pragma unroll
        for (int ks = 0; ks < 8; ++ks) {
            dma16((wp + (mt * 32 + r) * 128 + ks * 16 + hh * 8), (unsigned)(size_t)(buf + GB_W + (mt * 8 + ks) * 1024));
            dma16((qp + (mt * 32 + r) * 128 + ks * 16 + hh * 8), (unsigned)(size_t)(buf + GB_Q + (mt * 8 + ks) * 1024)); }
#pragma unroll
    for (int mt = 0; mt < 2; ++mt)
#pragma unroll
        for (int ks = 0; ks < 4; ++ks)
            dma16((ap + (mt * 32 + r) * 64 + ks * 16 + hh * 8), (unsigned)(size_t)(buf + GB_A + (mt * 4 + ks) * 1024));
#pragma unroll
    for (int i = 0; i < 4; ++i)
#pragma unroll
        for (int ks = 0; ks < 4; ++ks)
            dma16((kp + (i * 32 + r) * 64 + ks * 16 + hh * 8), (unsigned)(size_t)(buf + GB_K + (i * 4 + ks) * 1024));
#pragma unroll
    for (int j = 0; j < 4; ++j)
        dma16((up + (size_t)sl * 2048 + j * 512 + ln * 8), (unsigned)(size_t)(buf + GB_U + j * 1024));
}
DI void task_gdn_seq(const Ctx& c, int L, int unit) {
    const int sl = (unit >> 3) & 3, stream = (unit & 7) + 8 * (unit >> 5);
    const int b = stream >> 2, h = stream & 3;
    const int r0_ = c.lane & 31, hh0_ = c.lane >> 5; int r = r0_, hh = hh0_, ln = c.lane;
    PG8_LAS unsigned char* lbase = (PG8_LAS unsigned char*)c.lds;
    f32x16 S[4];
#pragma unroll
    for (int i = 0; i < 4; ++i)
#pragma unroll
        for (int j = 0; j < 16; ++j) S[i][j] = 0.f;
    bf16_t* yo = c.Y3 + (size_t)1 * MPAD * 512;
    gdn_issue(c, stream * 32, sl, r, hh, ln, lbase);
    for (int ch = 0; ch < 32; ++ch) {
        r = r0_; hh = hh0_; ln = c.lane; asm volatile("" : "+v"(r), "+v"(hh), "+v"(ln));
        const int item = stream * 32 + ch;
        const float gl = c.GL[item];
        asm volatile("s_waitcnt vmcnt(0)" ::: "memory");
        PG8_LAS unsigned char* buf = lbase + (ch & 1) * GB_BYTES;
        if (ch + 1 < 32) gdn_issue(c, item + 1, sl, r, hh, ln, lbase + ((ch + 1) & 1) * GB_BYTES);
        PG8_LAS unsigned char* lb = buf + ln * 16; asm volatile("" : "+v"(lb));
        PG8_LAS unsigned char* ub = buf + GB_U + ln * 2; asm volatile("" : "+v"(ub));
        f32x16 vn[2], o[2];
#pragma unroll
        for (int mt = 0; mt < 2; ++mt)
#pragma unroll
            for (int i = 0; i < 16; ++i) { vn[mt][i] = bf2f(*(const PG8_LAS bf16_t*)(ub + (mt * 16 + i) * 128)); o[mt][i] = 0.f; }
        bf16x8 Sb[8];
#pragma unroll
        for (int ks = 0; ks < 8; ++ks) Sb[ks] = pack16(S[ks >> 1], ks & 1);
#pragma unroll
        for (int mt = 0; mt < 2; ++mt)
#pragma unroll
            for (int ks = 0; ks < 8; ++ks) { const bf16x8 a = *(const PG8_LAS bf16x8*)(lb + GB_W + (mt * 8 + ks) * 1024); vn[mt] = MFMA32(a, Sb[ks], vn[mt]); }
#pragma unroll
        for (int mt = 0; mt < 2; ++mt)
#pragma unroll
            for (int ks = 0; ks < 8; ++ks) { const bf16x8 a = *(const PG8_LAS bf16x8*)(lb + GB_Q + (mt * 8 + ks) * 1024); o[mt] = MFMA32(a, Sb[ks], o[mt]); }
        bf16x8 Vb[4];
#pragma unroll
        for (int ks = 0; ks < 4; ++ks) Vb[ks] = pack16(vn[ks >> 1], ks & 1);
#pragma unroll
        for (int mt = 0; mt < 2; ++mt)
#pragma unroll
            for (int ks = 0; ks < 4; ++ks) { const bf16x8 a = *(const PG8_LAS bf16x8*)(lb + GB_A + (mt * 4 + ks) * 1024); o[mt] = MFMA32(a, Vb[ks], o[mt]); }
#pragma unroll
        for (int i = 0; i < 4; ++i) {
#pragma unroll
            for (int j = 0; j < 16; ++j) S[i][j] *= gl;
#pragma unroll
            for (int ks = 0; ks < 4; ++ks) { const bf16x8 a = *(const PG8_LAS bf16x8*)(lb + GB_K + (i * 4 + ks) * 1024); S[i] = MFMA32(a, Vb[ks], S[i]); }
        }
        const size_t rowb = (size_t)(b * SEQ + ch * 64);
#pragma unroll
        for (int mt = 0; mt < 2; ++mt)
#pragma unroll
            for (int i = 0; i < 16; ++i) yo[(rowb + mt * 32 + crow(i, hh)) * 512 + h * 128 + sl * 32 + r] = f2bf(o[mt][i]);
        asm volatile("s_waitcnt lgkmcnt(0)" ::: "memory");
    }
    float* so = c.out + O_GDN_P + ((size_t)(L * NB + b) * 4 + h) * 128 * 128;
#pragma unroll
    for (int i = 0; i < 4; ++i)
#pragma unroll
        for (int j = 0; j < 16; ++j) so[(size_t)(i * 32 + crow(j, hh)) * 128 + sl * 32 + r] = S[i][j];
}

DI void task_ml_gates(const Ctx& c, int L, int item) {
    const int ch = item & 31, h = (item >> 5) & 3, b = item >> 7, lane = c.lane;
    int r = lane & 31, hh = lane >> 5; asm volatile("" : "+v"(r), "+v"(hh));
    const size_t t0 = (size_t)(b * SEQ + ch * 64);
    const size_t row = t0 + lane;
    const float li = softcap_(c.SG[row * 16 + 8 + h] + c.in[27][L * 4 + h]);
    const float lf = logsig_(softcap_(c.SG[row * 16 + 12 + h] + c.in[28][L * 4 + h]));
    const float bc = wave_incl_sum(lf, lane);
    const float av = li - bc;
    const float cm = wave_incl_max(av, lane);
    float* mg = (float*)(c.ws + WS_MG) + (size_t)item * 320;
    mg[lane] = av; mg[64 + lane] = cm; mg[128 + lane] = bc;
    LAS float* a_s = (LAS float*)(c.lds + 122880 + c.wave * 1024);
    WAVE_FENCE();
    a_s[lane] = av;
    WAVE_FENCE();
    const bf16_t* qb = c.R1 + t0 * NPROJ + PMQ + h * 64; const bf16_t* kb = c.R1 + t0 * NPROJ + PMK + h * 64;
    f32x16 PT[2][2];
#pragma unroll
    for (int ms = 0; ms < 2; ++ms)
#pragma unroll
        for (int nt = 0; nt < 2; ++nt)
#pragma unroll
            for (int j = 0; j < 16; ++j) PT[ms][nt][j] = 0.f;
#pragma unroll
    for (int ks = 0; ks < 4; ++ks) { bf16x8 ak[2], bq[2];
#pragma unroll
        for (int m = 0; m < 2; ++m) { ak[m] = *(const bf16x8*)(kb + (size_t)(m * 32 + r) * NPROJ + ks * 16 + hh * 8); bq[m] = *(const bf16x8*)(qb + (size_t)(m * 32 + r) * NPROJ + ks * 16 + hh * 8); }
#pragma unroll
        for (int ms = 0; ms < 2; ++ms)
#pragma unroll
            for (int nt = 0; nt < 2; ++nt) PT[ms][nt] = MFMA32(ak[ms], bq[nt], PT[ms][nt]); }
    float dpv[2];
    unsigned char* pl = c.ws + WS_PL + (size_t)item * 8192 + lane * 16;
#pragma unroll
    for (int nt = 0; nt < 2; ++nt) { const float cmn = __shfl(cm, nt * 32 + r); float dp = 0.f;
#pragma unroll
        for (int ms = 0; ms < 2; ++ms)
#pragma unroll
            for (int g = 0; g < 4; ++g) { const f32x4 a4 = *(const LAS f32x4*)(a_s + ms * 32 + 8 * g + 4 * hh);
#pragma unroll
                for (int jj = 0; jj < 4; ++jj) { const int i = 4 * g + jj; const int s = ms * 32 + 8 * g + 4 * hh + jj;
                    const float wv = (s <= nt * 32 + r) ? __expf(a4[jj] - cmn) * 0.125f : 0.f;
                    PT[ms][nt][i] *= wv; dp += PT[ms][nt][i]; } }
        dp += __shfl_xor(dp, 32); dpv[nt] = dp;
#pragma unroll
        for (int ks = 0; ks < 4; ++ks) *(bf16x8*)(pl + (nt * 4 + ks) * 1024) = pack16(PT[ks >> 1][nt], ks & 1); }
    mg[192 + lane] = lane < 32 ? dpv[0] : dpv[1];
    { const float cm63 = __shfl(cm, 63);
      WAVE_FENCE();
      a_s[64 + lane] = __expf(av - cm63) * 0.125f;
      WAVE_FENCE();
      float dn = 0.f;
#pragma unroll 16
      for (int sq = 0; sq < 64; ++sq) dn += a_s[64 + sq] * bf2f(kb[(size_t)sq * NPROJ + lane]);
      mg[256 + lane] = dn;
      bf16x8 kw[2][4];
#pragma unroll
      for (int i = 0; i < 2; ++i)
#pragma unroll
          for (int ks = 0; ks < 4; ++ks) { f32x8 v;
#pragma unroll
              for (int j = 0; j < 8; ++j) { const int sc_ = 16 * ks + 8 * (j >> 2) + (j & 3); v[j] = bf2f(kb[(size_t)(sc_ + 4 * hh) * NPROJ + i * 32 + r]) * a_s[64 + sc_ + 4 * hh]; }
              kw[i][ks] = pack8v(v); }
      asm volatile("s_waitcnt vmcnt(0)" ::: "memory");
      bf16_t* kwb = c.R1 + t0 * NPROJ + PMK + h * 64;
#pragma unroll
      for (int i = 0; i < 2; ++i)
#pragma unroll
          for (int ks = 0; ks < 4; ++ks) *(bf16x8*)(kwb + (size_t)((i * 4 + ks) * 8 + (lane >> 3)) * NPROJ + (lane & 7) * 8) = kw[i][ks]; }
}
DI void ml_issue(const bf16_t* PR, const unsigned char* PLs  , int b, int h, int sl, int ch, int lane, unsigned bufaddr) {
    const size_t row = (size_t)(b * SEQ + ch * 64 + lane);
    const bf16_t* kp = PR + row * NPROJ + PMK + h * 64; const bf16_t* qp = PR + row * NPROJ + PMQ + h * 64; const bf16_t* vp = PR + row * NPROJ + PMV + h * 128 + sl * 32;
#pragma unroll
    for (int d8 = 0; d8 < 8; ++d8) { dma16(PR + (size_t)(b * SEQ + ch * 64 + d8 * 8 + (lane >> 3)) * NPROJ + PMK + h * 64 + (lane & 7) * 8, bufaddr + d8 * 1024); dma16(qp + d8 * 8, bufaddr + 8192 + d8 * 1024); }
#pragma unroll
    for (int d8 = 0; d8 < 4; ++d8) dma16(vp + d8 * 8, bufaddr + 16384 + d8 * 1024);
    const unsigned char* pl = PLs + (size_t)ch * 8192 + lane * 16;
#pragma unroll
    for (int fr = 0; fr < 8; ++fr) dma16(pl + fr * 1024, bufaddr + 20480 + fr * 1024);
}
DI void task_ml_seq(const Ctx& c, int L, int unit, float* wl  ) {
    const int sl = (unit >> 3) & 3, stream = (unit & 7) + 8 * (unit >> 5);
    const int b = stream >> 2, h = stream & 3;
    const int lane = c.lane, r0_ = lane & 31, hh0_ = lane >> 5;
    int r = r0_, hh = hh0_, lane_v = lane;
    LAS float* a_l = (LAS float*)wl; LAS float* w_l = a_l + 64; LAS float* sc_l = a_l + 128; LAS float* inv_l = a_l + 192;
    LAS float* n_l = a_l + 256;
    LAS unsigned char* bufs = (LAS unsigned char*)(a_l + 320);
    const unsigned bufaddr0 = (unsigned)(size_t)bufs;
    const bf16_t* PR = c.R1;
    f32x16 C[2];
#pragma unroll
    for (int i = 0; i < 2; ++i)
#pragma unroll
        for (int j = 0; j < 16; ++j) C[i][j] = 0.f;
    float nst = 0.f, mprev = 0.f;
    n_l[lane] = 0.f;
    bf16_t* yo = c.Y3 + (size_t)2 * MPAD * 512;
    float mgv[5];
    const unsigned char* PLs = c.ws + WS_PL + (size_t)(stream * 32) * 8192;
    { const float* mg = (const float*)(c.ws + WS_MG) + (size_t)(stream * 32) * 320; mgv[0] = mg[lane]; mgv[1] = mg[64 + lane]; mgv[2] = mg[128 + lane]; mgv[3] = mg[192 + lane]; mgv[4] = mg[256 + lane]; }
    ml_issue(PR, PLs, b, h, sl, 0, lane, bufaddr0);
    for (int ch = 0; ch < 32; ++ch) {
        r = r0_; hh = hh0_; lane_v = lane; asm volatile("" : "+v"(r), "+v"(hh), "+v"(lane_v));
        const float av = mgv[0], cmx = mgv[1], bc = mgv[2], dploc = mgv[3], dnloc = mgv[4];
        asm volatile("s_waitcnt vmcnt(0)" ::: "memory");
        if (ch + 1 < 32) ml_issue(PR, PLs, b, h, sl, ch + 1, lane_v, bufaddr0 + ((ch + 1) & 1) * 28672);
        { const int chn = ch + 1 < 32 ? ch + 1 : 31; const float* mg = (const float*)(c.ws + WS_MG) + (size_t)(stream * 32 + chn) * 320;
          mgv[0] = mg[lane_v]; mgv[1] = mg[64 + lane_v]; mgv[2] = mg[128 + lane_v]; mgv[3] = mg[192 + lane_v]; mgv[4] = mg[256 + lane_v]; }
        LAS unsigned char* Kc = bufs + (ch & 1) * 28672; asm volatile("" : "+v"(Kc));
        LAS unsigned char* Pf = Kc + 20480 + lane_v * 16; asm volatile("" : "+v"(Pf));
        LAS unsigned char* Qc = Kc + 8192; LAS unsigned char* Vc = Kc + 16384;
        LAS unsigned char* vbase = Vc + (r >> 3) * 1024 + (r & 7) * 2 + hh * 64; asm volatile("" : "+v"(vbase));
        LAS unsigned char* kbase = Kc + (r >> 3) * 1024 + (r & 7) * 2 + hh * 64; asm volatile("" : "+v"(kbase));
        LAS unsigned char* krow = Kc + hh * 1024 + r * 16; asm volatile("" : "+v"(krow));
        LAS unsigned char* qrow = Qc + hh * 1024 + r * 16; asm volatile("" : "+v"(qrow));
        LAS unsigned char* qr4 = Qc + r * 16 + hh * 8; asm volatile("" : "+v"(qr4));
        LAS unsigned char* kn = Kc + (lane_v >> 3) * 1024 + (lane_v & 7) * 2; asm volatile("" : "+v"(kn));
        LAS unsigned char* qln = Qc + lane_v * 16; asm volatile("" : "+v"(qln));
        LAS float* a4b = a_l + 4 * hh; asm volatile("" : "+v"(a4b));
        const size_t t0 = (size_t)(b * SEQ + ch * 64);
        const float Mt = fmaxf(mprev, cmx);
        const float sct = __expf(mprev - Mt);
        const float fsc = __expf(cmx - Mt);
        const float M63 = __shfl(Mt, 63), bc63 = __shfl(bc, 63);
        const float wlast = __expf(av - M63) * 0.125f;
        const float sclast = __expf(mprev - M63);
        WAVE_FENCE();
        float qn = 0.f;
#pragma unroll
        for (int d8 = 0; d8 < 8; ++d8) { const f32x8 qv = unpack8(*(const LAS bf16x8*)(qln + d8 * 1024));
            const f32x4 n0 = *(const LAS f32x4*)(n_l + d8 * 8), n1 = *(const LAS f32x4*)(n_l + d8 * 8 + 4);
            qn += qv[0] * n0[0] + qv[1] * n0[1] + qv[2] * n0[2] + qv[3] * n0[3] + qv[4] * n1[0] + qv[5] * n1[1] + qv[6] * n1[2] + qv[7] * n1[3]; }
        a_l[lane] = fsc; w_l[lane] = wlast;
        WAVE_FENCE();
        bf16x8 Vb[4];
#pragma unroll
        for (int ks = 0; ks < 4; ++ks)
#pragma unroll
            for (int j = 0; j < 8; ++j) Vb[ks][j] = (short)*(const LAS bf16_t*)(vbase + (16 * ks + 8 * (j >> 2) + (j & 3)) * 16);
        f32x16 num[2];
#pragma unroll
        for (int nt = 0; nt < 2; ++nt) {
#pragma unroll
            for (int j = 0; j < 16; ++j) num[nt][j] = 0.f;
#pragma unroll
            for (int ks = 0; ks < 4; ++ks) num[nt] = MFMA32(*(const LAS bf16x8*)(Pf + (nt * 4 + ks) * 1024), Vb[ks], num[nt]);
        }
        const float den = fsc * dploc + sct * qn;
        const float inv = 1.f / fmaxf(fabsf(den), __expf(-(bc + Mt)));
        sc_l[lane] = sct; inv_l[lane] = inv;
        WAVE_FENCE();
        { bf16x8 Cb[4];
#pragma unroll
          for (int kd = 0; kd < 4; ++kd) Cb[kd] = pack16(C[kd >> 1], kd & 1);
#pragma unroll
          for (int mt = 0; mt < 2; ++mt) { f32x16 qc;
#pragma unroll
              for (int j = 0; j < 16; ++j) qc[j] = 0.f;
#pragma unroll
              for (int kd = 0; kd < 4; ++kd) { const LAS unsigned char* qr = qr4 + kd * 2048 + mt * 512;
                  const s16x4 lo = *(const LAS s16x4*)qr, hi = *(const LAS s16x4*)(qr + 1024);
                  const bf16x8 a = __builtin_shufflevector(lo, hi, 0, 1, 2, 3, 4, 5, 6, 7);
                  qc = MFMA32(a, Cb[kd], qc); }
#pragma unroll
              for (int g = 0; g < 4; ++g) { const f32x4 f4 = *(const LAS f32x4*)(a4b + mt * 32 + 8 * g), s4 = *(const LAS f32x4*)(a4b + 128 + mt * 32 + 8 * g), i4 = *(const LAS f32x4*)(a4b + 192 + mt * 32 + 8 * g);
#pragma unroll
                  for (int jj = 0; jj < 4; ++jj) { const int i = 4 * g + jj; const float hv = (f4[jj] * num[mt][i] + s4[jj] * qc[i]) * i4[jj];
                      yo[(t0 + mt * 32 + 8 * g + 4 * hh + jj) * 512 + h * 128 + sl * 32 + r] = f2bf(hv); } }
                } }
        const float g63 = __expf(__shfl(cmx, 63) - M63);
        { LAS unsigned char* Kf = Kc + lane_v * 16; asm volatile("" : "+v"(Kf));
#pragma unroll
          for (int i = 0; i < 2; ++i) { f32x16 ct;
#pragma unroll
              for (int j = 0; j < 16; ++j) ct[j] = 0.f;
#pragma unroll
              for (int ks = 0; ks < 4; ++ks) ct = MFMA32(*(const LAS bf16x8*)(Kf + (i * 4 + ks) * 1024), Vb[ks], ct);
#pragma unroll
              for (int j = 0; j < 16; ++j) C[i][j] = sclast * C[i][j] + g63 * ct[j]; } }
        nst = sclast * nst + g63 * dnloc; n_l[lane] = nst;
        mprev = bc63 + M63;
        asm volatile("s_waitcnt lgkmcnt(0)" ::: "memory");
    }
    float* co = c.out + O_MLC_P + ((size_t)(L * NB + b) * 4 + h) * 64 * 128;
#pragma unroll
    for (int i = 0; i < 2; ++i)
#pragma unroll
        for (int j = 0; j < 16; ++j) co[(size_t)(i * 32 + crow(j, hh)) * 128 + sl * 32 + r] = C[i][j];
    if (sl == 0) { c.out[O_MLN_P + ((size_t)(L * NB + b) * 4 + h) * 64 + lane] = nst; if (lane == 0) c.out[O_MLM_P + (size_t)(L * NB + b) * 4 + h] = mprev; }
}

DI void task_gdn_sample(const Ctx& c, int L, int unit) {
    const int q4 = unit & 3, h = (unit >> 2) & 3, b = unit >> 4, lane = c.lane, c32 = lane & 31, hh2 = lane >> 5;
    const int dv = q4 * 32 + c32;
    const size_t row = (size_t)(MP + b);
    const bf16_t* pr = c.R1 + row * NPROJ;
    const float* cbuf = c.in[4] + ((size_t)L * MS + b) * 3 * 1536;
    const float* cw = c.in[23] + (size_t)L * 4 * 1536;
    float* cout = c.out + O_CONV_S + ((size_t)L * MS + b) * 3 * 1536;
    float qv[2], kv[2], vv;
#pragma unroll
    for (int w = 0; w < 5; ++w) {
        const int which = w < 2 ? 0 : w < 4 ? 1 : 2; const int d = (w == 4) ? dv : lane + 64 * (w & 1);
        const int cc = which * 512 + h * 128 + d;
        const float xin = bf2f(pr[PQ + cc]);
        const float b0 = cbuf[cc], b1 = cbuf[1536 + cc], b2 = cbuf[3072 + cc];
        float a = b0 * cw[cc] + b1 * cw[1536 + cc] + b2 * cw[3072 + cc] + xin * cw[4608 + cc];
        a = silu_(a);
        cout[cc] = b1; cout[1536 + cc] = b2; cout[3072 + cc] = xin;
        if (w < 2) qv[w] = a; else if (w < 4) kv[w - 2] = a; else vv = a;
    }
    { const float sq = wave_sum(qv[0] * qv[0] + qv[1] * qv[1]), sk = wave_sum(kv[0] * kv[0] + kv[1] * kv[1]);
      const float fq = rsqrtf(sq + EPS) * 0.08838834764831845f, fk = rsqrtf(sk + EPS);
      qv[0] *= fq; qv[1] *= fq; kv[0] *= fk; kv[1] *= fk; }
    const float qk = wave_sum(qv[0] * kv[0] + qv[1] * kv[1]);
    const float beta = sigm(c.SG[row * 16 + h]);
    const float g = -expf(c.in[24][L * 4 + h]) * softplus_(c.SG[row * 16 + 4 + h] + c.in[25][L * 4 + h]);
    const float eg = expf(g);
    const size_t soff = (((size_t)L * MS + b) * 4 + h) * 128 * 128 + (size_t)(hh2 * 64) * 128 + dv;
    const float* sin_ = c.in[5] + soff; float* sout = c.out + O_GDN_S + soff;
    float sreg[64];
#pragma unroll
    for (int d = 0; d < 64; ++d) sreg[d] = sin_[(size_t)d * 128];
    float kS = 0.f, qS = 0.f;
#pragma unroll
    for (int d = 0; d < 64; ++d) { const float ka = __shfl(kv[0], d), kb = __shfl(kv[1], d), qa = __shfl(qv[0], d), qb2 = __shfl(qv[1], d);
        kS += (hh2 ? kb : ka) * sreg[d]; qS += (hh2 ? qb2 : qa) * sreg[d]; }
    kS += __shfl_xor(kS, 32); qS += __shfl_xor(qS, 32);
    const float vnew = beta * (vv - eg * kS);
    const float o = eg * qS + qk * vnew;
#pragma unroll
    for (int d = 0; d < 64; ++d) { const float ka = __shfl(kv[0], d), kb = __shfl(kv[1], d); sout[(size_t)d * 128] = sreg[d] * eg + (hh2 ? kb : ka) * vnew; }
    if (hh2 == 0) c.Y3[(size_t)1 * MPAD * 512 + row * 512 + h * 128 + dv] = f2bf(o);
}
DI void task_ml_sample(const Ctx& c, int L, int unit) {
    const int half = unit & 1, h = (unit >> 1) & 3, b = unit >> 3, lane = c.lane;
    const size_t row = (size_t)(MP + b);
    const bf16_t* pr = c.R1 + row * NPROJ;
    const float q = bf2f(pr[PMQ + h * 64 + lane]), k = bf2f(pr[PMK + h * 64 + lane]) * 0.125f, v = bf2f(pr[PMV + h * 128 + half * 64 + lane]);
    const float li = softcap_(c.SG[row * 16 + 8 + h] + c.in[27][L * 4 + h]);
    const float lf = logsig_(softcap_(c.SG[row * 16 + 12 + h] + c.in[28][L * 4 + h]));
    const size_t sidx = ((size_t)L * MS + b) * 4 + h;
    const float m0 = c.in[8][sidx];
    const float mt = fmaxf(lf + m0, li), wts = expf(li - mt), sc = expf(lf + m0 - mt);
    const float n0 = c.in[7][sidx * 64 + lane];
    const float sqk = wave_sum(q * k) * wts, qn = wave_sum(q * n0);
    const float* cin = c.in[6] + sidx * 64 * 128 + half * 64 + lane;
    float* cout = c.out + O_MLC_S + sidx * 64 * 128 + half * 64 + lane;
    float cc[64]; float qC = 0.f;
#pragma unroll
    for (int d = 0; d < 64; ++d) { cc[d] = cin[(size_t)d * 128]; qC += __shfl(q, d) * cc[d]; }
    const float num = sqk * v + sc * qC, den = sqk + sc * qn;
    const float hv = num / fmaxf(fabsf(den), expf(-mt));
#pragma unroll
    for (int d = 0; d < 64; ++d) cout[(size_t)d * 128] = sc * cc[d] + wts * __shfl(k, d) * v;
    if (half == 0) { c.out[O_MLN_S + sidx * 64 + lane] = sc * n0 + wts * k; if (lane == 0) c.out[O_MLM_S + sidx] = mt; }
    c.Y3[(size_t)2 * MPAD * 512 + row * 512 + h * 128 + half * 64 + lane] = f2bf(hv);
}
struct S5P { float lr, li; f32x2 bb[16]; };
DI S5P s5_params(const Ctx& c, int L, int g, int p) {
    S5P P; const size_t gp = ((size_t)L * 32 + g) * 64 + p;
    const float are = c.in[13][gp], aim = c.in[14][gp], dt = expf(c.in[15][L * 32 + g]);
    const float mag = expf(are * dt); P.lr = mag * cosf(aim * dt); P.li = mag * sinf(aim * dt);
    const float inv = 1.f / (are * are + aim * aim), zr = P.lr - 1.f, zi = P.li;
    const float fre = (zr * are + zi * aim) * inv, fim = (zi * are - zr * aim) * inv;
    const float* Bre = c.in[16] + gp * 16; const float* Bim = c.in[17] + gp * 16;
#pragma unroll
    for (int q4 = 0; q4 < 4; ++q4) { const f32x4 br = *(const f32x4*)(Bre + 4 * q4), bi = *(const f32x4*)(Bim + 4 * q4);
#pragma unroll
        for (int e = 0; e < 4; ++e) { P.bb[4 * q4 + e][0] = fre * br[e] - fim * bi[e]; P.bb[4 * q4 + e][1] = fre * bi[e] + fim * br[e]; } }
    return P;
}
DI void task_s5_sample(const Ctx& c, int L, int unit) {
    const int g = unit & 31, b = unit >> 5, lane = c.lane;
    const S5P P = s5_params(c, L, g, lane);
    const size_t row = (size_t)(MP + b);
    const bf16_t* pr = c.R1 + row * NPROJ + PU + g * 16;
    float u[16];
    { const f32x8 u0 = unpack8(*(const bf16x8*)pr), u1 = unpack8(*(const bf16x8*)(pr + 8));
#pragma unroll
      for (int e = 0; e < 8; ++e) { u[e] = u0[e]; u[8 + e] = u1[e]; } }
    f32x2 bu = {0.f, 0.f};
#pragma unroll
    for (int cc = 0; cc < 16; ++cc) bu += P.bb[cc] * u[cc];
    const size_t si = (((size_t)L * MS + b) * 32 + g) * 64 + lane;
    const float h0r = c.in[2][si], h0i = c.in[3][si];
    const float hr = P.lr * h0r - P.li * h0i + bu[0], hi = P.lr * h0i + P.li * h0r + bu[1];
    c.out[O_S5RE_S + si] = hr; c.out[O_S5IM_S + si] = hi;
    const float* Cre = c.in[18] + ((size_t)L * 32 + g) * 16 * 64; const float* Cim = c.in[19] + ((size_t)L * 32 + g) * 16 * 64;
    float ya[16];
#pragma unroll
    for (int cc = 0; cc < 16; ++cc) ya[cc] = hr * Cre[cc * 64 + lane] - hi * Cim[cc * 64 + lane];
    butterfly16(ya, lane);
    if ((lane & 3) == 0) { const int cc = bsel16(lane); const float y = ya[0] + c.in[20][L * 512 + g * 16 + cc] * bf2f(pr[cc]);
        c.YS5[row * 512 + g * 16 + cc] = f2bf(gelu_t(y)); }
}

DI void task_s5_wave(const Ctx& c, int L, int unit, unsigned char* wlds  ) {
    LAS float* Uw = (LAS float*)wlds;
    LAS bf16_t* Hw = (LAS bf16_t*)(wlds + 4096);
    const int lane = c.lane;
    const int g = unit & 31, b = unit >> 5;
    const S5P P = s5_params(c, L, g, lane);
    const size_t rbase = (size_t)(b * SEQ);
    const bf16_t* ub = c.R1 + rbase * NPROJ + PU + g * 16;
    bf16x8 Cb[4];
    { const int cc = lane & 15, kq = (lane >> 4) * 8; const float* Cre = c.in[18] + (((size_t)L * 32 + g) * 16 + cc) * 64; const float* Cim = c.in[19] + (((size_t)L * 32 + g) * 16 + cc) * 64;
#pragma unroll
      for (int ks = 0; ks < 4; ++ks) { f32x8 v;
#pragma unroll
          for (int j = 0; j < 8; ++j) { const int k = ks * 32 + kq + j; v[j] = (k < 64) ? Cre[k] : -Cim[k - 64]; }
          Cb[ks] = pack8v(v); } }
    const float dskip = c.in[20][L * 512 + g * 16 + (lane & 15)];
    float hr = 0.f, hi = 0.f;
    for (int sub = 0; sub < 32; ++sub) {
        WAVE_FENCE();
        { const bf16_t* up = ub + (size_t)(sub * 64 + lane) * NPROJ; const f32x8 u0 = unpack8(*(const bf16x8*)up), u1 = unpack8(*(const bf16x8*)(up + 8));
          LAS f32x4* d = (LAS f32x4*)(Uw + lane * 16);
          d[0] = (f32x4){u0[0], u0[1], u0[2], u0[3]}; d[1] = (f32x4){u0[4], u0[5], u0[6], u0[7]}; d[2] = (f32x4){u1[0], u1[1], u1[2], u1[3]}; d[3] = (f32x4){u1[4], u1[5], u1[6], u1[7]}; }
        WAVE_FENCE();
        for (int blk = 0; blk < 4; ++blk) {
#pragma unroll 4
            for (int st = 0; st < 16; ++st) {
                const LAS f32x4* up4 = (const LAS f32x4*)(Uw + (blk * 16 + st) * 16);
                f32x2 bu = {0.f, 0.f};
#pragma unroll
                for (int q4 = 0; q4 < 4; ++q4) { const f32x4 uv = up4[q4];
#pragma unroll
                    for (int e = 0; e < 4; ++e) bu += P.bb[4 * q4 + e] * uv[e]; }
                const float nr = P.lr * hr - P.li * hi + bu[0], ni = P.lr * hi + P.li * hr + bu[1]; hr = nr; hi = ni;
                Hw[st * 128 + lane] = f2bf(hr); Hw[st * 128 + 64 + lane] = f2bf(hi);
            }
            WAVE_FENCE();
            f32x4 acc = {0.f, 0.f, 0.f, 0.f};
#pragma unroll
            for (int ks = 0; ks < 4; ++ks) { const bf16x8 a = *(const LAS bf16x8*)(Hw + (lane & 15) * 128 + ks * 32 + (lane >> 4) * 8); acc = MFMA16(a, Cb[ks], acc); }
            const int cc = lane & 15;
#pragma unroll
            for (int j = 0; j < 4; ++j) { const int st = (lane >> 4) * 4 + j; const int tl = blk * 16 + st;
                const float y = acc[j] + dskip * Uw[tl * 16 + cc];
                c.YS5[(rbase + sub * 64 + tl) * 512 + g * 16 + cc] = f2bf(gelu_t(y)); }
            WAVE_FENCE();
        }
    }
    { const size_t si = (((size_t)L * NB + b) * 32 + g) * 64 + lane; c.out[O_S5RE_P + si] = hr; c.out[O_S5IM_P + si] = hi; }
}

constexpr int S5Q_BASE = 122880, S5Q_F = S5Q_BASE + 32768, S5Q_FLAG = S5Q_F + 2048;
template <int PASS> DI void s5_steps16(const S5P& P, const LAS float* Ublk, LAS bf16_t* Hw, int lane, float& hr, float& hi) {
#pragma unroll
    for (int s4 = 0; s4 < 4; ++s4) {
        f32x4 uv[4][4];
#pragma unroll
        for (int j = 0; j < 4; ++j)
#pragma unroll
            for (int q4 = 0; q4 < 4; ++q4) uv[j][q4] = *(const LAS f32x4*)(Ublk + (s4 * 4 + j) * 16 + q4 * 4);
        asm volatile("" ::: "memory");
        f32x2 bu[4];
#pragma unroll
        for (int j = 0; j < 4; ++j) { f32x2 acc[4];
#pragma unroll
            for (int q4 = 0; q4 < 4; ++q4) { acc[q4] = P.bb[4 * q4] * uv[j][q4][0];
#pragma unroll
                for (int e = 1; e < 4; ++e) acc[q4] += P.bb[4 * q4 + e] * uv[j][q4][e]; }
            bu[j] = (acc[0] + acc[1]) + (acc[2] + acc[3]); }
#pragma unroll
        for (int j = 0; j < 4; ++j) { const float nr = P.lr * hr - P.li * hi + bu[j][0], ni = P.lr * hi + P.li * hr + bu[j][1]; hr = nr; hi = ni;
            if (PASS == 1) { Hw[(s4 * 4 + j) * 128 + lane] = f2bf(hr); Hw[(s4 * 4 + j) * 128 + 64 + lane] = f2bf(hi); } }
    }
}
DI void task_s5_quad(const Ctx& c, int L, int unit, int wq, int gen) {
    unsigned char* wlds = c.lds + S5Q_BASE + wq * 8192;
    LAS float* Uw = (LAS float*)wlds;
    LAS bf16_t* Hw = (LAS bf16_t*)(wlds + 4096);
    LAS float* F = (LAS float*)(c.lds + S5Q_F);
    volatile LAS int* flag = (volatile LAS int*)(c.lds + S5Q_FLAG);
    const int lane = c.lane;
    const int g = unit & 31, b = unit >> 5;
    const S5P P = s5_params(c, L, g, lane);
    float pr_ = P.lr, pi_ = P.li;
#pragma unroll
    for (int i = 0; i < 9; ++i) { const float nr = pr_ * pr_ - pi_ * pi_, ni = 2.f * pr_ * pi_; pr_ = nr; pi_ = ni; }
    const size_t rbase = (size_t)(b * SEQ + wq * 512);
    const bf16_t* ub = c.R1 + rbase * NPROJ + PU + g * 16;
    bf16x8 Cb[4];
    { const int cc = lane & 15, kq = (lane >> 4) * 8; const float* Cre = c.in[18] + (((size_t)L * 32 + g) * 16 + cc) * 64; const float* Cim = c.in[19] + (((size_t)L * 32 + g) * 16 + cc) * 64;
#pragma unroll
      for (int ks = 0; ks < 4; ++ks) { f32x8 v;
#pragma unroll
          for (int j = 0; j < 8; ++j) { const int k = ks * 32 + kq + j; v[j] = (k < 64) ? Cre[k] : -Cim[k - 64]; }
          Cb[ks] = pack8v(v); } }
    const float dskip = c.in[20][L * 512 + g * 16 + (lane & 15)];
    float hr = 0.f, hi = 0.f;
    for (int pass = 0; pass < 2; ++pass) {
        if (pass == 1) {
            hr = 0.f; hi = 0.f;
            for (int v = 0; v < wq; ++v) { while (flag[v] != gen) __builtin_amdgcn_s_sleep(2);
                asm volatile("" ::: "memory");
                const float fr = F[v * 128 + lane], fi = F[v * 128 + 64 + lane];
                const float nr = pr_ * hr - pi_ * hi + fr, ni = pr_ * hi + pi_ * hr + fi; hr = nr; hi = ni; }
        }
        for (int sub = 0; sub < 8; ++sub) {
            WAVE_FENCE();
            { const bf16_t* up = ub + (size_t)(sub * 64 + lane) * NPROJ; const f32x8 u0 = unpack8(*(const bf16x8*)up), u1 = unpack8(*(const bf16x8*)(up + 8));
              LAS f32x4* d = (LAS f32x4*)(Uw + lane * 16);
              d[0] = (f32x4){u0[0], u0[1], u0[2], u0[3]}; d[1] = (f32x4){u0[4], u0[5], u0[6], u0[7]}; d[2] = (f32x4){u1[0], u1[1], u1[2], u1[3]}; d[3] = (f32x4){u1[4], u1[5], u1[6], u1[7]}; }
            WAVE_FENCE();
            for (int blk = 0; blk < 4; ++blk) {
                if (pass == 1) s5_steps16<1>(P, Uw + blk * 256, Hw, lane, hr, hi); else s5_steps16<0>(P, Uw + blk * 256, Hw, lane, hr, hi);
                if (pass == 1) {
                    WAVE_FENCE();
                    f32x4 acc = {0.f, 0.f, 0.f, 0.f};
#pragma unroll
                    for (int ks = 0; ks < 4; ++ks) { const bf16x8 a = *(const LAS bf16x8*)(Hw + (lane & 15) * 128 + ks * 32 + (lane >> 4) * 8); acc = MFMA16(a, Cb[ks], acc); }
                    const int cc = lane & 15;
#pragma unroll
                    for (int j = 0; j < 4; ++j) { const int st = (lane >> 4) * 4 + j; const int tl = blk * 16 + st;
                        const float y = acc[j] + dskip * Uw[tl * 16 + cc];
                        c.YS5[(rbase + sub * 64 + tl) * 512 + g * 16 + cc] = f2bf(gelu_t(y)); }
                    WAVE_FENCE();
                }
            }
        }
        if (pass == 0) {
            if (wq < 3) { F[wq * 128 + lane] = hr; F[wq * 128 + 64 + lane] = hi; WAVE_FENCE(); if (lane == 0) flag[wq] = gen; }
        }
    }
    if (wq == 3) { const size_t si = (((size_t)L * NB + b) * 32 + g) * 64 + lane; c.out[O_S5RE_P + si] = hr; c.out[O_S5IM_P + si] = hi; }
}

DI void phase_s5_scan(const Ctx& c, int L) {
    float* U = (float*)c.lds;
    bf16_t* H = (bf16_t*)(c.lds + 32768);
    float* F = (float*)(c.lds + 65536);
    const int lane = c.lane, w = c.wave;
    float* Uw = U + w * 1024; bf16_t* Hw = H + w * 2048;
    for (int unit = c.bid; unit < 256; unit += c.G) {
        const int g = unit & 31, b = unit >> 5;
        const S5P P = s5_params(c, L, g, lane);
        float pr_ = P.lr, pi_ = P.li;
#pragma unroll
        for (int i = 0; i < 8; ++i) { const float nr = pr_ * pr_ - pi_ * pi_, ni = 2.f * pr_ * pi_; pr_ = nr; pi_ = ni; }
        const size_t rbase = (size_t)(b * SEQ + w * 256);
        const bf16_t* ub = c.R1 + rbase * NPROJ + PU + g * 16;
        bf16x8 Cb[4];
        { const int cc = lane & 15, kq = (lane >> 4) * 8; const float* Cre = c.in[18] + (((size_t)L * 32 + g) * 16 + cc) * 64; const float* Cim = c.in[19] + (((size_t)L * 32 + g) * 16 + cc) * 64;
#pragma unroll
          for (int ks = 0; ks < 4; ++ks) { f32x8 v;
#pragma unroll
              for (int j = 0; j < 8; ++j) { const int k = ks * 32 + kq + j; v[j] = (k < 64) ? Cre[k] : -Cim[k - 64]; }
              Cb[ks] = pack8v(v); } }
        const float dskip = c.in[20][L * 512 + g * 16 + (lane & 15)];
        float hr = 0.f, hi = 0.f;
        for (int pass = 0; pass < 2; ++pass) {
            if (pass == 1) {
                F[w * 128 + lane] = hr; F[w * 128 + 64 + lane] = hi;
                __syncthreads();
                hr = 0.f; hi = 0.f;
                for (int v = 0; v < w; ++v) { const float fr = F[v * 128 + lane], fi = F[v * 128 + 64 + lane];
                    const float nr = pr_ * hr - pi_ * hi + fr, ni = pr_ * hi + pi_ * hr + fi; hr = nr; hi = ni; }
            }
            for (int sub = 0; sub < 4; ++sub) {
                __syncthreads();
                { const bf16_t* up = ub + (size_t)(sub * 64 + lane) * NPROJ; const f32x8 u0 = unpack8(*(const bf16x8*)up), u1 = unpack8(*(const bf16x8*)(up + 8));
                  f32x4* d = (f32x4*)(Uw + lane * 16);
                  d[0] = (f32x4){u0[0], u0[1], u0[2], u0[3]}; d[1] = (f32x4){u0[4], u0[5], u0[6], u0[7]}; d[2] = (f32x4){u1[0], u1[1], u1[2], u1[3]}; d[3] = (f32x4){u1[4], u1[5], u1[6], u1[7]}; }
                __syncthreads();
                for (int blk = 0; blk < 4; ++blk) {
#pragma unroll 4
                    for (int st = 0; st < 16; ++st) {
                        const f32x4* up4 = (const f32x4*)(Uw + (blk * 16 + st) * 16);
                        f32x2 bu = {0.f, 0.f};
#pragma unroll
                        for (int q4 = 0; q4 < 4; ++q4) { const f32x4 uv = up4[q4];
#pragma unroll
                            for (int e = 0; e < 4; ++e) bu += P.bb[4 * q4 + e] * uv[e]; }
                        const float nr = P.lr * hr - P.li * hi + bu[0], ni = P.lr * hi + P.li * hr + bu[1]; hr = nr; hi = ni;
                        if (pass == 1) { Hw[st * 128 + lane] = f2bf(hr); Hw[st * 128 + 64 + lane] = f2bf(hi); }
                    }
                    if (pass == 1) {
                        __syncthreads();
                        f32x4 acc = {0.f, 0.f, 0.f, 0.f};
#pragma unroll
                        for (int ks = 0; ks < 4; ++ks) { const bf16x8 a = *(const bf16x8*)(Hw + (lane & 15) * 128 + ks * 32 + (lane >> 4) * 8); acc = MFMA16(a, Cb[ks], acc); }
                        const int cc = lane & 15;
#pragma unroll
                        for (int j = 0; j < 4; ++j) { const int st = (lane >> 4) * 4 + j; const int tl = blk * 16 + st;
                            const float y = acc[j] + dskip * Uw[tl * 16 + cc];
                            c.YS5[(rbase + sub * 64 + tl) * 512 + g * 16 + cc] = f2bf(gelu_t(y)); }
                        __syncthreads();
                    }
                }
            }
        }
        if (w == 7) { const size_t si = (((size_t)L * NB + b) * 32 + g) * 64 + lane; c.out[O_S5RE_P + si] = hr; c.out[O_S5IM_P + si] = hi; }
        __syncthreads();
    }
}


#ifdef SELFCHK
DI void blk_reduce2(float& a, float& b, float* red, int tid) {
    a = wave_sum(a); b = wave_sum(b);
    __syncthreads();
    if ((tid & 63) == 0) { red[tid >> 6] = a; red[8 + (tid >> 6)] = b; }
    __syncthreads();
    float x = 0.f, y = 0.f;
    for (int i = 0; i < 8; ++i) { x += red[i]; y += red[8 + i]; }
    a = x; b = y; __syncthreads();
}
DI void chk_gdn(const Ctx& c, int L, int b, int h, float* dg) {
    float* q = (float*)c.lds; float* k = q + 128; float* v = k + 128; float* part = v + 128; float* red = part + 512; float* sc_ = red + 16;
    const int tid = c.tid, dv = tid & 127, qt = tid >> 7;
    const float* convw = c.in[23] + (size_t)L * 4 * 1536;
    float S[32];
#pragma unroll
    for (int i = 0; i < 32; ++i) S[i] = 0.f;
    float e2 = 0.f, r2 = 0.f;
    for (int t = 0; t < SEQ; ++t) {
        const size_t row = (size_t)b * SEQ + t;
        if (tid < 384) { const int which = tid >> 7, d = tid & 127; float a = 0.f;
            for (int j = 0; j < 4; ++j) { const int tt = t + j - 3; if (tt >= 0) a += bf2f(c.R1[((size_t)b * SEQ + tt) * NPROJ + PQ + which * 512 + h * 128 + d]) * convw[j * 1536 + which * 512 + h * 128 + d]; }
            (which == 0 ? q : which == 1 ? k : v)[d] = silu_(a); }
        __syncthreads();
        float sq = 0.f, sk = 0.f;
        for (int d = 0; d < 128; ++d) { sq += q[d] * q[d]; sk += k[d] * k[d]; }
        const float fq = rsqrtf(sq + EPS) * 0.08838834764831845f, fk = rsqrtf(sk + EPS);
        const float beta = sigm(c.SG[row * 16 + h]);
        const float g = -expf(c.in[24][L * 4 + h]) * softplus_(c.SG[row * 16 + 4 + h] + c.in[25][L * 4 + h]);
        const float eg = expf(g);
        float ks = 0.f;
#pragma unroll
        for (int i = 0; i < 32; ++i) { S[i] *= eg; ks += k[qt * 32 + i] * fk * S[i]; }
        part[qt * 128 + dv] = ks;
        __syncthreads();
        const float kS = part[dv] + part[128 + dv] + part[256 + dv] + part[384 + dv];
        const float vnew = beta * (v[dv] - kS);
        float qs = 0.f;
#pragma unroll
        for (int i = 0; i < 32; ++i) { S[i] += k[qt * 32 + i] * fk * vnew; qs += q[qt * 32 + i] * fq * S[i]; }
        __syncthreads();
        part[qt * 128 + dv] = qs;
        __syncthreads();
        if (qt == 0) { const float o = part[dv] + part[128 + dv] + part[256 + dv] + part[384 + dv];
            const float got = bf2f(c.Y3[(size_t)1 * MPAD * 512 + row * 512 + h * 128 + dv]); e2 += (got - o) * (got - o); r2 += o * o; }
        __syncthreads();
    }
    blk_reduce2(e2, r2, red, tid);
    if (tid == 0) dg[0] = sqrtf(e2 / (r2 + 1e-30f));
    float e3 = 0.f, r3 = 0.f;
#pragma unroll
    for (int i = 0; i < 32; ++i) { const float got = c.out[O_GDN_P + (((size_t)L * NB + b) * 4 + h) * 16384 + (size_t)(qt * 32 + i) * 128 + dv]; e3 += (got - S[i]) * (got - S[i]); r3 += S[i] * S[i]; }
    blk_reduce2(e3, r3, red, tid);
    if (tid == 0) dg[1] = sqrtf(e3 / (r3 + 1e-30f));
    (void)sc_;
}
DI void chk_ml(const Ctx& c, int L, int b, int h, float* dg) {
    float* q = (float*)c.lds; float* k = q + 64; float* v = k + 64; float* n = v + 128; float* part = n + 64; float* red = part + 512;
    const int tid = c.tid, e = tid & 127, qt = tid >> 7;
    float C[16];
#pragma unroll
    for (int i = 0; i < 16; ++i) C[i] = 0.f;
    if (tid < 64) n[tid] = 0.f;
    float m = 0.f, e2 = 0.f, r2 = 0.f;
    __syncthreads();
    for (int t = 0; t < SEQ; ++t) {
        const size_t row = (size_t)b * SEQ + t;
        if (tid < 64) { q[tid] = bf2f(c.R1[row * NPROJ + PMQ + h * 64 + tid]); k[tid] = bf2f(c.R1[row * NPROJ + PMK + h * 64 + tid]) * 0.125f; }
        else if (tid < 192) v[tid - 64] = bf2f(c.R1[row * NPROJ + PMV + h * 128 + tid - 64]);
        __syncthreads();
        const float li = softcap_(c.SG[row * 16 + 8 + h] + c.in[27][L * 4 + h]);
        const float lf = logsig_(softcap_(c.SG[row * 16 + 12 + h] + c.in[28][L * 4 + h]));
        const float mn = fmaxf(lf + m, li), wts = expf(li - mn), sc = expf(lf + m - mn);
        float qk = 0.f, qn = 0.f;
        for (int d = 0; d < 64; ++d) { qk += q[d] * k[d]; qn += q[d] * n[d]; }
        float pc = 0.f;
#pragma unroll
        for (int i = 0; i < 16; ++i) pc += q[qt * 16 + i] * C[i];
        part[qt * 128 + e] = pc;
        __syncthreads();
        const float qC = part[e] + part[128 + e] + part[256 + e] + part[384 + e];
        const float sqk = qk * wts, num = sqk * v[e] + sc * qC, den = sqk + sc * qn;
        const float hv = num / fmaxf(fabsf(den), expf(-mn));
        if (qt == 0) { const float got = bf2f(c.Y3[(size_t)2 * MPAD * 512 + row * 512 + h * 128 + e]); e2 += (got - hv) * (got - hv); r2 += hv * hv; }
#pragma unroll
        for (int i = 0; i < 16; ++i) C[i] = sc * C[i] + wts * k[qt * 16 + i] * v[e];
        __syncthreads();
        if (tid < 64) n[tid] = sc * n[tid] + wts * k[tid];
        m = mn;
        __syncthreads();
    }
    blk_reduce2(e2, r2, red, tid);
    if (tid == 0) dg[2] = sqrtf(e2 / (r2 + 1e-30f));
    float e3 = 0.f, r3 = 0.f;
#pragma unroll
    for (int i = 0; i < 16; ++i) { const float got = c.out[O_MLC_P + (((size_t)L * NB + b) * 4 + h) * 8192 + (size_t)(qt * 16 + i) * 128 + e]; e3 += (got - C[i]) * (got - C[i]); r3 += C[i] * C[i]; }
    if (tid < 64) { const float got = c.out[O_MLN_P + (((size_t)L * NB + b) * 4 + h) * 64 + tid]; e3 += (got - n[tid]) * (got - n[tid]) * 64.f; r3 += n[tid] * n[tid] * 64.f; }
    if (tid == 0) { const float got = c.out[O_MLM_P + ((size_t)L * NB + b) * 4 + h]; e3 += (got - m) * (got - m) * 4096.f; r3 += m * m * 4096.f; }
    blk_reduce2(e3, r3, red, tid);
    if (tid == 0) dg[3] = sqrtf(e3 / (r3 + 1e-30f));
}
DI void chk_s5(const Ctx& c, int L, int b, int g, float* dg) {
    float* red = (float*)c.lds;
    float e2 = 0.f, r2 = 0.f, e3 = 0.f, r3 = 0.f;
    if (c.tid < 64) { const int lane = c.tid; const S5P P = s5_params(c, L, g, lane);
        const float* Cre = c.in[18] + ((size_t)L * 32 + g) * 16 * 64; const float* Cim = c.in[19] + ((size_t)L * 32 + g) * 16 * 64;
        float hr = 0.f, hi = 0.f;
        for (int t = 0; t < SEQ; ++t) { const size_t row = (size_t)b * SEQ + t; const bf16_t* pr = c.R1 + row * NPROJ + PU + g * 16;
            f32x2 bu = {0.f, 0.f};
#pragma unroll
            for (int cc = 0; cc < 16; ++cc) bu += P.bb[cc] * bf2f(pr[cc]);
            const float nr = P.lr * hr - P.li * hi + bu[0], ni = P.lr * hi + P.li * hr + bu[1]; hr = nr; hi = ni;
            for (int cc = 0; cc < 16; ++cc) { float y = wave_sum(hr * Cre[cc * 64 + lane] - hi * Cim[cc * 64 + lane]) + c.in[20][L * 512 + g * 16 + cc] * bf2f(pr[cc]);
                y = gelu_t(y); const float got = bf2f(c.YS5[row * 512 + g * 16 + cc]); if (lane == 0) { e2 += (got - y) * (got - y); r2 += y * y; } } }
        const size_t si = (((size_t)L * NB + b) * 32 + g) * 64 + lane;
        e3 = (c.out[O_S5RE_P + si] - hr) * (c.out[O_S5RE_P + si] - hr) + (c.out[O_S5IM_P + si] - hi) * (c.out[O_S5IM_P + si] - hi); r3 = hr * hr + hi * hi; }
    blk_reduce2(e2, r2, red, c.tid);
    blk_reduce2(e3, r3, red, c.tid);
    if (c.tid == 0) { dg[4] = sqrtf(e2 / (r2 + 1e-30f)); dg[5] = sqrtf(e3 / (r3 + 1e-30f)); }
}
#endif


#ifdef SELFCHK
DI float dot_bf(const bf16_t* a, const bf16_t* b, int K) { float s = 0.f; for (int k = 0; k < K; ++k) s += bf2f(a[k]) * bf2f(b[k]); return s; }
DI void chk_gemm(const Ctx& c, int L, int mode, float* dgp) {
    float* red = (float*)c.lds;
    float e2 = 0.f, r2 = 0.f;
    for (int rep = 0; rep < 2; ++rep) {
        const int sidx = c.tid + 512 * rep;
        const int row = (rep == 1 && c.tid < 64) ? MP + (c.tid * 2) : (int)(((unsigned)sidx * 7919u) % (unsigned)MP);
        float want = 0.f, got = 0.f;
        if (mode == 0) { const int col = (int)(((unsigned)sidx * 104729u) % 4096u); want = dot_bf(c.XN + (size_t)row * 1024, c.W + WO_IN + (size_t)col * 1024, 1024); got = bf2f(c.R1[(size_t)row * 4096 + col]); }
        if (mode == 1) { const int col = (int)(((unsigned)sidx * 104729u) % 3072u); want = sigm(dot_bf(c.XN + (size_t)row * 1024, c.W + WO_G + (size_t)col * 1024, 1024)); got = bf2f(c.R1[(size_t)row * 4096 + col]); }
        if (mode == 2) { const int col = (int)(((unsigned)sidx * 104729u) % 512u); const float y = bf2f(c.YS5[(size_t)row * 512 + col]);
            want = y * sigm(dot_bf(c.YS5 + (size_t)row * 512, c.W + WO_GLU + (size_t)col * 512, 512) + c.in[22][L * 512 + col]); got = bf2f(c.Y3[(size_t)row * 512 + col]); }
        if (mode == 3) { const int col = (int)(((unsigned)sidx * 104729u) % 1024u);
            for (int br = 0; br < 3; ++br) want += bf2f(c.R1[(size_t)row * 4096 + br * 1024 + col]) * dot_bf(c.Y3 + (size_t)br * MPAD * 512 + (size_t)row * 512, c.W + WO_BR + (size_t)br * 1024 * 512 + (size_t)col * 512, 512);
            got = bf2f(c.XN[(size_t)row * 1024 + col]); }
        if (mode == 4) { const int col = (int)(((unsigned)sidx * 104729u) % 4096u); const float d = fmaxf(dot_bf(c.XN + (size_t)row * 1024, c.W + WO_UP + (size_t)col * 1024, 1024), 0.f); want = d * d; got = bf2f(c.R1[(size_t)row * 4096 + col]); }
        if (mode == 5) { const int col = (int)(((unsigned)sidx * 104729u) % 1024u); want = dot_bf(c.Y3 + (size_t)row * 256, c.W + WO_PLE + (size_t)col * 256, 256); got = bf2f(c.Y3[(size_t)MPAD * 256 + (size_t)row * 1024 + col]); }
        e2 += (got - want) * (got - want); r2 += want * want;
    }
    blk_reduce2(e2, r2, red, c.tid);
    if (c.tid == 0) *dgp = sqrtf(e2 / (r2 + 1e-30f));
}
#endif

#ifdef SELFCHK
DI void chk_sg(const Ctx& c, float* dgp) {
    float* red = (float*)c.lds; float e2 = 0.f, r2 = 0.f;
    { const int sidx = c.tid >> 4, s = c.tid & 15; const int row = (sidx < 8) ? MP + sidx * 13 : (int)(((unsigned)sidx * 7919u * 37u) % (unsigned)MP);
      const float* x = row < MP ? c.in[0] + (size_t)row * 1024 : c.in[1] + (size_t)(row - MP) * 1024;
      const int sc = s < 4 ? 2560 + s : s < 8 ? 2564 + (s - 4) : s < 12 ? 4104 + (s - 8) : 4108 + (s - 12);
      float ss = 0.f; for (int k = 0; k < 1024; ++k) ss += x[k] * x[k];
      const float rs = rsqrtf(ss * (1.f / 1024.f) + EPS); float a = 0.f;
      for (int k = 0; k < 1024; ++k) a += x[k] * rs * c.in[11][k] * c.in[12][(size_t)k * DIN + sc];
      const float got = c.SG[(size_t)row * 16 + s]; e2 = (got - a) * (got - a); r2 = a * a; }
    blk_reduce2(e2, r2, red, c.tid);
    if (c.tid == 0) *dgp = sqrtf(e2 / (r2 + 1e-30f));
}
DI void chk_post(const Ctx& c, int L, float* dgp) {
    float* red = (float*)c.lds; float e2 = 0.f, r2 = 0.f;
    { const int hd8 = c.tid & 7, sidx = c.tid >> 3; const int row = (sidx < 8) ? MP + sidx * 11 : (int)(((unsigned)sidx * 7919u * 53u) % (unsigned)MP);
      const int br = hd8 >> 2, hd = hd8 & 3; float ms = 0.f;
      for (int e = 0; e < 128; ++e) { const float y = bf2f(c.Y3[(size_t)(1 + br) * MPAD * 512 + (size_t)row * 512 + hd * 128 + e]);
          const float z = bf2f(c.R1[(size_t)row * NPROJ + (br == 0 ? PZ : PMO) + hd * 128 + e]);
          const float gn = br == 0 ? c.in[26][L * 128 + e] : c.in[29][L * 512 + hd * 128 + e];
          const float w = y / (gn * (br == 0 ? silu_(z) : sigm(z))); ms += w * w; }
      ms *= (1.f / 128.f); e2 = (ms - 1.f) * (ms - 1.f); r2 = 1.f; }
    blk_reduce2(e2, r2, red, c.tid);
    if (c.tid == 0) *dgp = sqrtf(e2 / (r2 + 1e-30f));
}
DI void chk_res(const Ctx& c, int L, int mode, const float (&snap)[2], float* dgp) {
    float* red = (float*)c.lds; float e2 = 0.f, r2 = 0.f;
    for (int rep = 0; rep < 2; ++rep) { const int sidx = c.tid + 512 * rep;
        const int row = (rep == 1 && c.tid < 64) ? MP + (c.tid * 2) : (int)(((unsigned)sidx * 7919u) % (unsigned)MP); const int col = (int)(((unsigned)sidx * 104729u) % 1024u);
        const float now = c.out[(size_t)row * 1024 + col]; float before = snap[rep], want = 0.f;
        if (mode == 0) { before = row < MP ? c.in[0][(size_t)row * 1024 + col] : c.in[1][(size_t)(row - MP) * 1024 + col]; want = dot_bf(c.XN + (size_t)row * 1024, c.W + WO_OUT + (size_t)col * 1024, 1024); }
        if (mode == 1) want = dot_bf(c.R1 + (size_t)row * 4096, c.W + WO_DN + (size_t)col * 4096, 4096);
        if (mode == 2) want = bf2f(c.Y3[(size_t)MPAD * 256 + (size_t)row * 1024 + col]) * sigm(dot_bf(c.XN + (size_t)row * 1024, c.W + WO_PG + (size_t)col * 1024, 1024));
        e2 += (now - before - want) * (now - before - want); r2 += want * want; }
    blk_reduce2(e2, r2, red, c.tid);
    if (c.tid == 0) *dgp = sqrtf(e2 / (r2 + 1e-30f));
}
DI void snap_x(const Ctx& c, float (&snap)[2]) {
    for (int rep = 0; rep < 2; ++rep) { const int sidx = c.tid + 512 * rep;
        const int row = (rep == 1 && c.tid < 64) ? MP + (c.tid * 2) : (int)(((unsigned)sidx * 7919u) % (unsigned)MP); const int col = (int)(((unsigned)sidx * 104729u) % 1024u);
        snap[rep] = c.out[(size_t)row * 1024 + col]; }
}
DI void chk_sample(const Ctx& c, int L, int b, int h, float* dgp) {
    float* red = (float*)c.lds; float e2 = 0.f, r2 = 0.f, e3 = 0.f, r3 = 0.f;
    const size_t row = (size_t)(MP + b); const bf16_t* pr = c.R1 + row * NPROJ;
    if (c.tid < 128) { const int dv = c.tid;
        const float* cbuf = c.in[4] + ((size_t)L * MS + b) * 3 * 1536; const float* cw = c.in[23] + (size_t)L * 4 * 1536;
        float sq = 0.f, sk = 0.f;
        for (int d = 0; d < 128; ++d) for (int w = 0; w < 2; ++w) { const int cc = w * 512 + h * 128 + d;
            const float a = silu_(cbuf[cc] * cw[cc] + cbuf[1536 + cc] * cw[1536 + cc] + cbuf[3072 + cc] * cw[3072 + cc] + bf2f(pr[PQ + cc]) * cw[4608 + cc]); if (w == 0) sq += a * a; else sk += a * a; }
        const float fq = rsqrtf(sq + EPS) * 0.08838834764831845f, fk = rsqrtf(sk + EPS);
        const int cv = 1024 + h * 128 + dv;
        const float vv = silu_(cbuf[cv] * cw[cv] + cbuf[1536 + cv] * cw[1536 + cv] + cbuf[3072 + cv] * cw[3072 + cv] + bf2f(pr[PQ + cv]) * cw[4608 + cv]);
        const float beta = sigm(c.SG[row * 16 + h]), eg = expf(-expf(c.in[24][L * 4 + h]) * softplus_(c.SG[row * 16 + 4 + h] + c.in[25][L * 4 + h]));
        const float* S0 = c.in[5] + (((size_t)L * MS + b) * 4 + h) * 16384; const float* S1 = c.out + O_GDN_S + (((size_t)L * MS + b) * 4 + h) * 16384;
        float kS = 0.f, qS = 0.f, qk = 0.f;
        for (int d = 0; d < 128; ++d) { const int cq = h * 128 + d, ck = 512 + h * 128 + d;
            const float qd = silu_(cbuf[cq] * cw[cq] + cbuf[1536 + cq] * cw[1536 + cq] + cbuf[3072 + cq] * cw[3072 + cq] + bf2f(pr[PQ + cq]) * cw[4608 + cq]) * fq;
            const float kd = silu_(cbuf[ck] * cw[ck] + cbuf[1536 + ck] * cw[1536 + ck] + cbuf[3072 + ck] * cw[3072 + ck] + bf2f(pr[PQ + ck]) * cw[4608 + ck]) * fk;
            kS += kd * S0[d * 128 + dv]; qS += qd * S0[d * 128 + dv]; qk += qd * kd; }
        const float vnew = beta * (vv - eg * kS);
        for (int d = 0; d < 128; ++d) { const int ck = 512 + h * 128 + d;
            const float kd = silu_(cbuf[ck] * cw[ck] + cbuf[1536 + ck] * cw[1536 + ck] + cbuf[3072 + ck] * cw[3072 + ck] + bf2f(pr[PQ + ck]) * cw[4608 + ck]) * fk;
            const float want = S0[d * 128 + dv] * eg + kd * vnew, got = S1[d * 128 + dv]; e2 += (got - want) * (got - want); r2 += want * want; }
        (void)qS; (void)qk;
    } else if (c.tid < 256) { const int e = c.tid - 128;
        const size_t sidx = ((size_t)L * MS + b) * 4 + h;
        const float li = softcap_(c.SG[row * 16 + 8 + h] + c.in[27][L * 4 + h]), lf = logsig_(softcap_(c.SG[row * 16 + 12 + h] + c.in[28][L * 4 + h]));
        const float m0 = c.in[8][sidx], mt = fmaxf(lf + m0, li), wts = expf(li - mt), sc = expf(lf + m0 - mt);
        const float v = bf2f(pr[PMV + h * 128 + e]);
        for (int d = 0; d < 64; ++d) { const float k = bf2f(pr[PMK + h * 64 + d]) * 0.125f;
            const float want = sc * c.in[6][sidx * 8192 + d * 128 + e] + wts * k * v, got = c.out[O_MLC_S + sidx * 8192 + d * 128 + e]; e3 += (got - want) * (got - want); r3 += want * want; }
        if (e < 64) { const float k = bf2f(pr[PMK + h * 64 + e]) * 0.125f; const float want = sc * c.in[7][sidx * 64 + e] + wts * k, got = c.out[O_MLN_S + sidx * 64 + e]; e3 += 64.f * (got - want) * (got - want); r3 += 64.f * want * want; }
        if (e == 0) { const float got = c.out[O_MLM_S + sidx]; e3 += 4096.f * (got - mt) * (got - mt); r3 += 4096.f * mt * mt; }
    }
    blk_reduce2(e2, r2, red, c.tid);
    blk_reduce2(e3, r3, red, c.tid);
    if (c.tid == 0) { dgp[0] = sqrtf(e2 / (r2 + 1e-30f)); dgp[1] = sqrtf(e3 / (r3 + 1e-30f)); }
}
#endif
DI void phase_conv_state(const Ctx& c, int L) {
    for (int idx = c.bid * 512 + c.tid; idx < NB * 3 * 1536; idx += c.G * 512) { const int cc = idx % 1536, j = (idx / 1536) % 3, b = idx / (3 * 1536);
        c.out[O_CONV_P + ((size_t)L * NB + b) * 3 * 1536 + j * 1536 + cc] = bf2f(c.R1[(size_t)(b * SEQ + SEQ - 3 + j) * NPROJ + PQ + cc]); }
}
DI void phase_post(const Ctx& c, int L) {
    const int lane = c.lane, hd = lane >> 4, e0 = (lane & 15) * 8;
    bf16_t* yg = c.Y3 + (size_t)1 * MPAD * 512; bf16_t* ym = c.Y3 + (size_t)2 * MPAD * 512;
    const float* gg = c.in[26] + (size_t)L * 128 + e0; const float* gm = c.in[29] + (size_t)L * 512 + hd * 128 + e0;
    for (int row = c.bid * 8 + c.wave; row < MR; row += c.G * 8) {
        const bf16_t* pr = c.R1 + (size_t)row * NPROJ;
#pragma unroll
        for (int br = 0; br < 2; ++br) {
            bf16_t* yp = (br == 0 ? yg : ym) + (size_t)row * 512 + hd * 128 + e0;
            f32x8 o = unpack8(*(const bf16x8*)yp); const f32x8 z = unpack8(*(const bf16x8*)(pr + (br == 0 ? PZ : PMO) + hd * 128 + e0));
            float ss = 0.f;
#pragma unroll
            for (int e = 0; e < 8; ++e) ss += o[e] * o[e];
            ss += __shfl_xor(ss, 1); ss += __shfl_xor(ss, 2); ss += __shfl_xor(ss, 4); ss += __shfl_xor(ss, 8);
            const float rs = rsqrtf(ss * (1.f / 128.f) + EPS);
            const float* gp = br == 0 ? gg : gm;
#pragma unroll
            for (int e = 0; e < 8; ++e) o[e] = o[e] * rs * gp[e] * (br == 0 ? silu_(z[e]) : sigm(z[e]));
            *(bf16x8*)yp = pack8v(o);
        }
    }
}

DI void phase_cvt_ple(const Ctx& c, int L) {
    bf16_t* PB = c.Y3;
    for (size_t i = (size_t)c.bid * 512 + c.tid; i < (size_t)MR * 64; i += (size_t)c.G * 512) {
        const size_t row = i >> 6, c4 = (i & 63) * 4;
        const float* src = row < MP ? c.in[9] + ((size_t)L * MP + row) * 256 + c4 : c.in[10] + ((size_t)L * MS + (row - MP)) * 256 + c4;
        *(s16x4*)(PB + row * 256 + c4) = pack4v(*(const f32x4*)src); }
}
DI void phase_final_norm(const Ctx& c) {
    const float* gain = c.in[39];
    for (int row = c.bid * 8 + c.wave; row < MR; row += c.G * 8) {
        float* xp = c.out + (size_t)row * 1024; f32x4 x[4]; float ss = 0.f;
#pragma unroll
        for (int i = 0; i < 4; ++i) { x[i] = *(const f32x4*)(xp + c.lane * 4 + 256 * i); ss += x[i][0] * x[i][0] + x[i][1] * x[i][1] + x[i][2] * x[i][2] + x[i][3] * x[i][3]; }
        ss = wave_sum(ss); const float rs = rsqrtf(ss * (1.f / 1024.f) + EPS);
#pragma unroll
        for (int i = 0; i < 4; ++i) { const f32x4 g = *(const f32x4*)(gain + c.lane * 4 + 256 * i); *(f32x4*)(xp + c.lane * 4 + 256 * i) = x[i] * rs * g; }
    }
}

#define XB_TMO      128
#define XB_XCNT(j)  (256  + 64 * (j))
#define XB_XSUB(j)  (1280 + 64 * (j))
#define XB_XGEN(j)  (2304 + 64 * (j))
#define XB_TOP      3328
#define XB_TOPGEN   3392
#define XCD_BAR_WORDS 3456
#define XB_SPIN_CAP (1u << 18)

__device__ __forceinline__ unsigned xb_ld(unsigned* p)              { return __hip_atomic_load(p, __ATOMIC_RELAXED, __HIP_MEMORY_SCOPE_AGENT); }
__device__ __forceinline__ unsigned xb_add(unsigned* p, unsigned v) { return __hip_atomic_fetch_add(p, v, __ATOMIC_RELAXED, __HIP_MEMORY_SCOPE_AGENT); }
__device__ __forceinline__ unsigned xb_xcc_id() { return (unsigned)__builtin_amdgcn_s_getreg((3 << 11) | 20) & 0xFu; }
#define XB_SPIN(cond, bar) do { unsigned _sp = 0; while (cond) { __builtin_amdgcn_s_sleep(1); \
    if ((++_sp & 255u) == 0u) { if (xb_ld(&(bar)[XB_TMO])) break; if (_sp > XB_SPIN_CAP) { atomicAdd(&(bar)[XB_TMO], 1u); break; } } } } while (0)

struct XcdBarrier {
    unsigned* bar; unsigned x;
    volatile LAS unsigned* st;
};

__device__ __forceinline__ XcdBarrier xcd_barrier_post(unsigned* bar, volatile LAS unsigned* st) {
    XcdBarrier b; b.bar = bar; b.x = xb_xcc_id(); b.st = st;
    if (threadIdx.x == 0) (void)xb_add(&bar[XB_XCNT(b.x)], 1u);
    return b;
}
__device__ __forceinline__ void xcd_barrier_complete(unsigned* bar, unsigned x, unsigned& nloc, unsigned& nx) {
    const unsigned G = gridDim.x * gridDim.y * gridDim.z;
    unsigned sum, cnt, mine, sp = 0u;
    for (;;) {
        sum = 0u; cnt = 0u; mine = 0u;
#pragma unroll
        for (unsigned j = 0; j < 16; ++j) { const unsigned c = xb_ld(&bar[XB_XCNT(j)]); sum += c; cnt += (c > 0u) ? 1u : 0u; mine = (j == x) ? c : mine; }
        if (sum == G) break;
        __builtin_amdgcn_s_sleep(1);
        if ((++sp & 255u) == 0u) { if (xb_ld(&bar[XB_TMO])) break; if (sp > XB_SPIN_CAP) { atomicAdd(&bar[XB_TMO], 1u); break; } }
    }
    nloc = mine > 0u ? mine : 1u; nx = cnt > 0u ? cnt : 1u;
}

__device__ __forceinline__ void xcd_barrier(const XcdBarrier& b) {
    asm volatile("s_waitcnt vmcnt(0)" ::: "memory");
    __syncthreads();
    if (threadIdx.x == 0) {
        unsigned* bar = b.bar;
        __builtin_amdgcn_s_waitcnt(0);
        unsigned nloc = b.st[0], nx = b.st[1];
        if (nloc == 0u) { xcd_barrier_complete(bar, b.x, nloc, nx); b.st[0] = nloc; b.st[1] = nx; }
        const unsigned old = xb_add(&bar[XB_XSUB(b.x)], 1u);
        const unsigned gen = old / nloc;
        if (old + 1u == (gen + 1u) * nloc) {
            __builtin_amdgcn_fence(__ATOMIC_RELEASE, "agent");
            asm volatile("s_waitcnt vmcnt(0)" ::: "memory");
            const unsigned og = xb_add(&bar[XB_TOP], 1u);
            const unsigned tg = og / nx;
            if (og + 1u == (tg + 1u) * nx) xb_add(&bar[XB_TOPGEN], 1u);
            else XB_SPIN(xb_ld(&bar[XB_TOPGEN]) == tg, bar);
            __builtin_amdgcn_fence(__ATOMIC_ACQUIRE, "agent");
            xb_add(&bar[XB_XGEN(b.x)], 1u);
            asm volatile("s_waitcnt vmcnt(0)" ::: "memory");
        } else {
            XB_SPIN(xb_ld(&bar[XB_XGEN(b.x)]) == gen, bar);
            __builtin_amdgcn_fence(__ATOMIC_ACQUIRE, "agent");
            asm volatile("s_waitcnt vmcnt(0)" ::: "memory");
        }
    }
    __syncthreads();
}

__global__ void __launch_bounds__(512, 2) fwd_megakernel(KP kp) {
    extern __shared__ __attribute__((aligned(16))) unsigned char lds[];
    cg::grid_group grid = cg::this_grid();
    Ctx c; c.lds = lds; c.G = gridDim.x; c.bid = blockIdx.x;
    const ka_t ka0 = (ka_t)__builtin_amdgcn_kernarg_segment_ptr();
    (void)kp;
#define REFRESH() do { ka_t ka_ = ka0; asm volatile("" : "+s"(ka_)); int t_ = threadIdx.x; asm volatile("" : "+v"(t_)); \
        c.in.ka = ka_; c.out = (float*)(gfloat_t*)ka_[40]; unsigned char* w_ = (unsigned char*)(guchar_t*)ka_[41]; c.ws = w_; \
        c.R1 = (bf16_t*)(w_ + WS_R1); c.XN = (bf16_t*)(w_ + WS_XN); c.Y3 = (bf16_t*)(w_ + WS_Y3); c.W = (bf16_t*)(w_ + WS_W); c.YS5 = (bf16_t*)(w_ + WS_YS5); \
        c.GS = w_ + WS_GS; c.SG = (float*)(w_ + WS_SG); c.GL = (float*)(w_ + WS_GL); \
        c.tid = t_; c.lane = t_ & 63; c.wave = __builtin_amdgcn_readfirstlane(t_ >> 6); \
        int b_ = blockIdx.x, g_ = gridDim.x; asm volatile("" : "+s"(b_), "+s"(g_)); c.bid = b_; c.G = g_; } while (0)
    REFRESH();
    volatile LAS unsigned* bst = (volatile LAS unsigned*)(lds + LDS_BYTES - 16);
    if (c.tid < 4) bst[c.tid] = 0u;
    if (c.tid < 16) ((volatile LAS int*)(lds + S5Q_FLAG))[c.tid] = 0;
    __syncthreads();
    XcdBarrier xbar = xcd_barrier_post((unsigned*)(c.ws + WS_BAR), bst);
    int nsync_ = 0;
#ifndef PHMASK
#define PHMASK 0xFFFFFFFFu
#endif
#define PH(n) if (PHMASK & (1 << (n)))
#ifdef DUP_SYNC
#define GSYNC() do { grid.sync(); grid.sync(); } while (0)
#else
#define GSYNC() do { if (nsync_++ == 0) grid.sync(); else xcd_barrier(xbar); } while (0)
#endif
    for (int L = 0; L < 2; ++L) {
        REFRESH(); PH(0) phase_weights(c, L);
        REFRESH(); PH(1) phase_rmsnorm<0>(c, L);
        GSYNC();
        REFRESH(); PH(2) run_gemm(c, c.XN, c.W + WO_IN, NPROJ, 1024, FStore{c.R1, NPROJ});
#ifdef DUP_GEMM
        REFRESH(); PH(2) run_gemm(c, c.XN, c.W + WO_IN, NPROJ, 1024, FStore{c.R1, NPROJ});
#endif
        GSYNC();
#ifdef DUP_MIX
        for (int rep_ = 0; rep_ < 2; ++rep_) {
#else
        {
#endif
        REFRESH(); phase_conv_state(c, L);
        REFRESH(); for (int it = c.bid * 8 + c.wave; it < 1024; it += c.G * 8) task_ml_gates(c, L, it);
        REFRESH(); PH(3) phase_gdn_prep(c, L);
#ifdef DUP_PREP
        REFRESH(); PH(3) phase_gdn_prep(c, L);
#endif
#ifdef DUP_S5
#endif
        GSYNC();
#ifdef DUP_P4
        for (int rep4_ = 0; rep4_ < 2; ++rep4_) {
#else
        {
#endif
        if (c.wave == 0) {
            for (int u = c.bid; u < 256; u += c.G) { REFRESH(); if (u < 128) { PH(5) task_gdn_seq(c, L, u);
#ifdef DUP_GSEQ
                REFRESH(); task_gdn_seq(c, L, u);
#endif
              } else { PH(6) task_ml_seq(c, L, u - 128, (float*)lds);
#ifdef DUP_MSEQ
                REFRESH(); task_ml_seq(c, L, u - 128, (float*)lds);
#endif
              } }
        } else if (c.wave <= 4) {
            int it_ = 0;
            for (int u = c.bid; u < 256; u += c.G, ++it_) { REFRESH(); PH(4) task_s5_quad(c, L, u, c.wave - 1, L * 16 + it_ + 1); }
        } else {
            const int wid = c.bid * 3 + (c.wave - 5), nw = c.G * 3;
            REFRESH(); PH(7) for (int u = wid; u < 2048; u += nw) task_gdn_sample(c, L, u);
            REFRESH(); PH(8) for (int u = wid; u < 1024; u += nw) task_ml_sample(c, L, u);
            REFRESH(); PH(9) for (int u = wid; u < 4096; u += nw) task_s5_sample(c, L, u);
        }
        GSYNC();
        }
        }
#ifdef SELFCHK
        if (L == SELFCHK_L) { REFRESH(); if (c.bid == 0) { float* dg = (float*)(c.ws + WS_GL) + 1024; chk_gdn(c, L, 1, 2, dg); chk_ml(c, L, 1, 2, dg); chk_s5(c, L, 1, 7, dg); chk_gemm(c, L, 0, dg + 6); if (L == 0) chk_sg(c, dg + 12); chk_sample(c, L, 5, 1, dg + 17); } grid.sync(); }
#endif
        REFRESH(); PH(10) phase_post(c, L);
        REFRESH(); PH(11) run_gemm(c, c.XN, c.W + WO_G, NGATE, 1024, FSig{c.R1, NPROJ});
#ifdef DUP_GEMM
        REFRESH(); PH(11) run_gemm(c, c.XN, c.W + WO_G, NGATE, 1024, FSig{c.R1, NPROJ});
#endif
        REFRESH(); PH(12) run_gemm(c, c.YS5, c.W + WO_GLU, 512, 512, FGlu{c.YS5, c.in[22] + (size_t)L * 512, c.Y3});
#ifdef DUP_GEMM
        REFRESH(); PH(12) run_gemm(c, c.YS5, c.W + WO_GLU, 512, 512, FGlu{c.YS5, c.in[22] + (size_t)L * 512, c.Y3});
#endif
        GSYNC();
#ifdef SELFCHK
        if (L == SELFCHK_L) { REFRESH(); if (c.bid == 0) { float* dg = (float*)(c.ws + WS_GL) + 1024; chk_gemm(c, L, 1, dg + 7); chk_gemm(c, L, 2, dg + 8); chk_post(c, L, dg + 13); } grid.sync(); }
#endif
        REFRESH(); PH(13) for (int br = 0; br < 3; ++br)
            run_gemm(c, c.Y3 + (size_t)br * MPAD * 512, c.W + WO_BR + (size_t)br * 1024 * 512, 1024, 512, FBranch{c.R1 + br * 1024, c.XN, br == 0 ? 1 : 0});
#ifdef DUP_GEMM
        REFRESH(); PH(13) for (int br = 0; br < 3; ++br)
            run_gemm(c, c.Y3 + (size_t)br * MPAD * 512, c.W + WO_BR + (size_t)br * 1024 * 512, 1024, 512, FBranch{c.R1 + br * 1024, c.XN, br == 0 ? 1 : 0});
#endif
        GSYNC();
#ifdef SELFCHK
        if (L == SELFCHK_L) { REFRESH(); if (c.bid == 0) { float* dg = (float*)(c.ws + WS_GL) + 1024; chk_gemm(c, L, 3, dg + 9); } grid.sync(); }
#endif
        REFRESH(); PH(14) run_gemm(c, c.XN, c.W + WO_OUT, 1024, 1024, FRes{c.out});
        GSYNC();
#ifdef SELFCHK
        if (L == 0 && SELFCHK_L == 0) { REFRESH(); if (c.bid == 0) { float* dg = (float*)(c.ws + WS_GL) + 1024; float sn[2] = {0.f, 0.f}; chk_res(c, L, 0, sn, dg + 14); } grid.sync(); }
#endif
        REFRESH(); PH(15) phase_rmsnorm<1>(c, L);
        REFRESH(); PH(18) phase_cvt_ple(c, L);
        GSYNC();
        REFRESH(); PH(16) run_gemm(c, c.XN, c.W + WO_UP, DFF, 1024, FRelu2{c.R1});
#ifdef DUP_GEMM
        REFRESH(); PH(16) run_gemm(c, c.XN, c.W + WO_UP, DFF, 1024, FRelu2{c.R1});
#endif
        GSYNC();
#ifdef SELFCHK
        if (L == SELFCHK_L) { REFRESH(); if (c.bid == 0) { float* dg = (float*)(c.ws + WS_GL) + 1024; chk_gemm(c, L, 4, dg + 10); } grid.sync(); }
#endif
#ifdef SELFCHK
        float snp[2] = {0.f, 0.f}; REFRESH(); if (L == SELFCHK_L && c.bid == 0) snap_x(c, snp);
#endif
        REFRESH(); PH(17) run_gemm(c, c.R1, c.W + WO_DN, 1024, 4096, FResB{c.out, c.XN});
        GSYNC();
#ifdef SELFCHK
        if (L == SELFCHK_L) { REFRESH(); if (c.bid == 0) { float* dg = (float*)(c.ws + WS_GL) + 1024; chk_res(c, L, 1, snp, dg + 15); } grid.sync(); }
#endif
#ifdef SELFCHK
        REFRESH(); if (L == SELFCHK_L && c.bid == 0) snap_x(c, snp);
#endif
        REFRESH(); PH(19) run_gemm(c, c.Y3, c.W + WO_PLE, 1024, 256, FStore{c.Y3 + (size_t)MPAD * 256, 1024});
#ifdef DUP_GEMM
        REFRESH(); PH(19) run_gemm(c, c.Y3, c.W + WO_PLE, 1024, 256, FStore{c.Y3 + (size_t)MPAD * 256, 1024});
#endif
        REFRESH(); PH(20) run_gemm(c, c.XN, c.W + WO_PG, 1024, 1024, FPle{c.Y3 + (size_t)MPAD * 256, c.out});
        GSYNC();
#ifdef SELFCHK
        if (L == SELFCHK_L) { REFRESH(); if (c.bid == 0) { float* dg = (float*)(c.ws + WS_GL) + 1024; chk_gemm(c, L, 5, dg + 11); chk_res(c, L, 2, snp, dg + 16); } grid.sync(); }
#endif
    }
    REFRESH(); phase_final_norm(c);
#ifdef SELFCHK
    grid.sync(); REFRESH();
    if (c.bid == 0 && c.tid == 0) { const float* dg = (const float*)(c.ws + WS_GL) + 1024; int kk = -1; float dv = 0.f;
        for (int i = 18; i >= 0; --i) if (dg[i] > SELFCHK_THR) { kk = i; dv = dg[i]; }
        if (kk >= 0) c.out[0] = __powf(10.f, (float)(2 * kk + 4)) * (1.f + fminf(dv, 8.f)); }
#endif
}

extern "C" void kernel_launch(void* const* d_in, const int* in_sizes, int n_in, void* d_out, int out_size, void* d_ws, size_t ws_size, hipStream_t stream) {
    static int grid = 0;
    if (grid == 0) {
        int dev = 0, cus = 0, per_cu = 0;
        if (hipGetDevice(&dev) != hipSuccess || hipDeviceGetAttribute(&cus, hipDeviceAttributeMultiprocessorCount, dev) != hipSuccess) { fprintf(stderr, "kernel_launch: device query failed\n"); grid = -1; return; }
        if (hipFuncSetAttribute((const void*)fwd_megakernel, hipFuncAttributeMaxDynamicSharedMemorySize, LDS_BYTES) != hipSuccess) { fprintf(stderr, "kernel_launch: hipFuncSetAttribute failed\n"); grid = -1; return; }
        if (hipOccupancyMaxActiveBlocksPerMultiprocessor(&per_cu, (const void*)fwd_megakernel, 512, LDS_BYTES) != hipSuccess || per_cu < 1) { fprintf(stderr, "kernel_launch: occupancy query says %d blocks per CU\n", per_cu); grid = -1; return; }
        grid = cus;
        if (grid > 256) grid = 256;
    }
    if (grid < 0) return;
    if (n_in != 40 || (size_t)out_size != O_TOTAL || ws_size < WS_END) { fprintf(stderr, "kernel_launch: unexpected sizes n_in %d out %d ws %zu (need %zu)\n", n_in, out_size, ws_size, (size_t)WS_END); return; }
    if (hipMemsetAsync((char*)d_ws + WS_BAR, 0, SZ_BAR, stream) != hipSuccess) { fprintf(stderr, "kernel_launch: memset failed\n"); return; }
    KP kp{};
    for (int i = 0; i < 40; ++i) kp.in[i] = (const float*)d_in[i];
    kp.out = (float*)d_out; kp.ws = (unsigned char*)d_ws;
    void* args[] = {&kp};
    hipError_t e = hipLaunchCooperativeKernel((const void*)fwd_megakernel, dim3(grid), dim3(512), args, LDS_BYTES, stream);
    if (e != hipSuccess) fprintf(stderr, "kernel_launch: cooperative launch failed: %s (grid %d)\n", hipGetErrorString(e), grid);
}
```
